# Optimizing an MI355X kernel written in HIP

```python
import math
import jax
import jax.numpy as jnp
from jax import lax
import numpy as np

D_MODEL = 1024
BATCH = 1
SEQ = 16384
DEPTH = 4

GRID_W = 64
CTX_LEN = 256
N_MIXERS = 4
N_LRU = (DEPTH + 3) // N_MIXERS
N_RWKV = (DEPTH + 2) // N_MIXERS
N_RET = (DEPTH + 1) // N_MIXERS
N_HGRN = DEPTH // N_MIXERS
DEEPNORM_ALPHA = (2.0 * DEPTH) ** 0.25
DEEPNORM_BETA = (8.0 * DEPTH) ** -0.25
LN_EPS = 1e-5

LRU_WIDTH = D_MODEL
LRU_BLOCKS = 16
LRU_BLOCK = LRU_WIDTH // LRU_BLOCKS
LRU_CONV = 4
LRU_C = 8.0

RWKV_HEAD = 64
RWKV_HEADS = D_MODEL // RWKV_HEAD
RWKV_W_LORA = 64
RWKV_A_LORA = 64
RWKV_G_LORA = 128
RWKV_DECAY_SCALE = math.exp(-0.5)
RWKV_GN_EPS = 64e-5

RET_HEADS = 4
RET_QK = D_MODEL // RET_HEADS
RET_V = 2 * RET_QK
RET_CHUNK = 128
ROPE_BASE = 10000.0

HGRN_HEADS = 8
HGRN_EXPAND = D_MODEL // HGRN_HEADS
HGRN_HEAD_V = D_MODEL // HGRN_HEADS
HGRN_CHUNK = 64

N_EXPERTS = 64
TOP_K = 8
N_GROUPS = 8
TOPK_GROUPS = 4
EXPERT_DIM = 256
SHARED_DIM = 256
ROUTED_SCALE = 2.5
MOE_BLOCK = 128

kernel_name = 'hybrid_lru_rwkv7_retnet_hgrn2_moe_trunk'


def _layer_norm(h, g, b):
    hf = h.astype(jnp.float32)
    mu = jnp.mean(hf, axis=-1, keepdims=True)
    var = jnp.mean(jnp.square(hf - mu), axis=-1, keepdims=True)
    return ((hf - mu) * lax.rsqrt(var + LN_EPS)).astype(h.dtype) * g + b


def _head_norm(o, eps):
    of = o.astype(jnp.float32)
    mu = jnp.mean(of, axis=-1, keepdims=True)
    var = jnp.mean(jnp.square(of - mu), axis=-1, keepdims=True)
    return ((of - mu) * lax.rsqrt(var + eps)).astype(o.dtype)


def _head_rms(o, eps):
    of = o.astype(jnp.float32)
    return (of * lax.rsqrt(jnp.mean(jnp.square(of), axis=-1, keepdims=True) + eps)).astype(o.dtype)


def _modulate(h, shift, scale):
    return h * (1.0 + scale) + shift


def _heads(z, n):
    return z.reshape(*z.shape[:-1], n, z.shape[-1] // n)


def _merge(z):
    return z.reshape(*z.shape[:-2], z.shape[-2] * z.shape[-1])


def _rev(z, d):
    return z[:, ::-1] if d == 1 else z


def _to_blocks(z, size):
    b, t, h, f = z.shape
    return z.reshape(b, t // size, size, h, f).transpose(1, 0, 3, 2, 4)


def _from_blocks(z):
    n, b, h, size, f = z.shape
    return z.transpose(1, 0, 3, 2, 4).reshape(b, n * size, h, f)


def _dwconv_centred(z, w, b):
    k = w.shape[0]
    y = lax.conv_general_dilated(z, w[:, None, :], window_strides=(1,), padding=[((k - 1) // 2, k // 2)], dimension_numbers=('NWC', 'WIO', 'NWC'), feature_group_count=z.shape[-1])
    return y + b


def _rope(z, cos, sin):
    half = z.shape[-1] // 2
    rot = jnp.concatenate([-z[..., half:], z[..., :half]], axis=-1)
    return z * cos[None, :, None, :] + rot * sin[None, :, None, :]


def _lru_gates(xc, gate_w, gate_b, lam):
    b, t, w = xc.shape
    xb = xc.reshape(b, t, LRU_BLOCKS, LRU_BLOCK)
    gates = jax.nn.sigmoid(jnp.einsum('btni,gnij->gbtnj', xb, gate_w).reshape(2, b, t, w) + gate_b[:, None, None, :])
    log_a = -LRU_C * gates[0] * jax.nn.softplus(-lam)
    return jnp.exp(log_a), jnp.sqrt(1.0 - jnp.exp(2.0 * log_a)) * (gates[1] * xc)


def _linear_scan(a, bx, h0, reverse):
    def combine(e1, e2):
        return e1[0] * e2[0], e2[0] * e1[1] + e2[1]
    a_cum, b_cum = lax.associative_scan(combine, (a, bx), reverse=reverse, axis=1)
    return a_cum * h0[:, None, :] + b_cum


def _lru_mixer(u_ctx, u_lat, w_in, conv_w, conv_b, gate_w, gate_b, lam, w_out):
    def branches(u):
        gelu_in, rnn_in = jnp.split(u @ w_in, 2, axis=-1)
        return jax.nn.gelu(gelu_in), _dwconv_centred(rnn_in, conv_w, conv_b)
    g_ctx, x_ctx = branches(u_ctx)
    g_lat, x_lat = branches(u_lat)
    h0 = jnp.zeros_like(x_ctx[:, 0])
    hs_ctx, hs_lat = [], []
    for d in range(2):
        a_c, b_c = _lru_gates(x_ctx, gate_w[d], gate_b[d], lam[d])
        a_l, b_l = _lru_gates(x_lat, gate_w[d], gate_b[d], lam[d])
        h_c = _linear_scan(a_c, b_c, h0, d == 1)
        h_end = h_c[:, 0] if d == 1 else h_c[:, -1]
        hs_ctx.append(h_c)
        hs_lat.append(_linear_scan(a_l, b_l, h_end, d == 1))
    return (g_ctx * (hs_ctx[0] + hs_ctx[1])) @ w_out, (g_lat * (hs_lat[0] + hs_lat[1])) @ w_out


def _bi_shift(u):
    half = u.shape[-1] // 2
    prev = jnp.pad(u[:, :-1, :half], ((0, 0), (1, 0), (0, 0)))
    nxt = jnp.pad(u[:, 1:, half:], ((0, 0), (0, 1), (0, 0)))
    return jnp.concatenate([prev, nxt], axis=-1)


def _rwkv_prep(u, mu, w_in, w0, w_l1, w_l2, a0, a_l1, a_l2, g_l1, g_l2, k_k, k_a):
    xm = u[None] + (_bi_shift(u) - u)[None] * mu[:, None, None, :]
    rkv = jnp.einsum('cbtd,cde->cbte', xm[:3], w_in)
    r, k, v = rkv[0], rkv[1], rkv[2]
    d_w = w0[:, None, None, :] + jnp.einsum('zbtl,zld->zbtd', jnp.tanh(jnp.einsum('btd,zdl->zbtl', xm[3], w_l1)), w_l2)
    w = jnp.exp(-RWKV_DECAY_SCALE * jax.nn.sigmoid(d_w))
    a = jax.nn.sigmoid(a0[:, None, None, :] + jnp.einsum('zbtl,zld->zbtd', jnp.einsum('btd,zdl->zbtl', xm[4], a_l1), a_l2))
    g = jax.nn.sigmoid(xm[5] @ g_l1) @ g_l2
    kk = _heads(k * k_k, RWKV_HEADS)
    kk = kk * lax.rsqrt(jnp.sum(jnp.square(kk), axis=-1, keepdims=True) + 1e-12)
    k_t = k[None] * (1.0 + (a - 1.0) * k_a)
    h = RWKV_HEADS
    return _heads(r, h), _heads(v, h), kk, g, _heads(w, h), _heads(k_t, h), _heads(a, h)


def _rwkv_scan(r, w, k, v, kk, a, s0, reverse):
    xs = tuple(jnp.moveaxis(z, 1, 0) for z in (r, w, k, v, kk, a))
    def step(s, inp):
        r_t, w_t, k_t, v_t, kk_t, a_t = inp
        sa = jnp.einsum('bhvk,bhk->bhv', s, kk_t)
        s = s * w_t[:, :, None, :] - sa[..., None] * (kk_t * a_t)[:, :, None, :] + v_t[..., None] * k_t[:, :, None, :]
        return s, jnp.einsum('bhvk,bhk->bhv', s, r_t)
    s_end, o = lax.scan(step, s0, xs, reverse=reverse)
    return jnp.moveaxis(o, 0, 1), s_end


def _rwkv_mixer(u_ctx, u_lat, mu, w_in, w0, w_l1, w_l2, a0, a_l1, a_l2, g_l1, g_l2, k_k, k_a, r_k, ln_g, ln_b, w_out):
    def prep(u):
        return _rwkv_prep(u, mu, w_in, w0, w_l1, w_l2, a0, a_l1, a_l2, g_l1, g_l2, k_k, k_a)
    p_ctx = prep(u_ctx)
    p_lat = prep(u_lat)
    s0 = jnp.zeros((u_ctx.shape[0], RWKV_HEADS, RWKV_HEAD, RWKV_HEAD), u_ctx.dtype)
    o_ctx, o_lat = [], []
    for d in range(2):
        r, v, kk, _, w, k_t, a = p_ctx
        oc, s_c = _rwkv_scan(r, w[d], k_t[d], v, kk, a[d], s0, d == 1)
        r, v, kk, _, w, k_t, a = p_lat
        ol, _ = _rwkv_scan(r, w[d], k_t[d], v, kk, a[d], s_c, d == 1)
        o_ctx.append(oc)
        o_lat.append(ol)
    def readout(p, o):
        r, v, _, g, _, k_t, _ = p
        bonus = jnp.sum(r[None] * k_t * r_k, axis=-1, keepdims=True).sum(axis=0) * v
        y = _merge(_head_norm(o, RWKV_GN_EPS)) * ln_g + ln_b + _merge(bonus)
        return (y * g) @ w_out
    return readout(p_ctx, o_ctx[0] + o_ctx[1]), readout(p_lat, o_lat[0] + o_lat[1])


def _retention_chunks(q, k, v, log_gamma, r0):
    c = RET_CHUNK
    qb, kb, vb = _to_blocks(q, c), _to_blocks(k, c), _to_blocks(v, c)
    pos = jnp.arange(c, dtype=jnp.float32)
    rel = pos[:, None] - pos[None, :]
    lg = log_gamma[:, None, None]
    inner = jnp.where(rel >= 0, jnp.exp(jnp.maximum(rel, 0.0) * lg), 0.0).astype(q.dtype)
    q_dec = jnp.exp((pos + 1.0) * log_gamma[:, None]).astype(q.dtype)[:, :, None]
    k_dec = jnp.exp((c - 1.0 - pos) * log_gamma[:, None]).astype(q.dtype)[:, :, None]
    blk_dec = jnp.exp(c * log_gamma).astype(q.dtype)[:, None, None]
    def step(r, inp):
        q_c, k_c, v_c = inp
        scores = jnp.einsum('bhid,bhjd->bhij', q_c, k_c) * inner
        o = jnp.einsum('bhij,bhjv->bhiv', scores, v_c) + jnp.einsum('bhid,bhdv->bhiv', q_c, r) * q_dec
        r = r * blk_dec + jnp.einsum('bhjd,bhjv->bhdv', k_c * k_dec, v_c)
        return r, o
    r_end, o = lax.scan(step, r0, (qb, kb, vb))
    return _from_blocks(o), r_end


def _retention_mixer(u_ctx, u_lat, rope_cos, rope_sin, w_in, decay_logit, gn_g, gn_b, w_out):
    def proj(u):
        q, k, v, g = jnp.split(u @ w_in, [D_MODEL, 2 * D_MODEL, 2 * D_MODEL + RET_HEADS * RET_V], axis=-1)
        return _heads(q, RET_HEADS), _heads(k, RET_HEADS) * (RET_QK ** -0.5), _heads(v, RET_HEADS), g
    q_c, k_c, v_c, g_c = proj(u_ctx)
    q_l, k_l, v_l, g_l = proj(u_lat)
    q_l = _rope(q_l, rope_cos, rope_sin)
    k_l = _rope(k_l, rope_cos, rope_sin)
    log_gamma = jax.nn.log_sigmoid(decay_logit.astype(jnp.float32))
    r0 = jnp.zeros((u_ctx.shape[0], RET_HEADS, RET_QK, RET_V), u_ctx.dtype)
    o_ctx, o_lat = [], []
    for d in range(2):
        oc, r_c = _retention_chunks(_rev(q_c, d), _rev(k_c, d), _rev(v_c, d), log_gamma[d], r0)
        ol, _ = _retention_chunks(_rev(q_l, d), _rev(k_l, d), _rev(v_l, d), log_gamma[d], r_c)
        o_ctx.append(_rev(oc, d))
        o_lat.append(_rev(ol, d))
    def readout(o, g):
        y = _merge(_head_norm(o, LN_EPS)) * gn_g + gn_b
        return (jax.nn.silu(g) * y) @ w_out
    return readout(o_ctx[0] + o_ctx[1], g_c), readout(o_lat[0] + o_lat[1], g_l)


def _gla_chunks(q, k, v, log_f, s0):
    c = HGRN_CHUNK
    qb, kb, vb = _to_blocks(q, c), _to_blocks(k, c), _to_blocks(v, c)
    cum = jnp.cumsum(_to_blocks(log_f, c), axis=3)
    causal = jnp.tril(jnp.ones((c, c), dtype=bool))[:, :, None]
    def step(s, inp):
        q_c, k_c, v_c, b_c = inp
        diff = b_c[:, :, :, None, :] - b_c[:, :, None, :, :]
        decay = jnp.exp(jnp.where(causal, diff, -jnp.inf))
        scores = jnp.einsum('bhtk,bhsk,bhtsk->bhts', q_c, k_c, decay)
        o = jnp.einsum('bhts,bhsv->bhtv', scores, v_c) + jnp.einsum('bhtk,bhkv->bhtv', q_c * jnp.exp(b_c), s)
        b_last = b_c[:, :, -1:, :]
        s = s * jnp.exp(b_last[:, :, 0, :])[..., None] + jnp.einsum('bhsk,bhsv->bhkv', k_c * jnp.exp(b_last - b_c), v_c)
        return s, o
    s_end, o = lax.scan(step, s0, (qb, kb, vb, cum))
    return _from_blocks(o), s_end


def _hgrn_mixer(u_ctx, u_lat, lb, w_in, b_f, norm_g, w_out):
    def proj(u):
        q, f_fwd, f_bwd, i_in, g = jnp.split(u @ w_in, 5, axis=-1)
        f = lb + (1.0 - lb) * jax.nn.sigmoid(jnp.stack([f_fwd, f_bwd]) + b_f[:, None, None, :])
        return _heads(jax.nn.silu(q), HGRN_HEADS), _heads(i_in, HGRN_HEADS), _heads(f, HGRN_HEADS), g
    q_c, v_c, f_c, g_c = proj(u_ctx)
    q_l, v_l, f_l, g_l = proj(u_lat)
    s0 = jnp.zeros((u_ctx.shape[0], HGRN_HEADS, HGRN_EXPAND, HGRN_HEAD_V), u_ctx.dtype)
    o_ctx, o_lat = [], []
    for d in range(2):
        oc, s_c = _gla_chunks(_rev(q_c, d), _rev(1.0 - f_c[d], d), _rev(v_c, d), _rev(jnp.log(f_c[d]), d), s0)
        ol, _ = _gla_chunks(_rev(q_l, d), _rev(1.0 - f_l[d], d), _rev(v_l, d), _rev(jnp.log(f_l[d]), d), s_c)
        o_ctx.append(_rev(oc, d))
        o_lat.append(_rev(ol, d))
    def readout(o, g):
        return (_merge(_head_rms(o, LN_EPS) * norm_g) * jax.nn.silu(g)) @ w_out
    return readout(o_ctx[0] + o_ctx[1], g_c), readout(o_lat[0] + o_lat[1], g_l)


def _swiglu(z, w_gu, w_down):
    gate, up = jnp.split(z @ w_gu, 2, axis=-1)
    return (jax.nn.silu(gate) * up) @ w_down


def _routed_experts(u, top_idx, top_w, w_gu, w_down):
    n = u.shape[0]
    n_pairs = n * TOP_K
    n_blocks = -(-(n_pairs + N_EXPERTS * (MOE_BLOCK - 1)) // MOE_BLOCK)
    flat_e = top_idx.reshape(-1)
    flat_tok = jnp.arange(n_pairs, dtype=jnp.int32) // TOP_K
    order = jnp.argsort(flat_e)
    e_sorted = flat_e[order]
    counts = jnp.bincount(flat_e, length=N_EXPERTS)
    padded = (counts + MOE_BLOCK - 1) // MOE_BLOCK * MOE_BLOCK
    start = jnp.cumsum(counts) - counts
    padded_end = jnp.cumsum(padded)
    dest = (padded_end - padded)[e_sorted] + jnp.arange(n_pairs, dtype=jnp.int32) - start[e_sorted]
    row_tok = jnp.zeros((n_blocks * MOE_BLOCK,), jnp.int32).at[dest].set(flat_tok[order])
    row_w = jnp.zeros((n_blocks * MOE_BLOCK,), u.dtype).at[dest].set(top_w.reshape(-1)[order])
    block_e = jnp.minimum(jnp.searchsorted(padded_end, jnp.arange(n_blocks, dtype=jnp.int32) * MOE_BLOCK, side='right'), N_EXPERTS - 1)
    def body(acc, inp):
        e, toks, wts = inp
        y = _swiglu(u[toks], w_gu[e], w_down[e])
        return acc.at[toks].add(y * wts[:, None]), None
    acc, _ = lax.scan(body, jnp.zeros_like(u), (block_e, row_tok.reshape(n_blocks, MOE_BLOCK), row_w.reshape(n_blocks, MOE_BLOCK)))
    return acc


def _moe_ffn(u, router_w, router_bias, w_gu, w_down, sh_gu, sh_down):
    n = u.shape[0]
    scores = jax.nn.sigmoid((u @ router_w).astype(jnp.float32))
    choice = scores + router_bias.astype(jnp.float32)
    group_score = lax.top_k(choice.reshape(n, N_GROUPS, N_EXPERTS // N_GROUPS), 2)[0].sum(axis=-1)
    _, top_groups = lax.top_k(group_score, TOPK_GROUPS)
    group_mask = jnp.any(top_groups[:, :, None] == jnp.arange(N_GROUPS)[None, None, :], axis=1)
    expert_mask = jnp.repeat(group_mask, N_EXPERTS // N_GROUPS, axis=1)
    _, top_idx = lax.top_k(jnp.where(expert_mask, choice, -jnp.inf), TOP_K)
    top_w = jnp.take_along_axis(scores, top_idx, axis=1)
    top_w = ROUTED_SCALE * top_w / jnp.sum(top_w, axis=-1, keepdims=True)
    return _routed_experts(u, top_idx, top_w.astype(u.dtype), w_gu, w_down) + _swiglu(u, sh_gu, sh_down)


def setup_inputs(seed: int = 0) -> dict:
    key = jax.random.key(seed)
    ks = iter(jax.random.split(key, 64))
    f32 = jnp.float32
    d = D_MODEL

    def nrm(shape, scale=1.0):
        return jax.random.normal(next(ks), shape, f32) * scale

    def gain(shape):
        return 1.0 + nrm(shape, 0.01)

    lam_u = jax.random.uniform(next(ks), (N_LRU, 2, LRU_WIDTH), f32, 0.9, 0.999)
    p = 5.0 + jnp.arange(RET_HEADS, dtype=f32)
    gam = 1.0 - 2.0 ** (-p)
    ret_logit = jnp.log(gam) - jnp.log1p(-gam)
    hv = RET_HEADS * RET_V
    return {
        'x': nrm((BATCH, SEQ, d)),
        'c': nrm((BATCH, d)),
        'ctx': nrm((BATCH, CTX_LEN, d)),
        'c_ctx': nrm((d,)),
        'ada_w': nrm((DEPTH, d, 6 * d), 0.5 * d ** -0.5),
        'ada_b': nrm((DEPTH, 6 * d), 0.01),
        'post_ln_g': gain((DEPTH, 2, d)),
        'post_ln_b': nrm((DEPTH, 2, d), 0.01),
        'lru_w_in': nrm((N_LRU, d, 2 * LRU_WIDTH), d ** -0.5),
        'lru_conv_w': nrm((N_LRU, LRU_CONV, LRU_WIDTH), LRU_CONV ** -0.5),
        'lru_conv_b': nrm((N_LRU, LRU_WIDTH), 0.01),
        'lru_gate_w': nrm((N_LRU, 2, 2, LRU_BLOCKS, LRU_BLOCK, LRU_BLOCK), LRU_BLOCK ** -0.5),
        'lru_gate_b': nrm((N_LRU, 2, 2, LRU_WIDTH), 0.01),
        'lru_lambda': jnp.log(lam_u) - jnp.log1p(-lam_u),
        'lru_w_out': nrm((N_LRU, LRU_WIDTH, d), DEEPNORM_BETA * LRU_WIDTH ** -0.5),
        'rwkv_mu': jax.random.uniform(next(ks), (N_RWKV, 6, d), f32, 0.0, 1.0),
        'rwkv_w_in': nrm((N_RWKV, 3, d, d), d ** -0.5),
        'rwkv_w0': jax.random.uniform(next(ks), (N_RWKV, 2, d), f32, -4.0, 1.0),
        'rwkv_w_l1': nrm((N_RWKV, 2, d, RWKV_W_LORA), d ** -0.5),
        'rwkv_w_l2': nrm((N_RWKV, 2, RWKV_W_LORA, d), 0.1 * RWKV_W_LORA ** -0.5),
        'rwkv_a0': nrm((N_RWKV, 2, d), 0.1),
        'rwkv_a_l1': nrm((N_RWKV, 2, d, RWKV_A_LORA), d ** -0.5),
        'rwkv_a_l2': nrm((N_RWKV, 2, RWKV_A_LORA, d), 0.1 * RWKV_A_LORA ** -0.5),
        'rwkv_g_l1': nrm((N_RWKV, d, RWKV_G_LORA), d ** -0.5),
        'rwkv_g_l2': nrm((N_RWKV, RWKV_G_LORA, d), RWKV_G_LORA ** -0.5),
        'rwkv_k_k': 1.0 + nrm((N_RWKV, d), 0.1),
        'rwkv_k_a': 1.0 + nrm((N_RWKV, d), 0.1),
        'rwkv_r_k': nrm((N_RWKV, RWKV_HEADS, RWKV_HEAD), 0.1),
        'rwkv_ln_g': gain((N_RWKV, d)),
        'rwkv_ln_b': nrm((N_RWKV, d), 0.01),
        'rwkv_w_out': nrm((N_RWKV, d, d), DEEPNORM_BETA * d ** -0.5),
        'ret_w_in': nrm((N_RET, d, 2 * d + 2 * hv), d ** -0.5),
        'ret_decay': ret_logit[None, None, :] + nrm((N_RET, 2, RET_HEADS), 0.1),
        'ret_gn_g': gain((N_RET, hv)),
        'ret_gn_b': nrm((N_RET, hv), 0.01),
        'ret_w_out': nrm((N_RET, hv, d), DEEPNORM_BETA * hv ** -0.5),
        'hgrn_w_in': nrm((N_HGRN, d, 5 * d), d ** -0.5),
        'hgrn_b_f': nrm((N_HGRN, 2, d), 0.5),
        'hgrn_lb': nrm((DEPTH, d), 0.5),
        'hgrn_norm_g': gain((N_HGRN, HGRN_HEAD_V)),
        'hgrn_w_out': nrm((N_HGRN, d, d), DEEPNORM_BETA * d ** -0.5),
        'moe_router': nrm((DEPTH, d, N_EXPERTS), d ** -0.5),
        'moe_bias': nrm((DEPTH, N_EXPERTS), 0.01),
        'moe_w_gu': nrm((DEPTH, N_EXPERTS, d, 2 * EXPERT_DIM), d ** -0.5),
        'moe_w_down': nrm((DEPTH, N_EXPERTS, EXPERT_DIM, d), DEEPNORM_BETA * EXPERT_DIM ** -0.5),
        'moe_sh_gu': nrm((DEPTH, d, 2 * SHARED_DIM), d ** -0.5),
        'moe_sh_down': nrm((DEPTH, SHARED_DIM, d), DEEPNORM_BETA * SHARED_DIM ** -0.5),
    }


def reference(x, c, ctx, c_ctx, ada_w, ada_b, post_ln_g, post_ln_b,
              lru_w_in, lru_conv_w, lru_conv_b, lru_gate_w, lru_gate_b, lru_lambda, lru_w_out,
              rwkv_mu, rwkv_w_in, rwkv_w0, rwkv_w_l1, rwkv_w_l2, rwkv_a0, rwkv_a_l1, rwkv_a_l2,
              rwkv_g_l1, rwkv_g_l2, rwkv_k_k, rwkv_k_a, rwkv_r_k, rwkv_ln_g, rwkv_ln_b, rwkv_w_out,
              ret_w_in, ret_decay, ret_gn_g, ret_gn_b, ret_w_out,
              hgrn_w_in, hgrn_b_f, hgrn_lb, hgrn_norm_g, hgrn_w_out,
              moe_router, moe_bias, moe_w_gu, moe_w_down, moe_sh_gu, moe_sh_down):
    n_ctx = ctx.shape[1]
    n_lat = x.shape[1]
    rows = n_lat // GRID_W
    pos_row = jnp.repeat(jnp.arange(rows, dtype=jnp.float32), GRID_W)
    pos_col = jnp.tile(jnp.arange(GRID_W, dtype=jnp.float32), rows)
    n_freq = RET_QK // 4
    freqs = ROPE_BASE ** (-jnp.arange(n_freq, dtype=jnp.float32) / n_freq)
    ang = jnp.concatenate([pos_row[:, None] * freqs, pos_col[:, None] * freqs], axis=-1)
    ang = jnp.concatenate([ang, ang], axis=-1)
    rope_cos = jnp.cos(ang).astype(x.dtype)
    rope_sin = jnp.sin(ang).astype(x.dtype)
    lb_cum = jnp.cumsum(jax.nn.softmax(hgrn_lb.astype(jnp.float32), axis=0), axis=0).astype(x.dtype)

    s_lat = jax.nn.silu(c)[:, None, :]
    s_ctx = jax.nn.silu(c_ctx)[None, None, :]
    h_ctx, h_lat = ctx, x
    for i in range(DEPTH):
        kind, j = i % N_MIXERS, i // N_MIXERS
        m_lat = jnp.split(s_lat @ ada_w[i] + ada_b[i], 6, axis=-1)
        m_ctx = jnp.split(s_ctx @ ada_w[i] + ada_b[i], 6, axis=-1)
        u_ctx = _modulate(h_ctx, m_ctx[0], m_ctx[1])
        u_lat = _modulate(h_lat, m_lat[0], m_lat[1])
        if kind == 0:
            y_ctx, y_lat = _lru_mixer(u_ctx, u_lat, lru_w_in[j], lru_conv_w[j], lru_conv_b[j], lru_gate_w[j], lru_gate_b[j], lru_lambda[j], lru_w_out[j])
        elif kind == 1:
            y_ctx, y_lat = _rwkv_mixer(u_ctx, u_lat, rwkv_mu[j], rwkv_w_in[j], rwkv_w0[j], rwkv_w_l1[j], rwkv_w_l2[j], rwkv_a0[j], rwkv_a_l1[j], rwkv_a_l2[j], rwkv_g_l1[j], rwkv_g_l2[j], rwkv_k_k[j], rwkv_k_a[j], rwkv_r_k[j], rwkv_ln_g[j], rwkv_ln_b[j], rwkv_w_out[j])
        elif kind == 2:
            y_ctx, y_lat = _retention_mixer(u_ctx, u_lat, rope_cos, rope_sin, ret_w_in[j], ret_decay[j], ret_gn_g[j], ret_gn_b[j], ret_w_out[j])
        else:
            y_ctx, y_lat = _hgrn_mixer(u_ctx, u_lat, lb_cum[i] - lb_cum[0], hgrn_w_in[j], hgrn_b_f[j], hgrn_norm_g[j], hgrn_w_out[j])
        h_lat = _layer_norm(DEEPNORM_ALPHA * h_lat + m_lat[2] * y_lat, post_ln_g[i, 0], post_ln_b[i, 0])
        moe_args = (moe_router[i], moe_bias[i], moe_w_gu[i], moe_w_down[i], moe_sh_gu[i], moe_sh_down[i])
        if i < DEPTH - 1:
            h_ctx = _layer_norm(DEEPNORM_ALPHA * h_ctx + m_ctx[2] * y_ctx, post_ln_g[i, 0], post_ln_b[i, 0])
            u = jnp.concatenate([_modulate(h_ctx, m_ctx[3], m_ctx[4]), _modulate(h_lat, m_lat[3], m_lat[4])], axis=1)
            y = _moe_ffn(u.reshape(-1, D_MODEL), *moe_args).reshape(u.shape)
            h_ctx = _layer_norm(DEEPNORM_ALPHA * h_ctx + m_ctx[5] * y[:, :n_ctx], post_ln_g[i, 1], post_ln_b[i, 1])
            h_lat = _layer_norm(DEEPNORM_ALPHA * h_lat + m_lat[5] * y[:, n_ctx:], post_ln_g[i, 1], post_ln_b[i, 1])
        else:
            u = _modulate(h_lat, m_lat[3], m_lat[4])
            y = _moe_ffn(u.reshape(-1, D_MODEL), *moe_args).reshape(u.shape)
            h_lat = _layer_norm(DEEPNORM_ALPHA * h_lat + m_lat[5] * y, post_ln_g[i, 1], post_ln_b[i, 1])
    return h_lat
```

```cpp
#include <hip/hip_runtime.h>
#include <stdint.h>
#include <stdio.h>
#include <string.h>

#define LAS __attribute__((address_space(3)))
#define GAS __attribute__((address_space(1)))
typedef unsigned short bf16_t;
typedef short bf16x8 __attribute__((ext_vector_type(8)));
typedef short bf16x4 __attribute__((ext_vector_type(4)));
typedef float f32x4 __attribute__((ext_vector_type(4)));
typedef float f32x2 __attribute__((ext_vector_type(2)));
typedef unsigned u32x4 __attribute__((ext_vector_type(4)));
typedef unsigned u32x2 __attribute__((ext_vector_type(2)));

constexpr int D = 1024, SEQ = 16384, NCTX = 256, NTOK = SEQ + NCTX;
constexpr int NE = 64, TOPK = 8, EDIM = 256;
constexpr float ALPHA = 1.681792830507429f;
constexpr float LN_EPS = 1e-5f;
constexpr int NTHREADS = 512, NWAVES = 8;

#ifndef DUP
#define DUP 0
#endif
#ifndef RWKV_CHUNKED
#define RWKV_CHUNKED 1
#endif
#ifndef EN_LRU
#define EN_LRU 1
#endif
#ifndef EN_RWKV
#define EN_RWKV 1
#endif
#ifndef EN_RET
#define EN_RET 1
#endif
#ifndef EN_HGRN
#define EN_HGRN 1
#endif
#ifndef EN_MOE
#define EN_MOE 1
#endif

__device__ __forceinline__ unsigned f2bf(float f) { unsigned u = __builtin_bit_cast(unsigned, f); return (u + 0x7fffu + ((u >> 16) & 1u)) >> 16; }
__device__ __forceinline__ float bf2f(unsigned b) { return __builtin_bit_cast(float, b << 16); }
__device__ __forceinline__ unsigned pk2(float lo, float hi) { unsigned r; asm volatile("v_cvt_pk_bf16_f32 %0, %1, %2" : "=v"(r) : "v"(lo), "v"(hi)); return r; }
__device__ __forceinline__ float bflo(unsigned w) { return __builtin_bit_cast(float, w << 16); }
__device__ __forceinline__ float bfhi(unsigned w) { return __builtin_bit_cast(float, w & 0xffff0000u); }
__device__ __forceinline__ float sigmoidf_(float x) { return __builtin_amdgcn_rcpf(1.0f + __expf(-x)); }
__device__ __forceinline__ float siluf_(float x) { return x * __builtin_amdgcn_rcpf(1.0f + __expf(-x)); }
__device__ __forceinline__ float wave_sum(float v) {
#pragma unroll
    for (int o = 1; o < 64; o <<= 1) v += __shfl_xor(v, o);
    return v;
}

#define XB_TMO      128
#define XB_XCNT(j)  (256  + 64 * (j))
#define XB_XSUB(j)  (1280 + 64 * (j))
#define XB_XGEN(j)  (2304 + 64 * (j))
#define XB_TOP      3328
#define XB_TOPGEN   3392
#define XCD_BAR_WORDS 3456
#define XB_SPIN_CAP (1u << 22)
__device__ __forceinline__ unsigned xb_ld(unsigned* p)              { return __hip_atomic_load(p, __ATOMIC_RELAXED, __HIP_MEMORY_SCOPE_AGENT); }
__device__ __forceinline__ unsigned xb_add(unsigned* p, unsigned v) { return __hip_atomic_fetch_add(p, v, __ATOMIC_RELAXED, __HIP_MEMORY_SCOPE_AGENT); }
__device__ __forceinline__ unsigned xb_xcc_id() { return (unsigned)__builtin_amdgcn_s_getreg((3 << 11) | 20) & 0xFu; }
#define XB_SPIN(cond, bar) do { unsigned _sp = 0; while (cond) { __builtin_amdgcn_s_sleep(1); \
    if ((++_sp & 255u) == 0u) { if (xb_ld(&(bar)[XB_TMO])) break; if (_sp > XB_SPIN_CAP) { atomicAdd(&(bar)[XB_TMO], 1u); break; } } } } while (0)
struct XcdBarrier { unsigned* bar; unsigned x; volatile LAS unsigned* st; };
__device__ __forceinline__ XcdBarrier xcd_barrier_post(unsigned* bar, volatile LAS unsigned* st) {
    XcdBarrier b; b.bar = bar; b.x = xb_xcc_id(); b.st = st;
    if (threadIdx.x == 0) (void)xb_add(&bar[XB_XCNT(b.x)], 1u);
    return b;
}
__device__ __forceinline__ void xcd_barrier_complete(unsigned* bar, unsigned x, unsigned& nloc, unsigned& nx) {
    const unsigned G = gridDim.x * gridDim.y * gridDim.z;
    unsigned sum, cnt, mine, sp = 0u;
    for (;;) {
        sum = 0u; cnt = 0u; mine = 0u;
#pragma unroll
        for (unsigned j = 0; j < 16; ++j) { const unsigned c = xb_ld(&bar[XB_XCNT(j)]); sum += c; cnt += (c > 0u) ? 1u : 0u; mine = (j == x) ? c : mine; }
        if (sum == G) break;
        __builtin_amdgcn_s_sleep(1);
        if ((++sp & 255u) == 0u) { if (xb_ld(&bar[XB_TMO])) break; if (sp > XB_SPIN_CAP) { atomicAdd(&bar[XB_TMO], 1u); break; } }
    }
    nloc = mine > 0u ? mine : 1u; nx = cnt > 0u ? cnt : 1u;
}
__device__ __forceinline__ void xcd_barrier(const XcdBarrier& b) {
    asm volatile("s_waitcnt vmcnt(0)" ::: "memory");
    __syncthreads();
    if (threadIdx.x == 0) {
        unsigned* bar = b.bar;
        __builtin_amdgcn_s_waitcnt(0);
        unsigned nloc = b.st[0], nx = b.st[1];
        if (nloc == 0u) { xcd_barrier_complete(bar, b.x, nloc, nx); b.st[0] = nloc; b.st[1] = nx; }
        const unsigned old = xb_add(&bar[XB_XSUB(b.x)], 1u);
        const unsigned gen = old / nloc;
        if (old + 1u == (gen + 1u) * nloc) {
            __builtin_amdgcn_fence(__ATOMIC_RELEASE, "agent");
            asm volatile("s_waitcnt vmcnt(0)" ::: "memory");
            const unsigned og = xb_add(&bar[XB_TOP], 1u);
            const unsigned tg = og / nx;
            if (og + 1u == (tg + 1u) * nx) xb_add(&bar[XB_TOPGEN], 1u);
            else XB_SPIN(xb_ld(&bar[XB_TOPGEN]) == tg, bar);
            __builtin_amdgcn_fence(__ATOMIC_ACQUIRE, "agent");
            xb_add(&bar[XB_XGEN(b.x)], 1u);
            asm volatile("s_waitcnt vmcnt(0)" ::: "memory");
        } else {
            XB_SPIN(xb_ld(&bar[XB_XGEN(b.x)]) == gen, bar);
            __builtin_amdgcn_fence(__ATOMIC_ACQUIRE, "agent");
            asm volatile("s_waitcnt vmcnt(0)" ::: "memory");
        }
    }
    __syncthreads();
}

namespace gg {
constexpr int BM = 256, BK = 64, HALF = 128, HTB = HALF * BK * 2, STAGE_BYTES = 8 * HTB;
__device__ __forceinline__ int lds_byte(int r, int c) { const int st = (r >> 4) * 2 + (c >> 5), rr = r & 15, cc = c & 31, ob = rr * 64 + cc * 2; return st * 1024 + (ob ^ (((ob >> 9) & 1) << 5)); }
__device__ __forceinline__ void stage_rc(int b, int& R, int& C) { const int st = b / 1024, sb = b % 1024, swz = sb ^ (((sb >> 9) & 1) << 5); R = (st >> 1) * 16 + swz / 64; C = (st & 1) * 32 + (swz % 64) / 2; }
__device__ __forceinline__ int perm32(int rho) { const int n = rho >> 4, i = rho & 15; return 8 * (i >> 2) + 4 * n + (i & 3); }

struct Unit { const char* a; const char* b; const char* b2; int pm, pn, gofs, x; };
struct Dims { int K, lda, ldb, kseg, ldb2; };

typedef f32x4 Acc[2][2][4][2];

template <class Epi, class Sched, bool GATHER, bool SEGB>
__device__ __forceinline__ void gemm_phase(LAS unsigned char* lds, const Dims dm, const Sched& S, const Epi& E) {
    const int tid = threadIdx.x, wid = __builtin_amdgcn_readfirstlane(tid >> 6), lane = tid & 63, wr = wid >> 2, wc = wid & 3, fr = lane & 15, fq = lane >> 4;
    const int K = dm.K, nt = K / BK;
    unsigned voffB[2], voffB2[2], cAo[2][2], nAo[2][2]; int gR[2], gC[2];
    const unsigned hstepA = (unsigned)HALF * dm.lda * 2u, hstepB = (unsigned)HALF * dm.ldb * 2u, hstepB2 = (unsigned)HALF * dm.ldb2 * 2u;
#pragma unroll
    for (int i = 0; i < 2; ++i) { int R, C; stage_rc(tid * 16 + i * 8192, R, C); const int Rb = Epi::PERM ? ((R & ~31) + perm32(R & 31)) : R;
        gR[i] = R; gC[i] = C * 2; voffB[i] = (unsigned)(Rb * dm.ldb + C) * 2u; voffB2[i] = SEGB ? (unsigned)(Rb * dm.ldb2 + C) * 2u : 0u;
        cAo[0][i] = (unsigned)(R * dm.lda + C) * 2u; cAo[1][i] = cAo[0][i] + hstepA; }
    const unsigned ldsw = (unsigned)wid * 1024u;
    const int aoff = lds_byte(wr * 64 + fr, fq * 8), boff = lds_byte(wc * 32 + fr, fq * 8);
#define GG_SA(b, h) (((b) * 2 + (h)) * HTB)
#define GG_SB(b, h) ((4 + (b) * 2 + (h)) * HTB)
#define GG_STAGE(bufoff, gbase, voff) do { _Pragma("unroll") for (int _i = 0; _i < 2; ++_i) \
        __builtin_amdgcn_global_load_lds((const unsigned*)((const char*)(gbase) + (voff)[_i]), (LAS unsigned*)(lds + (bufoff) + ldsw + _i * 8192), 16, 0, 0); } while (0)
#define GG_LDA(dst, b, h) do { _Pragma("unroll") for (int m = 0; m < 4; ++m) _Pragma("unroll") for (int k = 0; k < 2; ++k) dst[m][k] = *(const LAS bf16x8*)(lds + GG_SA(b, h) + aoff + m * 2048 + k * 1024); } while (0)
#define GG_LDB(dst, b, h) do { _Pragma("unroll") for (int n = 0; n < 2; ++n) _Pragma("unroll") for (int k = 0; k < 2; ++k) dst[n][k] = *(const LAS bf16x8*)(lds + GG_SB(b, h) + boff + n * 2048 + k * 1024); } while (0)
#define GG_MMA(ai, bj, At, Bt) do { __builtin_amdgcn_s_setprio(1); _Pragma("unroll") for (int m = 0; m < 4; ++m) _Pragma("unroll") for (int n = 0; n < 2; ++n) _Pragma("unroll") for (int k = 0; k < 2; ++k) \
        acc[ai][bj][m][n] = __builtin_amdgcn_mfma_f32_16x16x32_bf16(Bt[n][k], At[m][k], acc[ai][bj][m][n], 0, 0, 0); __builtin_amdgcn_s_setprio(0); } while (0)
#define GG_WAIT_V(n) asm volatile("s_waitcnt vmcnt(" #n ")" ::: "memory")
#define GG_WAIT_L(n) asm volatile("s_waitcnt lgkmcnt(" #n ")" ::: "memory")
#define GG_BAR __builtin_amdgcn_s_barrier()
#define GG_SCHED __builtin_amdgcn_sched_barrier(0)
#define GG_BSRC(u, kt) ((SEGB && (kt) >= dm.kseg) ? (u).b2 + (size_t)((kt) - dm.kseg) * 128 : (u).b + (size_t)(kt) * 128)
#define GG_STAGE_B(bufoff, u, kt, h) do { const bool _s2 = SEGB && (kt) >= dm.kseg; \
        const char* _bp = _s2 ? (u).b2 + (size_t)((kt) - dm.kseg) * 128 + (h) * hstepB2 : (u).b + (size_t)(kt) * 128 + (h) * hstepB; \
        unsigned _vo[2]; _vo[0] = _s2 ? voffB2[0] : voffB[0]; _vo[1] = _s2 ? voffB2[1] : voffB[1]; GG_STAGE(bufoff, _bp, _vo); } while (0)
#define GG_GOFF(u, dst) do { if (GATHER) { const LAS int* _ix = (const LAS int*)(lds + (u).gofs); _Pragma("unroll") for (int _h = 0; _h < 2; ++_h) _Pragma("unroll") for (int _i = 0; _i < 2; ++_i) \
        dst[_h][_i] = (unsigned)_ix[_h * 128 + gR[_i]] * (unsigned)(dm.lda * 2) + (unsigned)gC[_i]; } } while (0)
    Unit cur, nxt; int ui = 0;
    if (!S.next(0, cur)) return;
    Acc acc;
#pragma unroll
    for (int a = 0; a < 2; ++a)
#pragma unroll
        for (int b = 0; b < 2; ++b)
#pragma unroll
            for (int m = 0; m < 4; ++m)
#pragma unroll
                for (int n = 0; n < 2; ++n) acc[a][b][m][n] = (f32x4){0.f, 0.f, 0.f, 0.f};
    bf16x8 At[4][2], B0[2][2], B1[2][2];
    GG_GOFF(cur, cAo);
    GG_STAGE_B(GG_SB(0, 0), cur, 0, 0); GG_STAGE(GG_SA(0, 0), cur.a, cAo[0]); GG_STAGE_B(GG_SB(0, 1), cur, 0, 1); GG_STAGE(GG_SA(0, 1), cur.a, cAo[1]);
    if (wr == 1) GG_BAR;
    GG_WAIT_V(4); GG_BAR;
    GG_STAGE_B(GG_SB(1, 0), cur, 1, 0); GG_STAGE(GG_SA(1, 0), cur.a + 128, cAo[0]); GG_STAGE_B(GG_SB(1, 1), cur, 1, 1);
    GG_WAIT_V(6); GG_BAR;
    for (;;) {
        const bool has_next = S.next(ui + 1, nxt);
        if (!has_next) nxt = cur;
        if (GATHER) { if (has_next) { GG_GOFF(nxt, nAo); } else {
#pragma unroll
            for (int h = 0; h < 2; ++h)
#pragma unroll
                for (int i = 0; i < 2; ++i) nAo[h][i] = cAo[h][i]; } }
        for (int t = 0; t < nt; t += 2) {
            const bool last = (t == nt - 2);
            const char* a1 = cur.a + (size_t)(t + 1) * 128;
            const char* a2 = last ? nxt.a : cur.a + (size_t)(t + 2) * 128;
            const char* a3 = a2 + 128;
            unsigned o2[2][2];
#pragma unroll
            for (int h = 0; h < 2; ++h)
#pragma unroll
                for (int i = 0; i < 2; ++i) o2[h][i] = (GATHER && last) ? nAo[h][i] : cAo[h][i];
            const int k2 = last ? 0 : t + 2, k3 = k2 + 1;
            struct { const char* b; const char* b2; } bu; bu.b = last ? nxt.b : cur.b; bu.b2 = last ? nxt.b2 : cur.b2;
            GG_LDB(B0, 0, 0); GG_SCHED; GG_LDA(At, 0, 0); GG_STAGE(GG_SA(1, 1), a1, cAo[1]);
            GG_WAIT_L(8); GG_BAR; GG_WAIT_L(0); GG_MMA(0, 0, At, B0); GG_BAR; GG_SCHED;
            GG_LDB(B1, 0, 1); GG_STAGE_B(GG_SB(0, 0), bu, k2, 0);
            GG_BAR; GG_WAIT_L(0); GG_MMA(0, 1, At, B1); GG_BAR;
            GG_LDA(At, 0, 1); GG_STAGE(GG_SA(0, 0), a2, o2[0]);
            GG_BAR; GG_WAIT_L(0); GG_MMA(1, 0, At, B0); GG_BAR; GG_SCHED;
            GG_STAGE_B(GG_SB(0, 1), bu, k2, 1);
            GG_WAIT_V(6); GG_BAR; GG_MMA(1, 1, At, B1); GG_BAR;
            GG_LDB(B0, 1, 0); GG_SCHED; GG_LDA(At, 1, 0); GG_STAGE(GG_SA(0, 1), a2, o2[1]);
            GG_WAIT_L(8); GG_BAR; GG_WAIT_L(0); GG_MMA(0, 0, At, B0); GG_BAR; GG_SCHED;
            GG_LDB(B1, 1, 1); GG_STAGE_B(GG_SB(1, 0), bu, k3, 0);
            GG_BAR; GG_WAIT_L(0); GG_MMA(0, 1, At, B1); GG_BAR;
            GG_LDA(At, 1, 1); GG_STAGE(GG_SA(1, 0), a3, o2[0]);
            GG_BAR; GG_WAIT_L(0); GG_MMA(1, 0, At, B0); GG_BAR; GG_SCHED;
            GG_STAGE_B(GG_SB(1, 1), bu, k3, 1);
            GG_WAIT_V(6); GG_BAR; GG_MMA(1, 1, At, B1); GG_BAR;
        }
        E(acc, cur, wr, wc, fr, fq);
        if (!has_next) break;
#pragma unroll
        for (int a = 0; a < 2; ++a)
#pragma unroll
            for (int b = 0; b < 2; ++b)
#pragma unroll
                for (int m = 0; m < 4; ++m)
#pragma unroll
                    for (int n = 0; n < 2; ++n) acc[a][b][m][n] = (f32x4){0.f, 0.f, 0.f, 0.f};
        cur = nxt; ++ui;
        if (GATHER) {
#pragma unroll
            for (int h = 0; h < 2; ++h)
#pragma unroll
                for (int i = 0; i < 2; ++i) cAo[h][i] = nAo[h][i]; }
    }
    GG_WAIT_V(0);
    if (wr == 0) GG_BAR;
    GG_BAR;
#undef GG_SA
#undef GG_SB
#undef GG_STAGE
#undef GG_LDA
#undef GG_LDB
#undef GG_MMA
#undef GG_WAIT_V
#undef GG_WAIT_L
#undef GG_BAR
#undef GG_SCHED
#undef GG_BSRC
#undef GG_STAGE_B
#undef GG_GOFF
}

struct DenseSched {
    const char* A; const char* Bt; int nM, nN, G, c; unsigned astep, bstep;
    __device__ __forceinline__ void init(const bf16_t* A_, const bf16_t* Bt_, int M, int N, int lda, int ldb) {
        A = (const char*)A_; Bt = (const char*)Bt_; nM = M / 256; nN = N / 256; G = gridDim.x; c = blockIdx.x; astep = 256u * lda * 2u; bstep = 256u * ldb * 2u; }
    __device__ __forceinline__ bool next(int i, Unit& u) const {
        const int L = i * G + c, nwg = nM * nN; if (L >= nwg) return false;
        int wgid; { const int q = nwg / 8, r = nwg % 8, xcd = L % 8, off = L / 8; wgid = (xcd < r ? xcd * (q + 1) : r * (q + 1) + (xcd - r) * q) + off; }
        const int nig = 8 * nN, gid = wgid / nig, fm = gid * 8, gsz = (nM - fm) < 8 ? (nM - fm) : 8;
        u.pm = fm + ((wgid % nig) % gsz); u.pn = (wgid % nig) / gsz;
        u.a = A + (size_t)u.pm * astep; u.b = Bt + (size_t)u.pn * bstep; u.b2 = nullptr; u.gofs = 0; u.x = 0; return true; }
};
}

constexpr size_t MiB = 1u << 20;
constexpr size_t WS_CTL = 0, CTL_BYTES = 1 * MiB;
constexpr int CW_BAR = 4096, CW_CNT = 8192, CW_CUR = 8192 + 256, CW_NT = 8192 + 512;
constexpr size_t WS_MODP = 1 * MiB, WS_MOD = 3 * MiB, WS_ROPE = 3 * MiB + 256 * 1024, WS_LBV = 3 * MiB + 512 * 1024;
constexpr size_t WS_W_LRU_IN = 4 * MiB, WS_W_LRU_OUT = 8 * MiB, WS_W_LRU_GATE = 10 * MiB;
constexpr size_t WS_W_RWKV_IN = 11 * MiB, WS_W_RWKV_L1 = 17 * MiB, WS_W_RWKV_OUT = 20 * MiB, WS_W_RWKV_WL2 = 556 * MiB;
constexpr size_t WS_W_RET_IN = 22 * MiB, WS_W_RET_OUT = 34 * MiB, WS_W_HGRN_IN = 38 * MiB, WS_W_HGRN_OUT = 48 * MiB;
constexpr size_t WS_MOE = 50 * MiB, MOE_STRIDE = 100 * MiB, MOE_GU = 0, MOE_DN = 64 * MiB, MOE_SHGU = 96 * MiB, MOE_SHDN = 97 * MiB, MOE_RT = 97 * MiB + 512 * 1024;
constexpr size_t WS_H = 450 * MiB, WS_U = 515 * MiB;
constexpr size_t WS_TOPI = 548 * MiB, WS_TOPW = 549 * MiB, WS_POS = 550 * MiB, WS_ROWTOK = 551 * MiB, WS_ROWW = 552 * MiB, WS_TILEE = 553 * MiB;
constexpr size_t WS_SCR = 560 * MiB;
constexpr size_t WS_ULO = WS_SCR + 760 * MiB;
constexpr size_t WS_DUMMY = 1500 * MiB;
constexpr int SH_BASE = 149504;
constexpr int NROWS_SORT = SH_BASE + NTOK;
constexpr size_t WS_ACT = WS_SCR, WS_OUT = WS_SCR + 82 * MiB;
constexpr size_t WS_END = WS_SCR + 880 * MiB;
constexpr size_t WS_MX0 = WS_SCR, WS_MX1 = WS_SCR + 33 * MiB, WS_MX2 = WS_SCR + 66 * MiB, WS_MX3 = WS_SCR + 99 * MiB, WS_MX4 = WS_SCR + 132 * MiB, WS_MX5 = WS_SCR + 165 * MiB;

constexpr int LDS_STAGE = 0, LDS_TAB = 131072, LDS_TAB_BYTES = 20480, LDS_MISC = LDS_TAB + LDS_TAB_BYTES, LDS_BYTES = 155648;

struct Args { const float* in[47]; float* out; unsigned char* ws; int ph_lo, ph_hi; };

struct Frame {
    LAS unsigned char* lds; volatile LAS unsigned* misc; unsigned* ctl; unsigned char* ws;
    int tid, lane, wave, gw, ngw;
};

struct TrJob { const float* src; bf16_t* dst; int ld_src, K, N, ld_dst, nb, sbs, dbs, mode, start; };
constexpr int MAXJOBS = 64;
__device__ __forceinline__ void tr_item(const TrJob& J, int item, LAS unsigned char* scr, int lane) {
    const int nblk = (J.N + 63) >> 6, kblk = J.K >> 6, per = nblk * kblk, bi = item / per, r = item - bi * per, kb = r / nblk, nb = r - kb * nblk, k0 = 64 * kb, n0 = 64 * nb;
    int c0 = n0;
    if (J.mode == 1) { const int pn = n0 >> 8, j = n0 & 255; c0 = (j < 128) ? (128 * pn + j) : (256 + 128 * pn + (j - 128)); }
    const float* W = J.src + (size_t)bi * J.sbs + (size_t)k0 * J.ld_src + c0; bf16_t* WT = J.dst + (size_t)bi * J.dbs + (size_t)n0 * J.ld_dst + k0;
    const int cq = lane & 15, rq = lane >> 4;
    const bool nok = (n0 + 4 * cq) < J.N;
    f32x4 v[16];
#pragma unroll
    for (int i = 0; i < 16; ++i) { v[i] = (f32x4){0.f, 0.f, 0.f, 0.f}; if (nok) v[i] = *(const f32x4*)(W + (size_t)(4 * i + rq) * J.ld_src + 4 * cq); }
#pragma unroll
    for (int i = 0; i < 16; ++i) { const int kk = 4 * i + rq;
#pragma unroll
        for (int e = 0; e < 4; ++e) { float x = v[i][e]; if (J.mode == 3) x = x - bf2f(f2bf(x)); *(LAS unsigned short*)(scr + (4 * cq + e) * 144 + kk * 2) = (unsigned short)f2bf(x); } }
    asm volatile("s_waitcnt lgkmcnt(0)" ::: "memory");
    const int ch = lane & 7, nr = lane >> 3;
#pragma unroll
    for (int j = 0; j < 8; ++j) { const int n = nr + 8 * j; if (n0 + n < J.N) *(u32x4*)(WT + (size_t)n * J.ld_dst + 8 * ch) = *(const LAS u32x4*)(scr + n * 144 + 16 * ch); }
    asm volatile("s_waitcnt lgkmcnt(0)" ::: "memory");
}
__device__ __forceinline__ void ldrow_f32(const float* row, int lane, float (&v)[16]) {
#pragma unroll
    for (int j = 0; j < 2; ++j) { const f32x4 a = *(const f32x4*)(row + 8 * lane + 512 * j), b = *(const f32x4*)(row + 8 * lane + 512 * j + 4);
        v[8 * j + 0] = a.x; v[8 * j + 1] = a.y; v[8 * j + 2] = a.z; v[8 * j + 3] = a.w; v[8 * j + 4] = b.x; v[8 * j + 5] = b.y; v[8 * j + 6] = b.z; v[8 * j + 7] = b.w; }
}
__device__ __forceinline__ void strow_f32(float* row, int lane, const float (&v)[16]) {
#pragma unroll
    for (int j = 0; j < 2; ++j) { *(f32x4*)(row + 8 * lane + 512 * j) = (f32x4){v[8 * j], v[8 * j + 1], v[8 * j + 2], v[8 * j + 3]}; *(f32x4*)(row + 8 * lane + 512 * j + 4) = (f32x4){v[8 * j + 4], v[8 * j + 5], v[8 * j + 6], v[8 * j + 7]}; }
}
__device__ __forceinline__ void ldrow_bf16(const bf16_t* row, int lane, float (&v)[16]) {
#pragma unroll
    for (int j = 0; j < 2; ++j) { const u32x4 a = *(const u32x4*)(row + 8 * lane + 512 * j);
        v[8 * j + 0] = bflo(a.x); v[8 * j + 1] = bfhi(a.x); v[8 * j + 2] = bflo(a.y); v[8 * j + 3] = bfhi(a.y); v[8 * j + 4] = bflo(a.z); v[8 * j + 5] = bfhi(a.z); v[8 * j + 6] = bflo(a.w); v[8 * j + 7] = bfhi(a.w); }
}
__device__ __forceinline__ void addrow_bf16(const bf16_t* row, int lane, float (&v)[16]) {
#pragma unroll
    for (int j = 0; j < 2; ++j) { const u32x4 a = *(const u32x4*)(row + 8 * lane + 512 * j);
        v[8 * j + 0] += bflo(a.x); v[8 * j + 1] += bfhi(a.x); v[8 * j + 2] += bflo(a.y); v[8 * j + 3] += bfhi(a.y); v[8 * j + 4] += bflo(a.z); v[8 * j + 5] += bfhi(a.z); v[8 * j + 6] += bflo(a.w); v[8 * j + 7] += bfhi(a.w); }
}
__device__ __forceinline__ void addrow_fp8(const unsigned char* row, int lane, float (&v)[16]) {
    typedef float f2v __attribute__((ext_vector_type(2)));
#pragma unroll
    for (int j = 0; j < 2; ++j) { const u32x2 a = *(const u32x2*)(row + 8 * lane + 512 * j);
        const f2v p0 = __builtin_amdgcn_cvt_pk_f32_fp8((int)a.x, false), p1 = __builtin_amdgcn_cvt_pk_f32_fp8((int)a.x, true), p2 = __builtin_amdgcn_cvt_pk_f32_fp8((int)a.y, false), p3 = __builtin_amdgcn_cvt_pk_f32_fp8((int)a.y, true);
        v[8 * j + 0] += p0[0]; v[8 * j + 1] += p0[1]; v[8 * j + 2] += p1[0]; v[8 * j + 3] += p1[1]; v[8 * j + 4] += p2[0]; v[8 * j + 5] += p2[1]; v[8 * j + 6] += p3[0]; v[8 * j + 7] += p3[1]; }
}
__device__ __forceinline__ void strow_bf16(bf16_t* row, int lane, const float (&v)[16]) {
#pragma unroll
    for (int j = 0; j < 2; ++j) { u32x4 o; o.x = pk2(v[8 * j], v[8 * j + 1]); o.y = pk2(v[8 * j + 2], v[8 * j + 3]); o.z = pk2(v[8 * j + 4], v[8 * j + 5]); o.w = pk2(v[8 * j + 6], v[8 * j + 7]);
        *(u32x4*)(row + 8 * lane + 512 * j) = o; }
}

#define add(src_, wsoff_, ld_src_, K_, N_, ld_dst_, nb_, sbs_, dbs_, mode_) do { TrJob J; J.src = (src_); J.dst = (bf16_t*)(a.ws + (wsoff_)); J.ld_src = (ld_src_); J.K = (K_); J.N = (N_); J.ld_dst = (ld_dst_); \
            J.nb = (nb_); J.sbs = (sbs_); J.dbs = (dbs_); J.mode = (mode_); J.start = start; jobs[n] = J; start += (nb_) * ((K_) / 64) * (((N_) + 63) / 64); ++n; } while (0)
__device__ __forceinline__ void add_moe_jobs(TrJob* jobs, int& n, int& start, const Args& a, int l) {
    const size_t mb = WS_MOE + l * MOE_STRIDE;
    add(a.in[43] + (size_t)l * 64 * 1024 * 512, mb + MOE_GU, 512, 1024, 512, 1024, 64, 1024 * 512, 512 * 1024, 1);
    add(a.in[44] + (size_t)l * 64 * 256 * 1024, mb + MOE_DN, 1024, 256, 1024, 256, 64, 256 * 1024, 1024 * 256, 0);
    add(a.in[45] + (size_t)l * 1024 * 512, mb + MOE_SHGU, 512, 1024, 512, 1024, 1, 0, 0, 1);
    add(a.in[46] + (size_t)l * 256 * 1024, mb + MOE_SHDN, 1024, 256, 1024, 256, 1, 0, 0, 0);
    add(a.in[41] + (size_t)l * 1024 * 64, mb + MOE_RT, 64, 1024, 64, 1024, 1, 0, 0, 2);
    add(a.in[41] + (size_t)l * 1024 * 64, mb + MOE_RT + 64 * 1024 * 2, 64, 1024, 64, 1024, 1, 0, 0, 3);
}
constexpr int BG_PER_LAYER = 12512, BG_NJOBS = 28, BG_E0 = 12512, BG_E1 = 27072, BG_E2 = 41120, BG_TOTAL = 53632;
__device__ __forceinline__ void bg_convert(Frame& F, const Args& a, int lo, int hi, int first, int stride) {
    if (lo >= hi) return;
    TrJob* jobs = (TrJob*)(F.lds + LDS_TAB);
    if (F.tid == 0) { int n = 0, start = 0;
        add_moe_jobs(jobs, n, start, a, 0);
        add_moe_jobs(jobs, n, start, a, 1);
        add(a.in[31], WS_W_RET_IN, 6144, 1024, 6144, 1024, 1, 0, 0, 0);
        add(a.in[35], WS_W_RET_OUT, 1024, 2048, 1024, 2048, 1, 0, 0, 0);
        add_moe_jobs(jobs, n, start, a, 2);
        add(a.in[36], WS_W_HGRN_IN, 5120, 1024, 5120, 1024, 1, 0, 0, 0);
        add(a.in[40], WS_W_HGRN_OUT, 1024, 1024, 1024, 1024, 1, 0, 0, 0);
        add_moe_jobs(jobs, n, start, a, 3);
        { TrJob J = jobs[n - 1]; J.start = start; J.nb = 0; jobs[n] = J; } }
    __syncthreads();
    LAS unsigned char* scr = F.lds + LDS_STAGE + F.wave * 16384;
    for (int it = lo + first; it < hi; it += stride) {
        int j = 0; while (j + 1 < BG_NJOBS && jobs[j + 1].start <= it) ++j;
        const TrJob J = jobs[j];
        tr_item(J, it - J.start, scr, F.lane);
    }
    __syncthreads();
}
template <int EV>
__device__ __forceinline__ void bg_range(int G, int& lo, int& hi, int& nidle, int& rem) {
    int ptr = 0; lo = hi = 0; nidle = 0; rem = 0;
#define BG_SLOT(e, nwg, q) if (EV >= (e)) { const int r_ = (nwg) % G, ni_ = r_ ? G - r_ : 0; lo = ptr; hi = min(ptr + (q) * ni_ * 8, BG_TOTAL); ptr = hi; nidle = ni_; rem = r_; }
#define BG_CATCH(e, end_) if (EV >= (e)) { lo = ptr; hi = max(ptr, (end_)); ptr = hi; nidle = 0; rem = 0; }
    BG_SLOT(0, 520, 4) BG_SLOT(1, 260, 4) BG_CATCH(2, BG_E0) BG_SLOT(3, 260, 6) BG_CATCH(4, BG_E1) BG_SLOT(5, 1560, 3) BG_SLOT(6, 260, 4) BG_CATCH(7, BG_E2) BG_SLOT(8, 1300, 7) BG_CATCH(9, BG_TOTAL)
#undef BG_SLOT
#undef BG_CATCH
}
template <int EV>
__device__ __forceinline__ void bg_slot(Frame& F, const Args& a) {
    int lo, hi, nidle, rem; bg_range<EV>((int)gridDim.x, lo, hi, nidle, rem);
    const int c = (int)blockIdx.x;
    if (nidle > 0 && c >= rem) bg_convert(F, a, lo, hi, (c - rem) * 8 + F.wave, nidle * 8);
}
template <int EV>
__device__ __forceinline__ void bg_catch(Frame& F, const Args& a) {
    int lo, hi, nidle, rem; bg_range<EV>((int)gridDim.x, lo, hi, nidle, rem);
    bg_convert(F, a, lo, hi, F.gw, F.ngw);
}

__device__ __forceinline__ void p0_phase(Frame& F, const Args& a) {
    TrJob* jobs = (TrJob*)(F.lds + LDS_TAB);
    int* njobs = (int*)(F.lds + LDS_TAB + MAXJOBS * sizeof(TrJob));
    if (F.tid == 0) {
        int n = 0, start = 0;
        add(a.in[8], WS_W_LRU_IN, 2048, 1024, 2048, 1024, 1, 0, 0, 0);
        add(a.in[14], WS_W_LRU_OUT, 1024, 1024, 1024, 1024, 1, 0, 0, 0);
        add(a.in[11], WS_W_LRU_GATE, 64, 64, 64, 64, 64, 4096, 4096, 0);
        add(a.in[16], WS_W_RWKV_IN, 1024, 1024, 1024, 1024, 3, 1024 * 1024, 1024 * 1024, 0);
        add(a.in[18], WS_W_RWKV_L1, 64, 1024, 64, 1024, 2, 1024 * 64, 64 * 1024, 0);
        add(a.in[21], WS_W_RWKV_L1 + 256 * 1024 * 2, 64, 1024, 64, 1024, 2, 1024 * 64, 64 * 1024, 0);
        add(a.in[23], WS_W_RWKV_L1 + 512 * 1024 * 2, 128, 1024, 128, 1024, 1, 0, 0, 0);
        add(a.in[19], WS_W_RWKV_WL2, 1024, 64, 1024, 256, 1, 0, 0, 0);
        add(a.in[19] + 64 * 1024, WS_W_RWKV_WL2 + (size_t)(1 * 1024 * 256 + 64) * 2, 1024, 64, 1024, 256, 1, 0, 0, 0);
        add(a.in[22], WS_W_RWKV_WL2 + (size_t)(2 * 1024 * 256) * 2, 1024, 64, 1024, 256, 1, 0, 0, 0);
        add(a.in[22] + 64 * 1024, WS_W_RWKV_WL2 + (size_t)(3 * 1024 * 256 + 64) * 2, 1024, 64, 1024, 256, 1, 0, 0, 0);
        add(a.in[24], WS_W_RWKV_WL2 + (size_t)(4 * 1024 * 256) * 2, 1024, 128, 1024, 256, 1, 0, 0, 0);
        add(a.in[30], WS_W_RWKV_OUT, 1024, 1024, 1024, 1024, 1, 0, 0, 0);
        { TrJob J = jobs[n - 1]; J.start = start; J.nb = 0; jobs[n] = J; }
        *njobs = n;
#undef add
    }
    __syncthreads();
    const int nj = *njobs, total = jobs[nj].start;
    LAS unsigned char* scr = F.lds + LDS_STAGE + F.wave * 16384;
    for (int it = F.gw; it < total; it += F.ngw) {
        int j = 0; while (j + 1 < nj && jobs[j + 1].start <= it) ++j;
        const TrJob J = jobs[j];
        tr_item(J, it - J.start, scr, F.lane);
    }
    { u32x4* z = (u32x4*)(a.ws + WS_W_RWKV_L1); const u32x4 zero = {0u, 0u, 0u, 0u};
      for (int i = blockIdx.x * NTHREADS + F.tid; i < 3 * 128 * 128; i += gridDim.x * NTHREADS) { const int blk = i / (128 * 128), r = i % (128 * 128); z[(size_t)(blk * 256 + 128) * 128 + r] = zero; } }
    { u32x4* z = (u32x4*)(a.ws + WS_W_RWKV_WL2); const u32x4 zero = {0u, 0u, 0u, 0u};
      for (int i = blockIdx.x * NTHREADS + F.tid; i < 5 * 1024 * 32; i += gridDim.x * NTHREADS) { const int g = i / (1024 * 32), c8 = (i & 31) * 8;
          const int lo = (g == 1 || g == 3) ? 64 : 0, hi = (g == 4) ? 128 : lo + 64; if (c8 < lo || c8 >= hi) z[i] = zero; } }
    const float* cvec = a.in[1]; const float* ccvec = a.in[3]; const float* adaw = a.in[4];
    float* modp = (float*)(a.ws + WS_MODP);
    for (int it = F.gw; it < 4 * 96 * 8; it += F.ngw) {
        const int s = it & 7, cb = (it >> 3) % 96, l = it / 768, j = cb * 64 + F.lane;
        const float* W = adaw + ((size_t)l * 1024 + s * 128) * 6144 + j;
        float al = 0.f, ac = 0.f;
#pragma unroll 8
        for (int k = 0; k < 128; ++k) { const float w = W[(size_t)k * 6144]; al += siluf_(cvec[s * 128 + k]) * w; ac += siluf_(ccvec[s * 128 + k]) * w; }
        modp[((size_t)(s * 4 + l) * 2 + 0) * 6144 + j] = al; modp[((size_t)(s * 4 + l) * 2 + 1) * 6144 + j] = ac;
    }
}
__device__ __forceinline__ void p1a_phase(Frame& F, const Args& a) {
    const float* modp = (const float*)(a.ws + WS_MODP); float* mod = (float*)(a.ws + WS_MOD); const float* adab = a.in[5];
    const int gt = blockIdx.x * NTHREADS + F.tid, ngt = gridDim.x * NTHREADS;
    for (int i = gt; i < 4 * 2 * 6144; i += ngt) { const int j = i % 6144, l = i / (2 * 6144);
        float s = adab[l * 6144 + j];
#pragma unroll
        for (int sl = 0; sl < 8; ++sl) s += modp[(size_t)sl * 4 * 2 * 6144 + i];
        mod[i] = s; }
    float* rope = (float*)(a.ws + WS_ROPE);
    for (int i = gt; i < 256 * 64; i += ngt) { const int p = i >> 6, f = i & 63; const double ang = (double)p * pow(10000.0, -(double)f / 64.0); rope[i] = (float)cos(ang); rope[256 * 64 + i] = (float)sin(ang); }
    float* lbv = (float*)(a.ws + WS_LBV); const float* hl = a.in[38];
    for (int i = gt; i < 1024; i += ngt) { const float x0 = hl[i], x1 = hl[1024 + i], x2 = hl[2048 + i], x3 = hl[3072 + i]; const float m = fmaxf(fmaxf(x0, x1), fmaxf(x2, x3));
        const float e0 = expf(x0 - m), e1 = expf(x1 - m), e2 = expf(x2 - m), e3 = expf(x3 - m); lbv[i] = (e1 + e2 + e3) / (e0 + e1 + e2 + e3); }
}
__device__ __forceinline__ const float* modptr(const unsigned char* ws, int l, int kind, int which) { return (const float*)(ws + WS_MOD) + ((size_t)(l * 2 + kind) * 6 + which) * 1024; }
__device__ __forceinline__ void p1b_phase(Frame& F, const Args& a) {
    bf16_t* H = (bf16_t*)(a.ws + WS_H); bf16_t* U = (bf16_t*)(a.ws + WS_U);
    { int* ROWTOK = (int*)(a.ws + WS_ROWTOK); float* ROWW = (float*)(a.ws + WS_ROWW);
      for (int t = blockIdx.x * NTHREADS + F.tid; t < NTOK; t += gridDim.x * NTHREADS) { ROWTOK[SH_BASE + t] = t; ROWW[SH_BASE + t] = 1.0f; } }
    for (int t = F.gw; t < NTOK; t += F.ngw) {
        const int kind = t < NCTX ? 1 : 0; const float* src = kind ? a.in[2] + (size_t)t * D : a.in[0] + (size_t)(t - NCTX) * D;
        float v[16], m0[16], m1[16]; ldrow_f32(src, F.lane, v); ldrow_f32(modptr(a.ws, 0, kind, 0), F.lane, m0); ldrow_f32(modptr(a.ws, 0, kind, 1), F.lane, m1);
        strow_bf16(H + (size_t)t * D, F.lane, v);
#pragma unroll
        for (int e = 0; e < 16; ++e) v[e] = v[e] * (1.0f + m1[e]) + m0[e];
        strow_bf16(U + (size_t)t * D, F.lane, v);
    }
}

template <int L, int MODE, bool DRY = false>
__device__ __forceinline__ void ln_phase(Frame& F, const Args& a) {
    bf16_t* H = (bf16_t*)(a.ws + WS_H); bf16_t* U = (bf16_t*)(a.ws + WS_U);
    bf16_t* Hw = DRY ? (bf16_t*)(a.ws + WS_DUMMY) : H; bf16_t* Uw = DRY ? (bf16_t*)(a.ws + WS_DUMMY + 70 * MiB) : U; float* outw = DRY ? (float*)(a.ws + WS_DUMMY) : a.out;
    const bf16_t* Y = (const bf16_t*)(a.ws + WS_MX5); const unsigned char* OUT = (const unsigned char*)(a.ws + WS_OUT); const int* POS = (const int*)(a.ws + WS_POS);
    const float* lg = a.in[6] + (size_t)(L * 2 + MODE) * D; const float* lb = a.in[7] + (size_t)(L * 2 + MODE) * D;
    constexpr bool LASTL = (L == 3);
#pragma unroll 1
    for (int kind = 0; kind < 2; ++kind) {
        if (LASTL && kind == 1) break;
        float mg[16], g[16], b[16], msh[16], msc[16];
        ldrow_f32(modptr(a.ws, L, kind, MODE == 0 ? 2 : 5), F.lane, mg); ldrow_f32(lg, F.lane, g); ldrow_f32(lb, F.lane, b);
        if (MODE == 0) { ldrow_f32(modptr(a.ws, L, kind, 3), F.lane, msh); ldrow_f32(modptr(a.ws, L, kind, 4), F.lane, msc); }
        else if (!LASTL) { ldrow_f32(modptr(a.ws, (L + 1) & 3, kind, 0), F.lane, msh); ldrow_f32(modptr(a.ws, (L + 1) & 3, kind, 1), F.lane, msc); }
        const int t0 = kind ? 0 : NCTX, t1 = kind ? NCTX : NTOK;
#pragma unroll 1
        for (int t = t0 + F.gw; t < t1; t += F.ngw) {
            float h[16], y[16];
            ldrow_bf16(H + (size_t)t * D, F.lane, h);
            if (MODE == 0) ldrow_bf16(Y + (size_t)t * D, F.lane, y);
            else if (!EN_MOE) {
#pragma unroll
                for (int e = 0; e < 16; ++e) y[e] = 0.f;
            } else {
                int p = 0; if (F.lane < 8) p = POS[t * 8 + F.lane];
#pragma unroll
                for (int e = 0; e < 16; ++e) y[e] = 0.f;
                addrow_fp8(OUT + (size_t)(SH_BASE + t) * D, F.lane, y);
#pragma unroll
                for (int s = 0; s < 8; ++s) { const int r = __builtin_amdgcn_readlane(p, s); addrow_fp8(OUT + (size_t)r * D, F.lane, y); }
            }
            float s = 0.f;
#pragma unroll
            for (int e = 0; e < 16; ++e) { h[e] = ALPHA * h[e] + mg[e] * y[e]; s += h[e]; }
            const float mean = wave_sum(s) * (1.0f / D); float q = 0.f;
#pragma unroll
            for (int e = 0; e < 16; ++e) { h[e] -= mean; q += h[e] * h[e]; }
            const float rstd = 1.0f / sqrtf(wave_sum(q) * (1.0f / D) + LN_EPS);
#pragma unroll
            for (int e = 0; e < 16; ++e) h[e] = h[e] * rstd * g[e] + b[e];
            if (MODE == 1 && LASTL) { strow_f32(outw + (size_t)(t - NCTX) * D, F.lane, h); }
            else {
                strow_bf16(Hw + (size_t)t * D, F.lane, h);
#pragma unroll
                for (int e = 0; e < 16; ++e) h[e] = h[e] * (1.0f + msc[e]) + msh[e];
                strow_bf16(Uw + (size_t)t * D, F.lane, h);
                if (MODE == 0) {
#pragma unroll
                    for (int e = 0; e < 16; ++e) h[e] = h[e] - bf2f(f2bf(h[e]));
                    strow_bf16((DRY ? Uw : (bf16_t*)(a.ws + WS_ULO)) + (size_t)t * D, F.lane, h); }
            }
        }
    }
}

template <int L, bool DRY = false>
__device__ __forceinline__ void moe_route_phase(Frame& F, const Args& a) {
    const bf16_t* U = (const bf16_t*)(a.ws + WS_U); const bf16_t* ULO = (const bf16_t*)(a.ws + WS_ULO);
    const bf16_t* Rhi = (const bf16_t*)(a.ws + WS_MOE + L * MOE_STRIDE + MOE_RT); const bf16_t* Rlo = Rhi + 64 * 1024;
    const float* bias = a.in[42] + L * 64;
    int* TOPI = (int*)(a.ws + (DRY ? WS_DUMMY : WS_TOPI)); float* TOPW = (float*)(a.ws + (DRY ? WS_DUMMY + 4 * MiB : WS_TOPW));
    LAS float* part = (LAS float*)(F.lds + LDS_STAGE);
    const int lane = F.lane, r16 = lane & 15, q = lane >> 4, w = F.wave;
    bf16x8 Bh[4][4], Bl[4][4];
#pragma unroll
    for (int n = 0; n < 4; ++n)
#pragma unroll
        for (int ks = 0; ks < 4; ++ks) { const size_t o = (size_t)(16 * n + r16) * 1024 + 128 * w + 32 * ks + 8 * q; Bh[n][ks] = *(const bf16x8*)(Rhi + o); Bl[n][ks] = *(const bf16x8*)(Rlo + o); }
    const int g0 = (L == 3) ? NCTX / 16 : 0;
    int cnt_e = 0;
    const float mybias = bias[lane];
#pragma unroll 1
    for (int grp = g0 + blockIdx.x; grp < NTOK / 16; grp += gridDim.x) {
        const size_t ao = (size_t)(grp * 16 + r16) * D + 128 * w + 8 * q;
        bf16x8 Ah[4], Al[4];
#pragma unroll
        for (int ks = 0; ks < 4; ++ks) { Ah[ks] = *(const bf16x8*)(U + ao + 32 * ks); Al[ks] = *(const bf16x8*)(ULO + ao + 32 * ks); }
        f32x4 acc[4];
#pragma unroll
        for (int n = 0; n < 4; ++n) { acc[n] = (f32x4){0.f, 0.f, 0.f, 0.f};
#pragma unroll
            for (int ks = 0; ks < 4; ++ks) {
                acc[n] = __builtin_amdgcn_mfma_f32_16x16x32_bf16(Ah[ks], Bh[n][ks], acc[n], 0, 0, 0);
                acc[n] = __builtin_amdgcn_mfma_f32_16x16x32_bf16(Ah[ks], Bl[n][ks], acc[n], 0, 0, 0);
                acc[n] = __builtin_amdgcn_mfma_f32_16x16x32_bf16(Al[ks], Bh[n][ks], acc[n], 0, 0, 0); } }
        __syncthreads();
#pragma unroll
        for (int n = 0; n < 4; ++n)
#pragma unroll
            for (int r = 0; r < 4; ++r) part[(w * 16 + 4 * q + r) * 64 + 16 * n + r16] = acc[n][r];
        __syncthreads();
#pragma unroll 1
        for (int rr = 0; rr < 2; ++rr) {
            const int row = 2 * w + rr, t = grp * 16 + row;
            float lgt = 0.f;
#pragma unroll
            for (int ww = 0; ww < 8; ++ww) lgt += part[(ww * 16 + row) * 64 + lane];
            const float sc = sigmoidf_(lgt);
            const float ch = sc + mybias;
            float m1 = -INFINITY, m2 = -INFINITY;
#pragma unroll
            for (int j = 0; j < 8; ++j) { const float v = __shfl(ch, (lane & ~7) + j); if (v > m1) { m2 = m1; m1 = v; } else if (v > m2) m2 = v; }
            const float gs = m1 + m2; const int g = lane >> 3;
            int grank = 0;
#pragma unroll
            for (int gg2 = 0; gg2 < 8; ++gg2) { const float v = __shfl(gs, 8 * gg2); grank += (v > gs || (v == gs && gg2 < g)) ? 1 : 0; }
            const bool sel = grank < 4;
            const float chm = sel ? ch : -INFINITY;
            int rank = 0;
#pragma unroll
            for (int e2 = 0; e2 < 64; ++e2) { const float v = __builtin_bit_cast(float, __builtin_amdgcn_readlane(__builtin_bit_cast(int, chm), e2)); rank += (v > chm || (v == chm && e2 < lane)) ? 1 : 0; }
            const bool chosen = sel && rank < 8;
            const float wsum = wave_sum(chosen ? sc : 0.f);
            const unsigned long long bal = __ballot(chosen);
            const int slot = __popcll(bal & ((1ull << lane) - 1ull));
            if (chosen) { TOPI[t * 8 + slot] = lane; TOPW[t * 8 + slot] = 2.5f * sc / wsum; cnt_e++; }
        }
    }
    if (cnt_e && !DRY) atomicAdd(F.ctl + CW_CNT + L * 64 + lane, (unsigned)cnt_e);
}

template <int L, bool DRY = false>
__device__ __forceinline__ void moe_dispatch_phase(Frame& F, const Args& a) {
    LAS int* pb = (LAS int*)(F.lds + LDS_TAB);
    if (F.wave == 0) {
        const int cnt = (int)F.ctl[CW_CNT + L * 64 + F.lane]; const int pad = (cnt + 255) & ~255;
        int inc = pad;
#pragma unroll
        for (int o = 1; o < 64; o <<= 1) { const int v = __shfl_up(inc, o); if (F.lane >= o) inc += v; }
        pb[F.lane] = inc - pad; pb[65 + F.lane] = cnt; if (F.lane == 63) pb[64] = inc;
    }
    __syncthreads();
    const int* TOPI = (const int*)(a.ws + WS_TOPI); const float* TOPW = (const float*)(a.ws + WS_TOPW);
    int* POS = (int*)(a.ws + (DRY ? WS_DUMMY : WS_POS)); int* ROWTOK = (int*)(a.ws + (DRY ? WS_DUMMY + 2 * MiB : WS_ROWTOK)); float* ROWW = (float*)(a.ws + (DRY ? WS_DUMMY + 4 * MiB : WS_ROWW)); int* TILEE = (int*)(a.ws + (DRY ? WS_DUMMY + 6 * MiB : WS_TILEE));
    const int p0 = (L == 3) ? NCTX * 8 : 0;
    LAS int* lcnt = pb + 160; LAS int* lbase = pb + 224;
    const int npairs = NTOK * 8 - p0, per = (npairs + (int)gridDim.x - 1) / (int)gridDim.x, lo = p0 + (int)blockIdx.x * per, hi = min(lo + per, NTOK * 8);
#pragma unroll 1
    for (int c0 = lo; c0 < hi; c0 += NTHREADS) {
        if (F.tid < 64) lcnt[F.tid] = 0;
        __syncthreads();
        const int p = c0 + F.tid; const bool ok = p < hi; int e = 0, lrank = 0;
        if (ok) { e = TOPI[p]; lrank = atomicAdd((int*)(lcnt + e), 1); }
        __syncthreads();
        if (F.tid < 64) { const int c = lcnt[F.tid]; lbase[F.tid] = pb[F.tid] + (c ? (int)atomicAdd(F.ctl + CW_CUR + (DRY ? 1024 : 0) + L * 64 + F.tid, (unsigned)c) : 0); }
        __syncthreads();
        if (ok) { const int dest = lbase[e] + lrank; POS[p] = dest; ROWTOK[dest] = p >> 3; ROWW[dest] = TOPW[p]; }
        __syncthreads();
    }
    if (blockIdx.x < 64) {
        const int e = blockIdx.x, base = pb[e], cnt = pb[65 + e], pad = (cnt + 255) & ~255;
        for (int r = cnt + F.tid; r < pad; r += NTHREADS) { ROWTOK[base + r] = NCTX; ROWW[base + r] = 0.f; }
        for (int tl = F.tid; tl < pad / 256; tl += NTHREADS) TILEE[base / 256 + tl] = e;
    }
    if (blockIdx.x == 64 && F.tid == 0 && !DRY) F.ctl[CW_NT + L] = (unsigned)(pb[64] / 256);
    __syncthreads();
}

struct ListSched {
    const LAS gg::Unit* tab; int n;
    __device__ __forceinline__ bool next(int i, gg::Unit& u) const {
        if (i >= n) return false;
        const LAS unsigned* p = (const LAS unsigned*)(tab + i); unsigned w[10];
#pragma unroll
        for (int k = 0; k < 10; ++k) w[k] = (unsigned)__builtin_amdgcn_readfirstlane((int)p[k]);
        u.a = (const char*)(((unsigned long long)w[1] << 32) | w[0]); u.b = (const char*)(((unsigned long long)w[3] << 32) | w[2]); u.b2 = (const char*)(((unsigned long long)w[5] << 32) | w[4]);
        u.pm = (int)w[6]; u.pn = (int)w[7]; u.gofs = (int)w[8]; u.x = (int)w[9]; return true; }
};
static_assert(sizeof(gg::Unit) == 40, "Unit layout");

struct EpiSwiglu {
    static constexpr bool PERM = true;
    bf16_t* ACT; LAS unsigned char* lds;
    __device__ __forceinline__ void operator()(const gg::Acc& acc, const gg::Unit& u, int wr, int wc, int fr, int fq) const {
        const int row0 = u.pm * 256 + wr * 64 + fr, col0 = u.pn * 128 + wc * 32 + 8 * fq;
        const LAS float* wl = (const LAS float*)(lds + u.gofs + 8192);
#pragma unroll
        for (int ai = 0; ai < 2; ++ai)
#pragma unroll
            for (int m = 0; m < 4; ++m) { const int row = row0 + ai * 128 + m * 16; const float w = wl[wr * 64 + fr + ai * 128 + m * 16];
                const f32x4 g0 = acc[ai][0][m][0], g1 = acc[ai][0][m][1], u0 = acc[ai][1][m][0], u1 = acc[ai][1][m][1];
                u32x4 o; o.x = pk2(siluf_(g0[0]) * u0[0] * w, siluf_(g0[1]) * u0[1] * w); o.y = pk2(siluf_(g0[2]) * u0[2] * w, siluf_(g0[3]) * u0[3] * w);
                o.z = pk2(siluf_(g1[0]) * u1[0] * w, siluf_(g1[1]) * u1[1] * w); o.w = pk2(siluf_(g1[2]) * u1[2] * w, siluf_(g1[3]) * u1[3] * w);
                *(u32x4*)(ACT + (size_t)row * 256 + col0) = o; }
    }
};
struct EpiBf16 {
    static constexpr bool PERM = true;
    bf16_t* O; int ldc;
    __device__ __forceinline__ void operator()(const gg::Acc& acc, const gg::Unit& u, int wr, int wc, int fr, int fq) const {
        const int row0 = u.pm * 256 + wr * 64 + fr, col0 = u.pn * 256 + wc * 32 + 8 * fq;
#pragma unroll
        for (int ai = 0; ai < 2; ++ai)
#pragma unroll
            for (int m = 0; m < 4; ++m) { bf16_t* rp = O + (size_t)(row0 + ai * 128 + m * 16) * ldc + col0;
#pragma unroll
                for (int bj = 0; bj < 2; ++bj) { const f32x4 v0 = acc[ai][bj][m][0], v1 = acc[ai][bj][m][1];
                    u32x4 o; o.x = pk2(v0[0], v0[1]); o.y = pk2(v0[2], v0[3]); o.z = pk2(v1[0], v1[1]); o.w = pk2(v1[2], v1[3]);
                    *(u32x4*)(rp + bj * 128) = o; } }
    }
};

__device__ __forceinline__ unsigned pk4_fp8(float a, float b, float c, float d) { int w = __builtin_amdgcn_cvt_pk_fp8_f32(a, b, 0, false); w = __builtin_amdgcn_cvt_pk_fp8_f32(c, d, w, true); return (unsigned)w; }
struct EpiFp8 {
    static constexpr bool PERM = true;
    unsigned char* O;
    __device__ __forceinline__ void operator()(const gg::Acc& acc, const gg::Unit& u, int wr, int wc, int fr, int fq) const {
        const int row0 = u.pm * 256 + wr * 64 + fr, col0 = u.pn * 256 + wc * 32 + 8 * fq;
#pragma unroll
        for (int ai = 0; ai < 2; ++ai)
#pragma unroll
            for (int m = 0; m < 4; ++m) { unsigned char* rp = O + (size_t)(row0 + ai * 128 + m * 16) * 1024 + col0;
#pragma unroll
                for (int bj = 0; bj < 2; ++bj) { const f32x4 v0 = acc[ai][bj][m][0], v1 = acc[ai][bj][m][1];
                    u32x2 o; o.x = pk4_fp8(v0[0], v0[1], v0[2], v0[3]); o.y = pk4_fp8(v1[0], v1[1], v1[2], v1[3]);
                    *(u32x2*)(rp + bj * 128) = o; } }
    }
};
template <int L>
__device__ __forceinline__ void moe_gateup_phase(Frame& F, const Args& a) {
    const int ntr = (int)F.ctl[CW_NT + L]; constexpr int s0 = (L == 3) ? 1 : 0; const int nsh = 65 - s0, nunits = (ntr + nsh) * 2;
    gg::Unit* tab = (gg::Unit*)(F.lds + LDS_TAB); LAS int* idx = (LAS int*)(F.lds + LDS_TAB + 512);
    const int* ROWTOK = (const int*)(a.ws + WS_ROWTOK); const int* TILEE = (const int*)(a.ws + WS_TILEE); const float* ROWW = (const float*)(a.ws + WS_ROWW);
    const char* Wgu = (const char*)(a.ws + WS_MOE + L * MOE_STRIDE + MOE_GU); const char* Wsh = (const char*)(a.ws + WS_MOE + L * MOE_STRIDE + MOE_SHGU);
    int nmine = 0;
    for (int i = 0; i < 8; ++i) { const int Lq = i * (int)gridDim.x + (int)blockIdx.x; if (Lq >= nunits) break; nmine = i + 1;
        int uidx; { const int q8 = nunits / 8, r8 = nunits % 8, xcd = Lq % 8, off = Lq / 8; uidx = (xcd < r8 ? xcd * (q8 + 1) : r8 * (q8 + 1) + (xcd - r8) * q8) + off; }
        const int tile = uidx >> 1, pn = uidx & 1; const bool routed = tile < ntr;
        const int rowtile = routed ? tile : (SH_BASE / 256 + s0 + (tile - ntr));
        if (F.tid == 0) { gg::Unit u; u.a = (const char*)(a.ws + WS_U); u.b = routed ? Wgu + ((size_t)TILEE[tile] * 512 + pn * 256) * 2048 : Wsh + (size_t)(pn * 256) * 2048; u.b2 = nullptr;
            u.pm = rowtile; u.pn = pn; u.gofs = LDS_TAB + 512 + i * 1024; u.x = 0; tab[i] = u; }
        if (F.tid < 256) { idx[i * 256 + F.tid] = ROWTOK[rowtile * 256 + F.tid]; ((LAS float*)(F.lds + LDS_TAB + 512 + 8192))[i * 256 + F.tid] = ROWW[rowtile * 256 + F.tid]; }
    }
    __syncthreads();
    ListSched S{(const LAS gg::Unit*)(F.lds + LDS_TAB), nmine}; EpiSwiglu E{(bf16_t*)(a.ws + WS_ACT), F.lds};
    gg::gemm_phase<EpiSwiglu, ListSched, true, false>(F.lds + LDS_STAGE, gg::Dims{1024, 1024, 1024, 0, 0}, S, E);
}
template <int L>
__device__ __forceinline__ void moe_down_phase(Frame& F, const Args& a) {
    const int ntr = (int)F.ctl[CW_NT + L]; constexpr int s0 = (L == 3) ? 1 : 0; const int nsh = 65 - s0, nunits = (ntr + nsh) * 4;
    gg::Unit* tab = (gg::Unit*)(F.lds + LDS_TAB);
    const int* TILEE = (const int*)(a.ws + WS_TILEE);
    const char* Wdn = (const char*)(a.ws + WS_MOE + L * MOE_STRIDE + MOE_DN); const char* Wsh = (const char*)(a.ws + WS_MOE + L * MOE_STRIDE + MOE_SHDN);
    int nmine = 0;
    for (int i = 0; i < 12; ++i) { const int Lq = i * (int)gridDim.x + (int)blockIdx.x; if (Lq >= nunits) break; nmine = i + 1;
        int uidx; { const int q8 = nunits / 8, r8 = nunits % 8, xcd = Lq % 8, off = Lq / 8; uidx = (xcd < r8 ? xcd * (q8 + 1) : r8 * (q8 + 1) + (xcd - r8) * q8) + off; }
        const int tile = uidx >> 2, pn = uidx & 3; const bool routed = tile < ntr;
        const int rowtile = routed ? tile : (SH_BASE / 256 + s0 + (tile - ntr));
        if (F.tid == 0) { gg::Unit u; u.a = (const char*)(a.ws + WS_ACT) + (size_t)rowtile * 256 * 512; u.b = routed ? Wdn + ((size_t)TILEE[tile] * 1024 + pn * 256) * 512 : Wsh + (size_t)(pn * 256) * 512; u.b2 = nullptr;
            u.pm = rowtile; u.pn = pn; u.gofs = 0; u.x = 0; tab[i] = u; }
    }
    __syncthreads();
    ListSched S{(const LAS gg::Unit*)(F.lds + LDS_TAB), nmine}; EpiFp8 E{(unsigned char*)(a.ws + WS_OUT)};
    gg::gemm_phase<EpiFp8, ListSched, false, false>(F.lds + LDS_STAGE, gg::Dims{256, 256, 256, 0, 0}, S, E);
}

__device__ __forceinline__ int xcd_remap(int L, int n) { const int q8 = n / 8, r8 = n % 8, xcd = L % 8, off = L / 8; return (xcd < r8 ? xcd * (q8 + 1) : r8 * (q8 + 1) + (xcd - r8) * q8) + off; }
__device__ __forceinline__ float gelu_tanh(float x) { const float z = 0.7978845608028654f * (x + 0.044715f * x * x * x); return x * (1.0f - __builtin_amdgcn_rcpf(1.0f + __expf(2.0f * z))); }
struct EpiLruIn {
    static constexpr bool PERM = true;
    bf16_t* GB; bf16_t* RNN;
    __device__ __forceinline__ void operator()(const gg::Acc& acc, const gg::Unit& u, int wr, int wc, int fr, int fq) const {
        const bool isg = u.pn < 4; bf16_t* O = isg ? GB : RNN;
        const int row0 = u.pm * 256 + wr * 64 + fr, col0 = (u.pn & 3) * 256 + wc * 32 + 8 * fq;
#pragma unroll
        for (int ai = 0; ai < 2; ++ai)
#pragma unroll
            for (int m = 0; m < 4; ++m) { bf16_t* rp = O + (size_t)(row0 + ai * 128 + m * 16) * 1024 + col0;
#pragma unroll
                for (int bj = 0; bj < 2; ++bj) { f32x4 v0 = acc[ai][bj][m][0], v1 = acc[ai][bj][m][1];
                    if (isg) {
#pragma unroll
                        for (int e = 0; e < 4; ++e) { v0[e] = gelu_tanh(v0[e]); v1[e] = gelu_tanh(v1[e]); } }
                    u32x4 o; o.x = pk2(v0[0], v0[1]); o.y = pk2(v0[2], v0[3]); o.z = pk2(v1[0], v1[1]); o.w = pk2(v1[2], v1[3]);
                    *(u32x4*)(rp + bj * 128) = o; } }
    }
};
template <bool REV>
__device__ __forceinline__ void lru_scan16(const float (&a)[4], const float (&b)[4], float (&h)[4], float& hc, float& at, int lane) {
    const int q = lane >> 4;
    float Ar[4], Br[4]; float A = 1.0f, B = 0.0f;
#pragma unroll
    for (int ri = 0; ri < 4; ++ri) { const int r = REV ? 3 - ri : ri; B = a[r] * B + b[r]; A = a[r] * A; Ar[r] = A; Br[r] = B; }
    float As = A, Bs = B;
    { const float pA = REV ? __shfl_down(As, 16) : __shfl_up(As, 16), pB = REV ? __shfl_down(Bs, 16) : __shfl_up(Bs, 16); const bool on = REV ? (q <= 2) : (q >= 1); if (on) { Bs = As * pB + Bs; As = As * pA; } }
    { const float pA = REV ? __shfl_down(As, 32) : __shfl_up(As, 32), pB = REV ? __shfl_down(Bs, 32) : __shfl_up(Bs, 32); const bool on = REV ? (q <= 1) : (q >= 2); if (on) { Bs = As * pB + Bs; As = As * pA; } }
    float eA = REV ? __shfl_down(As, 16) : __shfl_up(As, 16), eB = REV ? __shfl_down(Bs, 16) : __shfl_up(Bs, 16);
    const bool first = REV ? (q == 3) : (q == 0); if (first) { eA = 1.0f; eB = 0.0f; }
    const float Hin = eA * hc + eB;
#pragma unroll
    for (int r = 0; r < 4; ++r) h[r] = Ar[r] * Hin + Br[r];
    const int src = (REV ? 0 : 48) + (lane & 15);
    const float tA = __shfl(As, src), tB = __shfl(Bs, src);
    hc = tA * hc + tB; at *= tA;
}
template <bool SUMMARY>
__device__ __forceinline__ void lru_scan_phase(Frame& F, const Args& a) {
    const bf16_t* RNN = (const bf16_t*)(a.ws + WS_MX1); const bf16_t* GB = (const bf16_t*)(a.ws + WS_MX0); bf16_t* A2 = (bf16_t*)(a.ws + WS_MX2);
    float* SUMM = (float*)(a.ws + WS_MX3); const float* CARRY = (const float*)(a.ws + WS_MX4);
    const bf16_t* Wg = (const bf16_t*)(a.ws + WS_W_LRU_GATE);
    const float* cw = a.in[9]; const float* cb = a.in[10]; const float* gbias = a.in[12]; const float* lam = a.in[13];
    LAS unsigned char* xt = F.lds + LDS_STAGE + F.wave * 17408;
    LAS unsigned char* ot = xt + 9216;
    const int lane = F.lane, c16 = lane & 15, q = lane >> 4, cg = lane & 7, rg = lane >> 3;
#pragma unroll 1
    for (int task = F.gw; task < (NTOK / 64) * 16; task += F.ngw) {
        const int k = task >> 4;
        const int t0 = 64 * k, slo = (k < 4) ? 0 : NCTX, shi = (k < 4) ? NCTX : NTOK;
        {
            const int blk = task & 15, ch0 = blk * 64;
            {
                float w[4][8], bsv[8];
#pragma unroll
                for (int e = 0; e < 8; ++e) { bsv[e] = cb[ch0 + 8 * cg + e];
#pragma unroll
                    for (int j = 0; j < 4; ++j) w[j][e] = cw[j * 1024 + ch0 + 8 * cg + e]; }
#pragma unroll 1
                for (int ps = 0; ps < 2; ++ps) {
                    const int rq = rg + 8 * ps;
                    float xin[7][8];
#pragma unroll
                    for (int rr = 0; rr < 7; ++rr) { const int t = t0 + 4 * rq - 1 + rr; u32x4 v = {0u, 0u, 0u, 0u};
                        if (t >= slo && t < shi) v = *(const u32x4*)(RNN + (size_t)t * 1024 + ch0 + 8 * cg);
                        xin[rr][0] = bflo(v.x); xin[rr][1] = bfhi(v.x); xin[rr][2] = bflo(v.y); xin[rr][3] = bfhi(v.y); xin[rr][4] = bflo(v.z); xin[rr][5] = bfhi(v.z); xin[rr][6] = bflo(v.w); xin[rr][7] = bfhi(v.w); }
#pragma unroll
                    for (int r = 0; r < 4; ++r) { float o[8];
#pragma unroll
                        for (int e = 0; e < 8; ++e) o[e] = bsv[e] + w[0][e] * xin[r][e] + w[1][e] * xin[r + 1][e] + w[2][e] * xin[r + 2][e] + w[3][e] * xin[r + 3][e];
                        u32x4 pk; pk.x = pk2(o[0], o[1]); pk.y = pk2(o[2], o[3]); pk.z = pk2(o[4], o[5]); pk.w = pk2(o[6], o[7]);
                        *(LAS u32x4*)(xt + (4 * rq + r) * 144 + 16 * cg) = pk; }
                }
            }
            asm volatile("s_waitcnt lgkmcnt(0)" ::: "memory");
            bf16x8 Af[4][2];
#pragma unroll
            for (int T = 0; T < 4; ++T)
#pragma unroll
                for (int ks = 0; ks < 2; ++ks) Af[T][ks] = *(const LAS bf16x8*)(xt + (16 * T + c16) * 144 + (32 * ks + 8 * q) * 2);
#pragma unroll
            for (int g4 = 0; g4 < 4; ++g4) {
                const int ch = ch0 + 16 * g4 + c16;
                float xv[4][4];
#pragma unroll
                for (int T = 0; T < 4; ++T)
#pragma unroll
                    for (int r = 0; r < 4; ++r) xv[T][r] = bf2f(*(const LAS unsigned short*)(xt + (16 * T + 4 * q + r) * 144 + (16 * g4 + c16) * 2));
                float hsum[4][4];
#pragma unroll
                for (int d = 0; d < 2; ++d) {
                    f32x4 acc[2][4];
#pragma unroll
                    for (int gt = 0; gt < 2; ++gt) {
                        const bf16_t* wp = Wg + ((size_t)((d * 2 + gt) * 16 + blk) * 64 + 16 * g4 + c16) * 64 + 8 * q;
                        const bf16x8 b0 = *(const bf16x8*)wp, b1 = *(const bf16x8*)(wp + 32);
#pragma unroll
                        for (int T = 0; T < 4; ++T) { f32x4 z = {0.f, 0.f, 0.f, 0.f};
                            z = __builtin_amdgcn_mfma_f32_16x16x32_bf16(Af[T][0], b0, z, 0, 0, 0);
                            acc[gt][T] = __builtin_amdgcn_mfma_f32_16x16x32_bf16(Af[T][1], b1, z, 0, 0, 0); }
                    }
                    const float gb0 = gbias[(d * 2 + 0) * 1024 + ch], gb1 = gbias[(d * 2 + 1) * 1024 + ch];
                    const float lm = lam[d * 1024 + ch]; const float sp = log1pf(__expf(-lm));
                    float hc = 0.0f, at = 1.0f;
                    if (!SUMMARY) hc = CARRY[((size_t)d * 260 + k) * 1024 + ch];
#pragma unroll
                    for (int Ti = 0; Ti < 4; ++Ti) {
                        const int T = d ? 3 - Ti : Ti;
                        float av[4], bv[4], hv[4];
#pragma unroll
                        for (int r = 0; r < 4; ++r) { const float rgate = sigmoidf_(acc[0][T][r] + gb0), ig = sigmoidf_(acc[1][T][r] + gb1);
                            const float la = -8.0f * rgate * sp; const float aa = __expf(la); av[r] = aa; bv[r] = __builtin_amdgcn_sqrtf(fmaxf(1.0f - aa * aa, 0.f)) * ig * xv[T][r]; }
                        if (d == 0) lru_scan16<false>(av, bv, hv, hc, at, lane); else lru_scan16<true>(av, bv, hv, hc, at, lane);
                        if (!SUMMARY) {
#pragma unroll
                            for (int r = 0; r < 4; ++r) hsum[T][r] = (d == 0) ? hv[r] : hsum[T][r] + hv[r]; }
                    }
                    if (SUMMARY) { if (q == 0) { SUMM[((size_t)d * 260 + k) * 1024 + ch] = at; SUMM[((size_t)(2 + d) * 260 + k) * 1024 + ch] = hc; } }
                }
                if (!SUMMARY) {
#pragma unroll
                    for (int T = 0; T < 4; ++T)
#pragma unroll
                        for (int r = 0; r < 4; ++r) *(LAS unsigned short*)(ot + (16 * T + 4 * q + r) * 128 + (16 * g4 + c16) * 2) = (unsigned short)f2bf(hsum[T][r]);
                }
            }
            if (!SUMMARY) {
                asm volatile("s_waitcnt lgkmcnt(0)" ::: "memory");
#pragma unroll
                for (int r = 0; r < 8; ++r) { const int row = 8 * rg + r; const u32x4 hv = *(const LAS u32x4*)(ot + row * 128 + 16 * cg);
                    const u32x4 gv = *(const u32x4*)(GB + (size_t)(t0 + row) * 1024 + ch0 + 8 * cg);
                    u32x4 o; o.x = pk2(bflo(hv.x) * bflo(gv.x), bfhi(hv.x) * bfhi(gv.x)); o.y = pk2(bflo(hv.y) * bflo(gv.y), bfhi(hv.y) * bfhi(gv.y));
                    o.z = pk2(bflo(hv.z) * bflo(gv.z), bfhi(hv.z) * bfhi(gv.z)); o.w = pk2(bflo(hv.w) * bflo(gv.w), bfhi(hv.w) * bfhi(gv.w));
                    *(u32x4*)(A2 + (size_t)(t0 + row) * 1024 + ch0 + 8 * cg) = o; }
            }
            asm volatile("s_waitcnt lgkmcnt(0)" ::: "memory");
        }
    }
}
__device__ __forceinline__ void lru_carry_phase(Frame& F, const Args& a) {
    const float* SUMM = (const float*)(a.ws + WS_MX3); float* CARRY = (float*)(a.ws + WS_MX4);
    const int gid = blockIdx.x * NTHREADS + F.tid; if (gid >= 2048) return;
    const int d = gid >> 10, c = gid & 1023; float h = 0.0f;
    const float* At = SUMM + (size_t)d * 260 * 1024 + c; const float* He = SUMM + (size_t)(2 + d) * 260 * 1024 + c; float* Cy = CARRY + (size_t)d * 260 * 1024 + c;
#pragma unroll 1
    for (int b = 0; b < 10; ++b) {
        float av[26], hv[26]; int kk[26];
#pragma unroll
        for (int j = 0; j < 26; ++j) { const int st = b * 26 + j; kk[j] = d == 0 ? st : (st < 4 ? 3 - st : 263 - st); av[j] = At[(size_t)kk[j] * 1024]; hv[j] = He[(size_t)kk[j] * 1024]; }
#pragma unroll
        for (int j = 0; j < 26; ++j) { Cy[(size_t)kk[j] * 1024] = h; h = av[j] * h + hv[j]; }
    }
}
__device__ __forceinline__ void lru_in_gemm_phase(Frame& F, const Args& a) {
    gg::DenseSched S; S.init((const bf16_t*)(a.ws + WS_U), (const bf16_t*)(a.ws + WS_W_LRU_IN), NTOK, 2048, 1024, 1024);
    EpiLruIn E{(bf16_t*)(a.ws + WS_MX0), (bf16_t*)(a.ws + WS_MX1)};
    gg::gemm_phase<EpiLruIn, gg::DenseSched, false, false>(F.lds + LDS_STAGE, gg::Dims{1024, 1024, 1024, 0, 0}, S, E);
}
__device__ __forceinline__ void dense_gemm_bf16(Frame& F, const bf16_t* A, const bf16_t* Bt, bf16_t* O, int M, int N, int K) {
    gg::DenseSched S; S.init(A, Bt, M, N, K, K);
    EpiBf16 E{O, N};
    gg::gemm_phase<EpiBf16, gg::DenseSched, false, false>(F.lds + LDS_STAGE, gg::Dims{K, K, K, 0, 0}, S, E);
}

constexpr size_t RT_QR = WS_SCR, RT_KR = WS_SCR + 33 * MiB, RT_V = WS_SCR + 66 * MiB, RT_SG = WS_SCR + 132 * MiB, RT_ACAT = WS_SCR + 198 * MiB, RT_KTD = WS_SCR + 301 * MiB,
                 RT_VT = WS_SCR + 367 * MiB, RT_ST = WS_SCR + 433 * MiB, RT_O = WS_SCR + 564 * MiB, RT_A3 = RT_V, RT_END = WS_SCR + 630 * MiB;
constexpr int NBLK = NTOK / 256;
struct EpiBf16X {
    static constexpr bool PERM = true;
    bf16_t* O; int ldc;
    __device__ __forceinline__ void operator()(const gg::Acc& acc, const gg::Unit& u, int wr, int wc, int fr, int fq) const {
#pragma unroll
        for (int ai = 0; ai < 2; ++ai)
#pragma unroll
            for (int m = 0; m < 4; ++m) { bf16_t* rp = O + (size_t)(unsigned)u.x + (size_t)(ai * 128 + wr * 64 + m * 16 + fr) * ldc + wc * 32 + 8 * fq;
#pragma unroll
                for (int bj = 0; bj < 2; ++bj) { const f32x4 v0 = acc[ai][bj][m][0], v1 = acc[ai][bj][m][1];
                    u32x4 o; o.x = pk2(v0[0], v0[1]); o.y = pk2(v0[2], v0[3]); o.z = pk2(v1[0], v1[1]); o.w = pk2(v1[2], v1[3]);
                    *(u32x4*)(rp + bj * 128) = o; } }
    }
};
__device__ __forceinline__ float log_sigmoid(float x) { return -(fmaxf(-x, 0.f) + log1pf(__expf(-fabsf(x)))); }
struct EpiRetIn {
    static constexpr bool PERM = true;
    bf16_t *QR, *KR, *V, *SG, *ACAT; const float* rope; const float* decay;
    __device__ __forceinline__ void operator()(const gg::Acc& acc, const gg::Unit& u, int wr, int wc, int fr, int fq) const {
        const int pn = u.pn, row0 = u.pm * 256 + wr * 64 + fr, cx = wc * 32 + 8 * fq;
        if (pn < 8) {
            const int h = pn & 3; const bool isq = pn < 4;
            const float lg0 = log_sigmoid(decay[h]), lg1 = log_sigmoid(decay[4 + h]);
#pragma unroll
            for (int ai = 0; ai < 2; ++ai)
#pragma unroll
                for (int m = 0; m < 4; ++m) {
                    const int row = row0 + ai * 128 + m * 16, i = row & 255, b = row >> 8;
                    f32x4 lo[2] = {acc[ai][0][m][0], acc[ai][0][m][1]}, hi[2] = {acc[ai][1][m][0], acc[ai][1][m][1]};
                    if (row >= NCTX) {
                        const int tl = row - NCTX, pp = (wc < 2) ? (tl >> 6) : (tl & 63), i0 = (wc & 1) * 32 + 8 * fq;
                        const float* cp = rope + pp * 64 + i0; const float* sp = cp + 256 * 64;
#pragma unroll
                        for (int n = 0; n < 2; ++n) { const f32x4 c = *(const f32x4*)(cp + 4 * n), sn = *(const f32x4*)(sp + 4 * n);
                            const f32x4 l2 = lo[n] * c - hi[n] * sn, h2 = hi[n] * c + lo[n] * sn; lo[n] = l2; hi[n] = h2; }
                    }
                    if (isq) {
                        u32x4 o; o.x = pk2(lo[0][0], lo[0][1]); o.y = pk2(lo[0][2], lo[0][3]); o.z = pk2(lo[1][0], lo[1][1]); o.w = pk2(lo[1][2], lo[1][3]);
                        *(u32x4*)(QR + (size_t)row * 1024 + h * 256 + cx) = o;
                        o.x = pk2(hi[0][0], hi[0][1]); o.y = pk2(hi[0][2], hi[0][3]); o.z = pk2(hi[1][0], hi[1][1]); o.w = pk2(hi[1][2], hi[1][3]);
                        *(u32x4*)(QR + (size_t)row * 1024 + h * 256 + 128 + cx) = o;
                        bf16_t* ac = ACAT + ((size_t)(b * 4 + h) * 256 + i) * 768 + 256 + cx;
#pragma unroll
                        for (int d = 0; d < 2; ++d) { const float f = d ? __expf((float)(256 - i) * lg1) : __expf((float)(i + 1) * lg0);
                            o.x = pk2(lo[0][0] * f, lo[0][1] * f); o.y = pk2(lo[0][2] * f, lo[0][3] * f); o.z = pk2(lo[1][0] * f, lo[1][1] * f); o.w = pk2(lo[1][2] * f, lo[1][3] * f);
                            *(u32x4*)(ac + d * 256) = o;
                            o.x = pk2(hi[0][0] * f, hi[0][1] * f); o.y = pk2(hi[0][2] * f, hi[0][3] * f); o.z = pk2(hi[1][0] * f, hi[1][1] * f); o.w = pk2(hi[1][2] * f, hi[1][3] * f);
                            *(u32x4*)(ac + d * 256 + 128) = o; }
                    } else {
                        const float f = 0.0625f;
                        u32x4 o; o.x = pk2(lo[0][0] * f, lo[0][1] * f); o.y = pk2(lo[0][2] * f, lo[0][3] * f); o.z = pk2(lo[1][0] * f, lo[1][1] * f); o.w = pk2(lo[1][2] * f, lo[1][3] * f);
                        *(u32x4*)(KR + (size_t)row * 1024 + h * 256 + cx) = o;
                        o.x = pk2(hi[0][0] * f, hi[0][1] * f); o.y = pk2(hi[0][2] * f, hi[0][3] * f); o.z = pk2(hi[1][0] * f, hi[1][1] * f); o.w = pk2(hi[1][2] * f, hi[1][3] * f);
                        *(u32x4*)(KR + (size_t)row * 1024 + h * 256 + 128 + cx) = o;
                    }
                }
        } else {
            const bool isv = pn < 16; bf16_t* O = isv ? V : SG; const int col0 = ((pn - 8) & 7) * 256 + cx;
#pragma unroll
            for (int ai = 0; ai < 2; ++ai)
#pragma unroll
                for (int m = 0; m < 4; ++m) { bf16_t* rp = O + (size_t)(row0 + ai * 128 + m * 16) * 2048 + col0;
#pragma unroll
                    for (int bj = 0; bj < 2; ++bj) { f32x4 v0 = acc[ai][bj][m][0], v1 = acc[ai][bj][m][1];
                        if (!isv) {
#pragma unroll
                            for (int e = 0; e < 4; ++e) { v0[e] = siluf_(v0[e]); v1[e] = siluf_(v1[e]); } }
                        u32x4 o; o.x = pk2(v0[0], v0[1]); o.y = pk2(v0[2], v0[3]); o.z = pk2(v1[0], v1[1]); o.w = pk2(v1[2], v1[3]);
                        *(u32x4*)(rp + bj * 128) = o; } }
        }
    }
};
__device__ __forceinline__ void ret_in_gemm_phase(Frame& F, const Args& a) {
    gg::DenseSched S; S.init((const bf16_t*)(a.ws + WS_U), (const bf16_t*)(a.ws + WS_W_RET_IN), NTOK, 6144, 1024, 1024);
    EpiRetIn E{(bf16_t*)(a.ws + RT_QR), (bf16_t*)(a.ws + RT_KR), (bf16_t*)(a.ws + RT_V), (bf16_t*)(a.ws + RT_SG), (bf16_t*)(a.ws + RT_ACAT), (const float*)(a.ws + WS_ROPE), a.in[32]};
    gg::gemm_phase<EpiRetIn, gg::DenseSched, false, false>(F.lds + LDS_STAGE, gg::Dims{1024, 1024, 1024, 0, 0}, S, E);
}
__device__ __forceinline__ void tr64_bf16(const bf16_t* src, int ld_src, bf16_t* dst, int ld_dst, LAS unsigned char* scr, int lane, float lgam, int mode, int t0) {
    const int cg = lane & 7, rg = lane >> 3;
#pragma unroll
    for (int k = 0; k < 8; ++k) { const int t = rg + 8 * k; const u32x4 v = *(const u32x4*)(src + (size_t)t * ld_src + 8 * cg);
        float f = 1.0f; if (mode) { const int i = (t0 + t) & 255; f = __expf((float)(mode == 1 ? 255 - i : i) * lgam); }
        const unsigned w[4] = {v.x, v.y, v.z, v.w};
#pragma unroll
        for (int e = 0; e < 4; ++e) { *(LAS unsigned short*)(scr + (8 * cg + 2 * e) * 144 + t * 2) = (unsigned short)f2bf(bflo(w[e]) * f); *(LAS unsigned short*)(scr + (8 * cg + 2 * e + 1) * 144 + t * 2) = (unsigned short)f2bf(bfhi(w[e]) * f); } }
    asm volatile("s_waitcnt lgkmcnt(0)" ::: "memory");
#pragma unroll
    for (int k = 0; k < 8; ++k) { const int c = rg + 8 * k; const u32x4 v = *(const LAS u32x4*)(scr + c * 144 + 16 * cg); *(u32x4*)(dst + (size_t)c * ld_dst + 8 * cg) = v; }
    asm volatile("s_waitcnt lgkmcnt(0)" ::: "memory");
}
__device__ __forceinline__ void ret_transpose_phase(Frame& F, const Args& a) {
    const bf16_t* KR = (const bf16_t*)(a.ws + RT_KR); const bf16_t* V = (const bf16_t*)(a.ws + RT_V); bf16_t* KTD = (bf16_t*)(a.ws + RT_KTD); bf16_t* VT = (bf16_t*)(a.ws + RT_VT);
    LAS unsigned char* scr = F.lds + LDS_STAGE + F.wave * 9216;
    const float* decay = a.in[32];
    constexpr int NT = NTOK / 64;
    for (int it = F.gw; it < NT * (32 + 32); it += F.ngw) {
        const int tt = it % NT, cc = it / NT, t0 = tt * 64;
        if (cc < 32) { const int d = cc >> 4, c0 = (cc & 15) * 64, h = c0 >> 8; const float lg = log_sigmoid(decay[d * 4 + h]);
            tr64_bf16(KR + (size_t)t0 * 1024 + c0, 1024, KTD + ((size_t)d * 1024 + c0) * NTOK + t0, NTOK, scr, F.lane, lg, d ? 2 : 1, t0); }
        else { const int c0 = (cc - 32) * 64; tr64_bf16(V + (size_t)t0 * 2048 + c0, 2048, VT + (size_t)c0 * NTOK + t0, NTOK, scr, F.lane, 0.f, 0, t0); }
    }
}
struct RetKvSched {
    const char* VT; const char* KTD; int G, c;
    __device__ __forceinline__ bool next(int i, gg::Unit& u) const {
        const int L0 = i * G + c; if (L0 >= NBLK * 16) return false; const int L = xcd_remap(L0, NBLK * 16);
        const int dvt = L & 1, d = (L >> 1) & 1, h = (L >> 2) & 3, b = L >> 4;
        u.a = VT + ((size_t)(512 * h + 256 * dvt) * NTOK + 256 * b) * 2; u.b = KTD + ((size_t)(d * 1024 + 256 * h) * NTOK + 256 * b) * 2; u.b2 = nullptr;
        u.pm = 0; u.pn = 0; u.gofs = 0; u.x = ((b * 4 + h) * 512 + 256 * dvt) * 512 + 256 * d; return true; }
};
__device__ __forceinline__ void ret_kv_phase(Frame& F, const Args& a) {
    RetKvSched S{(const char*)(a.ws + RT_VT), (const char*)(a.ws + RT_KTD), (int)gridDim.x, (int)blockIdx.x};
    EpiBf16X E{(bf16_t*)(a.ws + RT_ST), 512};
    gg::gemm_phase<EpiBf16X, RetKvSched, false, false>(F.lds + LDS_STAGE, gg::Dims{256, NTOK, NTOK, 0, 0}, S, E);
}
template <bool DRY = false>
__device__ __forceinline__ void ret_prefix_phase(Frame& F, const Args& a) {
    bf16_t* ST = (bf16_t*)(a.ws + (DRY ? WS_DUMMY : RT_ST)); const float* decay = a.in[32];
    for (int gid = blockIdx.x * NTHREADS + F.tid; gid < 4 * 512 * 2 * 32; gid += gridDim.x * NTHREADS) {
        const int dk8 = gid & 31, d = (gid >> 5) & 1, dv = (gid >> 6) & 511, h = gid >> 15;
        const float gb = __expf(256.0f * log_sigmoid(decay[d * 4 + h]));
        float s[8];
#pragma unroll
        for (int e = 0; e < 8; ++e) s[e] = 0.f;
#define RT_BLK(st_) (((d == 0) || (st_) == 0) ? (st_) : (NBLK - (st_)))
#define RT_PTR(st_) ((u32x4*)(ST + ((size_t)(RT_BLK(st_) * 4 + h) * 512 + dv) * 512 + d * 256 + 8 * dk8))
        u32x4 kb[4];
#pragma unroll
        for (int j = 0; j < 4; ++j) kb[j] = *RT_PTR(j);
#pragma unroll 1
        for (int base = 0; base < 68; base += 4) {
#pragma unroll
            for (int j = 0; j < 4; ++j) { const int step = base + j; if (step < NBLK) {
                u32x4* p = RT_PTR(step); const u32x4 kv = kb[j];
                if (step + 4 < NBLK) kb[j] = *RT_PTR(step + 4);
                u32x4 o; o.x = pk2(s[0], s[1]); o.y = pk2(s[2], s[3]); o.z = pk2(s[4], s[5]); o.w = pk2(s[6], s[7]); *p = o;
                s[0] = s[0] * gb + bflo(kv.x); s[1] = s[1] * gb + bfhi(kv.x); s[2] = s[2] * gb + bflo(kv.y); s[3] = s[3] * gb + bfhi(kv.y);
                s[4] = s[4] * gb + bflo(kv.z); s[5] = s[5] * gb + bfhi(kv.z); s[6] = s[6] * gb + bflo(kv.w); s[7] = s[7] * gb + bfhi(kv.w); } }
        }
#undef RT_BLK
#undef RT_PTR
    }
    bf16_t* ACAT = (bf16_t*)(a.ws + (DRY ? WS_DUMMY + 140 * MiB : RT_ACAT));
    for (int gid = blockIdx.x * NTHREADS + F.tid; gid < NBLK * 4 * 256 * 32; gid += gridDim.x * NTHREADS) {
        const int j0 = (gid & 31) * 8, i = (gid >> 5) & 255, bh = gid >> 13, h = bh & 3;
        const float lg0 = log_sigmoid(decay[h]), lg1 = log_sigmoid(decay[4 + h]);
        u32x4* p = (u32x4*)(ACAT + ((size_t)bh * 256 + i) * 768 + j0);
        const u32x4 v = *p; const unsigned w[4] = {v.x, v.y, v.z, v.w}; unsigned o[4];
#pragma unroll
        for (int e = 0; e < 4; ++e) { const int ja = j0 + 2 * e, jb = ja + 1;
            const float wa = ((i >= ja) ? __expf((float)(i - ja) * lg0) : 0.f) + ((ja >= i) ? __expf((float)(ja - i) * lg1) : 0.f);
            const float wb = ((i >= jb) ? __expf((float)(i - jb) * lg0) : 0.f) + ((jb >= i) ? __expf((float)(jb - i) * lg1) : 0.f);
            o[e] = pk2(bflo(w[e]) * wa, bfhi(w[e]) * wb); }
        *p = (u32x4){o[0], o[1], o[2], o[3]};
    }
}
struct RetPSched {
    const char* QR; const char* KR; int G, c;
    __device__ __forceinline__ bool next(int i, gg::Unit& u) const {
        const int L0 = i * G + c; if (L0 >= NBLK * 4) return false; const int L = xcd_remap(L0, NBLK * 4);
        const int h = L & 3, b = L >> 2;
        u.a = QR + ((size_t)256 * b * 1024 + 256 * h) * 2; u.b = KR + ((size_t)256 * b * 1024 + 256 * h) * 2; u.b2 = nullptr;
        u.pm = b; u.pn = h; u.gofs = 0; u.x = (b * 4 + h) * 256 * 768; return true; }
};
__device__ __forceinline__ void ret_p_phase(Frame& F, const Args& a) {
    RetPSched S{(const char*)(a.ws + RT_QR), (const char*)(a.ws + RT_KR), (int)gridDim.x, (int)blockIdx.x};
    EpiBf16X E{(bf16_t*)(a.ws + RT_ACAT), 768};
    gg::gemm_phase<EpiBf16X, RetPSched, false, false>(F.lds + LDS_STAGE, gg::Dims{256, 1024, 1024, 0, 0}, S, E);
}
struct RetOSched {
    const char* ACAT; const char* VT; const char* ST; int G, c;
    __device__ __forceinline__ bool next(int i, gg::Unit& u) const {
        const int L0 = i * G + c; if (L0 >= NBLK * 8) return false; const int L = xcd_remap(L0, NBLK * 8);
        const int dvt = L & 1, h = (L >> 1) & 3, b = L >> 3;
        u.a = ACAT + (size_t)(b * 4 + h) * 256 * 768 * 2; u.b = VT + ((size_t)(512 * h + 256 * dvt) * NTOK + 256 * b) * 2; u.b2 = ST + ((size_t)((b * 4 + h) * 512 + 256 * dvt) * 512) * 2;
        u.pm = 0; u.pn = 0; u.gofs = 0; u.x = 256 * b * 2048 + 512 * h + 256 * dvt; return true; }
};
__device__ __forceinline__ void ret_o_phase(Frame& F, const Args& a) {
    RetOSched S{(const char*)(a.ws + RT_ACAT), (const char*)(a.ws + RT_VT), (const char*)(a.ws + RT_ST), (int)gridDim.x, (int)blockIdx.x};
    EpiBf16X E{(bf16_t*)(a.ws + RT_O), 2048};
    gg::gemm_phase<EpiBf16X, RetOSched, false, true>(F.lds + LDS_STAGE, gg::Dims{768, 768, NTOK, 4, 512}, S, E);
}
__device__ __forceinline__ void ret_readout_phase(Frame& F, const Args& a) {
    const bf16_t* O = (const bf16_t*)(a.ws + RT_O); const bf16_t* SG = (const bf16_t*)(a.ws + RT_SG); bf16_t* A3 = (bf16_t*)(a.ws + RT_A3);
    const float* gg_ = a.in[33]; const float* gb_ = a.in[34];
    const int lane = F.lane;
    for (int t = F.gw; t < NTOK; t += F.ngw) {
        float v[32]; float s = 0.f;
#pragma unroll
        for (int k = 0; k < 4; ++k) { const u32x4 w = *(const u32x4*)(O + (size_t)t * 2048 + 32 * lane + 8 * k);
            v[8 * k] = bflo(w.x); v[8 * k + 1] = bfhi(w.x); v[8 * k + 2] = bflo(w.y); v[8 * k + 3] = bfhi(w.y); v[8 * k + 4] = bflo(w.z); v[8 * k + 5] = bfhi(w.z); v[8 * k + 6] = bflo(w.w); v[8 * k + 7] = bfhi(w.w); }
#pragma unroll
        for (int e = 0; e < 32; ++e) s += v[e];
#pragma unroll
        for (int o = 1; o < 16; o <<= 1) s += __shfl_xor(s, o);
        const float mean = s * (1.0f / 512.0f); float q = 0.f;
#pragma unroll
        for (int e = 0; e < 32; ++e) { v[e] -= mean; q += v[e] * v[e]; }
#pragma unroll
        for (int o = 1; o < 16; o <<= 1) q += __shfl_xor(q, o);
        const float rstd = 1.0f / sqrtf(q * (1.0f / 512.0f) + LN_EPS);
#pragma unroll
        for (int k = 0; k < 4; ++k) { const u32x4 g = *(const u32x4*)(SG + (size_t)t * 2048 + 32 * lane + 8 * k); const unsigned gw[4] = {g.x, g.y, g.z, g.w}; unsigned ow[4];
#pragma unroll
            for (int e = 0; e < 4; ++e) { const int c = 32 * lane + 8 * k + 2 * e;
                const float y0 = (v[8 * k + 2 * e] * rstd * gg_[c] + gb_[c]) * bflo(gw[e]), y1 = (v[8 * k + 2 * e + 1] * rstd * gg_[c + 1] + gb_[c + 1]) * bfhi(gw[e]); ow[e] = pk2(y0, y1); }
            *(u32x4*)(A3 + (size_t)t * 2048 + 32 * lane + 8 * k) = (u32x4){ow[0], ow[1], ow[2], ow[3]}; }
    }
}

constexpr size_t HG_Q = WS_SCR, HG_F = WS_SCR + 33 * MiB, HG_V = WS_SCR + 99 * MiB, HG_G = WS_SCR + 132 * MiB, HG_O = WS_SCR + 165 * MiB, HG_S = WS_SCR + 231 * MiB, HG_D = WS_SCR + 297 * MiB, HG_A4 = HG_Q;
struct EpiHgrnIn {
    static constexpr bool PERM = true;
    bf16_t *Q, *Fp, *V, *G;
    __device__ __forceinline__ void operator()(const gg::Acc& acc, const gg::Unit& u, int wr, int wc, int fr, int fq) const {
        const int grp = u.pn >> 2; const bool act = (grp == 0 || grp == 4);
        bf16_t* O = grp == 0 ? Q : grp == 1 ? Fp : grp == 2 ? Fp + (size_t)NTOK * 1024 : grp == 3 ? V : G;
        const int row0 = u.pm * 256 + wr * 64 + fr, col0 = (u.pn & 3) * 256 + wc * 32 + 8 * fq;
#pragma unroll
        for (int ai = 0; ai < 2; ++ai)
#pragma unroll
            for (int m = 0; m < 4; ++m) { bf16_t* rp = O + (size_t)(row0 + ai * 128 + m * 16) * 1024 + col0;
#pragma unroll
                for (int bj = 0; bj < 2; ++bj) { f32x4 v0 = acc[ai][bj][m][0], v1 = acc[ai][bj][m][1];
                    if (act) {
#pragma unroll
                        for (int e = 0; e < 4; ++e) { v0[e] = siluf_(v0[e]); v1[e] = siluf_(v1[e]); } }
                    u32x4 o; o.x = pk2(v0[0], v0[1]); o.y = pk2(v0[2], v0[3]); o.z = pk2(v1[0], v1[1]); o.w = pk2(v1[2], v1[3]);
                    *(u32x4*)(rp + bj * 128) = o; } }
    }
};
__device__ __forceinline__ void hgrn_in_gemm_phase(Frame& F, const Args& a) {
    gg::DenseSched S; S.init((const bf16_t*)(a.ws + WS_U), (const bf16_t*)(a.ws + WS_W_HGRN_IN), NTOK, 5120, 1024, 1024);
    EpiHgrnIn E{(bf16_t*)(a.ws + HG_Q), (bf16_t*)(a.ws + HG_F), (bf16_t*)(a.ws + HG_V), (bf16_t*)(a.ws + HG_G)};
    gg::gemm_phase<EpiHgrnIn, gg::DenseSched, false, false>(F.lds + LDS_STAGE, gg::Dims{1024, 1024, 1024, 0, 0}, S, E);
}
typedef short v4s16 __attribute__((ext_vector_type(4)));
__device__ __forceinline__ bf16x8 lds_tr_frag(LAS unsigned char* tile, int stride, int r0, int c0, int lane) {
    const int g = lane >> 4, qq = (lane & 15) >> 2, p = lane & 3;
    LAS unsigned char* a0 = tile + (r0 + 8 * g + qq) * stride + (c0 + 4 * p) * 2;
    const v4s16 x = __builtin_amdgcn_ds_read_tr16_b64_v4i16((LAS v4s16*)a0), y = __builtin_amdgcn_ds_read_tr16_b64_v4i16((LAS v4s16*)(a0 + 4 * stride));
    return (bf16x8){x[0], x[1], x[2], x[3], y[0], y[1], y[2], y[3]};
}
__device__ __forceinline__ bf16x8 lds_row_frag(LAS unsigned char* tile, int stride, int row, int k0) { return *(const LAS bf16x8*)(tile + row * stride + k0 * 2); }
constexpr int HS = 272, HPS = 144;
template <int PASS>
__device__ __forceinline__ void hgrn_chunk_phase(Frame& F, const Args& a) {
    const bf16_t* Qb = (const bf16_t*)(a.ws + HG_Q); const bf16_t* Fb = (const bf16_t*)(a.ws + HG_F); const bf16_t* Vb = (const bf16_t*)(a.ws + HG_V);
    bf16_t* Ob = (bf16_t*)(a.ws + HG_O); float* Sb = (float*)(a.ws + HG_S); float* Db = (float*)(a.ws + HG_D);
    const float* LBV = (const float*)(a.ws + WS_LBV); const float* bfp = a.in[37];
    LAS unsigned char* QH = F.lds + LDS_STAGE; LAS unsigned char* KH = QH + 17408; LAS unsigned char* KB = QH + 34816; LAS unsigned char* VV = QH + 52224;
    LAS unsigned char* PP = QH + 69632; LAS unsigned char* SS = QH + 78848; LAS float* DEC = (LAS float*)(QH + 113664); LAS float* TOT = (LAS float*)(QH + 114176);
    const int tid = F.tid, lane = F.lane, w = F.wave, k = tid & 127, tg = tid >> 7, c16 = lane & 15, q4 = lane >> 4;
    const int lrow = tid >> 3, c8 = tid & 7;
    u32x4 rF[2], rV[2], rQ[2];
#define HG_ISSUE(unit_, bi_) do { const int d_ = (unit_) & 1, h_ = ((unit_) >> 1) & 7, seg_ = (unit_) >> 4; const int tr_ = (seg_ * 4 + (d_ ? 3 - (bi_) : (bi_))) * 64; \
        const size_t o_ = (size_t)(tr_ + (d_ ? 63 - lrow : lrow)) * 1024 + h_ * 128 + 8 * c8; const bf16_t* Fd_ = Fb + (size_t)d_ * NTOK * 1024; \
        rF[0] = *(const u32x4*)(Fd_ + o_); rF[1] = *(const u32x4*)(Fd_ + o_ + 64); rV[0] = *(const u32x4*)(Vb + o_); rV[1] = *(const u32x4*)(Vb + o_ + 64); \
        if (PASS) { rQ[0] = *(const u32x4*)(Qb + o_); rQ[1] = *(const u32x4*)(Qb + o_ + 64); } } while (0)
    if ((int)blockIdx.x < 65 * 16) HG_ISSUE((int)blockIdx.x, 0);
#pragma unroll 1
    for (int unit = blockIdx.x; unit < 65 * 16; unit += gridDim.x) {
        const int d = unit & 1, h = (unit >> 1) & 7, seg = unit >> 4, ch = h * 128 + k;
        const float lbv = LBV[ch], bfv = bfp[d * 1024 + ch];
        const bf16_t* Fd = Fb + (size_t)d * NTOK * 1024;
        f32x4 accS[8]; float dseg = 1.0f;
        float* Su = Sb + (size_t)unit * 16384;
#pragma unroll
        for (int kt = 0; kt < 8; ++kt)
#pragma unroll
            for (int r = 0; r < 4; ++r) accS[kt][r] = PASS ? Su[(16 * kt + 4 * q4 + r) * 128 + 16 * w + c16] : 0.f;
        if (PASS) {
#pragma unroll
            for (int kt = 0; kt < 8; ++kt)
#pragma unroll
                for (int r = 0; r < 4; ++r) *(LAS unsigned short*)(SS + (16 * kt + 4 * q4 + r) * HS + (16 * w + c16) * 2) = (unsigned short)f2bf(accS[kt][r]);
        }
#pragma unroll 1
        for (int bi = 0; bi < 4; ++bi) {
            const int trow0 = (seg * 4 + (d ? 3 - bi : bi)) * 64;
            { const int lo_ = lrow * HS + 16 * c8;
              *(LAS u32x4*)(KB + lo_) = rF[0]; *(LAS u32x4*)(KB + lo_ + 128) = rF[1]; *(LAS u32x4*)(VV + lo_) = rV[0]; *(LAS u32x4*)(VV + lo_ + 128) = rV[1];
              if (PASS) { *(LAS u32x4*)(QH + lo_) = rQ[0]; *(LAS u32x4*)(QH + lo_ + 128) = rQ[1]; } }
            { const int nu = bi < 3 ? unit : unit + (int)gridDim.x, nb = bi < 3 ? bi + 1 : 0; if (nu < 65 * 16) HG_ISSUE(nu, nb); }
            __syncthreads();
            float lfc[16]; float run = 0.f;
#pragma unroll
            for (int ii = 0; ii < 16; ++ii) { const int i = tg * 16 + ii;
                const float fp = bf2f(*(const LAS unsigned short*)(KB + i * HS + k * 2)); const float f = lbv + (1.0f - lbv) * sigmoidf_(fp + bfv);
                run += __logf(f); lfc[ii] = run; }
            TOT[tg * 128 + k] = run;
            __syncthreads();
            float off = 0.f, btot = 0.f;
#pragma unroll
            for (int g2 = 0; g2 < 4; ++g2) { const float tv = TOT[g2 * 128 + k]; btot += tv; if (g2 < tg) off += tv; }
#pragma unroll
            for (int ii = 0; ii < 16; ++ii) { const int i = tg * 16 + ii; const float B = off + lfc[ii];
                const float lf = lfc[ii] - (ii ? lfc[ii - 1] : 0.f); const float kkv = 1.0f - __expf(lf);
                *(LAS unsigned short*)(KB + i * HS + k * 2) = (unsigned short)f2bf(kkv * __expf(btot - B));
                if (PASS) { const float qv = bf2f(*(const LAS unsigned short*)(QH + i * HS + k * 2));
                            *(LAS unsigned short*)(QH + i * HS + k * 2) = (unsigned short)f2bf(qv * __expf(B));
                            *(LAS unsigned short*)(KH + i * HS + k * 2) = (unsigned short)f2bf(kkv * __expf(fminf(-B, 80.0f))); }
                if ((ii & 3) == 3) asm volatile("" ::: "memory"); }
            if (tg == 0) { const float e = __expf(btot); DEC[k] = e; dseg *= e; }
            __syncthreads();
            f32x4 ao[4];
            if (PASS) {
#pragma unroll
                for (int s2 = 0; s2 < 2; ++s2) { const int it = w >> 1, jt = 2 * (w & 1) + s2; f32x4 sc = {0.f, 0.f, 0.f, 0.f};
#pragma unroll
                    for (int ks = 0; ks < 4; ++ks) sc = __builtin_amdgcn_mfma_f32_16x16x32_bf16(lds_row_frag(QH, HS, 16 * it + c16, 32 * ks + 8 * q4), lds_row_frag(KH, HS, 16 * jt + c16, 32 * ks + 8 * q4), sc, 0, 0, 0);
#pragma unroll
                    for (int r = 0; r < 4; ++r) { const int i = 16 * it + 4 * q4 + r, j = 16 * jt + c16; *(LAS unsigned short*)(PP + i * HPS + j * 2) = (unsigned short)f2bf(j <= i ? sc[r] : 0.f); } }
                __syncthreads();
#pragma unroll
                for (int it = 0; it < 4; ++it) ao[it] = (f32x4){0.f, 0.f, 0.f, 0.f};
            }
            bf16x8 vf[2];
#pragma unroll
            for (int ks = 0; ks < 2; ++ks) vf[ks] = lds_tr_frag(VV, HS, 32 * ks, 16 * w, lane);
            if (PASS) {
#pragma unroll
                for (int ks = 0; ks < 2; ++ks)
#pragma unroll
                    for (int it = 0; it < 4; ++it) ao[it] = __builtin_amdgcn_mfma_f32_16x16x32_bf16(lds_row_frag(PP, HPS, 16 * it + c16, 32 * ks + 8 * q4), vf[ks], ao[it], 0, 0, 0);
#pragma unroll 1
                for (int ks = 0; ks < 4; ++ks) { const bf16x8 sf = lds_tr_frag(SS, HS, 32 * ks, 16 * w, lane);
#pragma unroll
                    for (int it = 0; it < 4; ++it) ao[it] = __builtin_amdgcn_mfma_f32_16x16x32_bf16(lds_row_frag(QH, HS, 16 * it + c16, 32 * ks + 8 * q4), sf, ao[it], 0, 0, 0); }
            }
#pragma unroll
            for (int kt = 0; kt < 8; ++kt) {
#pragma unroll
                for (int r = 0; r < 4; ++r) accS[kt][r] *= DEC[16 * kt + 4 * q4 + r];
#pragma unroll
                for (int ks = 0; ks < 2; ++ks) accS[kt] = __builtin_amdgcn_mfma_f32_16x16x32_bf16(lds_tr_frag(KB, HS, 32 * ks, 16 * kt, lane), vf[ks], accS[kt], 0, 0, 0);
            }
            __syncthreads();
            if (PASS) {
#pragma unroll
                for (int kt = 0; kt < 8; ++kt)
#pragma unroll
                    for (int r = 0; r < 4; ++r) *(LAS unsigned short*)(SS + (16 * kt + 4 * q4 + r) * HS + (16 * w + c16) * 2) = (unsigned short)f2bf(accS[kt][r]);
#pragma unroll
                for (int it = 0; it < 4; ++it)
#pragma unroll
                    for (int r = 0; r < 4; ++r) *(LAS unsigned short*)(KH + (16 * it + 4 * q4 + r) * HS + (16 * w + c16) * 2) = (unsigned short)f2bf(ao[it][r]);
                __syncthreads();
                bf16_t* Od = Ob + (size_t)d * NTOK * 1024;
#pragma unroll
                for (int cc = 0; cc < 2; ++cc) { const int row = tid >> 3, chunk = (tid & 7) + 8 * cc, t = trow0 + (d ? 63 - row : row);
                    *(u32x4*)(Od + (size_t)t * 1024 + h * 128 + 8 * chunk) = *(const LAS u32x4*)(KH + row * HS + 16 * chunk); }
            }
        }
        if (!PASS) {
#pragma unroll
            for (int kt = 0; kt < 8; ++kt)
#pragma unroll
                for (int r = 0; r < 4; ++r) Su[(16 * kt + 4 * q4 + r) * 128 + 16 * w + c16] = accS[kt][r];
            if (tg == 0) Db[(size_t)unit * 128 + k] = dseg;
        }
        __syncthreads();
    }
}
#undef HG_ISSUE
template <bool DRY = false>
__device__ __forceinline__ void hgrn_prefix_phase(Frame& F, const Args& a) {
    float* Sb = (float*)(a.ws + (DRY ? WS_DUMMY : HG_S)); const float* Db = (const float*)(a.ws + HG_D);
    for (int gid = blockIdx.x * NTHREADS + F.tid; gid < 16 * 4096; gid += gridDim.x * NTHREADS) {
        const int hd = gid >> 12, e4 = gid & 4095, krow = e4 >> 5, d = hd & 1;
        f32x4 s = {0.f, 0.f, 0.f, 0.f};
#define HG_SEG(st_) (((d == 0) || (st_) == 0) ? (st_) : 65 - (st_))
        f32x4 lb[4]; float db[4];
#pragma unroll
        for (int j = 0; j < 4; ++j) { const int u2 = HG_SEG(j) * 16 + hd; lb[j] = *((const f32x4*)(Sb + (size_t)u2 * 16384) + e4); db[j] = Db[(size_t)u2 * 128 + krow]; }
#pragma unroll 1
        for (int base = 0; base < 68; base += 4) {
#pragma unroll
            for (int j = 0; j < 4; ++j) { const int step = base + j; if (step < 65) {
                const int unit = HG_SEG(step) * 16 + hd; f32x4* p = (f32x4*)(Sb + (size_t)unit * 16384) + e4; const f32x4 loc = lb[j]; const float dec = db[j];
                if (step + 4 < 65) { const int u2 = HG_SEG(step + 4) * 16 + hd; lb[j] = *((const f32x4*)(Sb + (size_t)u2 * 16384) + e4); db[j] = Db[(size_t)u2 * 128 + krow]; }
                *p = s; s = s * dec + loc; } }
        }
#undef HG_SEG
    }
}
__device__ __forceinline__ void hgrn_readout_phase(Frame& F, const Args& a) {
    const bf16_t* O0 = (const bf16_t*)(a.ws + HG_O); const bf16_t* O1 = O0 + (size_t)NTOK * 1024; const bf16_t* G = (const bf16_t*)(a.ws + HG_G); bf16_t* A4 = (bf16_t*)(a.ws + HG_A4);
    const float* ng = a.in[39]; const int lane = F.lane;
    float gn[8];
#pragma unroll
    for (int e = 0; e < 8; ++e) gn[e] = ng[(8 * lane + e) & 127];
    for (int t = F.gw; t < NTOK; t += F.ngw) {
        float o[16], g[16]; ldrow_bf16(O0 + (size_t)t * 1024, lane, o); addrow_bf16(O1 + (size_t)t * 1024, lane, o); ldrow_bf16(G + (size_t)t * 1024, lane, g);
#pragma unroll
        for (int j = 0; j < 2; ++j) { float q = 0.f;
#pragma unroll
            for (int e = 0; e < 8; ++e) q += o[8 * j + e] * o[8 * j + e];
#pragma unroll
            for (int m = 1; m < 16; m <<= 1) q += __shfl_xor(q, m);
            const float rs = 1.0f / sqrtf(q * (1.0f / 128.0f) + LN_EPS);
#pragma unroll
            for (int e = 0; e < 8; ++e) o[8 * j + e] = o[8 * j + e] * rs * gn[e] * g[8 * j + e]; }
        strow_bf16(A4 + (size_t)t * 1024, lane, o);
    }
}

constexpr size_t RW_XM = WS_SCR, RW_WW = WS_SCR, RW_AA = WS_SCR + 131 * MiB, RW_R = WS_SCR + 196 * MiB, RW_K = WS_SCR + 229 * MiB, RW_V = WS_SCR + 262 * MiB, RW_L1 = WS_SCR + 295 * MiB,
                 RW_G = WS_SCR + 321 * MiB, RW_REC = WS_SCR + 354 * MiB, RW_PQ = WS_SCR + (RWKV_CHUNKED ? 354 : 0) * MiB, RW_SST = WS_SCR + (RWKV_CHUNKED ? 420 : 64) * MiB, RW_O = WS_SCR + 745 * MiB, RW_A5 = WS_SCR, RW_Y = WS_SCR + 812 * MiB, RW_END = WS_SCR + 880 * MiB;
constexpr int RECB = 768;
typedef _Float16 h2_t __attribute__((ext_vector_type(2)));
typedef _Float16 h8_t __attribute__((ext_vector_type(8)));
__device__ __forceinline__ void rwkv_xm_phase(Frame& F, const Args& a) {
    const bf16_t* U = (const bf16_t*)(a.ws + WS_U); bf16_t* XM = (bf16_t*)(a.ws + RW_XM); const float* mu = a.in[15];
    for (int t = F.gw; t < NTOK; t += F.ngw) {
        float u[16], sh[16]; ldrow_bf16(U + (size_t)t * D, F.lane, u);
        const bool hasp = (t != 0 && t != NCTX), hasn = (t != NCTX - 1 && t != NTOK - 1);
        { u32x4 pv = {0u, 0u, 0u, 0u}, nv = {0u, 0u, 0u, 0u};
          if (hasp) pv = *(const u32x4*)(U + (size_t)(t - 1) * D + 8 * F.lane);
          if (hasn) nv = *(const u32x4*)(U + (size_t)(t + 1) * D + 512 + 8 * F.lane);
          sh[0] = bflo(pv.x); sh[1] = bfhi(pv.x); sh[2] = bflo(pv.y); sh[3] = bfhi(pv.y); sh[4] = bflo(pv.z); sh[5] = bfhi(pv.z); sh[6] = bflo(pv.w); sh[7] = bfhi(pv.w);
          sh[8] = bflo(nv.x); sh[9] = bfhi(nv.x); sh[10] = bflo(nv.y); sh[11] = bfhi(nv.y); sh[12] = bflo(nv.z); sh[13] = bfhi(nv.z); sh[14] = bflo(nv.w); sh[15] = bfhi(nv.w); }
#pragma unroll 1
        for (int c = 0; c < 6; ++c) { float m[16], o[16]; ldrow_f32(mu + c * D, F.lane, m);
#pragma unroll
            for (int e = 0; e < 16; ++e) o[e] = u[e] + (sh[e] - u[e]) * m[e];
            strow_bf16(XM + ((size_t)c * NTOK + t) * D, F.lane, o); }
    }
}
struct RwkvInSched {
    const char* XM; const char* Win; const char* Wl1; int G, c;
    __device__ __forceinline__ bool next(int i, gg::Unit& u) const {
        const int L0 = i * G + c; if (L0 >= 975) return false; const int L = xcd_remap(L0, 975);
        int g, pm, pn;
        if (L < 780) { g = L / 260; const int r = L % 260; pm = r >> 2; pn = r & 3; u.b = Win + ((size_t)g * 1024 + pn * 256) * 2048; }
        else { const int r = L - 780; g = 3 + r / 65; pm = r % 65; pn = 0; u.b = Wl1 + (size_t)(g - 3) * 256 * 2048; }
        u.a = XM + ((size_t)g * NTOK + pm * 256) * 2048; u.b2 = nullptr; u.pm = pm; u.pn = pn; u.gofs = 0; u.x = g; return true; }
};
struct EpiRwkvIn {
    static constexpr bool PERM = true;
    bf16_t* RKV; bf16_t* L1;
    __device__ __forceinline__ void operator()(const gg::Acc& acc, const gg::Unit& u, int wr, int wc, int fr, int fq) const {
        const int g = u.x; const bool lora = g >= 3;
        bf16_t* O = lora ? L1 + (size_t)(g - 3) * NTOK * 256 : RKV + (size_t)g * (33 * MiB / 2); const int ldc = lora ? 256 : 1024;
        const int row0 = u.pm * 256 + wr * 64 + fr, col0 = u.pn * 256 + wc * 32 + 8 * fq;
#pragma unroll
        for (int ai = 0; ai < 2; ++ai)
#pragma unroll
            for (int m = 0; m < 4; ++m) { bf16_t* rp = O + (size_t)(row0 + ai * 128 + m * 16) * ldc + col0;
#pragma unroll
                for (int bj = 0; bj < 2; ++bj) { f32x4 v0 = acc[ai][bj][m][0], v1 = acc[ai][bj][m][1];
                    if (g == 3) {
#pragma unroll
                        for (int e = 0; e < 4; ++e) { v0[e] = 1.0f - 2.0f * __builtin_amdgcn_rcpf(1.0f + __expf(2.0f * v0[e])); v1[e] = 1.0f - 2.0f * __builtin_amdgcn_rcpf(1.0f + __expf(2.0f * v1[e])); } }
                    if (g == 5) {
#pragma unroll
                        for (int e = 0; e < 4; ++e) { v0[e] = sigmoidf_(v0[e]); v1[e] = sigmoidf_(v1[e]); } }
                    u32x4 o; o.x = pk2(v0[0], v0[1]); o.y = pk2(v0[2], v0[3]); o.z = pk2(v1[0], v1[1]); o.w = pk2(v1[2], v1[3]);
                    *(u32x4*)(rp + bj * 128) = o; } }
    }
};
__device__ __forceinline__ void rwkv_in_gemm_phase(Frame& F, const Args& a) {
    RwkvInSched S{(const char*)(a.ws + RW_XM), (const char*)(a.ws + WS_W_RWKV_IN), (const char*)(a.ws + WS_W_RWKV_L1), (int)gridDim.x, (int)blockIdx.x};
    EpiRwkvIn E{(bf16_t*)(a.ws + RW_R), (bf16_t*)(a.ws + RW_L1)};
    gg::gemm_phase<EpiRwkvIn, RwkvInSched, false, false>(F.lds + LDS_STAGE, gg::Dims{1024, 1024, 1024, 0, 0}, S, E);
}
struct RwkvL2Sched {
    const char* L1; const char* W2; int G, c;
    __device__ __forceinline__ bool next(int i, gg::Unit& u) const {
        const int L0 = i * G + c; if (L0 >= 1300) return false; const int L = xcd_remap(L0, 1300);
        const int g = L / 260, r = L % 260, pm = r >> 2, pn = r & 3, src = g >> 1;
        u.a = L1 + ((size_t)src * NTOK + pm * 256) * 512; u.b = W2 + ((size_t)g * 1024 + pn * 256) * 512; u.b2 = nullptr; u.pm = pm; u.pn = pn; u.gofs = 0; u.x = g; return true; }
};
struct EpiRwkvL2 {
    static constexpr bool PERM = true;
    float* WW; bf16_t* AA; bf16_t* GG;
    __device__ __forceinline__ void operator()(const gg::Acc& acc, const gg::Unit& u, int wr, int wc, int fr, int fq) const {
        const int g = u.x, z = g & 1; const int row0 = u.pm * 256 + wr * 64 + fr, col0 = u.pn * 256 + wc * 32 + 8 * fq;
        float* wbase = WW + (size_t)z * NTOK * 1024; bf16_t* obase = g < 4 ? AA + (size_t)z * NTOK * 1024 : GG;
#pragma unroll
        for (int ai = 0; ai < 2; ++ai)
#pragma unroll
            for (int m = 0; m < 4; ++m) { const size_t ro = (size_t)(row0 + ai * 128 + m * 16) * 1024 + col0;
#pragma unroll
                for (int bj = 0; bj < 2; ++bj) { const f32x4 v0 = acc[ai][bj][m][0], v1 = acc[ai][bj][m][1];
                    if (g < 2) { float* wp = wbase + ro + bj * 128; *(f32x4*)wp = v0; *(f32x4*)(wp + 4) = v1; }
                    else { u32x4 o; o.x = pk2(v0[0], v0[1]); o.y = pk2(v0[2], v0[3]); o.z = pk2(v1[0], v1[1]); o.w = pk2(v1[2], v1[3]); *(u32x4*)(obase + ro + bj * 128) = o; } } }
    }
};
__device__ __forceinline__ void rwkv_l2_gemm_phase(Frame& F, const Args& a) {
    RwkvL2Sched S{(const char*)(a.ws + RW_L1), (const char*)(a.ws + WS_W_RWKV_WL2), (int)gridDim.x, (int)blockIdx.x};
    EpiRwkvL2 E{(float*)(a.ws + RW_WW), (bf16_t*)(a.ws + RW_AA), (bf16_t*)(a.ws + RW_G)};
    gg::gemm_phase<EpiRwkvL2, RwkvL2Sched, false, false>(F.lds + LDS_STAGE, gg::Dims{256, 256, 256, 0, 0}, S, E);
}
__device__ __forceinline__ int rwkv_row(int z, int n) { return z == 0 ? n : (n < NCTX ? NCTX - 1 - n : NTOK - 1 + NCTX - n); }
__device__ __forceinline__ void rwkv_rec_phase(Frame& F, const Args& a) {
    const bf16_t* R = (const bf16_t*)(a.ws + RW_R); const bf16_t* K = (const bf16_t*)(a.ws + RW_K); const bf16_t* V = (const bf16_t*)(a.ws + RW_V);
    const float* WW = (const float*)(a.ws + RW_WW); const bf16_t* AA = (const bf16_t*)(a.ws + RW_AA); unsigned char* REC = a.ws + RW_REC;
    const int lane = F.lane;
    float kkw[16], kaw[16]; ldrow_f32(a.in[25], lane, kkw); ldrow_f32(a.in[26], lane, kaw);
#pragma unroll 1
    for (int t = F.gw; t < NTOK; t += F.ngw) {
        float k[16], r[16], v[16], kk[16];
        ldrow_bf16(K + (size_t)t * 1024, lane, k); ldrow_bf16(R + (size_t)t * 1024, lane, r); ldrow_bf16(V + (size_t)t * 1024, lane, v);
#pragma unroll
        for (int j = 0; j < 2; ++j) { float ss = 0.f;
#pragma unroll
            for (int e = 0; e < 8; ++e) { kk[8 * j + e] = k[8 * j + e] * kkw[8 * j + e]; ss += kk[8 * j + e] * kk[8 * j + e]; }
#pragma unroll
            for (int m = 1; m < 8; m <<= 1) ss += __shfl_xor(ss, m);
            const float rn = __builtin_amdgcn_rsqf(ss + 1e-12f);
#pragma unroll
            for (int e = 0; e < 8; ++e) kk[8 * j + e] *= rn; }
#pragma unroll
        for (int z = 0; z < 2; ++z) {
            float ap[16], wp[16], a0v[16], w0v[16];
            ldrow_bf16(AA + ((size_t)z * NTOK + t) * 1024, lane, ap); ldrow_f32(WW + ((size_t)z * NTOK + t) * 1024, lane, wp); ldrow_f32(a.in[20] + z * 1024, lane, a0v); ldrow_f32(a.in[17] + z * 1024, lane, w0v);
            const int n = (z == 0) ? t : (t < NCTX ? NCTX - 1 - t : NTOK - 1 + NCTX - t);
#pragma unroll
            for (int j = 0; j < 2; ++j) {
                const int col = 8 * lane + 512 * j, hh = col >> 6, cin = col & 63;
                h8_t ow, okk, ob, okt, orr, ov;
#pragma unroll
                for (int e = 0; e < 8; ++e) { const int x = 8 * j + e; const float av = sigmoidf_(a0v[x] + ap[x]), wv = __expf(-0.6065306597126334f * sigmoidf_(w0v[x] + wp[x]));
                    ow[e] = (_Float16)wv; okk[e] = (_Float16)kk[x]; ob[e] = (_Float16)(av * kk[x]); okt[e] = (_Float16)(k[x] * (1.0f + (av - 1.0f) * kaw[x])); orr[e] = (_Float16)r[x]; ov[e] = (_Float16)v[x]; }
                unsigned char* rec = REC + ((size_t)(z * 16 + hh) * NTOK + n) * RECB + cin * 2;
                *(h8_t*)(rec) = ow; *(h8_t*)(rec + 128) = okk; *(h8_t*)(rec + 256) = ob; *(h8_t*)(rec + 384) = okt; *(h8_t*)(rec + 512) = orr; *(h8_t*)(rec + 640) = ov;
            }
        }
    }
}
__device__ __forceinline__ float quad_sum(float x) {
    x += __builtin_bit_cast(float, __builtin_amdgcn_mov_dpp(__builtin_bit_cast(int, x), 0xB1, 0xF, 0xF, true));
    x += __builtin_bit_cast(float, __builtin_amdgcn_mov_dpp(__builtin_bit_cast(int, x), 0x4E, 0xF, 0xF, true));
    return x;
}
template <bool VTERM, bool OUT>
__device__ __forceinline__ void rwkv_scan_task(const unsigned char* rec, LAS unsigned char* buf, int lane, h2_t (&S)[4][8], bf16_t* Ozh, int z, int n0, int nck) {
    const int v_lo = lane >> 2, kq = lane & 3;
#define RW_DMA(ck_, bsel_) do { _Pragma("unroll") for (int m = 0; m < 6; ++m) \
        __builtin_amdgcn_global_load_lds((const unsigned*)(rec + (size_t)(ck_) * 8 * RECB + (size_t)(lane + 64 * m) * 16), (LAS unsigned*)(buf + (bsel_) * 6144 + m * 1024), 16, 0, 0); } while (0)
    RW_DMA(0, 0);
#pragma unroll 1
    for (int ck = 0; ck < nck; ++ck) {
        if (ck < nck - 1) { RW_DMA(ck + 1, (ck + 1) & 1); asm volatile("s_waitcnt vmcnt(6)" ::: "memory"); }
        else asm volatile("s_waitcnt vmcnt(0)" ::: "memory");
        const LAS unsigned char* cb = buf + (ck & 1) * 6144;
#pragma unroll 2
        for (int st = 0; st < 8; ++st) {
            const LAS unsigned char* b = cb + st * RECB + kq * 32;
            h2_t kk[8], wv[8], bv[8], kt[8], rv[8];
            { const h8_t x0 = *(const LAS h8_t*)(b + 128), x1 = *(const LAS h8_t*)(b + 128 + 16);
#pragma unroll
              for (int p2 = 0; p2 < 4; ++p2) { kk[p2] = (h2_t){x0[2 * p2], x0[2 * p2 + 1]}; kk[4 + p2] = (h2_t){x1[2 * p2], x1[2 * p2 + 1]}; } }
            float sa[4];
#pragma unroll
            for (int i = 0; i < 4; ++i) { float a0 = 0.f, a1 = 0.f;
#pragma unroll
                for (int p2 = 0; p2 < 8; p2 += 2) { a0 = __builtin_amdgcn_fdot2(S[i][p2], kk[p2], a0, false); a1 = __builtin_amdgcn_fdot2(S[i][p2 + 1], kk[p2 + 1], a1, false); }
                sa[i] = quad_sum(a0 + a1); }
            { const h8_t x0 = *(const LAS h8_t*)(b), x1 = *(const LAS h8_t*)(b + 16), y0 = *(const LAS h8_t*)(b + 256), y1 = *(const LAS h8_t*)(b + 256 + 16);
#pragma unroll
              for (int p2 = 0; p2 < 4; ++p2) { wv[p2] = (h2_t){x0[2 * p2], x0[2 * p2 + 1]}; wv[4 + p2] = (h2_t){x1[2 * p2], x1[2 * p2 + 1]}; bv[p2] = (h2_t){y0[2 * p2], y0[2 * p2 + 1]}; bv[4 + p2] = (h2_t){y1[2 * p2], y1[2 * p2 + 1]}; } }
            if (VTERM) { const h8_t x0 = *(const LAS h8_t*)(b + 384), x1 = *(const LAS h8_t*)(b + 384 + 16);
#pragma unroll
              for (int p2 = 0; p2 < 4; ++p2) { kt[p2] = (h2_t){x0[2 * p2], x0[2 * p2 + 1]}; kt[4 + p2] = (h2_t){x1[2 * p2], x1[2 * p2 + 1]}; } }
            if (OUT) { const h8_t x0 = *(const LAS h8_t*)(b + 512), x1 = *(const LAS h8_t*)(b + 512 + 16);
#pragma unroll
              for (int p2 = 0; p2 < 4; ++p2) { rv[p2] = (h2_t){x0[2 * p2], x0[2 * p2 + 1]}; rv[4 + p2] = (h2_t){x1[2 * p2], x1[2 * p2 + 1]}; } }
            float oi[4];
#pragma unroll
            for (int i = 0; i < 4; ++i) {
                const _Float16 nsa = (_Float16)(-sa[i]); const h2_t nsa2 = {nsa, nsa};
                h2_t vv2 = {(_Float16)0, (_Float16)0};
                if (VTERM) { const _Float16 vh = *(const LAS _Float16*)(cb + st * RECB + 640 + (16 * i + v_lo) * 2); vv2 = (h2_t){vh, vh}; }
                float o0 = 0.f, o1 = 0.f;
#pragma unroll
                for (int p2 = 0; p2 < 8; ++p2) {
                    h2_t t = nsa2 * bv[p2]; if (VTERM) t = __builtin_elementwise_fma(vv2, kt[p2], t);
                    S[i][p2] = __builtin_elementwise_fma(S[i][p2], wv[p2], t);
                    if (OUT) { if (p2 & 1) o1 = __builtin_amdgcn_fdot2(S[i][p2], rv[p2], o1, false); else o0 = __builtin_amdgcn_fdot2(S[i][p2], rv[p2], o0, false); } }
                if (OUT) oi[i] = quad_sum(o0 + o1);
            }
            if (OUT) { const float o = kq == 0 ? oi[0] : kq == 1 ? oi[1] : kq == 2 ? oi[2] : oi[3];
                Ozh[(size_t)rwkv_row(z, n0 + ck * 8 + st) * 1024 + 16 * kq + v_lo] = (unsigned short)f2bf(o); }
        }
    }
#undef RW_DMA
}
#define RW_STORE_STATE(dst_) do { _Pragma("unroll") for (int i = 0; i < 4; ++i) _Pragma("unroll") for (int p4 = 0; p4 < 4; ++p4) \
        *(f32x4*)((dst_) + (16 * i + v_lo) * 64 + 16 * kq + 4 * p4) = (f32x4){(float)S[i][2 * p4][0], (float)S[i][2 * p4][1], (float)S[i][2 * p4 + 1][0], (float)S[i][2 * p4 + 1][1]}; } while (0)
template <int KIND>
__device__ __forceinline__ void rwkv_scan_phase(Frame& F, const Args& a) {
    const unsigned char* REC = a.ws + RW_REC; float* PQ = (float*)(a.ws + RW_PQ); float* SST = (float*)(a.ws + RW_SST); bf16_t* O = (bf16_t*)(a.ws + RW_O); bf16_t* Y = (bf16_t*)(a.ws + RW_Y);
    LAS unsigned char* buf = F.lds + LDS_STAGE + F.wave * 12288;
    const int lane = F.lane, v_lo = lane >> 2, kq = lane & 3;
#pragma unroll 1
    for (int task = F.gw; task < 2048; task += F.ngw) {
        const int zh = task & 31, z = zh >> 4, h = zh & 15, sidx = task >> 5;
        h2_t S[4][8];
#pragma unroll
        for (int i = 0; i < 4; ++i)
#pragma unroll
            for (int p2 = 0; p2 < 8; ++p2) S[i][p2] = (h2_t){(_Float16)0.f, (_Float16)0.f};
        if (sidx == 0) {
            rwkv_scan_task<true, true>(REC + (size_t)zh * NTOK * RECB, buf, lane, S, O + (size_t)z * NTOK * 1024 + h * 64, z, 0, 64);
            float* dst = SST + ((size_t)zh * 65 + 2) * 4096; RW_STORE_STATE(dst);
        } else {
            const int s = sidx + 1; const unsigned char* rec = REC + ((size_t)zh * NTOK + (size_t)s * 256) * RECB;
            rwkv_scan_task<true, true>(rec, buf, lane, S, O + (size_t)z * NTOK * 1024 + h * 64, z, s * 256, 32);
            { float* dst = PQ + ((size_t)zh * 64 + (s - 1)) * 8192 + 4096; RW_STORE_STATE(dst); }
#pragma unroll
            for (int i = 0; i < 4; ++i)
#pragma unroll
                for (int p2 = 0; p2 < 8; ++p2) { const int key = 16 * kq + 2 * p2, vr = 16 * i + v_lo; S[i][p2] = (h2_t){(_Float16)(vr == key ? 1.0f : 0.f), (_Float16)(vr == key + 1 ? 1.0f : 0.f)}; }
            asm volatile("s_waitcnt lgkmcnt(0)" ::: "memory");
            rwkv_scan_task<false, true>(rec, buf, lane, S, Y + (size_t)z * NTOK * 1024 + h * 64, z, s * 256, 32);
            { float* dst = PQ + ((size_t)zh * 64 + (s - 1)) * 8192; RW_STORE_STATE(dst); }
        }
        asm volatile("s_waitcnt lgkmcnt(0)" ::: "memory");
    }
}
constexpr int CK_TS = 144, CK_YS = 272;
constexpr int CK_AH = 0, CK_BH = 9216, CK_KH = 18432, CK_RH = 27648, CK_VV = 36864, CK_BB = 46080, CK_KB = 55296, CK_NM = 64512, CK_MAK = 73728, CK_MRB = 82944, CK_MRK = 92160,
              CK_YY = 101376, CK_SS = 118784, CK_DEC = 137216, CK_TOT = 137472, CK_TD = 139776, CK_TMP = 141824, CK_CT = 150016;
__device__ __forceinline__ void rwkv_chunk_phase(Frame& F, const Args& a) {
    float* PQ = (float*)(a.ws + RW_PQ); float* SST = (float*)(a.ws + RW_SST);
    LAS unsigned char* L = F.lds + LDS_STAGE;
    LAS float* DEC = (LAS float*)(L + CK_DEC); LAS float* TOT = (LAS float*)(L + CK_TOT); LAS float* CT = (LAS float*)(L + CK_CT);
    const int tid = F.tid, lane = F.lane, w = F.wave, c16 = lane & 15, q = lane >> 4;
    const int si = tid >> 3, c8 = tid & 7;
    const bool zset = w >= 4;
#pragma unroll 1
    for (int unit = blockIdx.x; unit < 2048; unit += gridDim.x) {
        const int zh = unit & 31, z = zh >> 4, h = zh & 15, sidx = unit >> 5;
        const int n0 = sidx == 0 ? 0 : (sidx + 1) * 256, nblk = sidx == 0 ? 8 : 4; const bool use_p = sidx != 0;
        if (tid < 64) { CT[tid] = a.in[25][h * 64 + tid]; CT[64 + tid] = a.in[26][h * 64 + tid]; CT[128 + tid] = a.in[20][z * 1024 + h * 64 + tid]; CT[192 + tid] = a.in[17][z * 1024 + h * 64 + tid]; }
        f32x4 accS[4];
#pragma unroll
        for (int kt = 0; kt < 4; ++kt)
#pragma unroll
            for (int r = 0; r < 4; ++r) { const float v0 = (!zset && (16 * w + 4 * q + r) == (16 * kt + c16)) ? 1.0f : 0.f; accS[kt][r] = v0;
                *(LAS unsigned short*)(L + CK_SS + (16 * w + 4 * q + r) * CK_TS + (16 * kt + c16) * 2) = (unsigned short)f2bf(v0); }
        __syncthreads();
        u32x4 pkx, pax, prx, pvx; f32x4 pw0, pw1;
#define CK_PREFETCH(blk_) do { int _t = threadIdx.x; asm volatile("" : "+v"(_t)); const int _trow = rwkv_row(z, n0 + (blk_) * 64 + (_t >> 3)); const unsigned _go = (unsigned)(_trow * 1024 + h * 64 + 8 * (_t & 7)) * 2u; \
            const unsigned char* _w = a.ws; const unsigned _zo = (unsigned)z * (unsigned)(NTOK * 1024 * 2); \
            pkx = *(const u32x4*)(_w + RW_K + _go); pax = *(const u32x4*)(_w + RW_AA + _zo + _go); prx = *(const u32x4*)(_w + RW_R + _go); pvx = *(const u32x4*)(_w + RW_V + _go); \
            pw0 = *(const f32x4*)(_w + RW_WW + 2u * _zo + 2u * _go); pw1 = *(const f32x4*)(_w + RW_WW + 2u * _zo + 2u * _go + 16u); } while (0)
        CK_PREFETCH(0);
#pragma unroll 1
        for (int blk = 0; blk < nblk; ++blk) {
            int tid_o = threadIdx.x; asm volatile("" : "+v"(tid_o));
            const int lane = tid_o & 63, c16 = lane & 15, q = lane >> 4, si = tid_o >> 3, c8 = tid_o & 7;
            float lw[8], kkv[8], bv[8], ktv[8]; u32x4 rx, vx;
            {
                const u32x4 kx = pkx, ax = pax; rx = prx; vx = pvx; const f32x4 wx0 = pw0, wx1 = pw1;
                const float kf[8] = {bflo(kx.x), bfhi(kx.x), bflo(kx.y), bfhi(kx.y), bflo(kx.z), bfhi(kx.z), bflo(kx.w), bfhi(kx.w)};
                const float af[8] = {bflo(ax.x), bfhi(ax.x), bflo(ax.y), bfhi(ax.y), bflo(ax.z), bfhi(ax.z), bflo(ax.w), bfhi(ax.w)};
                const float wf[8] = {wx0[0], wx0[1], wx0[2], wx0[3], wx1[0], wx1[1], wx1[2], wx1[3]};
                const f32x4 c0a = *(const LAS f32x4*)(CT + 8 * c8), c0b = *(const LAS f32x4*)(CT + 8 * c8 + 4);
                float ss = 0.f;
#pragma unroll
                for (int e = 0; e < 8; ++e) { const float kkw = e < 4 ? c0a[e] : c0b[e - 4]; kkv[e] = kf[e] * kkw; ss += kkv[e] * kkv[e]; }
                ss += __shfl_xor(ss, 1); ss += __shfl_xor(ss, 2); ss += __shfl_xor(ss, 4);
                const float rn = __builtin_amdgcn_rsqf(ss + 1e-12f);
                asm volatile("" ::: "memory");
                const f32x4 c1a = *(const LAS f32x4*)(CT + 64 + 8 * c8), c1b = *(const LAS f32x4*)(CT + 64 + 8 * c8 + 4);
                const f32x4 c2a = *(const LAS f32x4*)(CT + 128 + 8 * c8), c2b = *(const LAS f32x4*)(CT + 128 + 8 * c8 + 4), c3a = *(const LAS f32x4*)(CT + 192 + 8 * c8), c3b = *(const LAS f32x4*)(CT + 192 + 8 * c8 + 4);
#pragma unroll
                for (int e = 0; e < 8; ++e) { const float kaw = e < 4 ? c1a[e] : c1b[e - 4], a0e = e < 4 ? c2a[e] : c2b[e - 4], w0e = e < 4 ? c3a[e] : c3b[e - 4];
                    const float av = sigmoidf_(a0e + af[e]); kkv[e] *= rn; bv[e] = av * kkv[e]; ktv[e] = kf[e] * (1.0f + (av - 1.0f) * kaw);
                    lw[e] = -0.6065306597126334f * sigmoidf_(w0e + wf[e]); }
            }
            float G[8];
#pragma unroll
            for (int e = 0; e < 8; ++e) { float x = lw[e]; float y = __shfl_up(x, 8); if (lane >= 8) x += y; y = __shfl_up(x, 16); if (lane >= 16) x += y; y = __shfl_up(x, 32); if (lane >= 32) x += y; G[e] = x; }
            if (lane >= 56) { *(LAS f32x4*)(TOT + w * 64 + 8 * c8) = (f32x4){G[0], G[1], G[2], G[3]}; *(LAS f32x4*)(TOT + w * 64 + 8 * c8 + 4) = (f32x4){G[4], G[5], G[6], G[7]}; }
            __syncthreads();
            {
                float tot[8];
#pragma unroll
                for (int e = 0; e < 8; ++e) tot[e] = 0.f;
#pragma unroll
                for (int ww = 0; ww < 8; ++ww) { const f32x4 t0 = *(const LAS f32x4*)(TOT + ww * 64 + 8 * c8), t1 = *(const LAS f32x4*)(TOT + ww * 64 + 8 * c8 + 4);
#pragma unroll
                    for (int e = 0; e < 8; ++e) { const float tv = e < 4 ? t0[e] : t1[e - 4]; tot[e] += tv; if (ww < w) G[e] += tv; } }
                if (si == 0) { *(LAS f32x4*)(DEC + 8 * c8) = (f32x4){__expf(tot[0]), __expf(tot[1]), __expf(tot[2]), __expf(tot[3])}; *(LAS f32x4*)(DEC + 8 * c8 + 4) = (f32x4){__expf(tot[4]), __expf(tot[5]), __expf(tot[6]), __expf(tot[7])}; }
                const unsigned rw4[4] = {rx.x, rx.y, rx.z, rx.w}; const int to = si * CK_TS + 16 * c8;
                *(LAS u32x4*)(L + CK_VV + to) = vx;
#pragma unroll
                for (int e2 = 0; e2 < 4; ++e2) { float o7[6][2];
#pragma unroll
                    for (int hh = 0; hh < 2; ++hh) { const int e = 2 * e2 + hh; const float Ge = G[e]; const float rve = hh ? bfhi(rw4[e2]) : bflo(rw4[e2]);
                        const float eg = __expf(Ge), egm = __expf(Ge - lw[e]), eng = __expf(fminf(-Ge, 80.0f)), etg = __expf(tot[e] - Ge);
                        o7[0][hh] = -kkv[e] * egm; o7[1][hh] = bv[e] * eng; o7[2][hh] = ktv[e] * eng; o7[3][hh] = rve * eg; o7[4][hh] = bv[e] * etg; o7[5][hh] = ktv[e] * etg; }
                    *(LAS unsigned*)(L + CK_AH + to + 4 * e2) = pk2(o7[0][0], o7[0][1]); *(LAS unsigned*)(L + CK_BH + to + 4 * e2) = pk2(o7[1][0], o7[1][1]); *(LAS unsigned*)(L + CK_KH + to + 4 * e2) = pk2(o7[2][0], o7[2][1]);
                    *(LAS unsigned*)(L + CK_RH + to + 4 * e2) = pk2(o7[3][0], o7[3][1]); *(LAS unsigned*)(L + CK_BB + to + 4 * e2) = pk2(o7[4][0], o7[4][1]); *(LAS unsigned*)(L + CK_KB + to + 4 * e2) = pk2(o7[5][0], o7[5][1]); }
                if (blk + 1 < nblk) CK_PREFETCH(blk + 1);
            }
            __syncthreads();
            { const int it = w >> 1;
              bf16x8 fa[2], fr[2];
#pragma unroll
              for (int ks = 0; ks < 2; ++ks) { fa[ks] = lds_row_frag(L + CK_AH, CK_TS, 16 * it + c16, 32 * ks + 8 * q); fr[ks] = lds_row_frag(L + CK_RH, CK_TS, 16 * it + c16, 32 * ks + 8 * q); }
#pragma unroll 1
              for (int s2 = 0; s2 < 2; ++s2) { const int jt = 2 * (w & 1) + s2; f32x4 n0v = {0.f, 0.f, 0.f, 0.f}, n1v = n0v, n2v = n0v, n3v = n0v;
#pragma unroll
                  for (int ks = 0; ks < 2; ++ks) { const bf16x8 fb = lds_row_frag(L + CK_BH, CK_TS, 16 * jt + c16, 32 * ks + 8 * q), fk = lds_row_frag(L + CK_KH, CK_TS, 16 * jt + c16, 32 * ks + 8 * q);
                      n0v = __builtin_amdgcn_mfma_f32_16x16x32_bf16(fa[ks], fb, n0v, 0, 0, 0); n1v = __builtin_amdgcn_mfma_f32_16x16x32_bf16(fa[ks], fk, n1v, 0, 0, 0);
                      n2v = __builtin_amdgcn_mfma_f32_16x16x32_bf16(fr[ks], fb, n2v, 0, 0, 0); n3v = __builtin_amdgcn_mfma_f32_16x16x32_bf16(fr[ks], fk, n3v, 0, 0, 0); }
#pragma unroll
                  for (int r = 0; r < 4; ++r) { const int i = 16 * it + 4 * q + r, j = 16 * jt + c16, o = i * CK_TS + j * 2;
                      n0v[r] = j < i ? n0v[r] : 0.f;
                      *(LAS unsigned short*)(L + CK_NM + o) = (unsigned short)f2bf(n0v[r]); *(LAS unsigned short*)(L + CK_MAK + o) = (unsigned short)f2bf(j < i ? n1v[r] : 0.f);
                      *(LAS unsigned short*)(L + CK_MRB + o) = (unsigned short)f2bf(j <= i ? n2v[r] : 0.f); *(LAS unsigned short*)(L + CK_MRK + o) = (unsigned short)f2bf(j <= i ? n3v[r] : 0.f); }
                  if (jt == it) {
                      LAS unsigned char* tp = L + CK_TMP + w * 1024; LAS unsigned char* tt = tp + 512;
                      f32x4 P = n0v, T = n0v;
#pragma unroll
                      for (int r = 0; r < 4; ++r) T[r] += (4 * q + r == c16) ? 1.0f : 0.f;
#pragma unroll
                      for (int pw = 0; pw < 3; ++pw) {
#pragma unroll
                          for (int r = 0; r < 4; ++r) { *(LAS unsigned short*)(tp + (4 * q + r) * 32 + c16 * 2) = (unsigned short)f2bf(P[r]); *(LAS unsigned short*)(tt + (4 * q + r) * 32 + c16 * 2) = (unsigned short)f2bf(T[r]); }
                          bf16x4 pb; pb[0] = (short)f2bf(P[0]); pb[1] = (short)f2bf(P[1]); pb[2] = (short)f2bf(P[2]); pb[3] = (short)f2bf(P[3]);
                          const bf16x4 pa = *(const LAS bf16x4*)(tp + c16 * 32 + 8 * q), ta = *(const LAS bf16x4*)(tt + c16 * 32 + 8 * q);
                          f32x4 zero = {0.f, 0.f, 0.f, 0.f};
                          P = __builtin_amdgcn_mfma_f32_16x16x16bf16_1k(pa, pb, zero, 0, 0, 0);
                          bf16x4 pn; pn[0] = (short)f2bf(P[0]); pn[1] = (short)f2bf(P[1]); pn[2] = (short)f2bf(P[2]); pn[3] = (short)f2bf(P[3]);
                          T = __builtin_amdgcn_mfma_f32_16x16x16bf16_1k(ta, pn, T, 0, 0, 0);
                      }
#pragma unroll
                      for (int r = 0; r < 4; ++r) *(LAS unsigned short*)(L + CK_TD + it * 512 + (4 * q + r) * 32 + c16 * 2) = (unsigned short)f2bf(T[r]);
                  } } }
            __syncthreads();
            const bool active = zset || use_p;
            if (active) {
                f32x4 yv[4];
#pragma unroll
                for (int it = 0; it < 4; ++it) yv[it] = (f32x4){0.f, 0.f, 0.f, 0.f};
                bf16x8 sb[2];
#pragma unroll
                for (int ks = 0; ks < 2; ++ks) { sb[ks] = lds_row_frag(L + CK_SS, CK_TS, 16 * w + c16, 32 * ks + 8 * q);
#pragma unroll
                    for (int it = 0; it < 4; ++it) yv[it] = __builtin_amdgcn_mfma_f32_16x16x32_bf16(lds_row_frag(L + CK_AH, CK_TS, 16 * it + c16, 32 * ks + 8 * q), sb[ks], yv[it], 0, 0, 0); }
                bf16x8 vb[2];
                if (zset) {
#pragma unroll
                    for (int ks = 0; ks < 2; ++ks) { vb[ks] = lds_tr_frag(L + CK_VV, CK_TS, 32 * ks, 16 * (w - 4), lane);
#pragma unroll
                        for (int it = 0; it < 4; ++it) yv[it] = __builtin_amdgcn_mfma_f32_16x16x32_bf16(lds_row_frag(L + CK_MAK, CK_TS, 16 * it + c16, 32 * ks + 8 * q), vb[ks], yv[it], 0, 0, 0); } }
                asm volatile("" ::: "memory");
                bf16x4 ub[4];
#pragma unroll
                for (int b = 0; b < 4; ++b) { f32x4 acc = yv[b];
#pragma unroll
                    for (int c = 0; c < 4; ++c) if (c < b) acc = __builtin_amdgcn_mfma_f32_16x16x16bf16_1k(*(const LAS bf16x4*)(L + CK_NM + (16 * b + c16) * CK_TS + (16 * c + 4 * q) * 2), ub[c], acc, 0, 0, 0);
                    bf16x4 ab; ab[0] = (short)f2bf(acc[0]); ab[1] = (short)f2bf(acc[1]); ab[2] = (short)f2bf(acc[2]); ab[3] = (short)f2bf(acc[3]);
                    const f32x4 zero = {0.f, 0.f, 0.f, 0.f};
                    const f32x4 ubf = __builtin_amdgcn_mfma_f32_16x16x16bf16_1k(*(const LAS bf16x4*)(L + CK_TD + b * 512 + c16 * 32 + 8 * q), ab, zero, 0, 0, 0);
                    ub[b][0] = (short)f2bf(ubf[0]); ub[b][1] = (short)f2bf(ubf[1]); ub[b][2] = (short)f2bf(ubf[2]); ub[b][3] = (short)f2bf(ubf[3]); }
                asm volatile("" ::: "memory");
                { int q3 = lane >> 4, c3 = lane & 15; asm volatile("" : "+v"(q3), "+v"(c3));
                  unsigned char* dstb = a.ws + (zset ? RW_O : RW_Y); const unsigned dco = ((unsigned)z * (unsigned)(NTOK * 1024) + (unsigned)(h * 64 + 16 * (w & 3) + c3)) * 2u;
#pragma unroll
                  for (int it = 0; it < 4; ++it) { f32x4 ov = {0.f, 0.f, 0.f, 0.f};
#pragma unroll
                      for (int ks = 0; ks < 2; ++ks) ov = __builtin_amdgcn_mfma_f32_16x16x32_bf16(lds_row_frag(L + CK_RH, CK_TS, 16 * it + c16, 32 * ks + 8 * q), sb[ks], ov, 0, 0, 0);
#pragma unroll
                      for (int c = 0; c < 4; ++c) if (c <= it) ov = __builtin_amdgcn_mfma_f32_16x16x16bf16_1k(*(const LAS bf16x4*)(L + CK_MRB + (16 * it + c16) * CK_TS + (16 * c + 4 * q) * 2), ub[c], ov, 0, 0, 0);
                      if (zset) {
#pragma unroll
                          for (int ks = 0; ks < 2; ++ks) ov = __builtin_amdgcn_mfma_f32_16x16x32_bf16(lds_row_frag(L + CK_MRK, CK_TS, 16 * it + c16, 32 * ks + 8 * q), vb[ks], ov, 0, 0, 0); }
#pragma unroll
                      for (int r = 0; r < 4; ++r) *(unsigned short*)(dstb + dco + (unsigned)rwkv_row(z, n0 + blk * 64 + 16 * it + 4 * q3 + r) * 2048u) = (unsigned short)f2bf(ov[r]);
                      asm volatile("" ::: "memory"); } }
                asm volatile("" ::: "memory");
#pragma unroll
                for (int kt = 0; kt < 4; ++kt) { const float dc = DEC[16 * kt + c16];
#pragma unroll
                    for (int r = 0; r < 4; ++r) accS[kt][r] *= dc;
#pragma unroll
                    for (int c = 0; c < 4; ++c) { const int g = lane >> 4, qq = (lane & 15) >> 2, pp = lane & 3;
                        const v4s16 bt = __builtin_amdgcn_ds_read_tr16_b64_v4i16((LAS v4s16*)(L + CK_BB + (16 * c + 4 * g + qq) * CK_TS + (16 * kt + 4 * pp) * 2));
                        accS[kt] = __builtin_amdgcn_mfma_f32_16x16x16bf16_1k(ub[c], (bf16x4){bt[0], bt[1], bt[2], bt[3]}, accS[kt], 0, 0, 0); } }
                if (zset) {
#pragma unroll
                    for (int ks = 0; ks < 2; ++ks) { const bf16x8 va = vb[ks];
#pragma unroll
                        for (int kt = 0; kt < 4; ++kt) accS[kt] = __builtin_amdgcn_mfma_f32_16x16x32_bf16(va, lds_tr_frag(L + CK_KB, CK_TS, 32 * ks, 16 * kt, lane), accS[kt], 0, 0, 0); } }
            }
            __syncthreads();
            if (active) {
#pragma unroll
                for (int kt = 0; kt < 4; ++kt)
#pragma unroll
                    for (int r = 0; r < 4; ++r) *(LAS unsigned short*)(L + CK_SS + (16 * w + 4 * q + r) * CK_TS + (16 * kt + c16) * 2) = (unsigned short)f2bf(accS[kt][r]);
            }
        }
        { float* dst = sidx == 0 ? (zset ? SST + ((size_t)zh * 65 + 2) * 4096 : nullptr) : PQ + ((size_t)zh * 64 + sidx) * 8192 + (zset ? 4096 : 0);
          if (dst) { int q2 = lane >> 4, c2 = lane & 15; asm volatile("" : "+v"(q2), "+v"(c2));
#pragma unroll
              for (int kt = 0; kt < 4; ++kt)
#pragma unroll
                  for (int r = 0; r < 4; ++r) dst[(16 * (w & 3) + 4 * q2 + r) * 64 + 16 * kt + c2] = accS[kt][r]; } }
        __syncthreads();
    }
}
__device__ __forceinline__ void rwkv_corr_phase(Frame& F, const Args& a) {
    const float* SST = (const float*)(a.ws + RW_SST); bf16_t* O = (bf16_t*)(a.ws + RW_O); const bf16_t* Y = (const bf16_t*)(a.ws + RW_Y);
    const int lane = F.lane, c16 = lane & 15, q = lane >> 4;
#pragma unroll 1
    for (int task = F.gw; task < 2016; task += F.ngw) {
        const int zh = task & 31, z = zh >> 4, h = zh & 15, s = (task >> 5) + 2;
        const float* Ss = SST + ((size_t)zh * 65 + s) * 4096;
        bf16x8 Sf[4][2];
#pragma unroll
        for (int vt = 0; vt < 4; ++vt)
#pragma unroll
            for (int ks = 0; ks < 2; ++ks) { const f32x4 x0 = *(const f32x4*)(Ss + (16 * vt + c16) * 64 + 32 * ks + 8 * q), x1 = *(const f32x4*)(Ss + (16 * vt + c16) * 64 + 32 * ks + 8 * q + 4);
                bf16x8 f; f[0] = (short)f2bf(x0[0]); f[1] = (short)f2bf(x0[1]); f[2] = (short)f2bf(x0[2]); f[3] = (short)f2bf(x0[3]); f[4] = (short)f2bf(x1[0]); f[5] = (short)f2bf(x1[1]); f[6] = (short)f2bf(x1[2]); f[7] = (short)f2bf(x1[3]); Sf[vt][ks] = f; }
        const bf16_t* Yz = Y + (size_t)z * NTOK * 1024 + h * 64; bf16_t* Oz = O + (size_t)z * NTOK * 1024 + h * 64;
#pragma unroll 2
        for (int T = 0; T < 16; ++T) {
            const size_t row = (size_t)rwkv_row(z, s * 256 + 16 * T + c16) * 1024;
            const bf16x8 y0 = *(const bf16x8*)(Yz + row + 8 * q), y1 = *(const bf16x8*)(Yz + row + 32 + 8 * q);
#pragma unroll
            for (int vt = 0; vt < 4; ++vt) { f32x4 d = {0.f, 0.f, 0.f, 0.f};
                d = __builtin_amdgcn_mfma_f32_16x16x32_bf16(Sf[vt][0], y0, d, 0, 0, 0); d = __builtin_amdgcn_mfma_f32_16x16x32_bf16(Sf[vt][1], y1, d, 0, 0, 0);
                u32x2* op = (u32x2*)(Oz + row + 16 * vt + 4 * q); const u32x2 old = *op;
                u32x2 nw; nw.x = pk2(bflo(old.x) + d[0], bfhi(old.x) + d[1]); nw.y = pk2(bflo(old.y) + d[2], bfhi(old.y) + d[3]); *op = nw; }
        }
    }
}
__device__ __forceinline__ void rwkv_prefix_phase(Frame& F, const Args& a) {
    const float* PQ = (const float*)(a.ws + RW_PQ); float* SST = (float*)(a.ws + RW_SST);
    if (blockIdx.x >= 128) return;
    const int zh = blockIdx.x >> 2, r0 = (blockIdx.x & 3) * 16, tid = F.tid, vl = tid >> 5, v = r0 + vl, c0 = (tid & 31) * 2;
    LAS float* Sl = (LAS float*)(F.lds + LDS_STAGE); LAS float* Pl = Sl + 16 * 68;
    { const float* s1 = SST + ((size_t)zh * 65 + 2) * 4096 + r0 * 64;
      for (int i = tid; i < 1024; i += NTHREADS) Sl[(i >> 6) * 68 + (i & 63)] = s1[i]; }
    f32x4 pn0, pn1; f32x2 qn;
    { const float* Pg = PQ + ((size_t)zh * 64 + 1) * 8192; pn0 = *(const f32x4*)(Pg + 4 * tid); pn1 = *(const f32x4*)(Pg + 4 * (tid + 512)); qn = *(const f32x2*)(Pg + 4096 + v * 64 + c0); }
#pragma unroll 1
    for (int s = 2; s < 64; ++s) {
        __syncthreads();
        *(LAS f32x4*)(Pl + 4 * tid) = pn0; *(LAS f32x4*)(Pl + 4 * (tid + 512)) = pn1;
        float a0 = qn[0], a1 = qn[1];
        if (s < 63) { const float* Pg = PQ + ((size_t)zh * 64 + s) * 8192; pn0 = *(const f32x4*)(Pg + 4 * tid); pn1 = *(const f32x4*)(Pg + 4 * (tid + 512)); qn = *(const f32x2*)(Pg + 4096 + v * 64 + c0); }
        __syncthreads();
#pragma unroll 16
        for (int k = 0; k < 64; ++k) { const float sv = Sl[vl * 68 + k]; const f32x2 pp = *(const LAS f32x2*)(Pl + k * 64 + c0); a0 += sv * pp[0]; a1 += sv * pp[1]; }
        __syncthreads();
        *(f32x2*)(SST + ((size_t)zh * 65 + s + 1) * 4096 + v * 64 + c0) = (f32x2){a0, a1};
        Sl[vl * 68 + c0] = a0; Sl[vl * 68 + c0 + 1] = a1;
    }
}
__device__ __forceinline__ void rwkv_readout_phase(Frame& F, const Args& a) {
    const bf16_t* O0 = (const bf16_t*)(a.ws + RW_O); const bf16_t* O1 = O0 + (size_t)NTOK * 1024; const bf16_t* R = (const bf16_t*)(a.ws + RW_R); const bf16_t* K = (const bf16_t*)(a.ws + RW_K);
    const bf16_t* V = (const bf16_t*)(a.ws + RW_V); const bf16_t* A0 = (const bf16_t*)(a.ws + RW_AA); const bf16_t* A1 = A0 + (size_t)NTOK * 1024; const bf16_t* G = (const bf16_t*)(a.ws + RW_G);
    bf16_t* A5 = (bf16_t*)(a.ws + RW_A5); const int lane = F.lane;
    float ka[16], rk[16], lg[16], lb[16], ab0[16], ab1[16]; ldrow_f32(a.in[20], lane, ab0); ldrow_f32(a.in[20] + 1024, lane, ab1); ldrow_f32(a.in[26], lane, ka); ldrow_f32(a.in[27], lane, rk); ldrow_f32(a.in[28], lane, lg); ldrow_f32(a.in[29], lane, lb);
    for (int t = F.gw; t < NTOK; t += F.ngw) {
        float o[16], r[16], k[16], v[16], a0[16], a1[16], g[16];
        ldrow_bf16(O0 + (size_t)t * 1024, lane, o); addrow_bf16(O1 + (size_t)t * 1024, lane, o); ldrow_bf16(R + (size_t)t * 1024, lane, r); ldrow_bf16(K + (size_t)t * 1024, lane, k);
        ldrow_bf16(V + (size_t)t * 1024, lane, v); ldrow_bf16(A0 + (size_t)t * 1024, lane, a0); ldrow_bf16(A1 + (size_t)t * 1024, lane, a1); ldrow_bf16(G + (size_t)t * 1024, lane, g);
#pragma unroll
        for (int j = 0; j < 2; ++j) { float s = 0.f, bn = 0.f;
#pragma unroll
            for (int e = 0; e < 8; ++e) { const int x = 8 * j + e; s += o[x]; bn += r[x] * k[x] * rk[x] * (2.0f + (sigmoidf_(a0[x] + ab0[x]) + sigmoidf_(a1[x] + ab1[x]) - 2.0f) * ka[x]); }
#pragma unroll
            for (int m = 1; m < 8; m <<= 1) { s += __shfl_xor(s, m); bn += __shfl_xor(bn, m); }
            const float mean = s * (1.0f / 64.0f); float q = 0.f;
#pragma unroll
            for (int e = 0; e < 8; ++e) { o[8 * j + e] -= mean; q += o[8 * j + e] * o[8 * j + e]; }
#pragma unroll
            for (int m = 1; m < 8; m <<= 1) q += __shfl_xor(q, m);
            const float rs = 1.0f / sqrtf(q * (1.0f / 64.0f) + 64e-5f);
#pragma unroll
            for (int e = 0; e < 8; ++e) { const int x = 8 * j + e; o[x] = (o[x] * rs * lg[x] + lb[x] + bn * v[x]) * g[x]; } }
        strow_bf16(A5 + (size_t)t * 1024, lane, o);
    }
}

__device__ __forceinline__ void zero_y_phase(Frame& F, const Args& a) {
    u32x4* y = (u32x4*)(a.ws + WS_MX5); const u32x4 z = {0u, 0u, 0u, 0u};
    for (size_t i = (size_t)blockIdx.x * NTHREADS + F.tid; i < (size_t)NTOK * D / 8; i += (size_t)gridDim.x * NTHREADS) y[i] = z;
}

__device__ __forceinline__ Frame mk_frame(const Args& a, unsigned char* lds_raw) {
    Frame F; int tid = threadIdx.x; asm volatile("" : "+v"(tid));
    F.lds = (LAS unsigned char*)lds_raw; F.misc = (volatile LAS unsigned*)(F.lds + LDS_MISC);
    F.tid = tid; F.lane = tid & 63; F.wave = __builtin_amdgcn_readfirstlane(tid >> 6);
    F.ws = a.ws; F.ctl = (unsigned*)(a.ws + WS_CTL);
    F.gw = blockIdx.x * NWAVES + F.wave; F.ngw = gridDim.x * NWAVES;
    return F;
}
__global__ void __launch_bounds__(NTHREADS, 2) fwd_kernel(Args a) {
    extern __shared__ __attribute__((aligned(16))) unsigned char lds_raw[];
    if (threadIdx.x < 64) ((volatile LAS unsigned*)((LAS unsigned char*)lds_raw + LDS_MISC))[threadIdx.x] = 0u;
    __syncthreads();
    (void)xcd_barrier_post((unsigned*)(a.ws + WS_CTL) + CW_BAR, (volatile LAS unsigned*)((LAS unsigned char*)lds_raw + LDS_MISC) + 8);
    int phase = 0;
#define PHASE(body) do { if (phase >= a.ph_lo && phase < a.ph_hi) { { Frame F = mk_frame(a, lds_raw); body; } \
        if (phase + 1 < a.ph_hi) { XcdBarrier bar; bar.bar = (unsigned*)(a.ws + WS_CTL) + CW_BAR; bar.x = xb_xcc_id(); bar.st = (volatile LAS unsigned*)((LAS unsigned char*)lds_raw + LDS_MISC) + 8; xcd_barrier(bar); } } ++phase; } while (0)

#define PHASED(bit, body) do { PHASE(body); if (DUP & (bit)) PHASE(body); } while (0)
    PHASED(1, p0_phase(F, a));
    PHASE(p1a_phase(F, a));
    PHASE(p1b_phase(F, a));

#define MOE_LAYER(L) do { \
    if (EN_MOE) { PHASE(moe_route_phase<L>(F, a)); if (DUP & (1 << 20)) PHASE((moe_route_phase<L, true>(F, a))); PHASE(moe_dispatch_phase<L>(F, a)); if (DUP & (1 << 26)) PHASE((moe_dispatch_phase<L, true>(F, a))); PHASED(2, moe_gateup_phase<L>(F, a)); PHASED(4, moe_down_phase<L>(F, a)); } \
    PHASE((ln_phase<L, 1>(F, a))); if (DUP & (1 << 21)) PHASE((ln_phase<L, 1, true>(F, a))); } while (0)

    if (EN_LRU) {
        PHASED(65536, { lru_in_gemm_phase(F, a); bg_slot<0>(F, a); });
        PHASED(131072, lru_scan_phase<true>(F, a));
        PHASED(1 << 24, lru_carry_phase(F, a));
        PHASED(131072, lru_scan_phase<false>(F, a));
        PHASED(1 << 25, { dense_gemm_bf16(F, (const bf16_t*)(a.ws + WS_MX2), (const bf16_t*)(a.ws + WS_W_LRU_OUT), (bf16_t*)(a.ws + WS_MX5), NTOK, 1024, 1024); bg_slot<1>(F, a); });
    } else PHASE(zero_y_phase(F, a));
    PHASE({ bg_catch<2>(F, a); (ln_phase<0, 0>(F, a)); }); if (DUP & (1 << 22)) PHASE((ln_phase<0, 0, true>(F, a)));
    MOE_LAYER(0);
    if (EN_RWKV) {
        PHASED(64, rwkv_xm_phase(F, a));
        PHASED(128, rwkv_in_gemm_phase(F, a));
        PHASED(256, rwkv_l2_gemm_phase(F, a));
#if !RWKV_CHUNKED
        PHASED(8, rwkv_rec_phase(F, a));
#endif
#if RWKV_CHUNKED
        PHASED(16, rwkv_chunk_phase(F, a));
#else
        PHASED(16, rwkv_scan_phase<0>(F, a));
#endif
        PHASED(1 << 24, rwkv_prefix_phase(F, a));
        PHASE(rwkv_corr_phase(F, a));
        PHASED(1 << 23, rwkv_readout_phase(F, a));
        PHASED(1 << 25, { dense_gemm_bf16(F, (const bf16_t*)(a.ws + RW_A5), (const bf16_t*)(a.ws + WS_W_RWKV_OUT), (bf16_t*)(a.ws + WS_MX5), NTOK, 1024, 1024); bg_slot<3>(F, a); });
    } else PHASE(zero_y_phase(F, a));
    PHASE({ bg_catch<4>(F, a); (ln_phase<1, 0>(F, a)); }); if (DUP & (1 << 22)) PHASE((ln_phase<1, 0, true>(F, a)));
    MOE_LAYER(1);
    if (EN_RET) {
        PHASED(4096, { ret_in_gemm_phase(F, a); bg_slot<5>(F, a); });
        PHASED(8192, { ret_p_phase(F, a); ret_transpose_phase(F, a); });
        PHASED(16384, ret_kv_phase(F, a));
        PHASE(ret_prefix_phase<false>(F, a)); if (DUP & (1 << 27)) PHASE(ret_prefix_phase<true>(F, a));
        PHASED(32768, ret_o_phase(F, a));
        PHASED(1 << 23, ret_readout_phase(F, a));
        PHASED(1 << 25, { dense_gemm_bf16(F, (const bf16_t*)(a.ws + RT_A3), (const bf16_t*)(a.ws + WS_W_RET_OUT), (bf16_t*)(a.ws + WS_MX5), NTOK, 1024, 2048); bg_slot<6>(F, a); });
    } else PHASE(zero_y_phase(F, a));
    PHASE({ bg_catch<7>(F, a); (ln_phase<2, 0>(F, a)); }); if (DUP & (1 << 22)) PHASE((ln_phase<2, 0, true>(F, a)));
    MOE_LAYER(2);
    if (EN_HGRN) {
        PHASED(2048, { hgrn_in_gemm_phase(F, a); bg_slot<8>(F, a); });
        PHASED(512, hgrn_chunk_phase<0>(F, a));
        PHASE(hgrn_prefix_phase<false>(F, a)); if (DUP & (1 << 27)) PHASE(hgrn_prefix_phase<true>(F, a));
        PHASED(1024, hgrn_chunk_phase<1>(F, a));
        PHASED(1 << 23, hgrn_readout_phase(F, a));
        PHASED(1 << 25, dense_gemm_bf16(F, (const bf16_t*)(a.ws + HG_A4) + (size_t)NCTX * 1024, (const bf16_t*)(a.ws + WS_W_HGRN_OUT), (bf16_t*)(a.ws + WS_MX5) + (size_t)NCTX * 1024, SEQ, 1024, 1024));
    } else PHASE(zero_y_phase(F, a));
    PHASE({ bg_catch<9>(F, a); (ln_phase<3, 0>(F, a)); }); if (DUP & (1 << 22)) PHASE((ln_phase<3, 0, true>(F, a)));
    MOE_LAYER(3);
}

extern "C" void kernel_launch(void* const* d_in, const int* in_sizes, int n_in, void* d_out, int out_size, void* d_ws, size_t ws_size, hipStream_t stream) {
    static int grid = 0;
    if (grid == 0) {
        if (n_in != 47 || out_size != SEQ * D || ws_size < WS_END) { fprintf(stderr, "kernel_launch: unexpected shapes (n_in %d out %d ws %zu need %zu)\n", n_in, out_size, ws_size, (size_t)WS_END); grid = -1; return; }
        int dev = 0, cus = 0, per_cu = 0;
        (void)hipGetDevice(&dev); (void)hipDeviceGetAttribute(&cus, hipDeviceAttributeMultiprocessorCount, dev);
        if (hipFuncSetAttribute((const void*)fwd_kernel, hipFuncAttributeMaxDynamicSharedMemorySize, LDS_BYTES) != hipSuccess) { fprintf(stderr, "kernel_launch: hipFuncSetAttribute failed\n"); grid = -1; return; }
        (void)hipOccupancyMaxActiveBlocksPerMultiprocessor(&per_cu, (const void*)fwd_kernel, NTHREADS, LDS_BYTES);
        (void)hipGetLastError();
        if (per_cu < 1) fprintf(stderr, "kernel_launch: occupancy query says %d blocks per CU\n", per_cu);
        grid = cus;
    }
    if (grid < 0) return;
    (void)hipMemsetAsync((char*)d_ws + WS_CTL, 0, CTL_BYTES, stream);
    Args a; memset(&a, 0, sizeof(a));
    for (int i = 0; i < 47; ++i) a.in[i] = (const float*)d_in[i];
    a.out = (float*)d_out; a.ws = (unsigned char*)d_ws; a.ph_lo = 0; a.ph_hi = 1000;
    hipLaunchKernelGGL(fwd_kernel, dim3(grid), dim3(NTHREADS), LDS_BYTES, stream, a);
}
```

```cpp
#include <hip/hip_runtime.h>
#include <stdint.h>
#include <stdio.h>
#include <string.h>

#define LAS __attribute__((address_space(3)))
#define GAS __attribute__((address_space(1)))
typedef unsigned short bf16_t;
typedef short bf16x8 __attribute__((ext_vector_type(8)));
typedef short bf16x4 __attribute__((ext_vector_type(4)));
typedef float f32x4 __attribute__((ext_vector_type(4)));
typedef float f32x2 __attribute__((ext_vector_type(2)));
typedef unsigned u32x4 __attribute__((ext_vector_type(4)));
typedef unsigned u32x2 __attribute__((ext_vector_type(2)));

constexpr int D = 1024, SEQ = 16384, NCTX = 256, NTOK = SEQ + NCTX;
constexpr int NE = 64, TOPK = 8, EDIM = 256;
constexpr float ALPHA = 1.681792830507429f;
constexpr float LN_EPS = 1e-5f;
constexpr int NTHREADS = 512, NWAVES = 8;

#ifndef DUP
#define DUP 0
#endif
#ifndef RWKV_CHUNKED
#define RWKV_CHUNKED 1
#endif
#ifndef EN_LRU
#define EN_LRU 1
#endif
#ifndef EN_RWKV
#define EN_RWKV 1
#endif
#ifndef EN_RET
#define EN_RET 1
#endif
#ifndef EN_HGRN
#define EN_HGRN 1
#endif
#ifndef EN_MOE
#define EN_MOE 1
#endif

__device__ __forceinline__ unsigned f2bf(float f) { unsigned u = __builtin_bit_cast(unsigned, f); return (u + 0x7fffu + ((u >> 16) & 1u)) >> 16; }
__device__ __forceinline__ float bf2f(unsigned b) { return __builtin_bit_cast(float, b << 16); }
__device__ __forceinline__ unsigned pk2(float lo, float hi) { unsigned r; asm volatile("v_cvt_pk_bf16_f32 %0, %1, %2" : "=v"(r) : "v"(lo), "v"(hi)); return r; }
__device__ __forceinline__ float bflo(unsigned w) { return __builtin_bit_cast(float, w << 16); }
__device__ __forceinline__ float bfhi(unsigned w) { return __builtin_bit_cast(float, w & 0xffff0000u); }
__device__ __forceinline__ float sigmoidf_(float x) { return __builtin_amdgcn_rcpf(1.0f + __expf(-x)); }
__device__ __forceinline__ float siluf_(float x) { return x * __builtin_amdgcn_rcpf(1.0f + __expf(-x)); }
__device__ __forceinline__ float wave_sum(float v) {
#pragma unroll
    for (int o = 1; o < 64; o <<= 1) v += __shfl_xor(v, o);
    return v;
}

#define XB_TMO      128
#define XB_XCNT(j)  (256  + 64 * (j))
#define XB_XSUB(j)  (1280 + 64 * (j))
#define XB_XGEN(j)  (2304 + 64 * (j))
#define XB_TOP      3328
#define XB_TOPGEN   3392
#define XCD_BAR_WORDS 3456
#define XB_SPIN_CAP (1u << 22)
__device__ __forceinline__ unsigned xb_ld(unsigned* p)              { return __hip_atomic_load(p, __ATOMIC_RELAXED, __HIP_MEMORY_SCOPE_AGENT); }
__device__ __forceinline__ unsigned xb_add(unsigned* p, unsigned v) { return __hip_atomic_fetch_add(p, v, __ATOMIC_RELAXED, __HIP_MEMORY_SCOPE_AGENT); }
__device__ __forceinline__ unsigned xb_xcc_id() { return (unsigned)__builtin_amdgcn_s_getreg((3 << 11) | 20) & 0xFu; }
#define XB_SPIN(cond, bar) do { unsigned _sp = 0; while (cond) { __builtin_amdgcn_s_sleep(1); \
    if ((++_sp & 255u) == 0u) { if (xb_ld(&(bar)[XB_TMO])) break; if (_sp > XB_SPIN_CAP) { atomicAdd(&(bar)[XB_TMO], 1u); break; } } } } while (0)
struct XcdBarrier { unsigned* bar; unsigned x; volatile LAS unsigned* st; };
__device__ __forceinline__ XcdBarrier xcd_barrier_post(unsigned* bar, volatile LAS unsigned* st) {
    XcdBarrier b; b.bar = bar; b.x = xb_xcc_id(); b.st = st;
    if (threadIdx.x == 0) (void)xb_add(&bar[XB_XCNT(b.x)], 1u);
    return b;
}
__device__ __forceinline__ void xcd_barrier_complete(unsigned* bar, unsigned x, unsigned& nloc, unsigned& nx) {
    const unsigned G = gridDim.x * gridDim.y * gridDim.z;
    unsigned sum, cnt, mine, sp = 0u;
    for (;;) {
        sum = 0u; cnt = 0u; mine = 0u;
#pragma unroll
        for (unsigned j = 0; j < 16; ++j) { const unsigned c = xb_ld(&bar[XB_XCNT(j)]); sum += c; cnt += (c > 0u) ? 1u : 0u; mine = (j == x) ? c : mine; }
        if (sum == G) break;
        __builtin_amdgcn_s_sleep(1);
        if ((++sp & 255u) == 0u) { if (xb_ld(&bar[XB_TMO])) break; if (sp > XB_SPIN_CAP) { atomicAdd(&bar[XB_TMO], 1u); break; } }
    }
    nloc = mine > 0u ? mine : 1u; nx = cnt > 0u ? cnt : 1u;
}
__device__ __forceinline__ void xcd_barrier(const XcdBarrier& b) {
    asm volatile("s_waitcnt vmcnt(0)" ::: "memory");
    __syncthreads();
    if (threadIdx.x == 0) {
        unsigned* bar = b.bar;
        __builtin_amdgcn_s_waitcnt(0);
        unsigned nloc = b.st[0], nx = b.st[1];
        if (nloc == 0u) { xcd_barrier_complete(bar, b.x, nloc, nx); b.st[0] = nloc; b.st[1] = nx; }
        const unsigned old = xb_add(&bar[XB_XSUB(b.x)], 1u);
        const unsigned gen = old / nloc;
        if (old + 1u == (gen + 1u) * nloc) {
            __builtin_amdgcn_fence(__ATOMIC_RELEASE, "agent");
            asm volatile("s_waitcnt vmcnt(0)" ::: "memory");
            const unsigned og = xb_add(&bar[XB_TOP], 1u);
            const unsigned tg = og / nx;
            if (og + 1u == (tg + 1u) * nx) xb_add(&bar[XB_TOPGEN], 1u);
            else XB_SPIN(xb_ld(&bar[XB_TOPGEN]) == tg, bar);
            __builtin_amdgcn_fence(__ATOMIC_ACQUIRE, "agent");
            xb_add(&bar[XB_XGEN(b.x)], 1u);
            asm volatile("s_waitcnt vmcnt(0)" ::: "memory");
        } else {
            XB_SPIN(xb_ld(&bar[XB_XGEN(b.x)]) == gen, bar);
            __builtin_amdgcn_fence(__ATOMIC_ACQUIRE, "agent");
            asm volatile("s_waitcnt vmcnt(0)" ::: "memory");
        }
    }
    __syncthreads();
}

namespace gg {
constexpr int BM = 256, BK = 64, HALF = 128, HTB = HALF * BK * 2, STAGE_BYTES = 8 * HTB;
__device__ __forceinline__ int lds_byte(int r, int c) { const int st = (r >> 4) * 2 + (c >> 5), rr = r & 15, cc = c & 31, ob = rr * 64 + cc * 2; return st * 1024 + (ob ^ (((ob >> 9) & 1) << 5)); }
__device__ __forceinline__ void stage_rc(int b, int& R, int& C) { const int st = b / 1024, sb = b % 1024, swz = sb ^ (((sb >> 9) & 1) << 5); R = (st >> 1) * 16 + swz / 64; C = (st & 1) * 32 + (swz % 64) / 2; }
__device__ __forceinline__ int perm32(int rho) { const int n = rho >> 4, i = rho & 15; return 8 * (i >> 2) + 4 * n + (i & 3); }

struct Unit { const char* a; const char* b; const char* b2; int pm, pn, gofs, x; };
struct Dims { int K, lda, ldb, kseg, ldb2; };

typedef f32x4 Acc[2][2][4][2];

template <class Epi, class Sched, bool GATHER, bool SEGB>
__device__ __forceinline__ void gemm_phase(LAS unsigned char* lds, const Dims dm, const Sched& S, const Epi& E) {
    const int tid = threadIdx.x, wid = __builtin_amdgcn_readfirstlane(tid >> 6), lane = tid & 63, wr = wid >> 2, wc = wid & 3, fr = lane & 15, fq = lane >> 4;
    const int K = dm.K, nt = K / BK;
    unsigned voffB[2], voffB2[2], cAo[2][2], nAo[2][2]; int gR[2], gC[2];
    const unsigned hstepA = (unsigned)HALF * dm.lda * 2u, hstepB = (unsigned)HALF * dm.ldb * 2u, hstepB2 = (unsigned)HALF * dm.ldb2 * 2u;
#pragma unroll
    for (int i = 0; i < 2; ++i) { int R, C; stage_rc(tid * 16 + i * 8192, R, C); const int Rb = Epi::PERM ? ((R & ~31) + perm32(R & 31)) : R;
        gR[i] = R; gC[i] = C * 2; voffB[i] = (unsigned)(Rb * dm.ldb + C) * 2u; voffB2[i] = SEGB ? (unsigned)(Rb * dm.ldb2 + C) * 2u : 0u;
        cAo[0][i] = (unsigned)(R * dm.lda + C) * 2u; cAo[1][i] = cAo[0][i] + hstepA; }
    const unsigned ldsw = (unsigned)wid * 1024u;
    const int aoff = lds_byte(wr * 64 + fr, fq * 8), boff = lds_byte(wc * 32 + fr, fq * 8);
#define GG_SA(b, h) (((b) * 2 + (h)) * HTB)
#define GG_SB(b, h) ((4 + (b) * 2 + (h)) * HTB)
#define GG_STAGE(bufoff, gbase, voff) do { _Pragma("unroll") for (int _i = 0; _i < 2; ++_i) \
        __builtin_amdgcn_global_load_lds((const unsigned*)((const char*)(gbase) + (voff)[_i]), (LAS unsigned*)(lds + (bufoff) + ldsw + _i * 8192), 16, 0, 0); } while (0)
#define GG_LDA(dst, b, h) do { _Pragma("unroll") for (int m = 0; m < 4; ++m) _Pragma("unroll") for (int k = 0; k < 2; ++k) dst[m][k] = *(const LAS bf16x8*)(lds + GG_SA(b, h) + aoff + m * 2048 + k * 1024); } while (0)
#define GG_LDB(dst, b, h) do { _Pragma("unroll") for (int n = 0; n < 2; ++n) _Pragma("unroll") for (int k = 0; k < 2; ++k) dst[n][k] = *(const LAS bf16x8*)(lds + GG_SB(b, h) + boff + n * 2048 + k * 1024); } while (0)
#define GG_MMA(ai, bj, At, Bt) do { __builtin_amdgcn_s_setprio(1); _Pragma("unroll") for (int m = 0; m < 4; ++m) _Pragma("unroll") for (int n = 0; n < 2; ++n) _Pragma("unroll") for (int k = 0; k < 2; ++k) \
        acc[ai][bj][m][n] = __builtin_amdgcn_mfma_f32_16x16x32_bf16(Bt[n][k], At[m][k], acc[ai][bj][m][n], 0, 0, 0); __builtin_amdgcn_s_setprio(0); } while (0)
#define GG_WAIT_V(n) asm volatile("s_waitcnt vmcnt(" #n ")" ::: "memory")
#define GG_WAIT_L(n) asm volatile("s_waitcnt lgkmcnt(" #n ")" ::: "memory")
#define GG_BAR __builtin_amdgcn_s_barrier()
#define GG_SCHED __builtin_amdgcn_sched_barrier(0)
#define GG_BSRC(u, kt) ((SEGB && (kt) >= dm.kseg) ? (u).b2 + (size_t)((kt) - dm.kseg) * 128 : (u).b + (size_t)(kt) * 128)
#define GG_STAGE_B(bufoff, u, kt, h) do { const bool _s2 = SEGB && (kt) >= dm.kseg; \
        const char* _bp = _s2 ? (u).b2 + (size_t)((kt) - dm.kseg) * 128 + (h) * hstepB2 : (u).b + (size_t)(kt) * 128 + (h) * hstepB; \
        unsigned _vo[2]; _vo[0] = _s2 ? voffB2[0] : voffB[0]; _vo[1] = _s2 ? voffB2[1] : voffB[1]; GG_STAGE(bufoff, _bp, _vo); } while (0)
#define GG_GOFF(u, dst) do { if (GATHER) { const LAS int* _ix = (const LAS int*)(lds + (u).gofs); _Pragma("unroll") for (int _h = 0; _h < 2; ++_h) _Pragma("unroll") for (int _i = 0; _i < 2; ++_i) \
        dst[_h][_i] = (unsigned)_ix[_h * 128 + gR[_i]] * (unsigned)(dm.lda * 2) + (unsigned)gC[_i]; } } while (0)
    Unit cur, nxt; int ui = 0;
    if (!S.next(0, cur)) return;
    Acc acc;
#pragma unroll
    for (int a = 0; a < 2; ++a)
#pragma unroll
        for (int b = 0; b < 2; ++b)
#pragma unroll
            for (int m = 0; m < 4; ++m)
#pragma unroll
                for (int n = 0; n < 2; ++n) acc[a][b][m][n] = (f32x4){0.f, 0.f, 0.f, 0.f};
    bf16x8 At[4][2], B0[2][2], B1[2][2];
    GG_GOFF(cur, cAo);
    GG_STAGE_B(GG_SB(0, 0), cur, 0, 0); GG_STAGE(GG_SA(0, 0), cur.a, cAo[0]); GG_STAGE_B(GG_SB(0, 1), cur, 0, 1); GG_STAGE(GG_SA(0, 1), cur.a, cAo[1]);
    if (wr == 1) GG_BAR;
    GG_WAIT_V(4); GG_BAR;
    GG_STAGE_B(GG_SB(1, 0), cur, 1, 0); GG_STAGE(GG_SA(1, 0), cur.a + 128, cAo[0]); GG_STAGE_B(GG_SB(1, 1), cur, 1, 1);
    GG_WAIT_V(6); GG_BAR;
    for (;;) {
        const bool has_next = S.next(ui + 1, nxt);
        if (!has_next) nxt = cur;
        if (GATHER) { if (has_next) { GG_GOFF(nxt, nAo); } else {
#pragma unroll
            for (int h = 0; h < 2; ++h)
#pragma unroll
                for (int i = 0; i < 2; ++i) nAo[h][i] = cAo[h][i]; } }
        for (int t = 0; t < nt; t += 2) {
            const bool last = (t == nt - 2);
            const char* a1 = cur.a + (size_t)(t + 1) * 128;
            const char* a2 = last ? nxt.a : cur.a + (size_t)(t + 2) * 128;
            const char* a3 = a2 + 128;
            unsigned o2[2][2];
#pragma unroll
            for (int h = 0; h < 2; ++h)
#pragma unroll
                for (int i = 0; i < 2; ++i) o2[h][i] = (GATHER && last) ? nAo[h][i] : cAo[h][i];
            const int k2 = last ? 0 : t + 2, k3 = k2 + 1;
            struct { const char* b; const char* b2; } bu; bu.b = last ? nxt.b : cur.b; bu.b2 = last ? nxt.b2 : cur.b2;
            GG_LDB(B0, 0, 0); GG_SCHED; GG_LDA(At, 0, 0); GG_STAGE(GG_SA(1, 1), a1, cAo[1]);
            GG_WAIT_L(8); GG_BAR; GG_WAIT_L(0); GG_MMA(0, 0, At, B0); GG_BAR; GG_SCHED;
            GG_LDB(B1, 0, 1); GG_STAGE_B(GG_SB(0, 0), bu, k2, 0);
            GG_BAR; GG_WAIT_L(0); GG_MMA(0, 1, At, B1); GG_BAR;
            GG_LDA(At, 0, 1); GG_STAGE(GG_SA(0, 0), a2, o2[0]);
            GG_BAR; GG_WAIT_L(0); GG_MMA(1, 0, At, B0); GG_BAR; GG_SCHED;
            GG_STAGE_B(GG_SB(0, 1), bu, k2, 1);
            GG_WAIT_V(6); GG_BAR; GG_MMA(1, 1, At, B1); GG_BAR;
            GG_LDB(B0, 1, 0); GG_SCHED; GG_LDA(At, 1, 0); GG_STAGE(GG_SA(0, 1), a2, o2[1]);
            GG_WAIT_L(8); GG_BAR; GG_WAIT_L(0); GG_MMA(0, 0, At, B0); GG_BAR; GG_SCHED;
            GG_LDB(B1, 1, 1); GG_STAGE_B(GG_SB(1, 0), bu, k3, 0);
            GG_BAR; GG_WAIT_L(0); GG_MMA(0, 1, At, B1); GG_BAR;
            GG_LDA(At, 1, 1); GG_STAGE(GG_SA(1, 0), a3, o2[0]);
            GG_BAR; GG_WAIT_L(0); GG_MMA(1, 0, At, B0); GG_BAR; GG_SCHED;
            GG_STAGE_B(GG_SB(1, 1), bu, k3, 1);
            GG_WAIT_V(6); GG_BAR; GG_MMA(1, 1, At, B1); GG_BAR;
        }
        E(acc, cur, wr, wc, fr, fq);
        if (!has_next) break;
#pragma unroll
        for (int a = 0; a < 2; ++a)
#pragma unroll
            for (int b = 0; b < 2; ++b)
#pragma unroll
                for (int m = 0; m < 4; ++m)
#pragma unroll
                    for (int n = 0; n < 2; ++n) acc[a][b][m][n] = (f32x4){0.f, 0.f, 0.f, 0.f};
        cur = nxt; ++ui;
        if (GATHER) {
#pragma unroll
            for (int h = 0; h < 2; ++h)
#pragma unroll
                for (int i = 0; i < 2; ++i) cAo[h][i] = nAo[h][i]; }
    }
    GG_WAIT_V(0);
    if (wr == 0) GG_BAR;
    GG_BAR;
#undef GG_SA
#undef GG_SB
#undef GG_STAGE
#undef GG_LDA
#undef GG_LDB
#undef GG_MMA
#undef GG_WAIT_V
#undef GG_WAIT_L
#undef GG_BAR
#undef GG_SCHED
#undef GG_BSRC
#undef GG_STAGE_B
#undef GG_GOFF
}

struct DenseSched {
    const char* A; const char* Bt; int nM, nN, G, c; unsigned astep, bstep;
    __device__ __forceinline__ void init(const bf16_t* A_, const bf16_t* Bt_, int M, int N, int lda, int ldb) {
        A = (const char*)A_; Bt = (const char*)Bt_; nM = M / 256; nN = N / 256; G = gridDim.x; c = blockIdx.x; astep = 256u * lda * 2u; bstep = 256u * ldb * 2u; }
    __device__ __forceinline__ bool next(int i, Unit& u) const {
        const int L = i * G + c, nwg = nM * nN; if (L >= nwg) return false;
        int wgid; { const int q = nwg / 8, r = nwg % 8, xcd = L % 8, off = L / 8; wgid = (xcd < r ? xcd * (q + 1) : r * (q + 1) + (xcd - r) * q) + off; }
        const int nig = 8 * nN, gid = wgid / nig, fm = gid * 8, gsz = (nM - fm) < 8 ? (nM - fm) : 8;
        u.pm = fm + ((wgid % nig) % gsz); u.pn = (wgid % nig) / gsz;
        u.a = A + (size_t)u.pm * astep; u.b = Bt + (size_t)u.pn * bstep; u.b2 = nullptr; u.gofs = 0; u.x = 0; return true; }
};
}

constexpr size_t MiB = 1u << 20;
constexpr size_t WS_CTL = 0, CTL_BYTES = 1 * MiB;
constexpr int CW_BAR = 4096, CW_CNT = 8192, CW_CUR = 8192 + 256, CW_NT = 8192 + 512;
constexpr size_t WS_MODP = 1 * MiB, WS_MOD = 3 * MiB, WS_ROPE = 3 * MiB + 256 * 1024, WS_LBV = 3 * MiB + 512 * 1024;
constexpr size_t WS_W_LRU_IN = 4 * MiB, WS_W_LRU_OUT = 8 * MiB, WS_W_LRU_GATE = 10 * MiB;
constexpr size_t WS_W_RWKV_IN = 11 * MiB, WS_W_RWKV_L1 = 17 * MiB, WS_W_RWKV_OUT = 20 * MiB, WS_W_RWKV_WL2 = 556 * MiB;
constexpr size_t WS_W_RET_IN = 22 * MiB, WS_W_RET_OUT = 34 * MiB, WS_W_HGRN_IN = 38 * MiB, WS_W_HGRN_OUT = 48 * MiB;
constexpr size_t WS_MOE = 50 * MiB, MOE_STRIDE = 100 * MiB, MOE_GU = 0, MOE_DN = 64 * MiB, MOE_SHGU = 96 * MiB, MOE_SHDN = 97 * MiB, MOE_RT = 97 * MiB + 512 * 1024;
constexpr size_t WS_H = 450 * MiB, WS_U = 515 * MiB;
constexpr size_t WS_TOPI = 548 * MiB, WS_TOPW = 549 * MiB, WS_POS = 550 * MiB, WS_ROWTOK = 551 * MiB, WS_ROWW = 552 * MiB, WS_TILEE = 553 * MiB;
constexpr size_t WS_SCR = 560 * MiB;
constexpr size_t WS_ULO = WS_SCR + 760 * MiB;
constexpr size_t WS_DUMMY = 1500 * MiB;
constexpr int SH_BASE = 149504;
constexpr int NROWS_SORT = SH_BASE + NTOK;
constexpr size_t WS_ACT = WS_SCR, WS_OUT = WS_SCR + 82 * MiB;
constexpr size_t WS_END = WS_SCR + 880 * MiB;
constexpr size_t WS_MX0 = WS_SCR, WS_MX1 = WS_SCR + 33 * MiB, WS_MX2 = WS_SCR + 66 * MiB, WS_MX3 = WS_SCR + 99 * MiB, WS_MX4 = WS_SCR + 132 * MiB, WS_MX5 = WS_SCR + 165 * MiB;

constexpr int LDS_STAGE = 0, LDS_TAB = 131072, LDS_TAB_BYTES = 20480, LDS_MISC = LDS_TAB + LDS_TAB_BYTES, LDS_BYTES = 155648;

struct Args { const float* in[47]; float* out; unsigned char* ws; int ph_lo, ph_hi; };

struct Frame {
    LAS unsigned char* lds; volatile LAS unsigned* misc; unsigned* ctl; unsigned char* ws;
    int tid, lane, wave, gw, ngw;
};

struct TrJob { const float* src; bf16_t* dst; int ld_src, K, N, ld_dst, nb, sbs, dbs, mode, start; };
constexpr int MAXJOBS = 64;
__device__ __forceinline__ void tr_item(const TrJob& J, int item, LAS unsigned char* scr, int lane) {
    const int nblk = (J.N + 63) >> 6, kblk = J.K >> 6, per = nblk * kblk, bi = item / per, r = item - bi * per, kb = r / nblk, nb = r - kb * nblk, k0 = 64 * kb, n0 = 64 * nb;
    int c0 = n0;
    if (J.mode == 1) { const int pn = n0 >> 8, j = n0 & 255; c0 = (j < 128) ? (128 * pn + j) : (256 + 128 * pn + (j - 128)); }
    const float* W = J.src + (size_t)bi * J.sbs + (size_t)k0 * J.ld_src + c0; bf16_t* WT = J.dst + (size_t)bi * J.dbs + (size_t)n0 * J.ld_dst + k0;
    const int cq = lane & 15, rq = lane >> 4;
    const bool nok = (n0 + 4 * cq) < J.N;
    f32x4 v[16];
#pragma unroll
    for (int i = 0; i < 16; ++i) { v[i] = (f32x4){0.f, 0.f, 0.f, 0.f}; if (nok) v[i] = *(const f32x4*)(W + (size_t)(4 * i + rq) * J.ld_src + 4 * cq); }
#pragma unroll
    for (int i = 0; i < 16; ++i) { const int kk = 4 * i + rq;
#pragma unroll
        for (int e = 0; e < 4; ++e) { float x = v[i][e]; if (J.mode == 3) x = x - bf2f(f2bf(x)); *(LAS unsigned short*)(scr + (4 * cq + e) * 144 + kk * 2) = (unsigned short)f2bf(x); } }
    asm volatile("s_waitcnt lgkmcnt(0)" ::: "memory");
    const int ch = lane & 7, nr = lane >> 3;
#pragma unroll
    for (int j = 0; j < 8; ++j) { const int n = nr + 8 * j; if (n0 + n < J.N) *(u32x4*)(WT + (size_t)n * J.ld_dst + 8 * ch) = *(const LAS u32x4*)(scr + n * 144 + 16 * ch); }
    asm volatile("s_waitcnt lgkmcnt(0)" ::: "memory");
}
__device__ __forceinline__ void ldrow_f32(const float* row, int lane, float (&v)[16]) {
#pragma unroll
    for (int j = 0; j < 2; ++j) { const f32x4 a = *(const f32x4*)(row + 8 * lane + 512 * j), b = *(const f32x4*)(row + 8 * lane + 512 * j + 4);
        v[8 * j + 0] = a.x; v[8 * j + 1] = a.y; v[8 * j + 2] = a.z; v[8 * j + 3] = a.w; v[8 * j + 4] = b.x; v[8 * j + 5] = b.y; v[8 * j + 6] = b.z; v[8 * j + 7] = b.w; }
}
__device__ __forceinline__ void strow_f32(float* row, int lane, const float (&v)[16]) {
#pragma unroll
    for (int j = 0; j < 2; ++j) { *(f32x4*)(row + 8 * lane + 512 * j) = (f32x4){v[8 * j], v[8 * j + 1], v[8 * j + 2], v[8 * j + 3]}; *(f32x4*)(row + 8 * lane + 512 * j + 4) = (f32x4){v[8 * j + 4], v[8 * j + 5], v[8 * j + 6], v[8 * j + 7]}; }
}
__device__ __forceinline__ void ldrow_bf16(const bf16_t* row, int lane, float (&v)[16]) {
#pragma unroll
    for (int j = 0; j < 2; ++j) { const u32x4 a = *(const u32x4*)(row + 8 * lane + 512 * j);
        v[8 * j + 0] = bflo(a.x); v[8 * j + 1] = bfhi(a.x); v[8 * j + 2] = bflo(a.y); v[8 * j + 3] = bfhi(a.y); v[8 * j + 4] = bflo(a.z); v[8 * j + 5] = bfhi(a.z); v[8 * j + 6] = bflo(a.w); v[8 * j + 7] = bfhi(a.w); }
}
__device__ __forceinline__ void addrow_bf16(const bf16_t* row, int lane, float (&v)[16]) {
#pragma unroll
    for (int j = 0; j < 2; ++j) { const u32x4 a = *(const u32x4*)(row + 8 * lane + 512 * j);
        v[8 * j + 0] += bflo(a.x); v[8 * j + 1] += bfhi(a.x); v[8 * j + 2] += bflo(a.y); v[8 * j + 3] += bfhi(a.y); v[8 * j + 4] += bflo(a.z); v[8 * j + 5] += bfhi(a.z); v[8 * j + 6] += bflo(a.w); v[8 * j + 7] += bfhi(a.w); }
}
__device__ __forceinline__ void addrow_fp8(const unsigned char* row, int lane, float (&v)[16]) {
    typedef float f2v __attribute__((ext_vector_type(2)));
#pragma unroll
    for (int j = 0; j < 2; ++j) { const u32x2 a = *(const u32x2*)(row + 8 * lane + 512 * j);
        const f2v p0 = __builtin_amdgcn_cvt_pk_f32_fp8((int)a.x, false), p1 = __builtin_amdgcn_cvt_pk_f32_fp8((int)a.x, true), p2 = __builtin_amdgcn_cvt_pk_f32_fp8((int)a.y, false), p3 = __builtin_amdgcn_cvt_pk_f32_fp8((int)a.y, true);
        v[8 * j + 0] += p0[0]; v[8 * j + 1] += p0[1]; v[8 * j + 2] += p1[0]; v[8 * j + 3] += p1[1]; v[8 * j + 4] += p2[0]; v[8 * j + 5] += p2[1]; v[8 * j + 6] += p3[0]; v[8 * j + 7] += p3[1]; }
}
__device__ __forceinline__ void strow_bf16(bf16_t* row, int lane, const float (&v)[16]) {
#pragma unroll
    for (int j = 0; j < 2; ++j) { u32x4 o; o.x = pk2(v[8 * j], v[8 * j + 1]); o.y = pk2(v[8 * j + 2], v[8 * j + 3]); o.z = pk2(v[8 * j + 4], v[8 * j + 5]); o.w = pk2(v[8 * j + 6], v[8 * j + 7]);
        *(u32x4*)(row + 8 * lane + 512 * j) = o; }
}

#define add(src_, wsoff_, ld_src_, K_, N_, ld_dst_, nb_, sbs_, dbs_, mode_) do { TrJob J; J.src = (src_); J.dst = (bf16_t*)(a.ws + (wsoff_)); J.ld_src = (ld_src_); J.K = (K_); J.N = (N_); J.ld_dst = (ld_dst_); \
            J.nb = (nb_); J.sbs = (sbs_); J.dbs = (dbs_); J.mode = (mode_); J.start = start; jobs[n] = J; start += (nb_) * ((K_) / 64) * (((N_) + 63) / 64); ++n; } while (0)
__device__ __forceinline__ void add_moe_jobs(TrJob* jobs, int& n, int& start, const Args& a, int l) {
    const size_t mb = WS_MOE + l * MOE_STRIDE;
    add(a.in[43] + (size_t)l * 64 * 1024 * 512, mb + MOE_GU, 512, 1024, 512, 1024, 64, 1024 * 512, 512 * 1024, 1);
    add(a.in[44] + (size_t)l * 64 * 256 * 1024, mb + MOE_DN, 1024, 256, 1024, 256, 64, 256 * 1024, 1024 * 256, 0);
    add(a.in[45] + (size_t)l * 1024 * 512, mb + MOE_SHGU, 512, 1024, 512, 1024, 1, 0, 0, 1);
    add(a.in[46] + (size_t)l * 256 * 1024, mb + MOE_SHDN, 1024, 256, 1024, 256, 1, 0, 0, 0);
    add(a.in[41] + (size_t)l * 1024 * 64, mb + MOE_RT, 64, 1024, 64, 1024, 1, 0, 0, 2);
    add(a.in[41] + (size_t)l * 1024 * 64, mb + MOE_RT + 64 * 1024 * 2, 64, 1024, 64, 1024, 1, 0, 0, 3);
}
constexpr int BG_PER_LAYER = 12512, BG_NJOBS = 28, BG_E0 = 12512, BG_E1 = 27072, BG_E2 = 41120, BG_TOTAL = 53632;
__device__ __forceinline__ void bg_convert(Frame& F, const Args& a, int lo, int hi, int first, int stride) {
    if (lo >= hi) return;
    TrJob* jobs = (TrJob*)(F.lds + LDS_TAB);
    if (F.tid == 0) { int n = 0, start = 0;
        add_moe_jobs(jobs, n, start, a, 0);
        add_moe_jobs(jobs, n, start, a, 1);
        add(a.in[31], WS_W_RET_IN, 6144, 1024, 6144, 1024, 1, 0, 0, 0);
        add(a.in[35], WS_W_RET_OUT, 1024, 2048, 1024, 2048, 1, 0, 0, 0);
        add_moe_jobs(jobs, n, start, a, 2);
        add(a.in[36], WS_W_HGRN_IN, 5120, 1024, 5120, 1024, 1, 0, 0, 0);
        add(a.in[40], WS_W_HGRN_OUT, 1024, 1024, 1024, 1024, 1, 0, 0, 0);
        add_moe_jobs(jobs, n, start, a, 3);
        { TrJob J = jobs[n - 1]; J.start = start; J.nb = 0; jobs[n] = J; } }
    __syncthreads();
    LAS unsigned char* scr = F.lds + LDS_STAGE + F.wave * 16384;
    for (int it = lo + first; it < hi; it += stride) {
        int j = 0; while (j + 1 < BG_NJOBS && jobs[j + 1].start <= it) ++j;
        const TrJob J = jobs[j];
        tr_item(J, it - J.start, scr, F.lane);
    }
    __syncthreads();
}
template <int EV>
__device__ __forceinline__ void bg_range(int G, int& lo, int& hi, int& nidle, int& rem) {
    int ptr = 0; lo = hi = 0; nidle = 0; rem = 0;
#define BG_SLOT(e, rem_, q) if (EV >= (e)) { const int r_ = (rem_), ni_ = G > r_ ? G - r_ : 0; lo = ptr; hi = min(ptr + (q) * ni_ * 8, BG_TOTAL); ptr = hi; nidle = ni_; rem = r_; }
#define BG_CATCH(e, end_) if (EV >= (e)) { lo = ptr; hi = max(ptr, (end_)); ptr = hi; nidle = 0; rem = 0; }
    BG_SLOT(0, 520 % G, 4) BG_SLOT(1, 260 % G, 4) BG_CATCH(2, BG_E0) BG_SLOT(3, 32, 3) BG_SLOT(4, 260 % G, 3) BG_CATCH(5, BG_E1) BG_SLOT(6, 1560 % G, 3) BG_SLOT(7, 260 % G, 4) BG_CATCH(8, BG_E2)
    BG_SLOT(9, 1300 % G, 3) BG_SLOT(10, 1040 % G, 1) BG_SLOT(11, 1040 % G, 3) BG_CATCH(12, BG_TOTAL)
#undef BG_SLOT
#undef BG_CATCH
}
template <int EV>
__device__ __forceinline__ void bg_slot(Frame& F, const Args& a) {
    int lo, hi, nidle, rem; bg_range<EV>((int)gridDim.x, lo, hi, nidle, rem);
    const int c = (int)blockIdx.x;
    if (nidle > 0 && c >= rem) bg_convert(F, a, lo, hi, (c - rem) * 8 + F.wave, nidle * 8);
}
template <int EV>
__device__ __forceinline__ void bg_catch(Frame& F, const Args& a) {
    int lo, hi, nidle, rem; bg_range<EV>((int)gridDim.x, lo, hi, nidle, rem);
    bg_convert(F, a, lo, hi, F.gw, F.ngw);
}

__device__ __forceinline__ void p0_phase(Frame& F, const Args& a) {
    TrJob* jobs = (TrJob*)(F.lds + LDS_TAB);
    int* njobs = (int*)(F.lds + LDS_TAB + MAXJOBS * sizeof(TrJob));
    if (F.tid == 0) {
        int n = 0, start = 0;
        add(a.in[8], WS_W_LRU_IN, 2048, 1024, 2048, 1024, 1, 0, 0, 0);
        add(a.in[14], WS_W_LRU_OUT, 1024, 1024, 1024, 1024, 1, 0, 0, 0);
        add(a.in[11], WS_W_LRU_GATE, 64, 64, 64, 64, 64, 4096, 4096, 0);
        add(a.in[16], WS_W_RWKV_IN, 1024, 1024, 1024, 1024, 3, 1024 * 1024, 1024 * 1024, 0);
        add(a.in[18], WS_W_RWKV_L1, 64, 1024, 64, 1024, 2, 1024 * 64, 64 * 1024, 0);
        add(a.in[21], WS_W_RWKV_L1 + 256 * 1024 * 2, 64, 1024, 64, 1024, 2, 1024 * 64, 64 * 1024, 0);
        add(a.in[23], WS_W_RWKV_L1 + 512 * 1024 * 2, 128, 1024, 128, 1024, 1, 0, 0, 0);
        add(a.in[19], WS_W_RWKV_WL2, 1024, 64, 1024, 256, 1, 0, 0, 0);
        add(a.in[19] + 64 * 1024, WS_W_RWKV_WL2 + (size_t)(1 * 1024 * 256 + 64) * 2, 1024, 64, 1024, 256, 1, 0, 0, 0);
        add(a.in[22], WS_W_RWKV_WL2 + (size_t)(2 * 1024 * 256) * 2, 1024, 64, 1024, 256, 1, 0, 0, 0);
        add(a.in[22] + 64 * 1024, WS_W_RWKV_WL2 + (size_t)(3 * 1024 * 256 + 64) * 2, 1024, 64, 1024, 256, 1, 0, 0, 0);
        add(a.in[24], WS_W_RWKV_WL2 + (size_t)(4 * 1024 * 256) * 2, 1024, 128, 1024, 256, 1, 0, 0, 0);
        add(a.in[30], WS_W_RWKV_OUT, 1024, 1024, 1024, 1024, 1, 0, 0, 0);
        { TrJob J = jobs[n - 1]; J.start = start; J.nb = 0; jobs[n] = J; }
        *njobs = n;
#undef add
    }
    __syncthreads();
    const int nj = *njobs, total = jobs[nj].start;
    LAS unsigned char* scr = F.lds + LDS_STAGE + F.wave * 16384;
    for (int it = F.gw; it < total; it += F.ngw) {
        int j = 0; while (j + 1 < nj && jobs[j + 1].start <= it) ++j;
        const TrJob J = jobs[j];
        tr_item(J, it - J.start, scr, F.lane);
    }
    { u32x4* z = (u32x4*)(a.ws + WS_W_RWKV_L1); const u32x4 zero = {0u, 0u, 0u, 0u};
      for (int i = blockIdx.x * NTHREADS + F.tid; i < 3 * 128 * 128; i += gridDim.x * NTHREADS) { const int blk = i / (128 * 128), r = i % (128 * 128); z[(size_t)(blk * 256 + 128) * 128 + r] = zero; } }
    { u32x4* z = (u32x4*)(a.ws + WS_W_RWKV_WL2); const u32x4 zero = {0u, 0u, 0u, 0u};
      for (int i = blockIdx.x * NTHREADS + F.tid; i < 5 * 1024 * 32; i += gridDim.x * NTHREADS) { const int g = i / (1024 * 32), c8 = (i & 31) * 8;
          const int lo = (g == 1 || g == 3) ? 64 : 0, hi = (g == 4) ? 128 : lo + 64; if (c8 < lo || c8 >= hi) z[i] = zero; } }
    const float* cvec = a.in[1]; const float* ccvec = a.in[3]; const float* adaw = a.in[4];
    float* modp = (float*)(a.ws + WS_MODP);
    for (int it = F.gw; it < 4 * 96 * 8; it += F.ngw) {
        const int s = it & 7, cb = (it >> 3) % 96, l = it / 768, j = cb * 64 + F.lane;
        const float* W = adaw + ((size_t)l * 1024 + s * 128) * 6144 + j;
        float al = 0.f, ac = 0.f;
#pragma unroll 8
        for (int k = 0; k < 128; ++k) { const float w = W[(size_t)k * 6144]; al += siluf_(cvec[s * 128 + k]) * w; ac += siluf_(ccvec[s * 128 + k]) * w; }
        modp[((size_t)(s * 4 + l) * 2 + 0) * 6144 + j] = al; modp[((size_t)(s * 4 + l) * 2 + 1) * 6144 + j] = ac;
    }
}
__device__ __forceinline__ void p1a_phase(Frame& F, const Args& a) {
    const float* modp = (const float*)(a.ws + WS_MODP); float* mod = (float*)(a.ws + WS_MOD); const float* adab = a.in[5];
    const int gt = blockIdx.x * NTHREADS + F.tid, ngt = gridDim.x * NTHREADS;
    for (int i = gt; i < 4 * 2 * 6144; i += ngt) { const int j = i % 6144, l = i / (2 * 6144);
        float s = adab[l * 6144 + j];
#pragma unroll
        for (int sl = 0; sl < 8; ++sl) s += modp[(size_t)sl * 4 * 2 * 6144 + i];
        mod[i] = s; }
    float* rope = (float*)(a.ws + WS_ROPE);
    for (int i = gt; i < 256 * 64; i += ngt) { const int p = i >> 6, f = i & 63; const double ang = (double)p * pow(10000.0, -(double)f / 64.0); rope[i] = (float)cos(ang); rope[256 * 64 + i] = (float)sin(ang); }
    float* lbv = (float*)(a.ws + WS_LBV); const float* hl = a.in[38];
    for (int i = gt; i < 1024; i += ngt) { const float x0 = hl[i], x1 = hl[1024 + i], x2 = hl[2048 + i], x3 = hl[3072 + i]; const float m = fmaxf(fmaxf(x0, x1), fmaxf(x2, x3));
        const float e0 = expf(x0 - m), e1 = expf(x1 - m), e2 = expf(x2 - m), e3 = expf(x3 - m); lbv[i] = (e1 + e2 + e3) / (e0 + e1 + e2 + e3); }
}
__device__ __forceinline__ const float* modptr(const unsigned char* ws, int l, int kind, int which) { return (const float*)(ws + WS_MOD) + ((size_t)(l * 2 + kind) * 6 + which) * 1024; }
__device__ __forceinline__ void p1b_phase(Frame& F, const Args& a) {
    bf16_t* H = (bf16_t*)(a.ws + WS_H); bf16_t* U = (bf16_t*)(a.ws + WS_U);
    { int* ROWTOK = (int*)(a.ws + WS_ROWTOK); float* ROWW = (float*)(a.ws + WS_ROWW);
      for (int t = blockIdx.x * NTHREADS + F.tid; t < NTOK; t += gridDim.x * NTHREADS) { ROWTOK[SH_BASE + t] = t; ROWW[SH_BASE + t] = 1.0f; } }
    for (int t = F.gw; t < NTOK; t += F.ngw) {
        const int kind = t < NCTX ? 1 : 0; const float* src = kind ? a.in[2] + (size_t)t * D : a.in[0] + (size_t)(t - NCTX) * D;
        float v[16], m0[16], m1[16]; ldrow_f32(src, F.lane, v); ldrow_f32(modptr(a.ws, 0, kind, 0), F.lane, m0); ldrow_f32(modptr(a.ws, 0, kind, 1), F.lane, m1);
        strow_bf16(H + (size_t)t * D, F.lane, v);
#pragma unroll
        for (int e = 0; e < 16; ++e) v[e] = v[e] * (1.0f + m1[e]) + m0[e];
        strow_bf16(U + (size_t)t * D, F.lane, v);
    }
}

template <int L, int MODE, bool DRY = false>
__device__ __forceinline__ void ln_phase(Frame& F, const Args& a) {
    bf16_t* H = (bf16_t*)(a.ws + WS_H); bf16_t* U = (bf16_t*)(a.ws + WS_U);
    bf16_t* Hw = DRY ? (bf16_t*)(a.ws + WS_DUMMY) : H; bf16_t* Uw = DRY ? (bf16_t*)(a.ws + WS_DUMMY + 70 * MiB) : U; float* outw = DRY ? (float*)(a.ws + WS_DUMMY) : a.out;
    const bf16_t* Y = (const bf16_t*)(a.ws + WS_MX5); const unsigned char* OUT = (const unsigned char*)(a.ws + WS_OUT); const int* POS = (const int*)(a.ws + WS_POS);
    const float* lg = a.in[6] + (size_t)(L * 2 + MODE) * D; const float* lb = a.in[7] + (size_t)(L * 2 + MODE) * D;
    constexpr bool LASTL = (L == 3);
#pragma unroll 1
    for (int kind = 0; kind < 2; ++kind) {
        if (LASTL && kind == 1) break;
        float mg[16], g[16], b[16], msh[16], msc[16];
        ldrow_f32(modptr(a.ws, L, kind, MODE == 0 ? 2 : 5), F.lane, mg); ldrow_f32(lg, F.lane, g); ldrow_f32(lb, F.lane, b);
        if (MODE == 0) { ldrow_f32(modptr(a.ws, L, kind, 3), F.lane, msh); ldrow_f32(modptr(a.ws, L, kind, 4), F.lane, msc); }
        else if (!LASTL) { ldrow_f32(modptr(a.ws, (L + 1) & 3, kind, 0), F.lane, msh); ldrow_f32(modptr(a.ws, (L + 1) & 3, kind, 1), F.lane, msc); }
        const int t0 = kind ? 0 : NCTX, t1 = kind ? NCTX : NTOK;
#pragma unroll 1
        for (int t = t0 + F.gw; t < t1; t += F.ngw) {
            float h[16], y[16];
            ldrow_bf16(H + (size_t)t * D, F.lane, h);
            if (MODE == 0) ldrow_bf16(Y + (size_t)t * D, F.lane, y);
            else if (!EN_MOE) {
#pragma unroll
                for (int e = 0; e < 16; ++e) y[e] = 0.f;
            } else {
                int p = 0; if (F.lane < 8) p = POS[t * 8 + F.lane];
#pragma unroll
                for (int e = 0; e < 16; ++e) y[e] = 0.f;
                addrow_fp8(OUT + (size_t)(SH_BASE + t) * D, F.lane, y);
#pragma unroll
                for (int s = 0; s < 8; ++s) { const int r = __builtin_amdgcn_readlane(p, s); addrow_fp8(OUT + (size_t)r * D, F.lane, y); }
            }
            float s = 0.f;
#pragma unroll
            for (int e = 0; e < 16; ++e) { h[e] = ALPHA * h[e] + mg[e] * y[e]; s += h[e]; }
            const float mean = wave_sum(s) * (1.0f / D); float q = 0.f;
#pragma unroll
            for (int e = 0; e < 16; ++e) { h[e] -= mean; q += h[e] * h[e]; }
            const float rstd = 1.0f / sqrtf(wave_sum(q) * (1.0f / D) + LN_EPS);
#pragma unroll
            for (int e = 0; e < 16; ++e) h[e] = h[e] * rstd * g[e] + b[e];
            if (MODE == 1 && LASTL) { strow_f32(outw + (size_t)(t - NCTX) * D, F.lane, h); }
            else {
                strow_bf16(Hw + (size_t)t * D, F.lane, h);
#pragma unroll
                for (int e = 0; e < 16; ++e) h[e] = h[e] * (1.0f + msc[e]) + msh[e];
                strow_bf16(Uw + (size_t)t * D, F.lane, h);
                if (MODE == 0) {
#pragma unroll
                    for (int e = 0; e < 16; ++e) h[e] = h[e] - bf2f(f2bf(h[e]));
                    strow_bf16((DRY ? Uw : (bf16_t*)(a.ws + WS_ULO)) + (size_t)t * D, F.lane, h); }
            }
        }
    }
}

template <int L, bool DRY = false>
__device__ __forceinline__ void moe_route_phase(Frame& F, const Args& a) {
    const bf16_t* U = (const bf16_t*)(a.ws + WS_U); const bf16_t* ULO = (const bf16_t*)(a.ws + WS_ULO);
    const bf16_t* Rhi = (const bf16_t*)(a.ws + WS_MOE + L * MOE_STRIDE + MOE_RT); const bf16_t* Rlo = Rhi + 64 * 1024;
    const float* bias = a.in[42] + L * 64;
    int* TOPI = (int*)(a.ws + (DRY ? WS_DUMMY : WS_TOPI)); float* TOPW = (float*)(a.ws + (DRY ? WS_DUMMY + 4 * MiB : WS_TOPW));
    LAS float* part = (LAS float*)(F.lds + LDS_STAGE);
    const int lane = F.lane, r16 = lane & 15, q = lane >> 4, w = F.wave;
    bf16x8 Bh[4][4], Bl[4][4];
#pragma unroll
    for (int n = 0; n < 4; ++n)
#pragma unroll
        for (int ks = 0; ks < 4; ++ks) { const size_t o = (size_t)(16 * n + r16) * 1024 + 128 * w + 32 * ks + 8 * q; Bh[n][ks] = *(const bf16x8*)(Rhi + o); Bl[n][ks] = *(const bf16x8*)(Rlo + o); }
    const int g0 = (L == 3) ? NCTX / 16 : 0;
    int cnt_e = 0;
    const float mybias = bias[lane];
#pragma unroll 1
    for (int grp = g0 + blockIdx.x; grp < NTOK / 16; grp += gridDim.x) {
        const size_t ao = (size_t)(grp * 16 + r16) * D + 128 * w + 8 * q;
        bf16x8 Ah[4], Al[4];
#pragma unroll
        for (int ks = 0; ks < 4; ++ks) { Ah[ks] = *(const bf16x8*)(U + ao + 32 * ks); Al[ks] = *(const bf16x8*)(ULO + ao + 32 * ks); }
        f32x4 acc[4];
#pragma unroll
        for (int n = 0; n < 4; ++n) { acc[n] = (f32x4){0.f, 0.f, 0.f, 0.f};
#pragma unroll
            for (int ks = 0; ks < 4; ++ks) {
                acc[n] = __builtin_amdgcn_mfma_f32_16x16x32_bf16(Ah[ks], Bh[n][ks], acc[n], 0, 0, 0);
                acc[n] = __builtin_amdgcn_mfma_f32_16x16x32_bf16(Ah[ks], Bl[n][ks], acc[n], 0, 0, 0);
                acc[n] = __builtin_amdgcn_mfma_f32_16x16x32_bf16(Al[ks], Bh[n][ks], acc[n], 0, 0, 0); } }
        __syncthreads();
#pragma unroll
        for (int n = 0; n < 4; ++n)
#pragma unroll
            for (int r = 0; r < 4; ++r) part[(w * 16 + 4 * q + r) * 64 + 16 * n + r16] = acc[n][r];
        __syncthreads();
#pragma unroll 1
        for (int rr = 0; rr < 2; ++rr) {
            const int row = 2 * w + rr, t = grp * 16 + row;
            float lgt = 0.f;
#pragma unroll
            for (int ww = 0; ww < 8; ++ww) lgt += part[(ww * 16 + row) * 64 + lane];
            const float sc = sigmoidf_(lgt);
            const float ch = sc + mybias;
            float m1 = -INFINITY, m2 = -INFINITY;
#pragma unroll
            for (int j = 0; j < 8; ++j) { const float v = __shfl(ch, (lane & ~7) + j); if (v > m1) { m2 = m1; m1 = v; } else if (v > m2) m2 = v; }
            const float gs = m1 + m2; const int g = lane >> 3;
            int grank = 0;
#pragma unroll
            for (int gg2 = 0; gg2 < 8; ++gg2) { const float v = __shfl(gs, 8 * gg2); grank += (v > gs || (v == gs && gg2 < g)) ? 1 : 0; }
            const bool sel = grank < 4;
            const float chm = sel ? ch : -INFINITY;
            int rank = 0;
#pragma unroll
            for (int e2 = 0; e2 < 64; ++e2) { const float v = __builtin_bit_cast(float, __builtin_amdgcn_readlane(__builtin_bit_cast(int, chm), e2)); rank += (v > chm || (v == chm && e2 < lane)) ? 1 : 0; }
            const bool chosen = sel && rank < 8;
            const float wsum = wave_sum(chosen ? sc : 0.f);
            const unsigned long long bal = __ballot(chosen);
            const int slot = __popcll(bal & ((1ull << lane) - 1ull));
            if (chosen) { TOPI[t * 8 + slot] = lane; TOPW[t * 8 + slot] = 2.5f * sc / wsum; cnt_e++; }
        }
    }
    if (cnt_e && !DRY) atomicAdd(F.ctl + CW_CNT + L * 64 + lane, (unsigned)cnt_e);
}

template <int L, bool DRY = false>
__device__ __forceinline__ void moe_dispatch_phase(Frame& F, const Args& a) {
    LAS int* pb = (LAS int*)(F.lds + LDS_TAB);
    if (F.wave == 0) {
        const int cnt = (int)F.ctl[CW_CNT + L * 64 + F.lane]; const int pad = (cnt + 255) & ~255;
        int inc = pad;
#pragma unroll
        for (int o = 1; o < 64; o <<= 1) { const int v = __shfl_up(inc, o); if (F.lane >= o) inc += v; }
        pb[F.lane] = inc - pad; pb[65 + F.lane] = cnt; if (F.lane == 63) pb[64] = inc;
    }
    __syncthreads();
    const int* TOPI = (const int*)(a.ws + WS_TOPI); const float* TOPW = (const float*)(a.ws + WS_TOPW);
    int* POS = (int*)(a.ws + (DRY ? WS_DUMMY : WS_POS)); int* ROWTOK = (int*)(a.ws + (DRY ? WS_DUMMY + 2 * MiB : WS_ROWTOK)); float* ROWW = (float*)(a.ws + (DRY ? WS_DUMMY + 4 * MiB : WS_ROWW)); int* TILEE = (int*)(a.ws + (DRY ? WS_DUMMY + 6 * MiB : WS_TILEE));
    const int p0 = (L == 3) ? NCTX * 8 : 0;
    LAS int* lcnt = pb + 160; LAS int* lbase = pb + 224;
    const int npairs = NTOK * 8 - p0, per = (npairs + (int)gridDim.x - 1) / (int)gridDim.x, lo = p0 + (int)blockIdx.x * per, hi = min(lo + per, NTOK * 8);
#pragma unroll 1
    for (int c0 = lo; c0 < hi; c0 += NTHREADS) {
        if (F.tid < 64) lcnt[F.tid] = 0;
        __syncthreads();
        const int p = c0 + F.tid; const bool ok = p < hi; int e = 0, lrank = 0;
        if (ok) { e = TOPI[p]; lrank = atomicAdd((int*)(lcnt + e), 1); }
        __syncthreads();
        if (F.tid < 64) { const int c = lcnt[F.tid]; lbase[F.tid] = pb[F.tid] + (c ? (int)atomicAdd(F.ctl + CW_CUR + (DRY ? 1024 : 0) + L * 64 + F.tid, (unsigned)c) : 0); }
        __syncthreads();
        if (ok) { const int dest = lbase[e] + lrank; POS[p] = dest; ROWTOK[dest] = p >> 3; ROWW[dest] = TOPW[p]; }
        __syncthreads();
    }
    if (blockIdx.x < 64) {
        const int e = blockIdx.x, base = pb[e], cnt = pb[65 + e], pad = (cnt + 255) & ~255;
        for (int r = cnt + F.tid; r < pad; r += NTHREADS) { ROWTOK[base + r] = NCTX; ROWW[base + r] = 0.f; }
        for (int tl = F.tid; tl < pad / 256; tl += NTHREADS) TILEE[base / 256 + tl] = e;
    }
    if (blockIdx.x == 64 && F.tid == 0 && !DRY) F.ctl[CW_NT + L] = (unsigned)(pb[64] / 256);
    __syncthreads();
}

struct ListSched {
    const LAS gg::Unit* tab; int n;
    __device__ __forceinline__ bool next(int i, gg::Unit& u) const {
        if (i >= n) return false;
        const LAS unsigned* p = (const LAS unsigned*)(tab + i); unsigned w[10];
#pragma unroll
        for (int k = 0; k < 10; ++k) w[k] = (unsigned)__builtin_amdgcn_readfirstlane((int)p[k]);
        u.a = (const char*)(((unsigned long long)w[1] << 32) | w[0]); u.b = (const char*)(((unsigned long long)w[3] << 32) | w[2]); u.b2 = (const char*)(((unsigned long long)w[5] << 32) | w[4]);
        u.pm = (int)w[6]; u.pn = (int)w[7]; u.gofs = (int)w[8]; u.x = (int)w[9]; return true; }
};
static_assert(sizeof(gg::Unit) == 40, "Unit layout");

struct EpiSwiglu {
    static constexpr bool PERM = true;
    bf16_t* ACT; LAS unsigned char* lds;
    __device__ __forceinline__ void operator()(const gg::Acc& acc, const gg::Unit& u, int wr, int wc, int fr, int fq) const {
        const int row0 = u.pm * 256 + wr * 64 + fr, col0 = u.pn * 128 + wc * 32 + 8 * fq;
        const LAS float* wl = (const LAS float*)(lds + u.gofs + 8192);
#pragma unroll
        for (int ai = 0; ai < 2; ++ai)
#pragma unroll
            for (int m = 0; m < 4; ++m) { const int row = row0 + ai * 128 + m * 16; const float w = wl[wr * 64 + fr + ai * 128 + m * 16];
                const f32x4 g0 = acc[ai][0][m][0], g1 = acc[ai][0][m][1], u0 = acc[ai][1][m][0], u1 = acc[ai][1][m][1];
                u32x4 o; o.x = pk2(siluf_(g0[0]) * u0[0] * w, siluf_(g0[1]) * u0[1] * w); o.y = pk2(siluf_(g0[2]) * u0[2] * w, siluf_(g0[3]) * u0[3] * w);
                o.z = pk2(siluf_(g1[0]) * u1[0] * w, siluf_(g1[1]) * u1[1] * w); o.w = pk2(siluf_(g1[2]) * u1[2] * w, siluf_(g1[3]) * u1[3] * w);
                *(u32x4*)(ACT + (size_t)row * 256 + col0) = o; }
    }
};
struct EpiBf16 {
    static constexpr bool PERM = true;
    bf16_t* O; int ldc;
    __device__ __forceinline__ void operator()(const gg::Acc& acc, const gg::Unit& u, int wr, int wc, int fr, int fq) const {
        const int row0 = u.pm * 256 + wr * 64 + fr, col0 = u.pn * 256 + wc * 32 + 8 * fq;
#pragma unroll
        for (int ai = 0; ai < 2; ++ai)
#pragma unroll
            for (int m = 0; m < 4; ++m) { bf16_t* rp = O + (size_t)(row0 + ai * 128 + m * 16) * ldc + col0;
#pragma unroll
                for (int bj = 0; bj < 2; ++bj) { const f32x4 v0 = acc[ai][bj][m][0], v1 = acc[ai][bj][m][1];
                    u32x4 o; o.x = pk2(v0[0], v0[1]); o.y = pk2(v0[2], v0[3]); o.z = pk2(v1[0], v1[1]); o.w = pk2(v1[2], v1[3]);
                    *(u32x4*)(rp + bj * 128) = o; } }
    }
};

__device__ __forceinline__ unsigned pk4_fp8(float a, float b, float c, float d) { int w = __builtin_amdgcn_cvt_pk_fp8_f32(a, b, 0, false); w = __builtin_amdgcn_cvt_pk_fp8_f32(c, d, w, true); return (unsigned)w; }
struct EpiFp8 {
    static constexpr bool PERM = true;
    unsigned char* O;
    __device__ __forceinline__ void operator()(const gg::Acc& acc, const gg::Unit& u, int wr, int wc, int fr, int fq) const {
        const int row0 = u.pm * 256 + wr * 64 + fr, col0 = u.pn * 256 + wc * 32 + 8 * fq;
#pragma unroll
        for (int ai = 0; ai < 2; ++ai)
#pragma unroll
            for (int m = 0; m < 4; ++m) { unsigned char* rp = O + (size_t)(row0 + ai * 128 + m * 16) * 1024 + col0;
#pragma unroll
                for (int bj = 0; bj < 2; ++bj) { const f32x4 v0 = acc[ai][bj][m][0], v1 = acc[ai][bj][m][1];
                    u32x2 o; o.x = pk4_fp8(v0[0], v0[1], v0[2], v0[3]); o.y = pk4_fp8(v1[0], v1[1], v1[2], v1[3]);
                    *(u32x2*)(rp + bj * 128) = o; } }
    }
};
template <int L>
__device__ __forceinline__ void moe_gateup_phase(Frame& F, const Args& a) {
    const int ntr = (int)F.ctl[CW_NT + L]; constexpr int s0 = (L == 3) ? 1 : 0; const int nsh = 65 - s0, nunits = (ntr + nsh) * 2;
    gg::Unit* tab = (gg::Unit*)(F.lds + LDS_TAB); LAS int* idx = (LAS int*)(F.lds + LDS_TAB + 512);
    const int* ROWTOK = (const int*)(a.ws + WS_ROWTOK); const int* TILEE = (const int*)(a.ws + WS_TILEE); const float* ROWW = (const float*)(a.ws + WS_ROWW);
    const char* Wgu = (const char*)(a.ws + WS_MOE + L * MOE_STRIDE + MOE_GU); const char* Wsh = (const char*)(a.ws + WS_MOE + L * MOE_STRIDE + MOE_SHGU);
    int nmine = 0;
    for (int i = 0; i < 8; ++i) { const int Lq = i * (int)gridDim.x + (int)blockIdx.x; if (Lq >= nunits) break; nmine = i + 1;
        int uidx; { const int q8 = nunits / 8, r8 = nunits % 8, xcd = Lq % 8, off = Lq / 8; uidx = (xcd < r8 ? xcd * (q8 + 1) : r8 * (q8 + 1) + (xcd - r8) * q8) + off; }
        const int tile = uidx >> 1, pn = uidx & 1; const bool routed = tile < ntr;
        const int rowtile = routed ? tile : (SH_BASE / 256 + s0 + (tile - ntr));
        if (F.tid == 0) { gg::Unit u; u.a = (const char*)(a.ws + WS_U); u.b = routed ? Wgu + ((size_t)TILEE[tile] * 512 + pn * 256) * 2048 : Wsh + (size_t)(pn * 256) * 2048; u.b2 = nullptr;
            u.pm = rowtile; u.pn = pn; u.gofs = LDS_TAB + 512 + i * 1024; u.x = 0; tab[i] = u; }
        if (F.tid < 256) { idx[i * 256 + F.tid] = ROWTOK[rowtile * 256 + F.tid]; ((LAS float*)(F.lds + LDS_TAB + 512 + 8192))[i * 256 + F.tid] = ROWW[rowtile * 256 + F.tid]; }
    }
    __syncthreads();
    ListSched S{(const LAS gg::Unit*)(F.lds + LDS_TAB), nmine}; EpiSwiglu E{(bf16_t*)(a.ws + WS_ACT), F.lds};
    gg::gemm_phase<EpiSwiglu, ListSched, true, false>(F.lds + LDS_STAGE, gg::Dims{1024, 1024, 1024, 0, 0}, S, E);
}
template <int L>
__device__ __forceinline__ void moe_down_phase(Frame& F, const Args& a) {
    const int ntr = (int)F.ctl[CW_NT + L]; constexpr int s0 = (L == 3) ? 1 : 0; const int nsh = 65 - s0, nunits = (ntr + nsh) * 4;
    gg::Unit* tab = (gg::Unit*)(F.lds + LDS_TAB);
    const int* TILEE = (const int*)(a.ws + WS_TILEE);
    const char* Wdn = (const char*)(a.ws + WS_MOE + L * MOE_STRIDE + MOE_DN); const char* Wsh = (const char*)(a.ws + WS_MOE + L * MOE_STRIDE + MOE_SHDN);
    int nmine = 0;
    for (int i = 0; i < 12; ++i) { const int Lq = i * (int)gridDim.x + (int)blockIdx.x; if (Lq >= nunits) break; nmine = i + 1;
        int uidx; { const int q8 = nunits / 8, r8 = nunits % 8, xcd = Lq % 8, off = Lq / 8; uidx = (xcd < r8 ? xcd * (q8 + 1) : r8 * (q8 + 1) + (xcd - r8) * q8) + off; }
        const int tile = uidx >> 2, pn = uidx & 3; const bool routed = tile < ntr;
        const int rowtile = routed ? tile : (SH_BASE / 256 + s0 + (tile - ntr));
        if (F.tid == 0) { gg::Unit u; u.a = (const char*)(a.ws + WS_ACT) + (size_t)rowtile * 256 * 512; u.b = routed ? Wdn + ((size_t)TILEE[tile] * 1024 + pn * 256) * 512 : Wsh + (size_t)(pn * 256) * 512; u.b2 = nullptr;
            u.pm = rowtile; u.pn = pn; u.gofs = 0; u.x = 0; tab[i] = u; }
    }
    __syncthreads();
    ListSched S{(const LAS gg::Unit*)(F.lds + LDS_TAB), nmine}; EpiFp8 E{(unsigned char*)(a.ws + WS_OUT)};
    gg::gemm_phase<EpiFp8, ListSched, false, false>(F.lds + LDS_STAGE, gg::Dims{256, 256, 256, 0, 0}, S, E);
}

__device__ __forceinline__ int xcd_remap(int L, int n) { const int q8 = n / 8, r8 = n % 8, xcd = L % 8, off = L / 8; return (xcd < r8 ? xcd * (q8 + 1) : r8 * (q8 + 1) + (xcd - r8) * q8) + off; }
__device__ __forceinline__ float gelu_tanh(float x) { const float z = 0.7978845608028654f * (x + 0.044715f * x * x * x); return x * (1.0f - __builtin_amdgcn_rcpf(1.0f + __expf(2.0f * z))); }
struct EpiLruIn {
    static constexpr bool PERM = true;
    bf16_t* GB; bf16_t* RNN;
    __device__ __forceinline__ void operator()(const gg::Acc& acc, const gg::Unit& u, int wr, int wc, int fr, int fq) const {
        const bool isg = u.pn < 4; bf16_t* O = isg ? GB : RNN;
        const int row0 = u.pm * 256 + wr * 64 + fr, col0 = (u.pn & 3) * 256 + wc * 32 + 8 * fq;
#pragma unroll
        for (int ai = 0; ai < 2; ++ai)
#pragma unroll
            for (int m = 0; m < 4; ++m) { bf16_t* rp = O + (size_t)(row0 + ai * 128 + m * 16) * 1024 + col0;
#pragma unroll
                for (int bj = 0; bj < 2; ++bj) { f32x4 v0 = acc[ai][bj][m][0], v1 = acc[ai][bj][m][1];
                    if (isg) {
#pragma unroll
                        for (int e = 0; e < 4; ++e) { v0[e] = gelu_tanh(v0[e]); v1[e] = gelu_tanh(v1[e]); } }
                    u32x4 o; o.x = pk2(v0[0], v0[1]); o.y = pk2(v0[2], v0[3]); o.z = pk2(v1[0], v1[1]); o.w = pk2(v1[2], v1[3]);
                    *(u32x4*)(rp + bj * 128) = o; } }
    }
};
template <bool REV>
__device__ __forceinline__ void lru_scan16(const float (&a)[4], const float (&b)[4], float (&h)[4], float& hc, float& at, int lane) {
    const int q = lane >> 4;
    float Ar[4], Br[4]; float A = 1.0f, B = 0.0f;
#pragma unroll
    for (int ri = 0; ri < 4; ++ri) { const int r = REV ? 3 - ri : ri; B = a[r] * B + b[r]; A = a[r] * A; Ar[r] = A; Br[r] = B; }
    float As = A, Bs = B;
    { const float pA = REV ? __shfl_down(As, 16) : __shfl_up(As, 16), pB = REV ? __shfl_down(Bs, 16) : __shfl_up(Bs, 16); const bool on = REV ? (q <= 2) : (q >= 1); if (on) { Bs = As * pB + Bs; As = As * pA; } }
    { const float pA = REV ? __shfl_down(As, 32) : __shfl_up(As, 32), pB = REV ? __shfl_down(Bs, 32) : __shfl_up(Bs, 32); const bool on = REV ? (q <= 1) : (q >= 2); if (on) { Bs = As * pB + Bs; As = As * pA; } }
    float eA = REV ? __shfl_down(As, 16) : __shfl_up(As, 16), eB = REV ? __shfl_down(Bs, 16) : __shfl_up(Bs, 16);
    const bool first = REV ? (q == 3) : (q == 0); if (first) { eA = 1.0f; eB = 0.0f; }
    const float Hin = eA * hc + eB;
#pragma unroll
    for (int r = 0; r < 4; ++r) h[r] = Ar[r] * Hin + Br[r];
    const int src = (REV ? 0 : 48) + (lane & 15);
    const float tA = __shfl(As, src), tB = __shfl(Bs, src);
    hc = tA * hc + tB; at *= tA;
}
template <bool SUMMARY>
__device__ __forceinline__ void lru_scan_phase(Frame& F, const Args& a) {
    const bf16_t* RNN = (const bf16_t*)(a.ws + WS_MX1); const bf16_t* GB = (const bf16_t*)(a.ws + WS_MX0); bf16_t* A2 = (bf16_t*)(a.ws + WS_MX2);
    float* SUMM = (float*)(a.ws + WS_MX3); const float* CARRY = (const float*)(a.ws + WS_MX4);
    const bf16_t* Wg = (const bf16_t*)(a.ws + WS_W_LRU_GATE);
    const float* cw = a.in[9]; const float* cb = a.in[10]; const float* gbias = a.in[12]; const float* lam = a.in[13];
    LAS unsigned char* xt = F.lds + LDS_STAGE + F.wave * 17408;
    LAS unsigned char* ot = xt + 9216;
    const int lane = F.lane, c16 = lane & 15, q = lane >> 4, cg = lane & 7, rg = lane >> 3;
#pragma unroll 1
    for (int task = F.gw; task < (NTOK / 64) * 16; task += F.ngw) {
        const int k = task >> 4;
        const int t0 = 64 * k, slo = (k < 4) ? 0 : NCTX, shi = (k < 4) ? NCTX : NTOK;
        {
            const int blk = task & 15, ch0 = blk * 64;
            {
                float w[4][8], bsv[8];
#pragma unroll
                for (int e = 0; e < 8; ++e) { bsv[e] = cb[ch0 + 8 * cg + e];
#pragma unroll
                    for (int j = 0; j < 4; ++j) w[j][e] = cw[j * 1024 + ch0 + 8 * cg + e]; }
#pragma unroll 1
                for (int ps = 0; ps < 2; ++ps) {
                    const int rq = rg + 8 * ps;
                    float xin[7][8];
#pragma unroll
                    for (int rr = 0; rr < 7; ++rr) { const int t = t0 + 4 * rq - 1 + rr; u32x4 v = {0u, 0u, 0u, 0u};
                        if (t >= slo && t < shi) v = *(const u32x4*)(RNN + (size_t)t * 1024 + ch0 + 8 * cg);
                        xin[rr][0] = bflo(v.x); xin[rr][1] = bfhi(v.x); xin[rr][2] = bflo(v.y); xin[rr][3] = bfhi(v.y); xin[rr][4] = bflo(v.z); xin[rr][5] = bfhi(v.z); xin[rr][6] = bflo(v.w); xin[rr][7] = bfhi(v.w); }
#pragma unroll
                    for (int r = 0; r < 4; ++r) { float o[8];
#pragma unroll
                        for (int e = 0; e < 8; ++e) o[e] = bsv[e] + w[0][e] * xin[r][e] + w[1][e] * xin[r + 1][e] + w[2][e] * xin[r + 2][e] + w[3][e] * xin[r + 3][e];
                        u32x4 pk; pk.x = pk2(o[0], o[1]); pk.y = pk2(o[2], o[3]); pk.z = pk2(o[4], o[5]); pk.w = pk2(o[6], o[7]);
                        *(LAS u32x4*)(xt + (4 * rq + r) * 144 + 16 * cg) = pk; }
                }
            }
            asm volatile("s_waitcnt lgkmcnt(0)" ::: "memory");
            bf16x8 Af[4][2];
#pragma unroll
            for (int T = 0; T < 4; ++T)
#pragma unroll
                for (int ks = 0; ks < 2; ++ks) Af[T][ks] = *(const LAS bf16x8*)(xt + (16 * T + c16) * 144 + (32 * ks + 8 * q) * 2);
#pragma unroll
            for (int g4 = 0; g4 < 4; ++g4) {
                const int ch = ch0 + 16 * g4 + c16;
                float xv[4][4];
#pragma unroll
                for (int T = 0; T < 4; ++T)
#pragma unroll
                    for (int r = 0; r < 4; ++r) xv[T][r] = bf2f(*(const LAS unsigned short*)(xt + (16 * T + 4 * q + r) * 144 + (16 * g4 + c16) * 2));
                float hsum[4][4];
#pragma unroll
                for (int d = 0; d < 2; ++d) {
                    f32x4 acc[2][4];
#pragma unroll
                    for (int gt = 0; gt < 2; ++gt) {
                        const bf16_t* wp = Wg + ((size_t)((d * 2 + gt) * 16 + blk) * 64 + 16 * g4 + c16) * 64 + 8 * q;
                        const bf16x8 b0 = *(const bf16x8*)wp, b1 = *(const bf16x8*)(wp + 32);
#pragma unroll
                        for (int T = 0; T < 4; ++T) { f32x4 z = {0.f, 0.f, 0.f, 0.f};
                            z = __builtin_amdgcn_mfma_f32_16x16x32_bf16(Af[T][0], b0, z, 0, 0, 0);
                            acc[gt][T] = __builtin_amdgcn_mfma_f32_16x16x32_bf16(Af[T][1], b1, z, 0, 0, 0); }
                    }
                    const float gb0 = gbias[(d * 2 + 0) * 1024 + ch], gb1 = gbias[(d * 2 + 1) * 1024 + ch];
                    const float lm = lam[d * 1024 + ch]; const float sp = log1pf(__expf(-lm));
                    float hc = 0.0f, at = 1.0f;
                    if (!SUMMARY) hc = CARRY[((size_t)d * 260 + k) * 1024 + ch];
#pragma unroll
                    for (int Ti = 0; Ti < 4; ++Ti) {
                        const int T = d ? 3 - Ti : Ti;
                        float av[4], bv[4], hv[4];
#pragma unroll
                        for (int r = 0; r < 4; ++r) { const float rgate = sigmoidf_(acc[0][T][r] + gb0), ig = sigmoidf_(acc[1][T][r] + gb1);
                            const float la = -8.0f * rgate * sp; const float aa = __expf(la); av[r] = aa; bv[r] = __builtin_amdgcn_sqrtf(fmaxf(1.0f - aa * aa, 0.f)) * ig * xv[T][r]; }
                        if (d == 0) lru_scan16<false>(av, bv, hv, hc, at, lane); else lru_scan16<true>(av, bv, hv, hc, at, lane);
                        if (!SUMMARY) {
#pragma unroll
                            for (int r = 0; r < 4; ++r) hsum[T][r] = (d == 0) ? hv[r] : hsum[T][r] + hv[r]; }
                    }
                    if (SUMMARY) { if (q == 0) { SUMM[((size_t)d * 260 + k) * 1024 + ch] = at; SUMM[((size_t)(2 + d) * 260 + k) * 1024 + ch] = hc; } }
                }
                if (!SUMMARY) {
#pragma unroll
                    for (int T = 0; T < 4; ++T)
#pragma unroll
                        for (int r = 0; r < 4; ++r) *(LAS unsigned short*)(ot + (16 * T + 4 * q + r) * 128 + (16 * g4 + c16) * 2) = (unsigned short)f2bf(hsum[T][r]);
                }
            }
            if (!SUMMARY) {
                asm volatile("s_waitcnt lgkmcnt(0)" ::: "memory");
#pragma unroll
                for (int r = 0; r < 8; ++r) { const int row = 8 * rg + r; const u32x4 hv = *(const LAS u32x4*)(ot + row * 128 + 16 * cg);
                    const u32x4 gv = *(const u32x4*)(GB + (size_t)(t0 + row) * 1024 + ch0 + 8 * cg);
                    u32x4 o; o.x = pk2(bflo(hv.x) * bflo(gv.x), bfhi(hv.x) * bfhi(gv.x)); o.y = pk2(bflo(hv.y) * bflo(gv.y), bfhi(hv.y) * bfhi(gv.y));
                    o.z = pk2(bflo(hv.z) * bflo(gv.z), bfhi(hv.z) * bfhi(gv.z)); o.w = pk2(bflo(hv.w) * bflo(gv.w), bfhi(hv.w) * bfhi(gv.w));
                    *(u32x4*)(A2 + (size_t)(t0 + row) * 1024 + ch0 + 8 * cg) = o; }
            }
            asm volatile("s_waitcnt lgkmcnt(0)" ::: "memory");
        }
    }
}
__device__ __forceinline__ void lru_carry_phase(Frame& F, const Args& a) {
    const float* SUMM = (const float*)(a.ws + WS_MX3); float* CARRY = (float*)(a.ws + WS_MX4);
    const int gid = blockIdx.x * NTHREADS + F.tid; if (gid >= 2048) return;
    const int d = gid >> 10, c = gid & 1023; float h = 0.0f;
    const float* At = SUMM + (size_t)d * 260 * 1024 + c; const float* He = SUMM + (size_t)(2 + d) * 260 * 1024 + c; float* Cy = CARRY + (size_t)d * 260 * 1024 + c;
#pragma unroll 1
    for (int b = 0; b < 10; ++b) {
        float av[26], hv[26]; int kk[26];
#pragma unroll
        for (int j = 0; j < 26; ++j) { const int st = b * 26 + j; kk[j] = d == 0 ? st : (st < 4 ? 3 - st : 263 - st); av[j] = At[(size_t)kk[j] * 1024]; hv[j] = He[(size_t)kk[j] * 1024]; }
#pragma unroll
        for (int j = 0; j < 26; ++j) { Cy[(size_t)kk[j] * 1024] = h; h = av[j] * h + hv[j]; }
    }
}
__device__ __forceinline__ void lru_in_gemm_phase(Frame& F, const Args& a) {
    gg::DenseSched S; S.init((const bf16_t*)(a.ws + WS_U), (const bf16_t*)(a.ws + WS_W_LRU_IN), NTOK, 2048, 1024, 1024);
    EpiLruIn E{(bf16_t*)(a.ws + WS_MX0), (bf16_t*)(a.ws + WS_MX1)};
    gg::gemm_phase<EpiLruIn, gg::DenseSched, false, false>(F.lds + LDS_STAGE, gg::Dims{1024, 1024, 1024, 0, 0}, S, E);
}
__device__ __forceinline__ void dense_gemm_bf16(Frame& F, const bf16_t* A, const bf16_t* Bt, bf16_t* O, int M, int N, int K) {
    gg::DenseSched S; S.init(A, Bt, M, N, K, K);
    EpiBf16 E{O, N};
    gg::gemm_phase<EpiBf16, gg::DenseSched, false, false>(F.lds + LDS_STAGE, gg::Dims{K, K, K, 0, 0}, S, E);
}

constexpr size_t RT_QR = WS_SCR, RT_KR = WS_SCR + 33 * MiB, RT_V = WS_SCR + 66 * MiB, RT_SG = WS_SCR + 132 * MiB, RT_ACAT = WS_SCR + 198 * MiB, RT_KTD = WS_SCR + 301 * MiB,
                 RT_VT = WS_SCR + 367 * MiB, RT_ST = WS_SCR + 433 * MiB, RT_O = WS_SCR + 564 * MiB, RT_A3 = RT_V, RT_END = WS_SCR + 630 * MiB;
constexpr int NBLK = NTOK / 256;
struct EpiBf16X {
    static constexpr bool PERM = true;
    bf16_t* O; int ldc;
    __device__ __forceinline__ void operator()(const gg::Acc& acc, const gg::Unit& u, int wr, int wc, int fr, int fq) const {
#pragma unroll
        for (int ai = 0; ai < 2; ++ai)
#pragma unroll
            for (int m = 0; m < 4; ++m) { bf16_t* rp = O + (size_t)(unsigned)u.x + (size_t)(ai * 128 + wr * 64 + m * 16 + fr) * ldc + wc * 32 + 8 * fq;
#pragma unroll
                for (int bj = 0; bj < 2; ++bj) { const f32x4 v0 = acc[ai][bj][m][0], v1 = acc[ai][bj][m][1];
                    u32x4 o; o.x = pk2(v0[0], v0[1]); o.y = pk2(v0[2], v0[3]); o.z = pk2(v1[0], v1[1]); o.w = pk2(v1[2], v1[3]);
                    *(u32x4*)(rp + bj * 128) = o; } }
    }
};
__device__ __forceinline__ float log_sigmoid(float x) { return -(fmaxf(-x, 0.f) + log1pf(__expf(-fabsf(x)))); }
struct EpiRetIn {
    static constexpr bool PERM = true;
    bf16_t *QR, *KR, *V, *SG, *ACAT; const float* rope; const float* decay;
    __device__ __forceinline__ void operator()(const gg::Acc& acc, const gg::Unit& u, int wr, int wc, int fr, int fq) const {
        const int pn = u.pn, row0 = u.pm * 256 + wr * 64 + fr, cx = wc * 32 + 8 * fq;
        if (pn < 8) {
            const int h = pn & 3; const bool isq = pn < 4;
            const float lg0 = log_sigmoid(decay[h]), lg1 = log_sigmoid(decay[4 + h]);
#pragma unroll
            for (int ai = 0; ai < 2; ++ai)
#pragma unroll
                for (int m = 0; m < 4; ++m) {
                    const int row = row0 + ai * 128 + m * 16, i = row & 255, b = row >> 8;
                    f32x4 lo[2] = {acc[ai][0][m][0], acc[ai][0][m][1]}, hi[2] = {acc[ai][1][m][0], acc[ai][1][m][1]};
                    if (row >= NCTX) {
                        const int tl = row - NCTX, pp = (wc < 2) ? (tl >> 6) : (tl & 63), i0 = (wc & 1) * 32 + 8 * fq;
                        const float* cp = rope + pp * 64 + i0; const float* sp = cp + 256 * 64;
#pragma unroll
                        for (int n = 0; n < 2; ++n) { const f32x4 c = *(const f32x4*)(cp + 4 * n), sn = *(const f32x4*)(sp + 4 * n);
                            const f32x4 l2 = lo[n] * c - hi[n] * sn, h2 = hi[n] * c + lo[n] * sn; lo[n] = l2; hi[n] = h2; }
                    }
                    if (isq) {
                        u32x4 o; o.x = pk2(lo[0][0], lo[0][1]); o.y = pk2(lo[0][2], lo[0][3]); o.z = pk2(lo[1][0], lo[1][1]); o.w = pk2(lo[1][2], lo[1][3]);
                        *(u32x4*)(QR + (size_t)row * 1024 + h * 256 + cx) = o;
                        o.x = pk2(hi[0][0], hi[0][1]); o.y = pk2(hi[0][2], hi[0][3]); o.z = pk2(hi[1][0], hi[1][1]); o.w = pk2(hi[1][2], hi[1][3]);
                        *(u32x4*)(QR + (size_t)row * 1024 + h * 256 + 128 + cx) = o;
                        bf16_t* ac = ACAT + ((size_t)(b * 4 + h) * 256 + i) * 768 + 256 + cx;
#pragma unroll
                        for (int d = 0; d < 2; ++d) { const float f = d ? __expf((float)(256 - i) * lg1) : __expf((float)(i + 1) * lg0);
                            o.x = pk2(lo[0][0] * f, lo[0][1] * f); o.y = pk2(lo[0][2] * f, lo[0][3] * f); o.z = pk2(lo[1][0] * f, lo[1][1] * f); o.w = pk2(lo[1][2] * f, lo[1][3] * f);
                            *(u32x4*)(ac + d * 256) = o;
                            o.x = pk2(hi[0][0] * f, hi[0][1] * f); o.y = pk2(hi[0][2] * f, hi[0][3] * f); o.z = pk2(hi[1][0] * f, hi[1][1] * f); o.w = pk2(hi[1][2] * f, hi[1][3] * f);
                            *(u32x4*)(ac + d * 256 + 128) = o; }
                    } else {
                        const float f = 0.0625f;
                        u32x4 o; o.x = pk2(lo[0][0] * f, lo[0][1] * f); o.y = pk2(lo[0][2] * f, lo[0][3] * f); o.z = pk2(lo[1][0] * f, lo[1][1] * f); o.w = pk2(lo[1][2] * f, lo[1][3] * f);
                        *(u32x4*)(KR + (size_t)row * 1024 + h * 256 + cx) = o;
                        o.x = pk2(hi[0][0] * f, hi[0][1] * f); o.y = pk2(hi[0][2] * f, hi[0][3] * f); o.z = pk2(hi[1][0] * f, hi[1][1] * f); o.w = pk2(hi[1][2] * f, hi[1][3] * f);
                        *(u32x4*)(KR + (size_t)row * 1024 + h * 256 + 128 + cx) = o;
                    }
                }
        } else {
            const bool isv = pn < 16; bf16_t* O = isv ? V : SG; const int col0 = ((pn - 8) & 7) * 256 + cx;
#pragma unroll
            for (int ai = 0; ai < 2; ++ai)
#pragma unroll
                for (int m = 0; m < 4; ++m) { bf16_t* rp = O + (size_t)(row0 + ai * 128 + m * 16) * 2048 + col0;
#pragma unroll
                    for (int bj = 0; bj < 2; ++bj) { f32x4 v0 = acc[ai][bj][m][0], v1 = acc[ai][bj][m][1];
                        if (!isv) {
#pragma unroll
                            for (int e = 0; e < 4; ++e) { v0[e] = siluf_(v0[e]); v1[e] = siluf_(v1[e]); } }
                        u32x4 o; o.x = pk2(v0[0], v0[1]); o.y = pk2(v0[2], v0[3]); o.z = pk2(v1[0], v1[1]); o.w = pk2(v1[2], v1[3]);
                        *(u32x4*)(rp + bj * 128) = o; } }
        }
    }
};
__device__ __forceinline__ void ret_in_gemm_phase(Frame& F, const Args& a) {
    gg::DenseSched S; S.init((const bf16_t*)(a.ws + WS_U), (const bf16_t*)(a.ws + WS_W_RET_IN), NTOK, 6144, 1024, 1024);
    EpiRetIn E{(bf16_t*)(a.ws + RT_QR), (bf16_t*)(a.ws + RT_KR), (bf16_t*)(a.ws + RT_V), (bf16_t*)(a.ws + RT_SG), (bf16_t*)(a.ws + RT_ACAT), (const float*)(a.ws + WS_ROPE), a.in[32]};
    gg::gemm_phase<EpiRetIn, gg::DenseSched, false, false>(F.lds + LDS_STAGE, gg::Dims{1024, 1024, 1024, 0, 0}, S, E);
}
__device__ __forceinline__ void tr64_bf16(const bf16_t* src, int ld_src, bf16_t* dst, int ld_dst, LAS unsigned char* scr, int lane, float lgam, int mode, int t0) {
    const int cg = lane & 7, rg = lane >> 3;
#pragma unroll
    for (int k = 0; k < 8; ++k) { const int t = rg + 8 * k; const u32x4 v = *(const u32x4*)(src + (size_t)t * ld_src + 8 * cg);
        float f = 1.0f; if (mode) { const int i = (t0 + t) & 255; f = __expf((float)(mode == 1 ? 255 - i : i) * lgam); }
        const unsigned w[4] = {v.x, v.y, v.z, v.w};
#pragma unroll
        for (int e = 0; e < 4; ++e) { *(LAS unsigned short*)(scr + (8 * cg + 2 * e) * 144 + t * 2) = (unsigned short)f2bf(bflo(w[e]) * f); *(LAS unsigned short*)(scr + (8 * cg + 2 * e + 1) * 144 + t * 2) = (unsigned short)f2bf(bfhi(w[e]) * f); } }
    asm volatile("s_waitcnt lgkmcnt(0)" ::: "memory");
#pragma unroll
    for (int k = 0; k < 8; ++k) { const int c = rg + 8 * k; const u32x4 v = *(const LAS u32x4*)(scr + c * 144 + 16 * cg); *(u32x4*)(dst + (size_t)c * ld_dst + 8 * cg) = v; }
    asm volatile("s_waitcnt lgkmcnt(0)" ::: "memory");
}
__device__ __forceinline__ void ret_transpose_phase(Frame& F, const Args& a) {
    const bf16_t* KR = (const bf16_t*)(a.ws + RT_KR); const bf16_t* V = (const bf16_t*)(a.ws + RT_V); bf16_t* KTD = (bf16_t*)(a.ws + RT_KTD); bf16_t* VT = (bf16_t*)(a.ws + RT_VT);
    LAS unsigned char* scr = F.lds + LDS_STAGE + F.wave * 9216;
    const float* decay = a.in[32];
    constexpr int NT = NTOK / 64;
    for (int it = F.gw; it < NT * (32 + 32); it += F.ngw) {
        const int tt = it % NT, cc = it / NT, t0 = tt * 64;
        if (cc < 32) { const int d = cc >> 4, c0 = (cc & 15) * 64, h = c0 >> 8; const float lg = log_sigmoid(decay[d * 4 + h]);
            tr64_bf16(KR + (size_t)t0 * 1024 + c0, 1024, KTD + ((size_t)d * 1024 + c0) * NTOK + t0, NTOK, scr, F.lane, lg, d ? 2 : 1, t0); }
        else { const int c0 = (cc - 32) * 64; tr64_bf16(V + (size_t)t0 * 2048 + c0, 2048, VT + (size_t)c0 * NTOK + t0, NTOK, scr, F.lane, 0.f, 0, t0); }
    }
}
struct RetKvSched {
    const char* VT; const char* KTD; int G, c;
    __device__ __forceinline__ bool next(int i, gg::Unit& u) const {
        const int L0 = i * G + c; if (L0 >= NBLK * 16) return false; const int L = xcd_remap(L0, NBLK * 16);
        const int dvt = L & 1, d = (L >> 1) & 1, h = (L >> 2) & 3, b = L >> 4;
        u.a = VT + ((size_t)(512 * h + 256 * dvt) * NTOK + 256 * b) * 2; u.b = KTD + ((size_t)(d * 1024 + 256 * h) * NTOK + 256 * b) * 2; u.b2 = nullptr;
        u.pm = 0; u.pn = 0; u.gofs = 0; u.x = ((b * 4 + h) * 512 + 256 * dvt) * 512 + 256 * d; return true; }
};
__device__ __forceinline__ void ret_kv_phase(Frame& F, const Args& a) {
    RetKvSched S{(const char*)(a.ws + RT_VT), (const char*)(a.ws + RT_KTD), (int)gridDim.x, (int)blockIdx.x};
    EpiBf16X E{(bf16_t*)(a.ws + RT_ST), 512};
    gg::gemm_phase<EpiBf16X, RetKvSched, false, false>(F.lds + LDS_STAGE, gg::Dims{256, NTOK, NTOK, 0, 0}, S, E);
}
template <bool DRY = false>
__device__ __forceinline__ void ret_prefix_phase(Frame& F, const Args& a) {
    bf16_t* ST = (bf16_t*)(a.ws + (DRY ? WS_DUMMY : RT_ST)); const float* decay = a.in[32];
    for (int gid = blockIdx.x * NTHREADS + F.tid; gid < 4 * 512 * 2 * 32; gid += gridDim.x * NTHREADS) {
        const int dk8 = gid & 31, d = (gid >> 5) & 1, dv = (gid >> 6) & 511, h = gid >> 15;
        const float gb = __expf(256.0f * log_sigmoid(decay[d * 4 + h]));
        float s[8];
#pragma unroll
        for (int e = 0; e < 8; ++e) s[e] = 0.f;
#define RT_BLK(st_) (((d == 0) || (st_) == 0) ? (st_) : (NBLK - (st_)))
#define RT_PTR(st_) ((u32x4*)(ST + ((size_t)(RT_BLK(st_) * 4 + h) * 512 + dv) * 512 + d * 256 + 8 * dk8))
        u32x4 kb[4];
#pragma unroll
        for (int j = 0; j < 4; ++j) kb[j] = *RT_PTR(j);
#pragma unroll 1
        for (int base = 0; base < 68; base += 4) {
#pragma unroll
            for (int j = 0; j < 4; ++j) { const int step = base + j; if (step < NBLK) {
                u32x4* p = RT_PTR(step); const u32x4 kv = kb[j];
                if (step + 4 < NBLK) kb[j] = *RT_PTR(step + 4);
                u32x4 o; o.x = pk2(s[0], s[1]); o.y = pk2(s[2], s[3]); o.z = pk2(s[4], s[5]); o.w = pk2(s[6], s[7]); *p = o;
                s[0] = s[0] * gb + bflo(kv.x); s[1] = s[1] * gb + bfhi(kv.x); s[2] = s[2] * gb + bflo(kv.y); s[3] = s[3] * gb + bfhi(kv.y);
                s[4] = s[4] * gb + bflo(kv.z); s[5] = s[5] * gb + bfhi(kv.z); s[6] = s[6] * gb + bflo(kv.w); s[7] = s[7] * gb + bfhi(kv.w); } }
        }
#undef RT_BLK
#undef RT_PTR
    }
    bf16_t* ACAT = (bf16_t*)(a.ws + (DRY ? WS_DUMMY + 140 * MiB : RT_ACAT));
    for (int gid = blockIdx.x * NTHREADS + F.tid; gid < NBLK * 4 * 256 * 32; gid += gridDim.x * NTHREADS) {
        const int j0 = (gid & 31) * 8, i = (gid >> 5) & 255, bh = gid >> 13, h = bh & 3;
        const float lg0 = log_sigmoid(decay[h]), lg1 = log_sigmoid(decay[4 + h]);
        u32x4* p = (u32x4*)(ACAT + ((size_t)bh * 256 + i) * 768 + j0);
        const u32x4 v = *p; const unsigned w[4] = {v.x, v.y, v.z, v.w}; unsigned o[4];
#pragma unroll
        for (int e = 0; e < 4; ++e) { const int ja = j0 + 2 * e, jb = ja + 1;
            const float wa = ((i >= ja) ? __expf((float)(i - ja) * lg0) : 0.f) + ((ja >= i) ? __expf((float)(ja - i) * lg1) : 0.f);
            const float wb = ((i >= jb) ? __expf((float)(i - jb) * lg0) : 0.f) + ((jb >= i) ? __expf((float)(jb - i) * lg1) : 0.f);
            o[e] = pk2(bflo(w[e]) * wa, bfhi(w[e]) * wb); }
        *p = (u32x4){o[0], o[1], o[2], o[3]};
    }
}
struct RetPSched {
    const char* QR; const char* KR; int G, c;
    __device__ __forceinline__ bool next(int i, gg::Unit& u) const {
        const int L0 = i * G + c; if (L0 >= NBLK * 4) return false; const int L = xcd_remap(L0, NBLK * 4);
        const int h = L & 3, b = L >> 2;
        u.a = QR + ((size_t)256 * b * 1024 + 256 * h) * 2; u.b = KR + ((size_t)256 * b * 1024 + 256 * h) * 2; u.b2 = nullptr;
        u.pm = b; u.pn = h; u.gofs = 0; u.x = (b * 4 + h) * 256 * 768; return true; }
};
__device__ __forceinline__ void ret_p_phase(Frame& F, const Args& a) {
    RetPSched S{(const char*)(a.ws + RT_QR), (const char*)(a.ws + RT_KR), (int)gridDim.x, (int)blockIdx.x};
    EpiBf16X E{(bf16_t*)(a.ws + RT_ACAT), 768};
    gg::gemm_phase<EpiBf16X, RetPSched, false, false>(F.lds + LDS_STAGE, gg::Dims{256, 1024, 1024, 0, 0}, S, E);
}
struct RetOSched {
    const char* ACAT; const char* VT; const char* ST; int G, c;
    __device__ __forceinline__ bool next(int i, gg::Unit& u) const {
        const int L0 = i * G + c; if (L0 >= NBLK * 8) return false; const int L = xcd_remap(L0, NBLK * 8);
        const int dvt = L & 1, h = (L >> 1) & 3, b = L >> 3;
        u.a = ACAT + (size_t)(b * 4 + h) * 256 * 768 * 2; u.b = VT + ((size_t)(512 * h + 256 * dvt) * NTOK + 256 * b) * 2; u.b2 = ST + ((size_t)((b * 4 + h) * 512 + 256 * dvt) * 512) * 2;
        u.pm = 0; u.pn = 0; u.gofs = 0; u.x = 256 * b * 2048 + 512 * h + 256 * dvt; return true; }
};
__device__ __forceinline__ void ret_o_phase(Frame& F, const Args& a) {
    RetOSched S{(const char*)(a.ws + RT_ACAT), (const char*)(a.ws + RT_VT), (const char*)(a.ws + RT_ST), (int)gridDim.x, (int)blockIdx.x};
    EpiBf16X E{(bf16_t*)(a.ws + RT_O), 2048};
    gg::gemm_phase<EpiBf16X, RetOSched, false, true>(F.lds + LDS_STAGE, gg::Dims{768, 768, NTOK, 4, 512}, S, E);
}
__device__ __forceinline__ void ret_readout_phase(Frame& F, const Args& a) {
    const bf16_t* O = (const bf16_t*)(a.ws + RT_O); const bf16_t* SG = (const bf16_t*)(a.ws + RT_SG); bf16_t* A3 = (bf16_t*)(a.ws + RT_A3);
    const float* gg_ = a.in[33]; const float* gb_ = a.in[34];
    const int lane = F.lane;
    for (int t = F.gw; t < NTOK; t += F.ngw) {
        float v[32]; float s = 0.f;
#pragma unroll
        for (int k = 0; k < 4; ++k) { const u32x4 w = *(const u32x4*)(O + (size_t)t * 2048 + 32 * lane + 8 * k);
            v[8 * k] = bflo(w.x); v[8 * k + 1] = bfhi(w.x); v[8 * k + 2] = bflo(w.y); v[8 * k + 3] = bfhi(w.y); v[8 * k + 4] = bflo(w.z); v[8 * k + 5] = bfhi(w.z); v[8 * k + 6] = bflo(w.w); v[8 * k + 7] = bfhi(w.w); }
#pragma unroll
        for (int e = 0; e < 32; ++e) s += v[e];
#pragma unroll
        for (int o = 1; o < 16; o <<= 1) s += __shfl_xor(s, o);
        const float mean = s * (1.0f / 512.0f); float q = 0.f;
#pragma unroll
        for (int e = 0; e < 32; ++e) { v[e] -= mean; q += v[e] * v[e]; }
#pragma unroll
        for (int o = 1; o < 16; o <<= 1) q += __shfl_xor(q, o);
        const float rstd = 1.0f / sqrtf(q * (1.0f / 512.0f) + LN_EPS);
#pragma unroll
        for (int k = 0; k < 4; ++k) { const u32x4 g = *(const u32x4*)(SG + (size_t)t * 2048 + 32 * lane + 8 * k); const unsigned gw[4] = {g.x, g.y, g.z, g.w}; unsigned ow[4];
#pragma unroll
            for (int e = 0; e < 4; ++e) { const int c = 32 * lane + 8 * k + 2 * e;
                const float y0 = (v[8 * k + 2 * e] * rstd * gg_[c] + gb_[c]) * bflo(gw[e]), y1 = (v[8 * k + 2 * e + 1] * rstd * gg_[c + 1] + gb_[c + 1]) * bfhi(gw[e]); ow[e] = pk2(y0, y1); }
            *(u32x4*)(A3 + (size_t)t * 2048 + 32 * lane + 8 * k) = (u32x4){ow[0], ow[1], ow[2], ow[3]}; }
    }
}

constexpr size_t HG_Q = WS_SCR, HG_F = WS_SCR + 33 * MiB, HG_V = WS_SCR + 99 * MiB, HG_G = WS_SCR + 132 * MiB, HG_O = WS_SCR + 165 * MiB, HG_S = WS_SCR + 231 * MiB, HG_D = WS_SCR + 297 * MiB, HG_A4 = HG_Q;
struct EpiHgrnIn {
    static constexpr bool PERM = true;
    bf16_t *Q, *Fp, *V, *G;
    __device__ __forceinline__ void operator()(const gg::Acc& acc, const gg::Unit& u, int wr, int wc, int fr, int fq) const {
        const int grp = u.pn >> 2; const bool act = (grp == 0 || grp == 4);
        bf16_t* O = grp == 0 ? Q : grp == 1 ? Fp : grp == 2 ? Fp + (size_t)NTOK * 1024 : grp == 3 ? V : G;
        const int row0 = u.pm * 256 + wr * 64 + fr, col0 = (u.pn & 3) * 256 + wc * 32 + 8 * fq;
#pragma unroll
        for (int ai = 0; ai < 2; ++ai)
#pragma unroll
            for (int m = 0; m < 4; ++m) { bf16_t* rp = O + (size_t)(row0 + ai * 128 + m * 16) * 1024 + col0;
#pragma unroll
                for (int bj = 0; bj < 2; ++bj) { f32x4 v0 = acc[ai][bj][m][0], v1 = acc[ai][bj][m][1];
                    if (act) {
#pragma unroll
                        for (int e = 0; e < 4; ++e) { v0[e] = siluf_(v0[e]); v1[e] = siluf_(v1[e]); } }
                    u32x4 o; o.x = pk2(v0[0], v0[1]); o.y = pk2(v0[2], v0[3]); o.z = pk2(v1[0], v1[1]); o.w = pk2(v1[2], v1[3]);
                    *(u32x4*)(rp + bj * 128) = o; } }
    }
};
__device__ __forceinline__ void hgrn_in_gemm_phase(Frame& F, const Args& a) {
    gg::DenseSched S; S.init((const bf16_t*)(a.ws + WS_U), (const bf16_t*)(a.ws + WS_W_HGRN_IN), NTOK, 5120, 1024, 1024);
    EpiHgrnIn E{(bf16_t*)(a.ws + HG_Q), (bf16_t*)(a.ws + HG_F), (bf16_t*)(a.ws + HG_V), (bf16_t*)(a.ws + HG_G)};
    gg::gemm_phase<EpiHgrnIn, gg::DenseSched, false, false>(F.lds + LDS_STAGE, gg::Dims{1024, 1024, 1024, 0, 0}, S, E);
}
typedef short v4s16 __attribute__((ext_vector_type(4)));
__device__ __forceinline__ bf16x8 lds_tr_frag(LAS unsigned char* tile, int stride, int r0, int c0, int lane) {
    const int g = lane >> 4, qq = (lane & 15) >> 2, p = lane & 3;
    LAS unsigned char* a0 = tile + (r0 + 8 * g + qq) * stride + (c0 + 4 * p) * 2;
    const v4s16 x = __builtin_amdgcn_ds_read_tr16_b64_v4i16((LAS v4s16*)a0), y = __builtin_amdgcn_ds_read_tr16_b64_v4i16((LAS v4s16*)(a0 + 4 * stride));
    return (bf16x8){x[0], x[1], x[2], x[3], y[0], y[1], y[2], y[3]};
}
__device__ __forceinline__ bf16x8 lds_row_frag(LAS unsigned char* tile, int stride, int row, int k0) { return *(const LAS bf16x8*)(tile + row * stride + k0 * 2); }
constexpr int HS = 272, HPS = 144;
template <int PASS>
__device__ __forceinline__ void hgrn_chunk_phase(Frame& F, const Args& a) {
    const bf16_t* Qb = (const bf16_t*)(a.ws + HG_Q); const bf16_t* Fb = (const bf16_t*)(a.ws + HG_F); const bf16_t* Vb = (const bf16_t*)(a.ws + HG_V);
    bf16_t* Ob = (bf16_t*)(a.ws + HG_O); float* Sb = (float*)(a.ws + HG_S); float* Db = (float*)(a.ws + HG_D);
    const float* LBV = (const float*)(a.ws + WS_LBV); const float* bfp = a.in[37];
    LAS unsigned char* QH = F.lds + LDS_STAGE; LAS unsigned char* KH = QH + 17408; LAS unsigned char* KB = QH + 34816; LAS unsigned char* VV = QH + 52224;
    LAS unsigned char* PP = QH + 69632; LAS unsigned char* SS = QH + 78848; LAS float* DEC = (LAS float*)(QH + 113664); LAS float* TOT = (LAS float*)(QH + 114176);
    const int tid = F.tid, lane = F.lane, w = F.wave, k = tid & 127, tg = tid >> 7, c16 = lane & 15, q4 = lane >> 4;
    const int lrow = tid >> 3, c8 = tid & 7;
    u32x4 rF[2], rV[2], rQ[2];
#define HG_ISSUE(unit_, bi_) do { const int d_ = (unit_) & 1, h_ = ((unit_) >> 1) & 7, seg_ = (unit_) >> 4; const int tr_ = (seg_ * 4 + (d_ ? 3 - (bi_) : (bi_))) * 64; \
        const size_t o_ = (size_t)(tr_ + (d_ ? 63 - lrow : lrow)) * 1024 + h_ * 128 + 8 * c8; const bf16_t* Fd_ = Fb + (size_t)d_ * NTOK * 1024; \
        rF[0] = *(const u32x4*)(Fd_ + o_); rF[1] = *(const u32x4*)(Fd_ + o_ + 64); rV[0] = *(const u32x4*)(Vb + o_); rV[1] = *(const u32x4*)(Vb + o_ + 64); \
        if (PASS) { rQ[0] = *(const u32x4*)(Qb + o_); rQ[1] = *(const u32x4*)(Qb + o_ + 64); } } while (0)
    if ((int)blockIdx.x < 65 * 16) HG_ISSUE((int)blockIdx.x, 0);
#pragma unroll 1
    for (int unit = blockIdx.x; unit < 65 * 16; unit += gridDim.x) {
        const int d = unit & 1, h = (unit >> 1) & 7, seg = unit >> 4, ch = h * 128 + k;
        const float lbv = LBV[ch], bfv = bfp[d * 1024 + ch];
        const bf16_t* Fd = Fb + (size_t)d * NTOK * 1024;
        f32x4 accS[8]; float dseg = 1.0f;
        float* Su = Sb + (size_t)unit * 16384;
#pragma unroll
        for (int kt = 0; kt < 8; ++kt)
#pragma unroll
            for (int r = 0; r < 4; ++r) accS[kt][r] = PASS ? Su[(16 * kt + 4 * q4 + r) * 128 + 16 * w + c16] : 0.f;
        if (PASS) {
#pragma unroll
            for (int kt = 0; kt < 8; ++kt)
#pragma unroll
                for (int r = 0; r < 4; ++r) *(LAS unsigned short*)(SS + (16 * kt + 4 * q4 + r) * HS + (16 * w + c16) * 2) = (unsigned short)f2bf(accS[kt][r]);
        }
#pragma unroll 1
        for (int bi = 0; bi < 4; ++bi) {
            const int trow0 = (seg * 4 + (d ? 3 - bi : bi)) * 64;
            { const int lo_ = lrow * HS + 16 * c8;
              *(LAS u32x4*)(KB + lo_) = rF[0]; *(LAS u32x4*)(KB + lo_ + 128) = rF[1]; *(LAS u32x4*)(VV + lo_) = rV[0]; *(LAS u32x4*)(VV + lo_ + 128) = rV[1];
              if (PASS) { *(LAS u32x4*)(QH + lo_) = rQ[0]; *(LAS u32x4*)(QH + lo_ + 128) = rQ[1]; } }
            { const int nu = bi < 3 ? unit : unit + (int)gridDim.x, nb = bi < 3 ? bi + 1 : 0; if (nu < 65 * 16) HG_ISSUE(nu, nb); }
            __syncthreads();
            float lfc[16]; float run = 0.f;
#pragma unroll
            for (int ii = 0; ii < 16; ++ii) { const int i = tg * 16 + ii;
                const float fp = bf2f(*(const LAS unsigned short*)(KB + i * HS + k * 2)); const float f = lbv + (1.0f - lbv) * sigmoidf_(fp + bfv);
                run += __logf(f); lfc[ii] = run; }
            TOT[tg * 128 + k] = run;
            __syncthreads();
            float off = 0.f, btot = 0.f;
#pragma unroll
            for (int g2 = 0; g2 < 4; ++g2) { const float tv = TOT[g2 * 128 + k]; btot += tv; if (g2 < tg) off += tv; }
#pragma unroll
            for (int ii = 0; ii < 16; ++ii) { const int i = tg * 16 + ii; const float B = off + lfc[ii];
                const float lf = lfc[ii] - (ii ? lfc[ii - 1] : 0.f); const float kkv = 1.0f - __expf(lf);
                *(LAS unsigned short*)(KB + i * HS + k * 2) = (unsigned short)f2bf(kkv * __expf(btot - B));
                if (PASS) { const float qv = bf2f(*(const LAS unsigned short*)(QH + i * HS + k * 2));
                            *(LAS unsigned short*)(QH + i * HS + k * 2) = (unsigned short)f2bf(qv * __expf(B));
                            *(LAS unsigned short*)(KH + i * HS + k * 2) = (unsigned short)f2bf(kkv * __expf(fminf(-B, 80.0f))); }
                if ((ii & 3) == 3) asm volatile("" ::: "memory"); }
            if (tg == 0) { const float e = __expf(btot); DEC[k] = e; dseg *= e; }
            __syncthreads();
            f32x4 ao[4];
            if (PASS) {
#pragma unroll
                for (int s2 = 0; s2 < 2; ++s2) { const int it = w >> 1, jt = 2 * (w & 1) + s2; f32x4 sc = {0.f, 0.f, 0.f, 0.f};
#pragma unroll
                    for (int ks = 0; ks < 4; ++ks) sc = __builtin_amdgcn_mfma_f32_16x16x32_bf16(lds_row_frag(QH, HS, 16 * it + c16, 32 * ks + 8 * q4), lds_row_frag(KH, HS, 16 * jt + c16, 32 * ks + 8 * q4), sc, 0, 0, 0);
#pragma unroll
                    for (int r = 0; r < 4; ++r) { const int i = 16 * it + 4 * q4 + r, j = 16 * jt + c16; *(LAS unsigned short*)(PP + i * HPS + j * 2) = (unsigned short)f2bf(j <= i ? sc[r] : 0.f); } }
                __syncthreads();
#pragma unroll
                for (int it = 0; it < 4; ++it) ao[it] = (f32x4){0.f, 0.f, 0.f, 0.f};
            }
            bf16x8 vf[2];
#pragma unroll
            for (int ks = 0; ks < 2; ++ks) vf[ks] = lds_tr_frag(VV, HS, 32 * ks, 16 * w, lane);
            if (PASS) {
#pragma unroll
                for (int ks = 0; ks < 2; ++ks)
#pragma unroll
                    for (int it = 0; it < 4; ++it) ao[it] = __builtin_amdgcn_mfma_f32_16x16x32_bf16(lds_row_frag(PP, HPS, 16 * it + c16, 32 * ks + 8 * q4), vf[ks], ao[it], 0, 0, 0);
#pragma unroll 1
                for (int ks = 0; ks < 4; ++ks) { const bf16x8 sf = lds_tr_frag(SS, HS, 32 * ks, 16 * w, lane);
#pragma unroll
                    for (int it = 0; it < 4; ++it) ao[it] = __builtin_amdgcn_mfma_f32_16x16x32_bf16(lds_row_frag(QH, HS, 16 * it + c16, 32 * ks + 8 * q4), sf, ao[it], 0, 0, 0); }
            }
#pragma unroll
            for (int kt = 0; kt < 8; ++kt) {
#pragma unroll
                for (int r = 0; r < 4; ++r) accS[kt][r] *= DEC[16 * kt + 4 * q4 + r];
#pragma unroll
                for (int ks = 0; ks < 2; ++ks) accS[kt] = __builtin_amdgcn_mfma_f32_16x16x32_bf16(lds_tr_frag(KB, HS, 32 * ks, 16 * kt, lane), vf[ks], accS[kt], 0, 0, 0);
            }
            __syncthreads();
            if (PASS) {
#pragma unroll
                for (int kt = 0; kt < 8; ++kt)
#pragma unroll
                    for (int r = 0; r < 4; ++r) *(LAS unsigned short*)(SS + (16 * kt + 4 * q4 + r) * HS + (16 * w + c16) * 2) = (unsigned short)f2bf(accS[kt][r]);
#pragma unroll
                for (int it = 0; it < 4; ++it)
#pragma unroll
                    for (int r = 0; r < 4; ++r) *(LAS unsigned short*)(KH + (16 * it + 4 * q4 + r) * HS + (16 * w + c16) * 2) = (unsigned short)f2bf(ao[it][r]);
                __syncthreads();
                bf16_t* Od = Ob + (size_t)d * NTOK * 1024;
#pragma unroll
                for (int cc = 0; cc < 2; ++cc) { const int row = tid >> 3, chunk = (tid & 7) + 8 * cc, t = trow0 + (d ? 63 - row : row);
                    *(u32x4*)(Od + (size_t)t * 1024 + h * 128 + 8 * chunk) = *(const LAS u32x4*)(KH + row * HS + 16 * chunk); }
            }
        }
        if (!PASS) {
#pragma unroll
            for (int kt = 0; kt < 8; ++kt)
#pragma unroll
                for (int r = 0; r < 4; ++r) Su[(16 * kt + 4 * q4 + r) * 128 + 16 * w + c16] = accS[kt][r];
            if (tg == 0) Db[(size_t)unit * 128 + k] = dseg;
        }
        __syncthreads();
    }
}
#undef HG_ISSUE
template <bool DRY = false>
__device__ __forceinline__ void hgrn_prefix_phase(Frame& F, const Args& a) {
    float* Sb = (float*)(a.ws + (DRY ? WS_DUMMY : HG_S)); const float* Db = (const float*)(a.ws + HG_D);
    for (int gid = blockIdx.x * NTHREADS + F.tid; gid < 16 * 4096; gid += gridDim.x * NTHREADS) {
        const int hd = gid >> 12, e4 = gid & 4095, krow = e4 >> 5, d = hd & 1;
        f32x4 s = {0.f, 0.f, 0.f, 0.f};
#define HG_SEG(st_) (((d == 0) || (st_) == 0) ? (st_) : 65 - (st_))
        f32x4 lb[4]; float db[4];
#pragma unroll
        for (int j = 0; j < 4; ++j) { const int u2 = HG_SEG(j) * 16 + hd; lb[j] = *((const f32x4*)(Sb + (size_t)u2 * 16384) + e4); db[j] = Db[(size_t)u2 * 128 + krow]; }
#pragma unroll 1
        for (int base = 0; base < 68; base += 4) {
#pragma unroll
            for (int j = 0; j < 4; ++j) { const int step = base + j; if (step < 65) {
                const int unit = HG_SEG(step) * 16 + hd; f32x4* p = (f32x4*)(Sb + (size_t)unit * 16384) + e4; const f32x4 loc = lb[j]; const float dec = db[j];
                if (step + 4 < 65) { const int u2 = HG_SEG(step + 4) * 16 + hd; lb[j] = *((const f32x4*)(Sb + (size_t)u2 * 16384) + e4); db[j] = Db[(size_t)u2 * 128 + krow]; }
                *p = s; s = s * dec + loc; } }
        }
#undef HG_SEG
    }
}
__device__ __forceinline__ void hgrn_readout_phase(Frame& F, const Args& a) {
    const bf16_t* O0 = (const bf16_t*)(a.ws + HG_O); const bf16_t* O1 = O0 + (size_t)NTOK * 1024; const bf16_t* G = (const bf16_t*)(a.ws + HG_G); bf16_t* A4 = (bf16_t*)(a.ws + HG_A4);
    const float* ng = a.in[39]; const int lane = F.lane;
    float gn[8];
#pragma unroll
    for (int e = 0; e < 8; ++e) gn[e] = ng[(8 * lane + e) & 127];
    for (int t = F.gw; t < NTOK; t += F.ngw) {
        float o[16], g[16]; ldrow_bf16(O0 + (size_t)t * 1024, lane, o); addrow_bf16(O1 + (size_t)t * 1024, lane, o); ldrow_bf16(G + (size_t)t * 1024, lane, g);
#pragma unroll
        for (int j = 0; j < 2; ++j) { float q = 0.f;
#pragma unroll
            for (int e = 0; e < 8; ++e) q += o[8 * j + e] * o[8 * j + e];
#pragma unroll
            for (int m = 1; m < 16; m <<= 1) q += __shfl_xor(q, m);
            const float rs = 1.0f / sqrtf(q * (1.0f / 128.0f) + LN_EPS);
#pragma unroll
            for (int e = 0; e < 8; ++e) o[8 * j + e] = o[8 * j + e] * rs * gn[e] * g[8 * j + e]; }
        strow_bf16(A4 + (size_t)t * 1024, lane, o);
    }
}

constexpr size_t RW_XM = WS_SCR, RW_WW = WS_SCR, RW_AA = WS_SCR + 131 * MiB, RW_R = WS_SCR + 196 * MiB, RW_K = WS_SCR + 229 * MiB, RW_V = WS_SCR + 262 * MiB, RW_L1 = WS_SCR + 295 * MiB,
                 RW_G = WS_SCR + 321 * MiB, RW_REC = WS_SCR + 354 * MiB, RW_PQ = WS_SCR + (RWKV_CHUNKED ? 354 : 0) * MiB, RW_SST = WS_SCR + (RWKV_CHUNKED ? 420 : 64) * MiB, RW_O = WS_SCR + 745 * MiB, RW_A5 = WS_SCR, RW_Y = WS_SCR + 812 * MiB, RW_END = WS_SCR + 880 * MiB;
constexpr int RECB = 768;
typedef _Float16 h2_t __attribute__((ext_vector_type(2)));
typedef _Float16 h8_t __attribute__((ext_vector_type(8)));
__device__ __forceinline__ void rwkv_xm_phase(Frame& F, const Args& a) {
    const bf16_t* U = (const bf16_t*)(a.ws + WS_U); bf16_t* XM = (bf16_t*)(a.ws + RW_XM); const float* mu = a.in[15];
    for (int t = F.gw; t < NTOK; t += F.ngw) {
        float u[16], sh[16]; ldrow_bf16(U + (size_t)t * D, F.lane, u);
        const bool hasp = (t != 0 && t != NCTX), hasn = (t != NCTX - 1 && t != NTOK - 1);
        { u32x4 pv = {0u, 0u, 0u, 0u}, nv = {0u, 0u, 0u, 0u};
          if (hasp) pv = *(const u32x4*)(U + (size_t)(t - 1) * D + 8 * F.lane);
          if (hasn) nv = *(const u32x4*)(U + (size_t)(t + 1) * D + 512 + 8 * F.lane);
          sh[0] = bflo(pv.x); sh[1] = bfhi(pv.x); sh[2] = bflo(pv.y); sh[3] = bfhi(pv.y); sh[4] = bflo(pv.z); sh[5] = bfhi(pv.z); sh[6] = bflo(pv.w); sh[7] = bfhi(pv.w);
          sh[8] = bflo(nv.x); sh[9] = bfhi(nv.x); sh[10] = bflo(nv.y); sh[11] = bfhi(nv.y); sh[12] = bflo(nv.z); sh[13] = bfhi(nv.z); sh[14] = bflo(nv.w); sh[15] = bfhi(nv.w); }
#pragma unroll 1
        for (int c = 0; c < 6; ++c) { float m[16], o[16]; ldrow_f32(mu + c * D, F.lane, m);
#pragma unroll
            for (int e = 0; e < 16; ++e) o[e] = u[e] + (sh[e] - u[e]) * m[e];
            strow_bf16(XM + ((size_t)c * NTOK + t) * D, F.lane, o); }
    }
}
struct RwkvInSched {
    const char* XM; const char* Win; const char* Wl1; int G, c;
    __device__ __forceinline__ bool next(int i, gg::Unit& u) const {
        const int L0 = i * G + c; if (L0 >= 975) return false; const int L = xcd_remap(L0, 975);
        int g, pm, pn;
        if (L < 780) { g = L / 260; const int r = L % 260; pm = r >> 2; pn = r & 3; u.b = Win + ((size_t)g * 1024 + pn * 256) * 2048; }
        else { const int r = L - 780; g = 3 + r / 65; pm = r % 65; pn = 0; u.b = Wl1 + (size_t)(g - 3) * 256 * 2048; }
        u.a = XM + ((size_t)g * NTOK + pm * 256) * 2048; u.b2 = nullptr; u.pm = pm; u.pn = pn; u.gofs = 0; u.x = g; return true; }
};
struct EpiRwkvIn {
    static constexpr bool PERM = true;
    bf16_t* RKV; bf16_t* L1;
    __device__ __forceinline__ void operator()(const gg::Acc& acc, const gg::Unit& u, int wr, int wc, int fr, int fq) const {
        const int g = u.x; const bool lora = g >= 3;
        bf16_t* O = lora ? L1 + (size_t)(g - 3) * NTOK * 256 : RKV + (size_t)g * (33 * MiB / 2); const int ldc = lora ? 256 : 1024;
        const int row0 = u.pm * 256 + wr * 64 + fr, col0 = u.pn * 256 + wc * 32 + 8 * fq;
#pragma unroll
        for (int ai = 0; ai < 2; ++ai)
#pragma unroll
            for (int m = 0; m < 4; ++m) { bf16_t* rp = O + (size_t)(row0 + ai * 128 + m * 16) * ldc + col0;
#pragma unroll
                for (int bj = 0; bj < 2; ++bj) { f32x4 v0 = acc[ai][bj][m][0], v1 = acc[ai][bj][m][1];
                    if (g == 3) {
#pragma unroll
                        for (int e = 0; e < 4; ++e) { v0[e] = 1.0f - 2.0f * __builtin_amdgcn_rcpf(1.0f + __expf(2.0f * v0[e])); v1[e] = 1.0f - 2.0f * __builtin_amdgcn_rcpf(1.0f + __expf(2.0f * v1[e])); } }
                    if (g == 5) {
#pragma unroll
                        for (int e = 0; e < 4; ++e) { v0[e] = sigmoidf_(v0[e]); v1[e] = sigmoidf_(v1[e]); } }
                    u32x4 o; o.x = pk2(v0[0], v0[1]); o.y = pk2(v0[2], v0[3]); o.z = pk2(v1[0], v1[1]); o.w = pk2(v1[2], v1[3]);
                    *(u32x4*)(rp + bj * 128) = o; } }
    }
};
__device__ __forceinline__ void rwkv_in_gemm_phase(Frame& F, const Args& a) {
    RwkvInSched S{(const char*)(a.ws + RW_XM), (const char*)(a.ws + WS_W_RWKV_IN), (const char*)(a.ws + WS_W_RWKV_L1), (int)gridDim.x, (int)blockIdx.x};
    EpiRwkvIn E{(bf16_t*)(a.ws + RW_R), (bf16_t*)(a.ws + RW_L1)};
    gg::gemm_phase<EpiRwkvIn, RwkvInSched, false, false>(F.lds + LDS_STAGE, gg::Dims{1024, 1024, 1024, 0, 0}, S, E);
}
struct RwkvL2Sched {
    const char* L1; const char* W2; int G, c;
    __device__ __forceinline__ bool next(int i, gg::Unit& u) const {
        const int L0 = i * G + c; if (L0 >= 1300) return false; const int L = xcd_remap(L0, 1300);
        const int g = L / 260, r = L % 260, pm = r >> 2, pn = r & 3, src = g >> 1;
        u.a = L1 + ((size_t)src * NTOK + pm * 256) * 512; u.b = W2 + ((size_t)g * 1024 + pn * 256) * 512; u.b2 = nullptr; u.pm = pm; u.pn = pn; u.gofs = 0; u.x = g; return true; }
};
struct EpiRwkvL2 {
    static constexpr bool PERM = true;
    float* WW; bf16_t* AA; bf16_t* GG;
    __device__ __forceinline__ void operator()(const gg::Acc& acc, const gg::Unit& u, int wr, int wc, int fr, int fq) const {
        const int g = u.x, z = g & 1; const int row0 = u.pm * 256 + wr * 64 + fr, col0 = u.pn * 256 + wc * 32 + 8 * fq;
        float* wbase = WW + (size_t)z * NTOK * 1024; bf16_t* obase = g < 4 ? AA + (size_t)z * NTOK * 1024 : GG;
#pragma unroll
        for (int ai = 0; ai < 2; ++ai)
#pragma unroll
            for (int m = 0; m < 4; ++m) { const size_t ro = (size_t)(row0 + ai * 128 + m * 16) * 1024 + col0;
#pragma unroll
                for (int bj = 0; bj < 2; ++bj) { const f32x4 v0 = acc[ai][bj][m][0], v1 = acc[ai][bj][m][1];
                    if (g < 2) { float* wp = wbase + ro + bj * 128; *(f32x4*)wp = v0; *(f32x4*)(wp + 4) = v1; }
                    else { u32x4 o; o.x = pk2(v0[0], v0[1]); o.y = pk2(v0[2], v0[3]); o.z = pk2(v1[0], v1[1]); o.w = pk2(v1[2], v1[3]); *(u32x4*)(obase + ro + bj * 128) = o; } } }
    }
};
__device__ __forceinline__ void rwkv_l2_gemm_phase(Frame& F, const Args& a) {
    RwkvL2Sched S{(const char*)(a.ws + RW_L1), (const char*)(a.ws + WS_W_RWKV_WL2), (int)gridDim.x, (int)blockIdx.x};
    EpiRwkvL2 E{(float*)(a.ws + RW_WW), (bf16_t*)(a.ws + RW_AA), (bf16_t*)(a.ws + RW_G)};
    gg::gemm_phase<EpiRwkvL2, RwkvL2Sched, false, false>(F.lds + LDS_STAGE, gg::Dims{256, 256, 256, 0, 0}, S, E);
}
__device__ __forceinline__ int rwkv_row(int z, int n) { return z == 0 ? n : (n < NCTX ? NCTX - 1 - n : NTOK - 1 + NCTX - n); }
__device__ __forceinline__ void rwkv_rec_phase(Frame& F, const Args& a) {
    const bf16_t* R = (const bf16_t*)(a.ws + RW_R); const bf16_t* K = (const bf16_t*)(a.ws + RW_K); const bf16_t* V = (const bf16_t*)(a.ws + RW_V);
    const float* WW = (const float*)(a.ws + RW_WW); const bf16_t* AA = (const bf16_t*)(a.ws + RW_AA); unsigned char* REC = a.ws + RW_REC;
    const int lane = F.lane;
    float kkw[16], kaw[16]; ldrow_f32(a.in[25], lane, kkw); ldrow_f32(a.in[26], lane, kaw);
#pragma unroll 1
    for (int t = F.gw; t < NTOK; t += F.ngw) {
        float k[16], r[16], v[16], kk[16];
        ldrow_bf16(K + (size_t)t * 1024, lane, k); ldrow_bf16(R + (size_t)t * 1024, lane, r); ldrow_bf16(V + (size_t)t * 1024, lane, v);
#pragma unroll
        for (int j = 0; j < 2; ++j) { float ss = 0.f;
#pragma unroll
            for (int e = 0; e < 8; ++e) { kk[8 * j + e] = k[8 * j + e] * kkw[8 * j + e]; ss += kk[8 * j + e] * kk[8 * j + e]; }
#pragma unroll
            for (int m = 1; m < 8; m <<= 1) ss += __shfl_xor(ss, m);
            const float rn = __builtin_amdgcn_rsqf(ss + 1e-12f);
#pragma unroll
            for (int e = 0; e < 8; ++e) kk[8 * j + e] *= rn; }
#pragma unroll
        for (int z = 0; z < 2; ++z) {
            float ap[16], wp[16], a0v[16], w0v[16];
            ldrow_bf16(AA + ((size_t)z * NTOK + t) * 1024, lane, ap); ldrow_f32(WW + ((size_t)z * NTOK + t) * 1024, lane, wp); ldrow_f32(a.in[20] + z * 1024, lane, a0v); ldrow_f32(a.in[17] + z * 1024, lane, w0v);
            const int n = (z == 0) ? t : (t < NCTX ? NCTX - 1 - t : NTOK - 1 + NCTX - t);
#pragma unroll
            for (int j = 0; j < 2; ++j) {
                const int col = 8 * lane + 512 * j, hh = col >> 6, cin = col & 63;
                h8_t ow, okk, ob, okt, orr, ov;
#pragma unroll
                for (int e = 0; e < 8; ++e) { const int x = 8 * j + e; const float av = sigmoidf_(a0v[x] + ap[x]), wv = __expf(-0.6065306597126334f * sigmoidf_(w0v[x] + wp[x]));
                    ow[e] = (_Float16)wv; okk[e] = (_Float16)kk[x]; ob[e] = (_Float16)(av * kk[x]); okt[e] = (_Float16)(k[x] * (1.0f + (av - 1.0f) * kaw[x])); orr[e] = (_Float16)r[x]; ov[e] = (_Float16)v[x]; }
                unsigned char* rec = REC + ((size_t)(z * 16 + hh) * NTOK + n) * RECB + cin * 2;
                *(h8_t*)(rec) = ow; *(h8_t*)(rec + 128) = okk; *(h8_t*)(rec + 256) = ob; *(h8_t*)(rec + 384) = okt; *(h8_t*)(rec + 512) = orr; *(h8_t*)(rec + 640) = ov;
            }
        }
    }
}
__device__ __forceinline__ float quad_sum(float x) {
    x += __builtin_bit_cast(float, __builtin_amdgcn_mov_dpp(__builtin_bit_cast(int, x), 0xB1, 0xF, 0xF, true));
    x += __builtin_bit_cast(float, __builtin_amdgcn_mov_dpp(__builtin_bit_cast(int, x), 0x4E, 0xF, 0xF, true));
    return x;
}
template <bool VTERM, bool OUT>
__device__ __forceinline__ void rwkv_scan_task(const unsigned char* rec, LAS unsigned char* buf, int lane, h2_t (&S)[4][8], bf16_t* Ozh, int z, int n0, int nck) {
    const int v_lo = lane >> 2, kq = lane & 3;
#define RW_DMA(ck_, bsel_) do { _Pragma("unroll") for (int m = 0; m < 6; ++m) \
        __builtin_amdgcn_global_load_lds((const unsigned*)(rec + (size_t)(ck_) * 8 * RECB + (size_t)(lane + 64 * m) * 16), (LAS unsigned*)(buf + (bsel_) * 6144 + m * 1024), 16, 0, 0); } while (0)
    RW_DMA(0, 0);
#pragma unroll 1
    for (int ck = 0; ck < nck; ++ck) {
        if (ck < nck - 1) { RW_DMA(ck + 1, (ck + 1) & 1); asm volatile("s_waitcnt vmcnt(6)" ::: "memory"); }
        else asm volatile("s_waitcnt vmcnt(0)" ::: "memory");
        const LAS unsigned char* cb = buf + (ck & 1) * 6144;
#pragma unroll 2
        for (int st = 0; st < 8; ++st) {
            const LAS unsigned char* b = cb + st * RECB + kq * 32;
            h2_t kk[8], wv[8], bv[8], kt[8], rv[8];
            { const h8_t x0 = *(const LAS h8_t*)(b + 128), x1 = *(const LAS h8_t*)(b + 128 + 16);
#pragma unroll
              for (int p2 = 0; p2 < 4; ++p2) { kk[p2] = (h2_t){x0[2 * p2], x0[2 * p2 + 1]}; kk[4 + p2] = (h2_t){x1[2 * p2], x1[2 * p2 + 1]}; } }
            float sa[4];
#pragma unroll
            for (int i = 0; i < 4; ++i) { float a0 = 0.f, a1 = 0.f;
#pragma unroll
                for (int p2 = 0; p2 < 8; p2 += 2) { a0 = __builtin_amdgcn_fdot2(S[i][p2], kk[p2], a0, false); a1 = __builtin_amdgcn_fdot2(S[i][p2 + 1], kk[p2 + 1], a1, false); }
                sa[i] = quad_sum(a0 + a1); }
            { const h8_t x0 = *(const LAS h8_t*)(b), x1 = *(const LAS h8_t*)(b + 16), y0 = *(const LAS h8_t*)(b + 256), y1 = *(const LAS h8_t*)(b + 256 + 16);
#pragma unroll
              for (int p2 = 0; p2 < 4; ++p2) { wv[p2] = (h2_t){x0[2 * p2], x0[2 * p2 + 1]}; wv[4 + p2] = (h2_t){x1[2 * p2], x1[2 * p2 + 1]}; bv[p2] = (h2_t){y0[2 * p2], y0[2 * p2 + 1]}; bv[4 + p2] = (h2_t){y1[2 * p2], y1[2 * p2 + 1]}; } }
            if (VTERM) { const h8_t x0 = *(const LAS h8_t*)(b + 384), x1 = *(const LAS h8_t*)(b + 384 + 16);
#pragma unroll
              for (int p2 = 0; p2 < 4; ++p2) { kt[p2] = (h2_t){x0[2 * p2], x0[2 * p2 + 1]}; kt[4 + p2] = (h2_t){x1[2 * p2], x1[2 * p2 + 1]}; } }
            if (OUT) { const h8_t x0 = *(const LAS h8_t*)(b + 512), x1 = *(const LAS h8_t*)(b + 512 + 16);
#pragma unroll
              for (int p2 = 0; p2 < 4; ++p2) { rv[p2] = (h2_t){x0[2 * p2], x0[2 * p2 + 1]}; rv[4 + p2] = (h2_t){x1[2 * p2], x1[2 * p2 + 1]}; } }
            float oi[4];
#pragma unroll
            for (int i = 0; i < 4; ++i) {
                const _Float16 nsa = (_Float16)(-sa[i]); const h2_t nsa2 = {nsa, nsa};
                h2_t vv2 = {(_Float16)0, (_Float16)0};
                if (VTERM) { const _Float16 vh = *(const LAS _Float16*)(cb + st * RECB + 640 + (16 * i + v_lo) * 2); vv2 = (h2_t){vh, vh}; }
                float o0 = 0.f, o1 = 0.f;
#pragma unroll
                for (int p2 = 0; p2 < 8; ++p2) {
                    h2_t t = nsa2 * bv[p2]; if (VTERM) t = __builtin_elementwise_fma(vv2, kt[p2], t);
                    S[i][p2] = __builtin_elementwise_fma(S[i][p2], wv[p2], t);
                    if (OUT) { if (p2 & 1) o1 = __builtin_amdgcn_fdot2(S[i][p2], rv[p2], o1, false); else o0 = __builtin_amdgcn_fdot2(S[i][p2], rv[p2], o0, false); } }
                if (OUT) oi[i] = quad_sum(o0 + o1);
            }
            if (OUT) { const float o = kq == 0 ? oi[0] : kq == 1 ? oi[1] : kq == 2 ? oi[2] : oi[3];
                Ozh[(size_t)rwkv_row(z, n0 + ck * 8 + st) * 1024 + 16 * kq + v_lo] = (unsigned short)f2bf(o); }
        }
    }
#undef RW_DMA
}
#define RW_STORE_STATE(dst_) do { _Pragma("unroll") for (int i = 0; i < 4; ++i) _Pragma("unroll") for (int p4 = 0; p4 < 4; ++p4) \
        *(f32x4*)((dst_) + (16 * i + v_lo) * 64 + 16 * kq + 4 * p4) = (f32x4){(float)S[i][2 * p4][0], (float)S[i][2 * p4][1], (float)S[i][2 * p4 + 1][0], (float)S[i][2 * p4 + 1][1]}; } while (0)
template <int KIND>
__device__ __forceinline__ void rwkv_scan_phase(Frame& F, const Args& a) {
    const unsigned char* REC = a.ws + RW_REC; float* PQ = (float*)(a.ws + RW_PQ); float* SST = (float*)(a.ws + RW_SST); bf16_t* O = (bf16_t*)(a.ws + RW_O); bf16_t* Y = (bf16_t*)(a.ws + RW_Y);
    LAS unsigned char* buf = F.lds + LDS_STAGE + F.wave * 12288;
    const int lane = F.lane, v_lo = lane >> 2, kq = lane & 3;
#pragma unroll 1
    for (int task = F.gw; task < 2048; task += F.ngw) {
        const int zh = task & 31, z = zh >> 4, h = zh & 15, sidx = task >> 5;
        h2_t S[4][8];
#pragma unroll
        for (int i = 0; i < 4; ++i)
#pragma unroll
            for (int p2 = 0; p2 < 8; ++p2) S[i][p2] = (h2_t){(_Float16)0.f, (_Float16)0.f};
        if (sidx == 0) {
            rwkv_scan_task<true, true>(REC + (size_t)zh * NTOK * RECB, buf, lane, S, O + (size_t)z * NTOK * 1024 + h * 64, z, 0, 64);
            float* dst = SST + ((size_t)zh * 65 + 2) * 4096; RW_STORE_STATE(dst);
        } else {
            const int s = sidx + 1; const unsigned char* rec = REC + ((size_t)zh * NTOK + (size_t)s * 256) * RECB;
            rwkv_scan_task<true, true>(rec, buf, lane, S, O + (size_t)z * NTOK * 1024 + h * 64, z, s * 256, 32);
            { float* dst = PQ + ((size_t)zh * 64 + (s - 1)) * 8192 + 4096; RW_STORE_STATE(dst); }
#pragma unroll
            for (int i = 0; i < 4; ++i)
#pragma unroll
                for (int p2 = 0; p2 < 8; ++p2) { const int key = 16 * kq + 2 * p2, vr = 16 * i + v_lo; S[i][p2] = (h2_t){(_Float16)(vr == key ? 1.0f : 0.f), (_Float16)(vr == key + 1 ? 1.0f : 0.f)}; }
            asm volatile("s_waitcnt lgkmcnt(0)" ::: "memory");
            rwkv_scan_task<false, true>(rec, buf, lane, S, Y + (size_t)z * NTOK * 1024 + h * 64, z, s * 256, 32);
            { float* dst = PQ + ((size_t)zh * 64 + (s - 1)) * 8192; RW_STORE_STATE(dst); }
        }
        asm volatile("s_waitcnt lgkmcnt(0)" ::: "memory");
    }
}
constexpr int CK_TS = 144, CK_YS = 272;
constexpr int CK_AH = 0, CK_BH = 9216, CK_KH = 18432, CK_RH = 27648, CK_VV = 36864, CK_BB = 46080, CK_KB = 55296, CK_NM = 64512, CK_MAK = 73728, CK_MRB = 82944, CK_MRK = 92160,
              CK_YY = 101376, CK_SS = 118784, CK_DEC = 137216, CK_TOT = 137472, CK_TD = 139776, CK_TMP = 141824, CK_CT = 150016;
__device__ __forceinline__ void rwkv_chunk_phase(Frame& F, const Args& a) {
    float* PQ = (float*)(a.ws + RW_PQ); float* SST = (float*)(a.ws + RW_SST);
    LAS unsigned char* L = F.lds + LDS_STAGE;
    LAS float* DEC = (LAS float*)(L + CK_DEC); LAS float* TOT = (LAS float*)(L + CK_TOT); LAS float* CT = (LAS float*)(L + CK_CT);
    const int tid = F.tid, lane = F.lane, w = F.wave, c16 = lane & 15, q = lane >> 4;
    const int si = tid >> 3, c8 = tid & 7;
    const bool zset = w >= 4;
#pragma unroll 1
    for (int unit = blockIdx.x; unit < 2048; unit += gridDim.x) {
        const int zh = unit & 31, z = zh >> 4, h = zh & 15, sidx = unit >> 5;
        const int n0 = sidx == 0 ? 0 : (sidx + 1) * 256, nblk = sidx == 0 ? 8 : 4; const bool use_p = sidx != 0;
        if (tid < 64) { CT[tid] = a.in[25][h * 64 + tid]; CT[64 + tid] = a.in[26][h * 64 + tid]; CT[128 + tid] = a.in[20][z * 1024 + h * 64 + tid]; CT[192 + tid] = a.in[17][z * 1024 + h * 64 + tid]; }
        f32x4 accS[4];
#pragma unroll
        for (int kt = 0; kt < 4; ++kt)
#pragma unroll
            for (int r = 0; r < 4; ++r) { const float v0 = (!zset && (16 * w + 4 * q + r) == (16 * kt + c16)) ? 1.0f : 0.f; accS[kt][r] = v0;
                *(LAS unsigned short*)(L + CK_SS + (16 * w + 4 * q + r) * CK_TS + (16 * kt + c16) * 2) = (unsigned short)f2bf(v0); }
        __syncthreads();
        u32x4 pkx, pax, prx, pvx; f32x4 pw0, pw1;
#define CK_PREFETCH(blk_) do { int _t = threadIdx.x; asm volatile("" : "+v"(_t)); const int _trow = rwkv_row(z, n0 + (blk_) * 64 + (_t >> 3)); const unsigned _go = (unsigned)(_trow * 1024 + h * 64 + 8 * (_t & 7)) * 2u; \
            const unsigned char* _w = a.ws; const unsigned _zo = (unsigned)z * (unsigned)(NTOK * 1024 * 2); \
            pkx = *(const u32x4*)(_w + RW_K + _go); pax = *(const u32x4*)(_w + RW_AA + _zo + _go); prx = *(const u32x4*)(_w + RW_R + _go); pvx = *(const u32x4*)(_w + RW_V + _go); \
            pw0 = *(const f32x4*)(_w + RW_WW + 2u * _zo + 2u * _go); pw1 = *(const f32x4*)(_w + RW_WW + 2u * _zo + 2u * _go + 16u); } while (0)
        CK_PREFETCH(0);
#pragma unroll 1
        for (int blk = 0; blk < nblk; ++blk) {
            int tid_o = threadIdx.x; asm volatile("" : "+v"(tid_o));
            const int lane = tid_o & 63, c16 = lane & 15, q = lane >> 4, si = tid_o >> 3, c8 = tid_o & 7;
            float lw[8], kkv[8], bv[8], ktv[8]; u32x4 rx, vx;
            {
                const u32x4 kx = pkx, ax = pax; rx = prx; vx = pvx; const f32x4 wx0 = pw0, wx1 = pw1;
                const float kf[8] = {bflo(kx.x), bfhi(kx.x), bflo(kx.y), bfhi(kx.y), bflo(kx.z), bfhi(kx.z), bflo(kx.w), bfhi(kx.w)};
                const float af[8] = {bflo(ax.x), bfhi(ax.x), bflo(ax.y), bfhi(ax.y), bflo(ax.z), bfhi(ax.z), bflo(ax.w), bfhi(ax.w)};
                const float wf[8] = {wx0[0], wx0[1], wx0[2], wx0[3], wx1[0], wx1[1], wx1[2], wx1[3]};
                const f32x4 c0a = *(const LAS f32x4*)(CT + 8 * c8), c0b = *(const LAS f32x4*)(CT + 8 * c8 + 4);
                float ss = 0.f;
#pragma unroll
                for (int e = 0; e < 8; ++e) { const float kkw = e < 4 ? c0a[e] : c0b[e - 4]; kkv[e] = kf[e] * kkw; ss += kkv[e] * kkv[e]; }
                ss += __shfl_xor(ss, 1); ss += __shfl_xor(ss, 2); ss += __shfl_xor(ss, 4);
                const float rn = __builtin_amdgcn_rsqf(ss + 1e-12f);
                asm volatile("" ::: "memory");
                const f32x4 c1a = *(const LAS f32x4*)(CT + 64 + 8 * c8), c1b = *(const LAS f32x4*)(CT + 64 + 8 * c8 + 4);
                const f32x4 c2a = *(const LAS f32x4*)(CT + 128 + 8 * c8), c2b = *(const LAS f32x4*)(CT + 128 + 8 * c8 + 4), c3a = *(const LAS f32x4*)(CT + 192 + 8 * c8), c3b = *(const LAS f32x4*)(CT + 192 + 8 * c8 + 4);
#pragma unroll
                for (int e = 0; e < 8; ++e) { const float kaw = e < 4 ? c1a[e] : c1b[e - 4], a0e = e < 4 ? c2a[e] : c2b[e - 4], w0e = e < 4 ? c3a[e] : c3b[e - 4];
                    const float av = sigmoidf_(a0e + af[e]); kkv[e] *= rn; bv[e] = av * kkv[e]; ktv[e] = kf[e] * (1.0f + (av - 1.0f) * kaw);
                    lw[e] = -0.6065306597126334f * sigmoidf_(w0e + wf[e]); }
            }
            float G[8];
#pragma unroll
            for (int e = 0; e < 8; ++e) { float x = lw[e]; float y = __shfl_up(x, 8); if (lane >= 8) x += y; y = __shfl_up(x, 16); if (lane >= 16) x += y; y = __shfl_up(x, 32); if (lane >= 32) x += y; G[e] = x; }
            if (lane >= 56) { *(LAS f32x4*)(TOT + w * 64 + 8 * c8) = (f32x4){G[0], G[1], G[2], G[3]}; *(LAS f32x4*)(TOT + w * 64 + 8 * c8 + 4) = (f32x4){G[4], G[5], G[6], G[7]}; }
            __syncthreads();
            {
                float tot[8];
#pragma unroll
                for (int e = 0; e < 8; ++e) tot[e] = 0.f;
#pragma unroll
                for (int ww = 0; ww < 8; ++ww) { const f32x4 t0 = *(const LAS f32x4*)(TOT + ww * 64 + 8 * c8), t1 = *(const LAS f32x4*)(TOT + ww * 64 + 8 * c8 + 4);
#pragma unroll
                    for (int e = 0; e < 8; ++e) { const float tv = e < 4 ? t0[e] : t1[e - 4]; tot[e] += tv; if (ww < w) G[e] += tv; } }
                if (si == 0) { *(LAS f32x4*)(DEC + 8 * c8) = (f32x4){__expf(tot[0]), __expf(tot[1]), __expf(tot[2]), __expf(tot[3])}; *(LAS f32x4*)(DEC + 8 * c8 + 4) = (f32x4){__expf(tot[4]), __expf(tot[5]), __expf(tot[6]), __expf(tot[7])}; }
                const unsigned rw4[4] = {rx.x, rx.y, rx.z, rx.w}; const int to = si * CK_TS + 16 * c8;
                *(LAS u32x4*)(L + CK_VV + to) = vx;
#pragma unroll
                for (int e2 = 0; e2 < 4; ++e2) { float o7[6][2];
#pragma unroll
                    for (int hh = 0; hh < 2; ++hh) { const int e = 2 * e2 + hh; const float Ge = G[e]; const float rve = hh ? bfhi(rw4[e2]) : bflo(rw4[e2]);
                        const float eg = __expf(Ge), egm = __expf(Ge - lw[e]), eng = __expf(fminf(-Ge, 80.0f)), etg = __expf(tot[e] - Ge);
                        o7[0][hh] = -kkv[e] * egm; o7[1][hh] = bv[e] * eng; o7[2][hh] = ktv[e] * eng; o7[3][hh] = rve * eg; o7[4][hh] = bv[e] * etg; o7[5][hh] = ktv[e] * etg; }
                    *(LAS unsigned*)(L + CK_AH + to + 4 * e2) = pk2(o7[0][0], o7[0][1]); *(LAS unsigned*)(L + CK_BH + to + 4 * e2) = pk2(o7[1][0], o7[1][1]); *(LAS unsigned*)(L + CK_KH + to + 4 * e2) = pk2(o7[2][0], o7[2][1]);
                    *(LAS unsigned*)(L + CK_RH + to + 4 * e2) = pk2(o7[3][0], o7[3][1]); *(LAS unsigned*)(L + CK_BB + to + 4 * e2) = pk2(o7[4][0], o7[4][1]); *(LAS unsigned*)(L + CK_KB + to + 4 * e2) = pk2(o7[5][0], o7[5][1]); }
                if (blk + 1 < nblk) CK_PREFETCH(blk + 1);
            }
            __syncthreads();
            { const int it = w >> 1;
              bf16x8 fa[2], fr[2];
#pragma unroll
              for (int ks = 0; ks < 2; ++ks) { fa[ks] = lds_row_frag(L + CK_AH, CK_TS, 16 * it + c16, 32 * ks + 8 * q); fr[ks] = lds_row_frag(L + CK_RH, CK_TS, 16 * it + c16, 32 * ks + 8 * q); }
#pragma unroll 1
              for (int s2 = 0; s2 < 2; ++s2) { const int jt = 2 * (w & 1) + s2; f32x4 n0v = {0.f, 0.f, 0.f, 0.f}, n1v = n0v, n2v = n0v, n3v = n0v;
#pragma unroll
                  for (int ks = 0; ks < 2; ++ks) { const bf16x8 fb = lds_row_frag(L + CK_BH, CK_TS, 16 * jt + c16, 32 * ks + 8 * q), fk = lds_row_frag(L + CK_KH, CK_TS, 16 * jt + c16, 32 * ks + 8 * q);
                      n0v = __builtin_amdgcn_mfma_f32_16x16x32_bf16(fa[ks], fb, n0v, 0, 0, 0); n1v = __builtin_amdgcn_mfma_f32_16x16x32_bf16(fa[ks], fk, n1v, 0, 0, 0);
                      n2v = __builtin_amdgcn_mfma_f32_16x16x32_bf16(fr[ks], fb, n2v, 0, 0, 0); n3v = __builtin_amdgcn_mfma_f32_16x16x32_bf16(fr[ks], fk, n3v, 0, 0, 0); }
#pragma unroll
                  for (int r = 0; r < 4; ++r) { const int i = 16 * it + 4 * q + r, j = 16 * jt + c16, o = i * CK_TS + j * 2;
                      n0v[r] = j < i ? n0v[r] : 0.f;
                      *(LAS unsigned short*)(L + CK_NM + o) = (unsigned short)f2bf(n0v[r]); *(LAS unsigned short*)(L + CK_MAK + o) = (unsigned short)f2bf(j < i ? n1v[r] : 0.f);
                      *(LAS unsigned short*)(L + CK_MRB + o) = (unsigned short)f2bf(j <= i ? n2v[r] : 0.f); *(LAS unsigned short*)(L + CK_MRK + o) = (unsigned short)f2bf(j <= i ? n3v[r] : 0.f); }
                  if (jt == it) {
                      LAS unsigned char* tp = L + CK_TMP + w * 1024; LAS unsigned char* tt = tp + 512;
                      f32x4 P = n0v, T = n0v;
#pragma unroll
                      for (int r = 0; r < 4; ++r) T[r] += (4 * q + r == c16) ? 1.0f : 0.f;
#pragma unroll
                      for (int pw = 0; pw < 3; ++pw) {
#pragma unroll
                          for (int r = 0; r < 4; ++r) { *(LAS unsigned short*)(tp + (4 * q + r) * 32 + c16 * 2) = (unsigned short)f2bf(P[r]); *(LAS unsigned short*)(tt + (4 * q + r) * 32 + c16 * 2) = (unsigned short)f2bf(T[r]); }
                          bf16x4 pb; pb[0] = (short)f2bf(P[0]); pb[1] = (short)f2bf(P[1]); pb[2] = (short)f2bf(P[2]); pb[3] = (short)f2bf(P[3]);
                          const bf16x4 pa = *(const LAS bf16x4*)(tp + c16 * 32 + 8 * q), ta = *(const LAS bf16x4*)(tt + c16 * 32 + 8 * q);
                          f32x4 zero = {0.f, 0.f, 0.f, 0.f};
                          P = __builtin_amdgcn_mfma_f32_16x16x16bf16_1k(pa, pb, zero, 0, 0, 0);
                          bf16x4 pn; pn[0] = (short)f2bf(P[0]); pn[1] = (short)f2bf(P[1]); pn[2] = (short)f2bf(P[2]); pn[3] = (short)f2bf(P[3]);
                          T = __builtin_amdgcn_mfma_f32_16x16x16bf16_1k(ta, pn, T, 0, 0, 0);
                      }
#pragma unroll
                      for (int r = 0; r < 4; ++r) *(LAS unsigned short*)(L + CK_TD + it * 512 + (4 * q + r) * 32 + c16 * 2) = (unsigned short)f2bf(T[r]);
                  } } }
            __syncthreads();
            const bool active = zset || use_p;
            if (active) {
                f32x4 yv[4];
#pragma unroll
                for (int it = 0; it < 4; ++it) yv[it] = (f32x4){0.f, 0.f, 0.f, 0.f};
                bf16x8 sb[2];
#pragma unroll
                for (int ks = 0; ks < 2; ++ks) { sb[ks] = lds_row_frag(L + CK_SS, CK_TS, 16 * w + c16, 32 * ks + 8 * q);
#pragma unroll
                    for (int it = 0; it < 4; ++it) yv[it] = __builtin_amdgcn_mfma_f32_16x16x32_bf16(lds_row_frag(L + CK_AH, CK_TS, 16 * it + c16, 32 * ks + 8 * q), sb[ks], yv[it], 0, 0, 0); }
                bf16x8 vb[2];
                if (zset) {
#pragma unroll
                    for (int ks = 0; ks < 2; ++ks) { vb[ks] = lds_tr_frag(L + CK_VV, CK_TS, 32 * ks, 16 * (w - 4), lane);
#pragma unroll
                        for (int it = 0; it < 4; ++it) yv[it] = __builtin_amdgcn_mfma_f32_16x16x32_bf16(lds_row_frag(L + CK_MAK, CK_TS, 16 * it + c16, 32 * ks + 8 * q), vb[ks], yv[it], 0, 0, 0); } }
                asm volatile("" ::: "memory");
                bf16x4 ub[4];
#pragma unroll
                for (int b = 0; b < 4; ++b) { f32x4 acc = yv[b];
#pragma unroll
                    for (int c = 0; c < 4; ++c) if (c < b) acc = __builtin_amdgcn_mfma_f32_16x16x16bf16_1k(*(const LAS bf16x4*)(L + CK_NM + (16 * b + c16) * CK_TS + (16 * c + 4 * q) * 2), ub[c], acc, 0, 0, 0);
                    bf16x4 ab; ab[0] = (short)f2bf(acc[0]); ab[1] = (short)f2bf(acc[1]); ab[2] = (short)f2bf(acc[2]); ab[3] = (short)f2bf(acc[3]);
                    const f32x4 zero = {0.f, 0.f, 0.f, 0.f};
                    const f32x4 ubf = __builtin_amdgcn_mfma_f32_16x16x16bf16_1k(*(const LAS bf16x4*)(L + CK_TD + b * 512 + c16 * 32 + 8 * q), ab, zero, 0, 0, 0);
                    ub[b][0] = (short)f2bf(ubf[0]); ub[b][1] = (short)f2bf(ubf[1]); ub[b][2] = (short)f2bf(ubf[2]); ub[b][3] = (short)f2bf(ubf[3]); }
                asm volatile("" ::: "memory");
                { int q3 = lane >> 4, c3 = lane & 15; asm volatile("" : "+v"(q3), "+v"(c3));
                  unsigned char* dstb = a.ws + (zset ? RW_O : RW_Y); const unsigned dco = ((unsigned)z * (unsigned)(NTOK * 1024) + (unsigned)(h * 64 + 16 * (w & 3) + c3)) * 2u;
#pragma unroll
                  for (int it = 0; it < 4; ++it) { f32x4 ov = {0.f, 0.f, 0.f, 0.f};
#pragma unroll
                      for (int ks = 0; ks < 2; ++ks) ov = __builtin_amdgcn_mfma_f32_16x16x32_bf16(lds_row_frag(L + CK_RH, CK_TS, 16 * it + c16, 32 * ks + 8 * q), sb[ks], ov, 0, 0, 0);
#pragma unroll
                      for (int c = 0; c < 4; ++c) if (c <= it) ov = __builtin_amdgcn_mfma_f32_16x16x16bf16_1k(*(const LAS bf16x4*)(L + CK_MRB + (16 * it + c16) * CK_TS + (16 * c + 4 * q) * 2), ub[c], ov, 0, 0, 0);
                      if (zset) {
#pragma unroll
                          for (int ks = 0; ks < 2; ++ks) ov = __builtin_amdgcn_mfma_f32_16x16x32_bf16(lds_row_frag(L + CK_MRK, CK_TS, 16 * it + c16, 32 * ks + 8 * q), vb[ks], ov, 0, 0, 0); }
#pragma unroll
                      for (int r = 0; r < 4; ++r) *(unsigned short*)(dstb + dco + (unsigned)rwkv_row(z, n0 + blk * 64 + 16 * it + 4 * q3 + r) * 2048u) = (unsigned short)f2bf(ov[r]);
                      asm volatile("" ::: "memory"); } }
                asm volatile("" ::: "memory");
#pragma unroll
                for (int kt = 0; kt < 4; ++kt) { const float dc = DEC[16 * kt + c16];
#pragma unroll
                    for (int r = 0; r < 4; ++r) accS[kt][r] *= dc;
#pragma unroll
                    for (int c = 0; c < 4; ++c) { const int g = lane >> 4, qq = (lane & 15) >> 2, pp = lane & 3;
                        const v4s16 bt = __builtin_amdgcn_ds_read_tr16_b64_v4i16((LAS v4s16*)(L + CK_BB + (16 * c + 4 * g + qq) * CK_TS + (16 * kt + 4 * pp) * 2));
                        accS[kt] = __builtin_amdgcn_mfma_f32_16x16x16bf16_1k(ub[c], (bf16x4){bt[0], bt[1], bt[2], bt[3]}, accS[kt], 0, 0, 0); } }
                if (zset) {
#pragma unroll
                    for (int ks = 0; ks < 2; ++ks) { const bf16x8 va = vb[ks];
#pragma unroll
                        for (int kt = 0; kt < 4; ++kt) accS[kt] = __builtin_amdgcn_mfma_f32_16x16x32_bf16(va, lds_tr_frag(L + CK_KB, CK_TS, 32 * ks, 16 * kt, lane), accS[kt], 0, 0, 0); } }
            }
            __syncthreads();
            if (active) {
#pragma unroll
                for (int kt = 0; kt < 4; ++kt)
#pragma unroll
                    for (int r = 0; r < 4; ++r) *(LAS unsigned short*)(L + CK_SS + (16 * w + 4 * q + r) * CK_TS + (16 * kt + c16) * 2) = (unsigned short)f2bf(accS[kt][r]);
            }
        }
        { float* dst = sidx == 0 ? (zset ? SST + ((size_t)zh * 65 + 2) * 4096 : nullptr) : PQ + ((size_t)zh * 64 + sidx) * 8192 + (zset ? 4096 : 0);
          if (dst) { int q2 = lane >> 4, c2 = lane & 15; asm volatile("" : "+v"(q2), "+v"(c2));
#pragma unroll
              for (int kt = 0; kt < 4; ++kt)
#pragma unroll
                  for (int r = 0; r < 4; ++r) dst[(16 * (w & 3) + 4 * q2 + r) * 64 + 16 * kt + c2] = accS[kt][r]; } }
        __syncthreads();
    }
}
__device__ __forceinline__ void rwkv_corr_phase(Frame& F, const Args& a) {
    const float* SST = (const float*)(a.ws + RW_SST); bf16_t* O = (bf16_t*)(a.ws + RW_O); const bf16_t* Y = (const bf16_t*)(a.ws + RW_Y);
    const int lane = F.lane, c16 = lane & 15, q = lane >> 4;
#pragma unroll 1
    for (int task = F.gw; task < 2016; task += F.ngw) {
        const int zh = task & 31, z = zh >> 4, h = zh & 15, s = (task >> 5) + 2;
        const float* Ss = SST + ((size_t)zh * 65 + s) * 4096;
        bf16x8 Sf[4][2];
#pragma unroll
        for (int vt = 0; vt < 4; ++vt)
#pragma unroll
            for (int ks = 0; ks < 2; ++ks) { const f32x4 x0 = *(const f32x4*)(Ss + (16 * vt + c16) * 64 + 32 * ks + 8 * q), x1 = *(const f32x4*)(Ss + (16 * vt + c16) * 64 + 32 * ks + 8 * q + 4);
                bf16x8 f; f[0] = (short)f2bf(x0[0]); f[1] = (short)f2bf(x0[1]); f[2] = (short)f2bf(x0[2]); f[3] = (short)f2bf(x0[3]); f[4] = (short)f2bf(x1[0]); f[5] = (short)f2bf(x1[1]); f[6] = (short)f2bf(x1[2]); f[7] = (short)f2bf(x1[3]); Sf[vt][ks] = f; }
        const bf16_t* Yz = Y + (size_t)z * NTOK * 1024 + h * 64; bf16_t* Oz = O + (size_t)z * NTOK * 1024 + h * 64;
#pragma unroll 2
        for (int T = 0; T < 16; ++T) {
            const size_t row = (size_t)rwkv_row(z, s * 256 + 16 * T + c16) * 1024;
            const bf16x8 y0 = *(const bf16x8*)(Yz + row + 8 * q), y1 = *(const bf16x8*)(Yz + row + 32 + 8 * q);
#pragma unroll
            for (int vt = 0; vt < 4; ++vt) { f32x4 d = {0.f, 0.f, 0.f, 0.f};
                d = __builtin_amdgcn_mfma_f32_16x16x32_bf16(Sf[vt][0], y0, d, 0, 0, 0); d = __builtin_amdgcn_mfma_f32_16x16x32_bf16(Sf[vt][1], y1, d, 0, 0, 0);
                u32x2* op = (u32x2*)(Oz + row + 16 * vt + 4 * q); const u32x2 old = *op;
                u32x2 nw; nw.x = pk2(bflo(old.x) + d[0], bfhi(old.x) + d[1]); nw.y = pk2(bflo(old.y) + d[2], bfhi(old.y) + d[3]); *op = nw; }
        }
    }
}
__device__ __forceinline__ void rwkv_prefix_phase(Frame& F, const Args& a) {
    const float* PQ = (const float*)(a.ws + RW_PQ); float* SST = (float*)(a.ws + RW_SST);
    if (blockIdx.x >= 128) return;
    const int zh = blockIdx.x >> 2, r0 = (blockIdx.x & 3) * 16, tid = F.tid, vl = tid >> 5, v = r0 + vl, c0 = (tid & 31) * 2;
    LAS float* Sl = (LAS float*)(F.lds + LDS_STAGE); LAS float* Pl = Sl + 16 * 68;
    { const float* s1 = SST + ((size_t)zh * 65 + 2) * 4096 + r0 * 64;
      for (int i = tid; i < 1024; i += NTHREADS) Sl[(i >> 6) * 68 + (i & 63)] = s1[i]; }
    f32x4 pn0, pn1; f32x2 qn;
    { const float* Pg = PQ + ((size_t)zh * 64 + 1) * 8192; pn0 = *(const f32x4*)(Pg + 4 * tid); pn1 = *(const f32x4*)(Pg + 4 * (tid + 512)); qn = *(const f32x2*)(Pg + 4096 + v * 64 + c0); }
#pragma unroll 1
    for (int s = 2; s < 64; ++s) {
        __syncthreads();
        *(LAS f32x4*)(Pl + 4 * tid) = pn0; *(LAS f32x4*)(Pl + 4 * (tid + 512)) = pn1;
        float a0 = qn[0], a1 = qn[1];
        if (s < 63) { const float* Pg = PQ + ((size_t)zh * 64 + s) * 8192; pn0 = *(const f32x4*)(Pg + 4 * tid); pn1 = *(const f32x4*)(Pg + 4 * (tid + 512)); qn = *(const f32x2*)(Pg + 4096 + v * 64 + c0); }
        __syncthreads();
#pragma unroll 16
        for (int k = 0; k < 64; ++k) { const float sv = Sl[vl * 68 + k]; const f32x2 pp = *(const LAS f32x2*)(Pl + k * 64 + c0); a0 += sv * pp[0]; a1 += sv * pp[1]; }
        __syncthreads();
        *(f32x2*)(SST + ((size_t)zh * 65 + s + 1) * 4096 + v * 64 + c0) = (f32x2){a0, a1};
        Sl[vl * 68 + c0] = a0; Sl[vl * 68 + c0 + 1] = a1;
    }
}
__device__ __forceinline__ void rwkv_readout_phase(Frame& F, const Args& a) {
    const bf16_t* O0 = (const bf16_t*)(a.ws + RW_O); const bf16_t* O1 = O0 + (size_t)NTOK * 1024; const bf16_t* R = (const bf16_t*)(a.ws + RW_R); const bf16_t* K = (const bf16_t*)(a.ws + RW_K);
    const bf16_t* V = (const bf16_t*)(a.ws + RW_V); const bf16_t* A0 = (const bf16_t*)(a.ws + RW_AA); const bf16_t* A1 = A0 + (size_t)NTOK * 1024; const bf16_t* G = (const bf16_t*)(a.ws + RW_G);
    bf16_t* A5 = (bf16_t*)(a.ws + RW_A5); const int lane = F.lane;
    float ka[16], rk[16], lg[16], lb[16], ab0[16], ab1[16]; ldrow_f32(a.in[20], lane, ab0); ldrow_f32(a.in[20] + 1024, lane, ab1); ldrow_f32(a.in[26], lane, ka); ldrow_f32(a.in[27], lane, rk); ldrow_f32(a.in[28], lane, lg); ldrow_f32(a.in[29], lane, lb);
    for (int t = F.gw; t < NTOK; t += F.ngw) {
        float o[16], r[16], k[16], v[16], a0[16], a1[16], g[16];
        ldrow_bf16(O0 + (size_t)t * 1024, lane, o); addrow_bf16(O1 + (size_t)t * 1024, lane, o); ldrow_bf16(R + (size_t)t * 1024, lane, r); ldrow_bf16(K + (size_t)t * 1024, lane, k);
        ldrow_bf16(V + (size_t)t * 1024, lane, v); ldrow_bf16(A0 + (size_t)t * 1024, lane, a0); ldrow_bf16(A1 + (size_t)t * 1024, lane, a1); ldrow_bf16(G + (size_t)t * 1024, lane, g);
#pragma unroll
        for (int j = 0; j < 2; ++j) { float s = 0.f, bn = 0.f;
#pragma unroll
            for (int e = 0; e < 8; ++e) { const int x = 8 * j + e; s += o[x]; bn += r[x] * k[x] * rk[x] * (2.0f + (sigmoidf_(a0[x] + ab0[x]) + sigmoidf_(a1[x] + ab1[x]) - 2.0f) * ka[x]); }
#pragma unroll
            for (int m = 1; m < 8; m <<= 1) { s += __shfl_xor(s, m); bn += __shfl_xor(bn, m); }
            const float mean = s * (1.0f / 64.0f); float q = 0.f;
#pragma unroll
            for (int e = 0; e < 8; ++e) { o[8 * j + e] -= mean; q += o[8 * j + e] * o[8 * j + e]; }
#pragma unroll
            for (int m = 1; m < 8; m <<= 1) q += __shfl_xor(q, m);
            const float rs = 1.0f / sqrtf(q * (1.0f / 64.0f) + 64e-5f);
#pragma unroll
            for (int e = 0; e < 8; ++e) { const int x = 8 * j + e; o[x] = (o[x] * rs * lg[x] + lb[x] + bn * v[x]) * g[x]; } }
        strow_bf16(A5 + (size_t)t * 1024, lane, o);
    }
}

__device__ __forceinline__ void zero_y_phase(Frame& F, const Args& a) {
    u32x4* y = (u32x4*)(a.ws + WS_MX5); const u32x4 z = {0u, 0u, 0u, 0u};
    for (size_t i = (size_t)blockIdx.x * NTHREADS + F.tid; i < (size_t)NTOK * D / 8; i += (size_t)gridDim.x * NTHREADS) y[i] = z;
}

__device__ __forceinline__ Frame mk_frame(const Args& a, unsigned char* lds_raw) {
    Frame F; int tid = threadIdx.x; asm volatile("" : "+v"(tid));
    F.lds = (LAS unsigned char*)lds_raw; F.misc = (volatile LAS unsigned*)(F.lds + LDS_MISC);
    F.tid = tid; F.lane = tid & 63; F.wave = __builtin_amdgcn_readfirstlane(tid >> 6);
    F.ws = a.ws; F.ctl = (unsigned*)(a.ws + WS_CTL);
    F.gw = blockIdx.x * NWAVES + F.wave; F.ngw = gridDim.x * NWAVES;
    return F;
}
__global__ void __launch_bounds__(NTHREADS, 2) fwd_kernel(Args a) {
    extern __shared__ __attribute__((aligned(16))) unsigned char lds_raw[];
    if (threadIdx.x < 64) ((volatile LAS unsigned*)((LAS unsigned char*)lds_raw + LDS_MISC))[threadIdx.x] = 0u;
    __syncthreads();
    (void)xcd_barrier_post((unsigned*)(a.ws + WS_CTL) + CW_BAR, (volatile LAS unsigned*)((LAS unsigned char*)lds_raw + LDS_MISC) + 8);
    int phase = 0;
#define PHASE(body) do { if (phase >= a.ph_lo && phase < a.ph_hi) { { Frame F = mk_frame(a, lds_raw); body; } \
        if (phase + 1 < a.ph_hi) { XcdBarrier bar; bar.bar = (unsigned*)(a.ws + WS_CTL) + CW_BAR; bar.x = xb_xcc_id(); bar.st = (volatile LAS unsigned*)((LAS unsigned char*)lds_raw + LDS_MISC) + 8; xcd_barrier(bar); } } ++phase; } while (0)

#define PHASED(bit, body) do { PHASE(body); if (DUP & (bit)) PHASE(body); } while (0)
    PHASED(1, p0_phase(F, a));
    PHASE(p1a_phase(F, a));
    PHASE(p1b_phase(F, a));

#define MOE_LAYER(L) do { \
    if (EN_MOE) { PHASE(moe_route_phase<L>(F, a)); if (DUP & (1 << 20)) PHASE((moe_route_phase<L, true>(F, a))); PHASE(moe_dispatch_phase<L>(F, a)); if (DUP & (1 << 26)) PHASE((moe_dispatch_phase<L, true>(F, a))); PHASED(2, moe_gateup_phase<L>(F, a)); PHASED(4, moe_down_phase<L>(F, a)); } \
    PHASE((ln_phase<L, 1>(F, a))); if (DUP & (1 << 21)) PHASE((ln_phase<L, 1, true>(F, a))); } while (0)

    if (EN_LRU) {
        PHASED(65536, { lru_in_gemm_phase(F, a); bg_slot<0>(F, a); });
        PHASED(131072, lru_scan_phase<true>(F, a));
        PHASED(1 << 24, lru_carry_phase(F, a));
        PHASED(131072, lru_scan_phase<false>(F, a));
        PHASED(1 << 25, { dense_gemm_bf16(F, (const bf16_t*)(a.ws + WS_MX2), (const bf16_t*)(a.ws + WS_W_LRU_OUT), (bf16_t*)(a.ws + WS_MX5), NTOK, 1024, 1024); bg_slot<1>(F, a); });
    } else PHASE(zero_y_phase(F, a));
    PHASE({ bg_catch<2>(F, a); (ln_phase<0, 0>(F, a)); }); if (DUP & (1 << 22)) PHASE((ln_phase<0, 0, true>(F, a)));
    MOE_LAYER(0);
    if (EN_RWKV) {
        PHASED(64, rwkv_xm_phase(F, a));
        PHASED(128, rwkv_in_gemm_phase(F, a));
        PHASED(256, rwkv_l2_gemm_phase(F, a));
#if !RWKV_CHUNKED
        PHASED(8, rwkv_rec_phase(F, a));
#endif
#if RWKV_CHUNKED
        PHASED(16, { rwkv_chunk_phase(F, a); bg_slot<3>(F, a); });
#else
        PHASED(16, rwkv_scan_phase<0>(F, a));
#endif
        PHASED(1 << 24, rwkv_prefix_phase(F, a));
        PHASE(rwkv_corr_phase(F, a));
        PHASED(1 << 23, rwkv_readout_phase(F, a));
        PHASED(1 << 25, { dense_gemm_bf16(F, (const bf16_t*)(a.ws + RW_A5), (const bf16_t*)(a.ws + WS_W_RWKV_OUT), (bf16_t*)(a.ws + WS_MX5), NTOK, 1024, 1024); bg_slot<4>(F, a); });
    } else PHASE(zero_y_phase(F, a));
    PHASE({ bg_catch<5>(F, a); (ln_phase<1, 0>(F, a)); }); if (DUP & (1 << 22)) PHASE((ln_phase<1, 0, true>(F, a)));
    MOE_LAYER(1);
    if (EN_RET) {
        PHASED(4096, { ret_in_gemm_phase(F, a); bg_slot<6>(F, a); });
        PHASED(8192, { ret_p_phase(F, a); ret_transpose_phase(F, a); });
        PHASED(16384, ret_kv_phase(F, a));
        PHASE(ret_prefix_phase<false>(F, a)); if (DUP & (1 << 27)) PHASE(ret_prefix_phase<true>(F, a));
        PHASED(32768, ret_o_phase(F, a));
        PHASED(1 << 23, ret_readout_phase(F, a));
        PHASED(1 << 25, { dense_gemm_bf16(F, (const bf16_t*)(a.ws + RT_A3), (const bf16_t*)(a.ws + WS_W_RET_OUT), (bf16_t*)(a.ws + WS_MX5), NTOK, 1024, 2048); bg_slot<7>(F, a); });
    } else PHASE(zero_y_phase(F, a));
    PHASE({ bg_catch<8>(F, a); (ln_phase<2, 0>(F, a)); }); if (DUP & (1 << 22)) PHASE((ln_phase<2, 0, true>(F, a)));
    MOE_LAYER(2);
    if (EN_HGRN) {
        PHASED(2048, { hgrn_in_gemm_phase(F, a); bg_slot<9>(F, a); });
        PHASED(512, { hgrn_chunk_phase<0>(F, a); bg_slot<10>(F, a); });
        PHASE(hgrn_prefix_phase<false>(F, a)); if (DUP & (1 << 27)) PHASE(hgrn_prefix_phase<true>(F, a));
        PHASED(1024, { hgrn_chunk_phase<1>(F, a); bg_slot<11>(F, a); });
        PHASED(1 << 23, hgrn_readout_phase(F, a));
        PHASED(1 << 25, dense_gemm_bf16(F, (const bf16_t*)(a.ws + HG_A4) + (size_t)NCTX * 1024, (const bf16_t*)(a.ws + WS_W_HGRN_OUT), (bf16_t*)(a.ws + WS_MX5) + (size_t)NCTX * 1024, SEQ, 1024, 1024));
    } else PHASE(zero_y_phase(F, a));
    PHASE({ bg_catch<12>(F, a); (ln_phase<3, 0>(F, a)); }); if (DUP & (1 << 22)) PHASE((ln_phase<3, 0, true>(F, a)));
    MOE_LAYER(3);
}

extern "C" void kernel_launch(void* const* d_in, const int* in_sizes, int n_in, void* d_out, int out_size, void* d_ws, size_t ws_size, hipStream_t stream) {
    static int grid = 0;
    if (grid == 0) {
        if (n_in != 47 || out_size != SEQ * D || ws_size < WS_END) { fprintf(stderr, "kernel_launch: unexpected shapes (n_in %d out %d ws %zu need %zu)\n", n_in, out_size, ws_size, (size_t)WS_END); grid = -1; return; }
        int dev = 0, cus = 0, per_cu = 0;
        (void)hipGetDevice(&dev); (void)hipDeviceGetAttribute(&cus, hipDeviceAttributeMultiprocessorCount, dev);
        if (hipFuncSetAttribute((const void*)fwd_kernel, hipFuncAttributeMaxDynamicSharedMemorySize, LDS_BYTES) != hipSuccess) { fprintf(stderr, "kernel_launch: hipFuncSetAttribute failed\n"); grid = -1; return; }
        (void)hipOccupancyMaxActiveBlocksPerMultiprocessor(&per_cu, (const void*)fwd_kernel, NTHREADS, LDS_BYTES);
        (void)hipGetLastError();
        if (per_cu < 1) fprintf(stderr, "kernel_launch: occupancy query says %d blocks per CU\n", per_cu);
        grid = cus;
    }
    if (grid < 0) return;
    (void)hipMemsetAsync((char*)d_ws + WS_CTL, 0, CTL_BYTES, stream);
    Args a; memset(&a, 0, sizeof(a));
    for (int i = 0; i < 47; ++i) a.in[i] = (const float*)d_in[i];
    a.out = (float*)d_out; a.ws = (unsigned char*)d_ws; a.ph_lo = 0; a.ph_hi = 1000;
    hipLaunchKernelGGL(fwd_kernel, dim3(grid), dim3(NTHREADS), LDS_BYTES, stream, a);
}
```

```cpp
#include <hip/hip_runtime.h>
#include <stdint.h>
#include <stdio.h>
#include <string.h>

#define LAS __attribute__((address_space(3)))
#define GAS __attribute__((address_space(1)))
typedef unsigned short bf16_t;
typedef short bf16x8 __attribute__((ext_vector_type(8)));
typedef short bf16x4 __attribute__((ext_vector_type(4)));
typedef float f32x4 __attribute__((ext_vector_type(4)));
typedef float f32x2 __attribute__((ext_vector_type(2)));
typedef unsigned u32x4 __attribute__((ext_vector_type(4)));
typedef unsigned u32x2 __attribute__((ext_vector_type(2)));

constexpr int D = 1024, SEQ = 16384, NCTX = 256, NTOK = SEQ + NCTX;
constexpr int NE = 64, TOPK = 8, EDIM = 256;
constexpr float ALPHA = 1.681792830507429f;
constexpr float LN_EPS = 1e-5f;
constexpr int NTHREADS = 512, NWAVES = 8;

#ifndef TPROBE
#define TPROBE 0
#endif
#define BQ(q) ((TPROBE & 0xFF) ? 0 : (q))
#ifndef DUP
#define DUP 0
#define DOWN_PROBE_MODE 3
#endif
#ifndef RWKV_CHUNKED
#define RWKV_CHUNKED 1
#endif
#ifndef EN_LRU
#define EN_LRU 1
#endif
#ifndef EN_RWKV
#define EN_RWKV 1
#endif
#ifndef EN_RET
#define EN_RET 1
#endif
#ifndef EN_HGRN
#define EN_HGRN 1
#endif
#ifndef EN_MOE
#define EN_MOE 1
#endif

__device__ __forceinline__ unsigned f2bf(float f) { unsigned u = __builtin_bit_cast(unsigned, f); return (u + 0x7fffu + ((u >> 16) & 1u)) >> 16; }
__device__ __forceinline__ float bf2f(unsigned b) { return __builtin_bit_cast(float, b << 16); }
__device__ __forceinline__ unsigned pk2(float lo, float hi) { unsigned r; asm volatile("v_cvt_pk_bf16_f32 %0, %1, %2" : "=v"(r) : "v"(lo), "v"(hi)); return r; }
__device__ __forceinline__ float bflo(unsigned w) { return __builtin_bit_cast(float, w << 16); }
__device__ __forceinline__ float bfhi(unsigned w) { return __builtin_bit_cast(float, w & 0xffff0000u); }
__device__ __forceinline__ float sigmoidf_(float x) { return __builtin_amdgcn_rcpf(1.0f + __expf(-x)); }
__device__ __forceinline__ float siluf_(float x) { return x * __builtin_amdgcn_rcpf(1.0f + __expf(-x)); }
__device__ __forceinline__ float wave_sum(float v) {
#pragma unroll
    for (int o = 1; o < 64; o <<= 1) v += __shfl_xor(v, o);
    return v;
}

#define XB_TMO      128
#define XB_XCNT(j)  (256  + 64 * (j))
#define XB_XSUB(j)  (1280 + 64 * (j))
#define XB_XGEN(j)  (2304 + 64 * (j))
#define XB_TOP      3328
#define XB_TOPGEN   3392
#define XCD_BAR_WORDS 3456
#define XB_SPIN_CAP (1u << 22)
__device__ __forceinline__ unsigned xb_ld(unsigned* p)              { return __hip_atomic_load(p, __ATOMIC_RELAXED, __HIP_MEMORY_SCOPE_AGENT); }
__device__ __forceinline__ unsigned xb_add(unsigned* p, unsigned v) { return __hip_atomic_fetch_add(p, v, __ATOMIC_RELAXED, __HIP_MEMORY_SCOPE_AGENT); }
__device__ __forceinline__ unsigned xb_xcc_id() { return (unsigned)__builtin_amdgcn_s_getreg((3 << 11) | 20) & 0xFu; }
#define XB_SPIN(cond, bar) do { unsigned _sp = 0; while (cond) { __builtin_amdgcn_s_sleep(1); \
    if ((++_sp & 255u) == 0u) { if (xb_ld(&(bar)[XB_TMO])) break; if (_sp > XB_SPIN_CAP) { atomicAdd(&(bar)[XB_TMO], 1u); break; } } } } while (0)
struct XcdBarrier { unsigned* bar; unsigned x; volatile LAS unsigned* st; };
__device__ __forceinline__ XcdBarrier xcd_barrier_post(unsigned* bar, volatile LAS unsigned* st) {
    XcdBarrier b; b.bar = bar; b.x = xb_xcc_id(); b.st = st;
    if (threadIdx.x == 0) (void)xb_add(&bar[XB_XCNT(b.x)], 1u);
    return b;
}
__device__ __forceinline__ void xcd_barrier_complete(unsigned* bar, unsigned x, unsigned& nloc, unsigned& nx) {
    const unsigned G = gridDim.x * gridDim.y * gridDim.z;
    unsigned sum, cnt, mine, sp = 0u;
    for (;;) {
        sum = 0u; cnt = 0u; mine = 0u;
#pragma unroll
        for (unsigned j = 0; j < 16; ++j) { const unsigned c = xb_ld(&bar[XB_XCNT(j)]); sum += c; cnt += (c > 0u) ? 1u : 0u; mine = (j == x) ? c : mine; }
        if (sum == G) break;
        __builtin_amdgcn_s_sleep(1);
        if ((++sp & 255u) == 0u) { if (xb_ld(&bar[XB_TMO])) break; if (sp > XB_SPIN_CAP) { atomicAdd(&bar[XB_TMO], 1u); break; } }
    }
    nloc = mine > 0u ? mine : 1u; nx = cnt > 0u ? cnt : 1u;
}
__device__ __forceinline__ void xcd_barrier(const XcdBarrier& b) {
    asm volatile("s_waitcnt vmcnt(0)" ::: "memory");
    __syncthreads();
    if (threadIdx.x == 0) {
        unsigned* bar = b.bar;
        __builtin_amdgcn_s_waitcnt(0);
        unsigned nloc = b.st[0], nx = b.st[1];
        if (nloc == 0u) { xcd_barrier_complete(bar, b.x, nloc, nx); b.st[0] = nloc; b.st[1] = nx; }
        const unsigned old = xb_add(&bar[XB_XSUB(b.x)], 1u);
        const unsigned gen = old / nloc;
        if (old + 1u == (gen + 1u) * nloc) {
            __builtin_amdgcn_fence(__ATOMIC_RELEASE, "agent");
            asm volatile("s_waitcnt vmcnt(0)" ::: "memory");
            const unsigned og = xb_add(&bar[XB_TOP], 1u);
            const unsigned tg = og / nx;
            if (og + 1u == (tg + 1u) * nx) xb_add(&bar[XB_TOPGEN], 1u);
            else XB_SPIN(xb_ld(&bar[XB_TOPGEN]) == tg, bar);
            __builtin_amdgcn_fence(__ATOMIC_ACQUIRE, "agent");
            xb_add(&bar[XB_XGEN(b.x)], 1u);
            asm volatile("s_waitcnt vmcnt(0)" ::: "memory");
        } else {
            XB_SPIN(xb_ld(&bar[XB_XGEN(b.x)]) == gen, bar);
            __builtin_amdgcn_fence(__ATOMIC_ACQUIRE, "agent");
            asm volatile("s_waitcnt vmcnt(0)" ::: "memory");
        }
    }
    __syncthreads();
}

namespace gg {
constexpr int BM = 256, BK = 64, HALF = 128, HTB = HALF * BK * 2, STAGE_BYTES = 8 * HTB;
__device__ __forceinline__ int lds_byte(int r, int c) { const int st = (r >> 4) * 2 + (c >> 5), rr = r & 15, cc = c & 31, ob = rr * 64 + cc * 2; return st * 1024 + (ob ^ (((ob >> 9) & 1) << 5)); }
__device__ __forceinline__ void stage_rc(int b, int& R, int& C) { const int st = b / 1024, sb = b % 1024, swz = sb ^ (((sb >> 9) & 1) << 5); R = (st >> 1) * 16 + swz / 64; C = (st & 1) * 32 + (swz % 64) / 2; }
__device__ __forceinline__ int perm32(int rho) { const int n = rho >> 4, i = rho & 15; return 8 * (i >> 2) + 4 * n + (i & 3); }

struct Unit { const char* a; const char* b; const char* b2; int pm, pn, gofs, x; };
struct Dims { int K, lda, ldb, kseg, ldb2; };

typedef f32x4 Acc[2][2][4][2];

template <class Epi, class Sched, bool GATHER, bool SEGB>
__device__ __forceinline__ void gemm_phase(LAS unsigned char* lds, const Dims dm, const Sched& S, const Epi& E) {
    const int tid = threadIdx.x, wid = __builtin_amdgcn_readfirstlane(tid >> 6), lane = tid & 63, wr = wid >> 2, wc = wid & 3, fr = lane & 15, fq = lane >> 4;
    const int K = dm.K, nt = K / BK;
    unsigned voffB[2], voffB2[2], cAo[2][2], nAo[2][2]; int gR[2], gC[2];
    const unsigned hstepA = (unsigned)HALF * dm.lda * 2u, hstepB = (unsigned)HALF * dm.ldb * 2u, hstepB2 = (unsigned)HALF * dm.ldb2 * 2u;
#pragma unroll
    for (int i = 0; i < 2; ++i) { int R, C; stage_rc(tid * 16 + i * 8192, R, C); const int Rb = Epi::PERM ? ((R & ~31) + perm32(R & 31)) : R;
        gR[i] = R; gC[i] = C * 2; voffB[i] = (unsigned)(Rb * dm.ldb + C) * 2u; voffB2[i] = SEGB ? (unsigned)(Rb * dm.ldb2 + C) * 2u : 0u;
        cAo[0][i] = (unsigned)(R * dm.lda + C) * 2u; cAo[1][i] = cAo[0][i] + hstepA; }
    const unsigned ldsw = (unsigned)wid * 1024u;
    const int aoff = lds_byte(wr * 64 + fr, fq * 8), boff = lds_byte(wc * 32 + fr, fq * 8);
#define GG_SA(b, h) (((b) * 2 + (h)) * HTB)
#define GG_SB(b, h) ((4 + (b) * 2 + (h)) * HTB)
#define GG_STAGE(bufoff, gbase, voff) do { _Pragma("unroll") for (int _i = 0; _i < 2; ++_i) \
        __builtin_amdgcn_global_load_lds((const unsigned*)((const char*)(gbase) + (voff)[_i]), (LAS unsigned*)(lds + (bufoff) + ldsw + _i * 8192), 16, 0, 0); } while (0)
#define GG_LDA(dst, b, h) do { _Pragma("unroll") for (int m = 0; m < 4; ++m) _Pragma("unroll") for (int k = 0; k < 2; ++k) dst[m][k] = *(const LAS bf16x8*)(lds + GG_SA(b, h) + aoff + m * 2048 + k * 1024); } while (0)
#define GG_LDB(dst, b, h) do { _Pragma("unroll") for (int n = 0; n < 2; ++n) _Pragma("unroll") for (int k = 0; k < 2; ++k) dst[n][k] = *(const LAS bf16x8*)(lds + GG_SB(b, h) + boff + n * 2048 + k * 1024); } while (0)
#define GG_MMA(ai, bj, At, Bt) do { __builtin_amdgcn_s_setprio(1); _Pragma("unroll") for (int m = 0; m < 4; ++m) _Pragma("unroll") for (int n = 0; n < 2; ++n) _Pragma("unroll") for (int k = 0; k < 2; ++k) \
        acc[ai][bj][m][n] = __builtin_amdgcn_mfma_f32_16x16x32_bf16(Bt[n][k], At[m][k], acc[ai][bj][m][n], 0, 0, 0); __builtin_amdgcn_s_setprio(0); } while (0)
#define GG_WAIT_V(n) asm volatile("s_waitcnt vmcnt(" #n ")" ::: "memory")
#define GG_WAIT_L(n) asm volatile("s_waitcnt lgkmcnt(" #n ")" ::: "memory")
#define GG_BAR __builtin_amdgcn_s_barrier()
#define GG_SCHED __builtin_amdgcn_sched_barrier(0)
#define GG_BSRC(u, kt) ((SEGB && (kt) >= dm.kseg) ? (u).b2 + (size_t)((kt) - dm.kseg) * 128 : (u).b + (size_t)(kt) * 128)
#define GG_STAGE_B(bufoff, u, kt, h) do { const bool _s2 = SEGB && (kt) >= dm.kseg; \
        const char* _bp = _s2 ? (u).b2 + (size_t)((kt) - dm.kseg) * 128 + (h) * hstepB2 : (u).b + (size_t)(kt) * 128 + (h) * hstepB; \
        unsigned _vo[2]; _vo[0] = _s2 ? voffB2[0] : voffB[0]; _vo[1] = _s2 ? voffB2[1] : voffB[1]; GG_STAGE(bufoff, _bp, _vo); } while (0)
#define GG_GOFF(u, dst) do { if (GATHER) { const LAS int* _ix = (const LAS int*)(lds + (u).gofs); _Pragma("unroll") for (int _h = 0; _h < 2; ++_h) _Pragma("unroll") for (int _i = 0; _i < 2; ++_i) \
        dst[_h][_i] = (unsigned)_ix[_h * 128 + gR[_i]] * (unsigned)(dm.lda * 2) + (unsigned)gC[_i]; } } while (0)
    Unit cur, nxt; int ui = 0;
    if (!S.next(0, cur)) return;
    Acc acc;
#pragma unroll
    for (int a = 0; a < 2; ++a)
#pragma unroll
        for (int b = 0; b < 2; ++b)
#pragma unroll
            for (int m = 0; m < 4; ++m)
#pragma unroll
                for (int n = 0; n < 2; ++n) acc[a][b][m][n] = (f32x4){0.f, 0.f, 0.f, 0.f};
    bf16x8 At[4][2], B0[2][2], B1[2][2];
    GG_GOFF(cur, cAo);
    GG_STAGE_B(GG_SB(0, 0), cur, 0, 0); GG_STAGE(GG_SA(0, 0), cur.a, cAo[0]); GG_STAGE_B(GG_SB(0, 1), cur, 0, 1); GG_STAGE(GG_SA(0, 1), cur.a, cAo[1]);
    if (wr == 1) GG_BAR;
    GG_WAIT_V(4); GG_BAR;
    GG_STAGE_B(GG_SB(1, 0), cur, 1, 0); GG_STAGE(GG_SA(1, 0), cur.a + 128, cAo[0]); GG_STAGE_B(GG_SB(1, 1), cur, 1, 1);
    GG_WAIT_V(6); GG_BAR;
    for (;;) {
        const bool has_next = S.next(ui + 1, nxt);
        if (!has_next) nxt = cur;
        if (GATHER) { if (has_next) { GG_GOFF(nxt, nAo); } else {
#pragma unroll
            for (int h = 0; h < 2; ++h)
#pragma unroll
                for (int i = 0; i < 2; ++i) nAo[h][i] = cAo[h][i]; } }
        for (int t = 0; t < nt; t += 2) {
            const bool last = (t == nt - 2);
            const char* a1 = cur.a + (size_t)(t + 1) * 128;
            const char* a2 = last ? nxt.a : cur.a + (size_t)(t + 2) * 128;
            const char* a3 = a2 + 128;
            unsigned o2[2][2];
#pragma unroll
            for (int h = 0; h < 2; ++h)
#pragma unroll
                for (int i = 0; i < 2; ++i) o2[h][i] = (GATHER && last) ? nAo[h][i] : cAo[h][i];
            const int k2 = last ? 0 : t + 2, k3 = k2 + 1;
            struct { const char* b; const char* b2; } bu; bu.b = last ? nxt.b : cur.b; bu.b2 = last ? nxt.b2 : cur.b2;
            GG_LDB(B0, 0, 0); GG_SCHED; GG_LDA(At, 0, 0); GG_STAGE(GG_SA(1, 1), a1, cAo[1]);
            GG_WAIT_L(8); GG_BAR; GG_WAIT_L(0); GG_MMA(0, 0, At, B0); GG_BAR; GG_SCHED;
            GG_LDB(B1, 0, 1); GG_STAGE_B(GG_SB(0, 0), bu, k2, 0);
            GG_BAR; GG_WAIT_L(0); GG_MMA(0, 1, At, B1); GG_BAR;
            GG_LDA(At, 0, 1); GG_STAGE(GG_SA(0, 0), a2, o2[0]);
            GG_BAR; GG_WAIT_L(0); GG_MMA(1, 0, At, B0); GG_BAR; GG_SCHED;
            GG_STAGE_B(GG_SB(0, 1), bu, k2, 1);
            GG_WAIT_V(6); GG_BAR; GG_MMA(1, 1, At, B1); GG_BAR;
            GG_LDB(B0, 1, 0); GG_SCHED; GG_LDA(At, 1, 0); GG_STAGE(GG_SA(0, 1), a2, o2[1]);
            GG_WAIT_L(8); GG_BAR; GG_WAIT_L(0); GG_MMA(0, 0, At, B0); GG_BAR; GG_SCHED;
            GG_LDB(B1, 1, 1); GG_STAGE_B(GG_SB(1, 0), bu, k3, 0);
            GG_BAR; GG_WAIT_L(0); GG_MMA(0, 1, At, B1); GG_BAR;
            GG_LDA(At, 1, 1); GG_STAGE(GG_SA(1, 0), a3, o2[0]);
            GG_BAR; GG_WAIT_L(0); GG_MMA(1, 0, At, B0); GG_BAR; GG_SCHED;
            GG_STAGE_B(GG_SB(1, 1), bu, k3, 1);
            GG_WAIT_V(6); GG_BAR; GG_MMA(1, 1, At, B1); GG_BAR;
        }
        E(acc, cur, wr, wc, fr, fq);
        if (!has_next) break;
#pragma unroll
        for (int a = 0; a < 2; ++a)
#pragma unroll
            for (int b = 0; b < 2; ++b)
#pragma unroll
                for (int m = 0; m < 4; ++m)
#pragma unroll
                    for (int n = 0; n < 2; ++n) acc[a][b][m][n] = (f32x4){0.f, 0.f, 0.f, 0.f};
        cur = nxt; ++ui;
        if (GATHER) {
#pragma unroll
            for (int h = 0; h < 2; ++h)
#pragma unroll
                for (int i = 0; i < 2; ++i) cAo[h][i] = nAo[h][i]; }
    }
    GG_WAIT_V(0);
    if (wr == 0) GG_BAR;
    GG_BAR;
#undef GG_SA
#undef GG_SB
#undef GG_STAGE
#undef GG_LDA
#undef GG_LDB
#undef GG_MMA
#undef GG_WAIT_V
#undef GG_WAIT_L
#undef GG_BAR
#undef GG_SCHED
#undef GG_BSRC
#undef GG_STAGE_B
#undef GG_GOFF
}

struct DenseSched {
    const char* A; const char* Bt; int nM, nN, G, c; unsigned astep, bstep;
    __device__ __forceinline__ void init(const bf16_t* A_, const bf16_t* Bt_, int M, int N, int lda, int ldb) {
        A = (const char*)A_; Bt = (const char*)Bt_; nM = M / 256; nN = N / 256; G = gridDim.x; c = blockIdx.x; astep = 256u * lda * 2u; bstep = 256u * ldb * 2u; }
    __device__ __forceinline__ bool next(int i, Unit& u) const {
        const int L = i * G + c, nwg = nM * nN; if (L >= nwg) return false;
        int wgid; { const int q = nwg / 8, r = nwg % 8, xcd = L % 8, off = L / 8; wgid = (xcd < r ? xcd * (q + 1) : r * (q + 1) + (xcd - r) * q) + off; }
        const int nig = 8 * nN, gid = wgid / nig, fm = gid * 8, gsz = (nM - fm) < 8 ? (nM - fm) : 8;
        u.pm = fm + ((wgid % nig) % gsz); u.pn = (wgid % nig) / gsz;
        u.a = A + (size_t)u.pm * astep; u.b = Bt + (size_t)u.pn * bstep; u.b2 = nullptr; u.gofs = 0; u.x = 0; return true; }
};
}

constexpr size_t MiB = 1u << 20;
constexpr size_t WS_CTL = 0, CTL_BYTES = 1 * MiB;
constexpr int CW_BAR = 4096, CW_CNT = 8192, CW_CUR = 8192 + 256, CW_NT = 8192 + 512;
constexpr size_t WS_MODP = 1 * MiB, WS_MOD = 3 * MiB, WS_ROPE = 3 * MiB + 256 * 1024, WS_LBV = 3 * MiB + 512 * 1024;
constexpr size_t WS_W_LRU_IN = 4 * MiB, WS_W_LRU_OUT = 8 * MiB, WS_W_LRU_GATE = 10 * MiB;
constexpr size_t WS_W_RWKV_IN = 11 * MiB, WS_W_RWKV_L1 = 17 * MiB, WS_W_RWKV_OUT = 20 * MiB, WS_W_RWKV_WL2 = 556 * MiB;
constexpr size_t WS_W_RET_IN = 22 * MiB, WS_W_RET_OUT = 34 * MiB, WS_W_HGRN_IN = 38 * MiB, WS_W_HGRN_OUT = 48 * MiB;
constexpr size_t WS_MOE = 50 * MiB, MOE_STRIDE = 100 * MiB, MOE_GU = 0, MOE_DN = 64 * MiB, MOE_SHGU = 96 * MiB, MOE_SHDN = 97 * MiB, MOE_RT = 97 * MiB + 512 * 1024;
constexpr size_t WS_H = 450 * MiB, WS_U = 515 * MiB;
constexpr size_t WS_TOPI = 548 * MiB, WS_TOPW = 549 * MiB, WS_POS = 550 * MiB, WS_ROWTOK = 551 * MiB, WS_ROWW = 552 * MiB, WS_TILEE = 553 * MiB;
constexpr size_t WS_SCR = 560 * MiB;
constexpr size_t WS_ULO = WS_SCR + 760 * MiB;
constexpr size_t WS_DUMMY = 1500 * MiB;
constexpr int SH_BASE = 149504;
constexpr int NROWS_SORT = SH_BASE + NTOK;
constexpr size_t WS_ACT = WS_SCR, WS_OUT = WS_SCR + 82 * MiB;
constexpr size_t WS_END = WS_SCR + 880 * MiB;
constexpr size_t WS_MX0 = WS_SCR, WS_MX1 = WS_SCR + 33 * MiB, WS_MX2 = WS_SCR + 66 * MiB, WS_MX3 = WS_SCR + 99 * MiB, WS_MX4 = WS_SCR + 132 * MiB, WS_MX5 = WS_SCR + 165 * MiB;

constexpr int LDS_STAGE = 0, LDS_TAB = 131072, LDS_TAB_BYTES = 20480, LDS_MISC = LDS_TAB + LDS_TAB_BYTES, LDS_BYTES = 155648;

struct Args { const float* in[47]; float* out; unsigned char* ws; int ph_lo, ph_hi; };

struct Frame {
    LAS unsigned char* lds; volatile LAS unsigned* misc; unsigned* ctl; unsigned char* ws;
    int tid, lane, wave, gw, ngw;
    unsigned long long tacc;
};

struct TrJob { const float* src; bf16_t* dst; int ld_src, K, N, ld_dst, nb, sbs, dbs, mode, start; };
constexpr int MAXJOBS = 64;
__device__ __forceinline__ void tr_item(const TrJob& J, int item, LAS unsigned char* scr, int lane) {
    const int nblk = (J.N + 63) >> 6, kblk = J.K >> 6, per = nblk * kblk, bi = item / per, r = item - bi * per, kb = r / nblk, nb = r - kb * nblk, k0 = 64 * kb, n0 = 64 * nb;
    int c0 = n0;
    if (J.mode == 1) { const int pn = n0 >> 8, j = n0 & 255; c0 = (j < 128) ? (128 * pn + j) : (256 + 128 * pn + (j - 128)); }
    const float* W = J.src + (size_t)bi * J.sbs + (size_t)k0 * J.ld_src + c0; bf16_t* WT = J.dst + (size_t)bi * J.dbs + (size_t)n0 * J.ld_dst + k0;
    const int cq = lane & 15, rq = lane >> 4;
    const bool nok = (n0 + 4 * cq) < J.N;
    f32x4 v[16];
#pragma unroll
    for (int i = 0; i < 16; ++i) { v[i] = (f32x4){0.f, 0.f, 0.f, 0.f}; if (nok) v[i] = *(const f32x4*)(W + (size_t)(4 * i + rq) * J.ld_src + 4 * cq); }
#pragma unroll
    for (int i = 0; i < 16; ++i) { const int kk = 4 * i + rq;
#pragma unroll
        for (int e = 0; e < 4; ++e) { float x = v[i][e]; if (J.mode == 3) x = x - bf2f(f2bf(x)); *(LAS unsigned short*)(scr + (4 * cq + e) * 144 + kk * 2) = (unsigned short)f2bf(x); } }
    asm volatile("s_waitcnt lgkmcnt(0)" ::: "memory");
    const int ch = lane & 7, nr = lane >> 3;
#pragma unroll
    for (int j = 0; j < 8; ++j) { const int n = nr + 8 * j; if (n0 + n < J.N) *(u32x4*)(WT + (size_t)n * J.ld_dst + 8 * ch) = *(const LAS u32x4*)(scr + n * 144 + 16 * ch); }
    asm volatile("s_waitcnt lgkmcnt(0)" ::: "memory");
}
__device__ __forceinline__ void ldrow_f32(const float* row, int lane, float (&v)[16]) {
#pragma unroll
    for (int j = 0; j < 2; ++j) { const f32x4 a = *(const f32x4*)(row + 8 * lane + 512 * j), b = *(const f32x4*)(row + 8 * lane + 512 * j + 4);
        v[8 * j + 0] = a.x; v[8 * j + 1] = a.y; v[8 * j + 2] = a.z; v[8 * j + 3] = a.w; v[8 * j + 4] = b.x; v[8 * j + 5] = b.y; v[8 * j + 6] = b.z; v[8 * j + 7] = b.w; }
}
__device__ __forceinline__ void strow_f32(float* row, int lane, const float (&v)[16]) {
#pragma unroll
    for (int j = 0; j < 2; ++j) { *(f32x4*)(row + 8 * lane + 512 * j) = (f32x4){v[8 * j], v[8 * j + 1], v[8 * j + 2], v[8 * j + 3]}; *(f32x4*)(row + 8 * lane + 512 * j + 4) = (f32x4){v[8 * j + 4], v[8 * j + 5], v[8 * j + 6], v[8 * j + 7]}; }
}
__device__ __forceinline__ void ldrow_bf16(const bf16_t* row, int lane, float (&v)[16]) {
#pragma unroll
    for (int j = 0; j < 2; ++j) { const u32x4 a = *(const u32x4*)(row + 8 * lane + 512 * j);
        v[8 * j + 0] = bflo(a.x); v[8 * j + 1] = bfhi(a.x); v[8 * j + 2] = bflo(a.y); v[8 * j + 3] = bfhi(a.y); v[8 * j + 4] = bflo(a.z); v[8 * j + 5] = bfhi(a.z); v[8 * j + 6] = bflo(a.w); v[8 * j + 7] = bfhi(a.w); }
}
__device__ __forceinline__ void addrow_bf16(const bf16_t* row, int lane, float (&v)[16]) {
#pragma unroll
    for (int j = 0; j < 2; ++j) { const u32x4 a = *(const u32x4*)(row + 8 * lane + 512 * j);
        v[8 * j + 0] += bflo(a.x); v[8 * j + 1] += bfhi(a.x); v[8 * j + 2] += bflo(a.y); v[8 * j + 3] += bfhi(a.y); v[8 * j + 4] += bflo(a.z); v[8 * j + 5] += bfhi(a.z); v[8 * j + 6] += bflo(a.w); v[8 * j + 7] += bfhi(a.w); }
}
__device__ __forceinline__ void addrow_fp8(const unsigned char* row, int lane, float (&v)[16]) {
    typedef float f2v __attribute__((ext_vector_type(2)));
#pragma unroll
    for (int j = 0; j < 2; ++j) { const u32x2 a = *(const u32x2*)(row + 8 * lane + 512 * j);
        const f2v p0 = __builtin_amdgcn_cvt_pk_f32_fp8((int)a.x, false), p1 = __builtin_amdgcn_cvt_pk_f32_fp8((int)a.x, true), p2 = __builtin_amdgcn_cvt_pk_f32_fp8((int)a.y, false), p3 = __builtin_amdgcn_cvt_pk_f32_fp8((int)a.y, true);
        v[8 * j + 0] += p0[0]; v[8 * j + 1] += p0[1]; v[8 * j + 2] += p1[0]; v[8 * j + 3] += p1[1]; v[8 * j + 4] += p2[0]; v[8 * j + 5] += p2[1]; v[8 * j + 6] += p3[0]; v[8 * j + 7] += p3[1]; }
}
__device__ __forceinline__ void strow_bf16(bf16_t* row, int lane, const float (&v)[16]) {
#pragma unroll
    for (int j = 0; j < 2; ++j) { u32x4 o; o.x = pk2(v[8 * j], v[8 * j + 1]); o.y = pk2(v[8 * j + 2], v[8 * j + 3]); o.z = pk2(v[8 * j + 4], v[8 * j + 5]); o.w = pk2(v[8 * j + 6], v[8 * j + 7]);
        *(u32x4*)(row + 8 * lane + 512 * j) = o; }
}

#define add(src_, wsoff_, ld_src_, K_, N_, ld_dst_, nb_, sbs_, dbs_, mode_) do { TrJob J; J.src = (src_); J.dst = (bf16_t*)(a.ws + (wsoff_)); J.ld_src = (ld_src_); J.K = (K_); J.N = (N_); J.ld_dst = (ld_dst_); \
            J.nb = (nb_); J.sbs = (sbs_); J.dbs = (dbs_); J.mode = (mode_); J.start = start; jobs[n] = J; start += (nb_) * ((K_) / 64) * (((N_) + 63) / 64); ++n; } while (0)
__device__ __forceinline__ void add_moe_jobs(TrJob* jobs, int& n, int& start, const Args& a, int l) {
    const size_t mb = WS_MOE + l * MOE_STRIDE;
    add(a.in[43] + (size_t)l * 64 * 1024 * 512, mb + MOE_GU, 512, 1024, 512, 1024, 64, 1024 * 512, 512 * 1024, 1);
    add(a.in[44] + (size_t)l * 64 * 256 * 1024, mb + MOE_DN, 1024, 256, 1024, 256, 64, 256 * 1024, 1024 * 256, 0);
    add(a.in[45] + (size_t)l * 1024 * 512, mb + MOE_SHGU, 512, 1024, 512, 1024, 1, 0, 0, 1);
    add(a.in[46] + (size_t)l * 256 * 1024, mb + MOE_SHDN, 1024, 256, 1024, 256, 1, 0, 0, 0);
    add(a.in[41] + (size_t)l * 1024 * 64, mb + MOE_RT, 64, 1024, 64, 1024, 1, 0, 0, 2);
    add(a.in[41] + (size_t)l * 1024 * 64, mb + MOE_RT + 64 * 1024 * 2, 64, 1024, 64, 1024, 1, 0, 0, 3);
}
constexpr int BG_PER_LAYER = 12512, BG_NJOBS = 28, BG_E0 = 12512, BG_E1 = 27072, BG_E2 = 41120, BG_TOTAL = 53632;
constexpr int BG_NW = 8;
__device__ __forceinline__ void bg_convert(Frame& F, const Args& a, int lo, int hi, int first, int stride, bool active = true) {
    if (lo >= hi) return;
    __syncthreads();
    TrJob* jobs = (TrJob*)(F.lds + LDS_TAB);
    if (F.tid == 0) { int n = 0, start = 0;
        add_moe_jobs(jobs, n, start, a, 0);
        add_moe_jobs(jobs, n, start, a, 1);
        add(a.in[31], WS_W_RET_IN, 6144, 1024, 6144, 1024, 1, 0, 0, 0);
        add(a.in[35], WS_W_RET_OUT, 1024, 2048, 1024, 2048, 1, 0, 0, 0);
        add_moe_jobs(jobs, n, start, a, 2);
        add(a.in[36], WS_W_HGRN_IN, 5120, 1024, 5120, 1024, 1, 0, 0, 0);
        add(a.in[40], WS_W_HGRN_OUT, 1024, 1024, 1024, 1024, 1, 0, 0, 0);
        add_moe_jobs(jobs, n, start, a, 3);
        { TrJob J = jobs[n - 1]; J.start = start; J.nb = 0; jobs[n] = J; } }
    __syncthreads();
    LAS unsigned char* scr = F.lds + LDS_STAGE + F.wave * 16384;
    if (active) for (int it = lo + first; it < hi; it += stride) {
        int j = 0; while (j + 1 < BG_NJOBS && jobs[j + 1].start <= it) ++j;
        const TrJob J = jobs[j];
        tr_item(J, it - J.start, scr, F.lane);
    }
    __syncthreads();
}
enum BgEv { EV_LRU_IN, EV_S1, EV_CARRY, EV_S3, EV_LRU_OUT, EV_C0, EV_ROUTE0, EV_RW_IN, EV_RW_L2, EV_RW_CHUNK, EV_RW_PREFIX, EV_RW_OUT, EV_C1, EV_ROUTE1,
            EV_RET_IN, EV_RET_P, EV_RET_KV, EV_RET_O, EV_RET_OUT, EV_C2, EV_ROUTE2, EV_HG_IN, EV_HG_C0, EV_HG_PREFIX, EV_HG_C1, EV_C3 };
template <int EV>
__device__ __forceinline__ void bg_range(int G, int& lo, int& hi, int& nidle, int& rem) {
    int ptr = 0; lo = hi = 0; nidle = 0; rem = 0;
#define BG_SLOT(e, rem_, q) if (EV >= (e)) { const int r_ = (rem_), ni_ = G > r_ ? G - r_ : 0; lo = ptr; hi = min(ptr + ((q) * ni_ * 8) / 2, BG_TOTAL); ptr = hi; nidle = ni_; rem = r_; }
#define BG_CATCH(e, end_) if (EV >= (e)) { lo = ptr; hi = max(ptr, (end_)); ptr = hi; nidle = 0; rem = 0; }
    BG_SLOT(EV_LRU_IN, 520 % G, BQ(3)) BG_SLOT(EV_S1, 8, BQ(7)) BG_SLOT(EV_CARRY, 4, 0) BG_SLOT(EV_S3, 8, BQ(7)) BG_SLOT(EV_LRU_OUT, 260 % G, BQ(3)) BG_CATCH(EV_C0, BG_E0)
    BG_SLOT(EV_ROUTE0, 1040 % G, 0) BG_SLOT(EV_RW_IN, 975 % G, 0) BG_SLOT(EV_RW_L2, 1300 % G, 0) BG_SLOT(EV_RW_CHUNK, 32, BQ(7)) BG_SLOT(EV_RW_PREFIX, 128, 0) BG_SLOT(EV_RW_OUT, 260 % G, BQ(3)) BG_CATCH(EV_C1, BG_E1)
    BG_SLOT(EV_ROUTE1, 1040 % G, 0) BG_SLOT(EV_RET_IN, 1560 % G, BQ(3)) BG_SLOT(EV_RET_P, 260 % G, 0) BG_SLOT(EV_RET_KV, 1040 % G, 0) BG_SLOT(EV_RET_O, 520 % G, BQ(3)) BG_SLOT(EV_RET_OUT, 260 % G, BQ(7)) BG_CATCH(EV_C2, BG_E2)
    BG_SLOT(EV_ROUTE2, 1040 % G, 0) BG_SLOT(EV_HG_IN, 1300 % G, BQ(3)) BG_SLOT(EV_HG_C0, 1040 % G, BQ(3)) BG_SLOT(EV_HG_PREFIX, 128, 0) BG_SLOT(EV_HG_C1, 1040 % G, BQ(7)) BG_CATCH(EV_C3, BG_TOTAL)
#undef BG_SLOT
#undef BG_CATCH
}
template <int EV>
__device__ __forceinline__ void bg_slot(Frame& F, const Args& a) {
    int lo, hi, nidle, rem; bg_range<EV>((int)gridDim.x, lo, hi, nidle, rem);
    const int c = (int)blockIdx.x;
    if (nidle > 0 && c >= rem) { unsigned long long t0 = 0; if (TPROBE) t0 = __builtin_amdgcn_s_memrealtime(); bg_convert(F, a, lo, hi, (c - rem) * BG_NW + F.wave, nidle * BG_NW, F.wave < BG_NW); if (TPROBE) F.tacc += __builtin_amdgcn_s_memrealtime() - t0; }
}
template <int EV>
__device__ __forceinline__ void bg_catch(Frame& F, const Args& a) {
    int lo, hi, nidle, rem; bg_range<EV>((int)gridDim.x, lo, hi, nidle, rem);
    bg_convert(F, a, lo, hi, F.gw, F.ngw);
}

__device__ __forceinline__ void p0_phase(Frame& F, const Args& a) {
    TrJob* jobs = (TrJob*)(F.lds + LDS_TAB);
    int* njobs = (int*)(F.lds + LDS_TAB + MAXJOBS * sizeof(TrJob));
    if (F.tid == 0) {
        int n = 0, start = 0;
        add(a.in[8], WS_W_LRU_IN, 2048, 1024, 2048, 1024, 1, 0, 0, 0);
        add(a.in[14], WS_W_LRU_OUT, 1024, 1024, 1024, 1024, 1, 0, 0, 0);
        add(a.in[11], WS_W_LRU_GATE, 64, 64, 64, 64, 64, 4096, 4096, 0);
        add(a.in[16], WS_W_RWKV_IN, 1024, 1024, 1024, 1024, 3, 1024 * 1024, 1024 * 1024, 0);
        add(a.in[18], WS_W_RWKV_L1, 64, 1024, 64, 1024, 2, 1024 * 64, 64 * 1024, 0);
        add(a.in[21], WS_W_RWKV_L1 + 256 * 1024 * 2, 64, 1024, 64, 1024, 2, 1024 * 64, 64 * 1024, 0);
        add(a.in[23], WS_W_RWKV_L1 + 512 * 1024 * 2, 128, 1024, 128, 1024, 1, 0, 0, 0);
        add(a.in[19], WS_W_RWKV_WL2, 1024, 64, 1024, 256, 1, 0, 0, 0);
        add(a.in[19] + 64 * 1024, WS_W_RWKV_WL2 + (size_t)(1 * 1024 * 256 + 64) * 2, 1024, 64, 1024, 256, 1, 0, 0, 0);
        add(a.in[22], WS_W_RWKV_WL2 + (size_t)(2 * 1024 * 256) * 2, 1024, 64, 1024, 256, 1, 0, 0, 0);
        add(a.in[22] + 64 * 1024, WS_W_RWKV_WL2 + (size_t)(3 * 1024 * 256 + 64) * 2, 1024, 64, 1024, 256, 1, 0, 0, 0);
        add(a.in[24], WS_W_RWKV_WL2 + (size_t)(4 * 1024 * 256) * 2, 1024, 128, 1024, 256, 1, 0, 0, 0);
        add(a.in[30], WS_W_RWKV_OUT, 1024, 1024, 1024, 1024, 1, 0, 0, 0);
        { TrJob J = jobs[n - 1]; J.start = start; J.nb = 0; jobs[n] = J; }
        *njobs = n;
#undef add
    }
    __syncthreads();
    const int nj = *njobs, total = jobs[nj].start;
    LAS unsigned char* scr = F.lds + LDS_STAGE + F.wave * 16384;
    for (int it = F.gw; it < total; it += F.ngw) {
        int j = 0; while (j + 1 < nj && jobs[j + 1].start <= it) ++j;
        const TrJob J = jobs[j];
        tr_item(J, it - J.start, scr, F.lane);
    }
    { u32x4* z = (u32x4*)(a.ws + WS_W_RWKV_L1); const u32x4 zero = {0u, 0u, 0u, 0u};
      for (int i = blockIdx.x * NTHREADS + F.tid; i < 3 * 128 * 128; i += gridDim.x * NTHREADS) { const int blk = i / (128 * 128), r = i % (128 * 128); z[(size_t)(blk * 256 + 128) * 128 + r] = zero; } }
    { u32x4* z = (u32x4*)(a.ws + WS_W_RWKV_WL2); const u32x4 zero = {0u, 0u, 0u, 0u};
      for (int i = blockIdx.x * NTHREADS + F.tid; i < 5 * 1024 * 32; i += gridDim.x * NTHREADS) { const int g = i / (1024 * 32), c8 = (i & 31) * 8;
          const int lo = (g == 1 || g == 3) ? 64 : 0, hi = (g == 4) ? 128 : lo + 64; if (c8 < lo || c8 >= hi) z[i] = zero; } }
    const float* cvec = a.in[1]; const float* ccvec = a.in[3]; const float* adaw = a.in[4];
    float* modp = (float*)(a.ws + WS_MODP);
    for (int it = F.gw; it < 4 * 96 * 8; it += F.ngw) {
        const int s = it & 7, cb = (it >> 3) % 96, l = it / 768, j = cb * 64 + F.lane;
        const float* W = adaw + ((size_t)l * 1024 + s * 128) * 6144 + j;
        float al = 0.f, ac = 0.f;
#pragma unroll 8
        for (int k = 0; k < 128; ++k) { const float w = W[(size_t)k * 6144]; al += siluf_(cvec[s * 128 + k]) * w; ac += siluf_(ccvec[s * 128 + k]) * w; }
        modp[((size_t)(s * 4 + l) * 2 + 0) * 6144 + j] = al; modp[((size_t)(s * 4 + l) * 2 + 1) * 6144 + j] = ac;
    }
}
__device__ __forceinline__ void p1a_phase(Frame& F, const Args& a) {
    const float* modp = (const float*)(a.ws + WS_MODP); float* mod = (float*)(a.ws + WS_MOD); const float* adab = a.in[5];
    const int gt = blockIdx.x * NTHREADS + F.tid, ngt = gridDim.x * NTHREADS;
    for (int i = gt; i < 4 * 2 * 6144; i += ngt) { const int j = i % 6144, l = i / (2 * 6144);
        float s = adab[l * 6144 + j];
#pragma unroll
        for (int sl = 0; sl < 8; ++sl) s += modp[(size_t)sl * 4 * 2 * 6144 + i];
        mod[i] = s; }
    float* rope = (float*)(a.ws + WS_ROPE);
    for (int i = gt; i < 256 * 64; i += ngt) { const int p = i >> 6, f = i & 63; const double ang = (double)p * pow(10000.0, -(double)f / 64.0); rope[i] = (float)cos(ang); rope[256 * 64 + i] = (float)sin(ang); }
    float* lbv = (float*)(a.ws + WS_LBV); const float* hl = a.in[38];
    for (int i = gt; i < 1024; i += ngt) { const float x0 = hl[i], x1 = hl[1024 + i], x2 = hl[2048 + i], x3 = hl[3072 + i]; const float m = fmaxf(fmaxf(x0, x1), fmaxf(x2, x3));
        const float e0 = expf(x0 - m), e1 = expf(x1 - m), e2 = expf(x2 - m), e3 = expf(x3 - m); lbv[i] = (e1 + e2 + e3) / (e0 + e1 + e2 + e3); }
}
__device__ __forceinline__ const float* modptr(const unsigned char* ws, int l, int kind, int which) { return (const float*)(ws + WS_MOD) + ((size_t)(l * 2 + kind) * 6 + which) * 1024; }
__device__ __forceinline__ void p1b_phase(Frame& F, const Args& a) {
    bf16_t* H = (bf16_t*)(a.ws + WS_H); bf16_t* U = (bf16_t*)(a.ws + WS_U);
    { int* ROWTOK = (int*)(a.ws + WS_ROWTOK); float* ROWW = (float*)(a.ws + WS_ROWW);
      for (int t = blockIdx.x * NTHREADS + F.tid; t < NTOK; t += gridDim.x * NTHREADS) { ROWTOK[SH_BASE + t] = t; ROWW[SH_BASE + t] = 1.0f; } }
    for (int t = F.gw; t < NTOK; t += F.ngw) {
        const int kind = t < NCTX ? 1 : 0; const float* src = kind ? a.in[2] + (size_t)t * D : a.in[0] + (size_t)(t - NCTX) * D;
        float v[16], m0[16], m1[16]; ldrow_f32(src, F.lane, v); ldrow_f32(modptr(a.ws, 0, kind, 0), F.lane, m0); ldrow_f32(modptr(a.ws, 0, kind, 1), F.lane, m1);
        strow_bf16(H + (size_t)t * D, F.lane, v);
#pragma unroll
        for (int e = 0; e < 16; ++e) v[e] = v[e] * (1.0f + m1[e]) + m0[e];
        strow_bf16(U + (size_t)t * D, F.lane, v);
    }
}

template <int L, int MODE, bool DRY = false>
__device__ __forceinline__ void ln_phase(Frame& F, const Args& a) {
    bf16_t* H = (bf16_t*)(a.ws + WS_H); bf16_t* U = (bf16_t*)(a.ws + WS_U);
    bf16_t* Hw = DRY ? (bf16_t*)(a.ws + WS_DUMMY) : H; bf16_t* Uw = DRY ? (bf16_t*)(a.ws + WS_DUMMY + 70 * MiB) : U; float* outw = DRY ? (float*)(a.ws + WS_DUMMY) : a.out;
    const bf16_t* Y = (const bf16_t*)(a.ws + WS_MX5); const unsigned char* OUT = (const unsigned char*)(a.ws + WS_OUT); const int* POS = (const int*)(a.ws + WS_POS);
    const float* lg = a.in[6] + (size_t)(L * 2 + MODE) * D; const float* lb = a.in[7] + (size_t)(L * 2 + MODE) * D;
    constexpr bool LASTL = (L == 3);
#pragma unroll 1
    for (int kind = 0; kind < 2; ++kind) {
        if (LASTL && kind == 1) break;
        float mg[16], g[16], b[16], msh[16], msc[16];
        ldrow_f32(modptr(a.ws, L, kind, MODE == 0 ? 2 : 5), F.lane, mg); ldrow_f32(lg, F.lane, g); ldrow_f32(lb, F.lane, b);
        if (MODE == 0) { ldrow_f32(modptr(a.ws, L, kind, 3), F.lane, msh); ldrow_f32(modptr(a.ws, L, kind, 4), F.lane, msc); }
        else if (!LASTL) { ldrow_f32(modptr(a.ws, (L + 1) & 3, kind, 0), F.lane, msh); ldrow_f32(modptr(a.ws, (L + 1) & 3, kind, 1), F.lane, msc); }
        const int t0 = kind ? 0 : NCTX, t1 = kind ? NCTX : NTOK;
#pragma unroll 1
        for (int t = t0 + F.gw; t < t1; t += F.ngw) {
            float h[16], y[16];
            ldrow_bf16(H + (size_t)t * D, F.lane, h);
            if (MODE == 0) ldrow_bf16(Y + (size_t)t * D, F.lane, y);
            else if (!EN_MOE) {
#pragma unroll
                for (int e = 0; e < 16; ++e) y[e] = 0.f;
            } else {
                int p = 0; if (F.lane < 8) p = POS[t * 8 + F.lane];
#pragma unroll
                for (int e = 0; e < 16; ++e) y[e] = 0.f;
                addrow_fp8(OUT + (size_t)(SH_BASE + t) * D, F.lane, y);
#pragma unroll
                for (int s = 0; s < 8; ++s) { const int r = __builtin_amdgcn_readlane(p, s); addrow_fp8(OUT + (size_t)r * D, F.lane, y); }
            }
            float s = 0.f;
#pragma unroll
            for (int e = 0; e < 16; ++e) { h[e] = ALPHA * h[e] + mg[e] * y[e]; s += h[e]; }
            const float mean = wave_sum(s) * (1.0f / D); float q = 0.f;
#pragma unroll
            for (int e = 0; e < 16; ++e) { h[e] -= mean; q += h[e] * h[e]; }
            const float rstd = 1.0f / sqrtf(wave_sum(q) * (1.0f / D) + LN_EPS);
#pragma unroll
            for (int e = 0; e < 16; ++e) h[e] = h[e] * rstd * g[e] + b[e];
            if (MODE == 1 && LASTL) { strow_f32(outw + (size_t)(t - NCTX) * D, F.lane, h); }
            else {
                strow_bf16(Hw + (size_t)t * D, F.lane, h);
#pragma unroll
                for (int e = 0; e < 16; ++e) h[e] = h[e] * (1.0f + msc[e]) + msh[e];
                strow_bf16(Uw + (size_t)t * D, F.lane, h);

            }
        }
    }
}

template <int L, bool DRY = false>
__device__ __forceinline__ void moe_route_phase(Frame& F, const Args& a) {
    const bf16_t* U = (const bf16_t*)(a.ws + WS_U); const bf16_t* ULO = (const bf16_t*)(a.ws + WS_ULO);
    const bf16_t* Rhi = (const bf16_t*)(a.ws + WS_MOE + L * MOE_STRIDE + MOE_RT); const bf16_t* Rlo = Rhi + 64 * 1024;
    const float* bias = a.in[42] + L * 64;
    int* TOPI = (int*)(a.ws + (DRY ? WS_DUMMY : WS_TOPI)); float* TOPW = (float*)(a.ws + (DRY ? WS_DUMMY + 4 * MiB : WS_TOPW));
    LAS float* part = (LAS float*)(F.lds + LDS_STAGE);
    const int lane = F.lane, r16 = lane & 15, q = lane >> 4, w = F.wave;
    bf16x8 Bh[4][4], Bl[4][4];
#pragma unroll
    for (int n = 0; n < 4; ++n)
#pragma unroll
        for (int ks = 0; ks < 4; ++ks) { const size_t o = (size_t)(16 * n + r16) * 1024 + 128 * w + 32 * ks + 8 * q; Bh[n][ks] = *(const bf16x8*)(Rhi + o); Bl[n][ks] = *(const bf16x8*)(Rlo + o); }
    const int g0 = (L == 3) ? NCTX / 16 : 0;
    int cnt_e = 0;
    const float mybias = bias[lane];
    bf16x8 Ahn[4];
    if (g0 + (int)blockIdx.x < NTOK / 16) { const size_t ao = (size_t)((g0 + (int)blockIdx.x) * 16 + r16) * D + 128 * w + 8 * q;
#pragma unroll
        for (int ks = 0; ks < 4; ++ks) Ahn[ks] = *(const bf16x8*)(U + ao + 32 * ks); }
#pragma unroll 1
    for (int grp = g0 + blockIdx.x; grp < NTOK / 16; grp += gridDim.x) {
        bf16x8 Ah[4];
#pragma unroll
        for (int ks = 0; ks < 4; ++ks) Ah[ks] = Ahn[ks];
        if (grp + (int)gridDim.x < NTOK / 16) { const size_t ao = (size_t)((grp + (int)gridDim.x) * 16 + r16) * D + 128 * w + 8 * q;
#pragma unroll
            for (int ks = 0; ks < 4; ++ks) Ahn[ks] = *(const bf16x8*)(U + ao + 32 * ks); }
        f32x4 acc[4];
#pragma unroll
        for (int n = 0; n < 4; ++n) { acc[n] = (f32x4){0.f, 0.f, 0.f, 0.f};
#pragma unroll
            for (int ks = 0; ks < 4; ++ks) {
                acc[n] = __builtin_amdgcn_mfma_f32_16x16x32_bf16(Ah[ks], Bh[n][ks], acc[n], 0, 0, 0);
                acc[n] = __builtin_amdgcn_mfma_f32_16x16x32_bf16(Ah[ks], Bl[n][ks], acc[n], 0, 0, 0); } }
        __syncthreads();
#pragma unroll
        for (int n = 0; n < 4; ++n)
#pragma unroll
            for (int r = 0; r < 4; ++r) part[(w * 16 + 4 * q + r) * 64 + 16 * n + r16] = acc[n][r];
        __syncthreads();
#pragma unroll 1
        for (int rr = 0; rr < 2; ++rr) {
            const int row = 2 * w + rr, t = grp * 16 + row;
            float lgt = 0.f;
#pragma unroll
            for (int ww = 0; ww < 8; ++ww) lgt += part[(ww * 16 + row) * 64 + lane];
            const float sc = sigmoidf_(lgt);
            const float ch = sc + mybias;
            float m1 = -INFINITY, m2 = -INFINITY;
#pragma unroll
            for (int j = 0; j < 8; ++j) { const float v = __shfl(ch, (lane & ~7) + j); if (v > m1) { m2 = m1; m1 = v; } else if (v > m2) m2 = v; }
            const float gs = m1 + m2; const int g = lane >> 3;
            int grank = 0;
#pragma unroll
            for (int gg2 = 0; gg2 < 8; ++gg2) { const float v = __shfl(gs, 8 * gg2); grank += (v > gs || (v == gs && gg2 < g)) ? 1 : 0; }
            const bool sel = grank < 4;
            const float chm = sel ? ch : -INFINITY;
            int rank = 0;
#pragma unroll
            for (int e2 = 0; e2 < 64; ++e2) { const float v = __builtin_bit_cast(float, __builtin_amdgcn_readlane(__builtin_bit_cast(int, chm), e2)); rank += (v > chm || (v == chm && e2 < lane)) ? 1 : 0; }
            const bool chosen = sel && rank < 8;
            const float wsum = wave_sum(chosen ? sc : 0.f);
            const unsigned long long bal = __ballot(chosen);
            const int slot = __popcll(bal & ((1ull << lane) - 1ull));
            if (chosen) { TOPI[t * 8 + slot] = lane; TOPW[t * 8 + slot] = 2.5f * sc / wsum; cnt_e++; }
        }
    }
    if (cnt_e && !DRY) atomicAdd(F.ctl + CW_CNT + L * 64 + lane, (unsigned)cnt_e);
}

template <int L, bool DRY = false>
__device__ __forceinline__ void moe_dispatch_phase(Frame& F, const Args& a) {
    LAS int* pb = (LAS int*)(F.lds + LDS_TAB);
    if (F.wave == 0) {
        const int cnt = (int)F.ctl[CW_CNT + L * 64 + F.lane]; const int pad = (cnt + 255) & ~255;
        int inc = pad;
#pragma unroll
        for (int o = 1; o < 64; o <<= 1) { const int v = __shfl_up(inc, o); if (F.lane >= o) inc += v; }
        pb[F.lane] = inc - pad; pb[65 + F.lane] = cnt; if (F.lane == 63) pb[64] = inc;
    }
    __syncthreads();
    const int* TOPI = (const int*)(a.ws + WS_TOPI); const float* TOPW = (const float*)(a.ws + WS_TOPW);
    int* POS = (int*)(a.ws + (DRY ? WS_DUMMY : WS_POS)); int* ROWTOK = (int*)(a.ws + (DRY ? WS_DUMMY + 2 * MiB : WS_ROWTOK)); float* ROWW = (float*)(a.ws + (DRY ? WS_DUMMY + 4 * MiB : WS_ROWW)); int* TILEE = (int*)(a.ws + (DRY ? WS_DUMMY + 6 * MiB : WS_TILEE));
    const int p0 = (L == 3) ? NCTX * 8 : 0;
    LAS int* lcnt = pb + 160; LAS int* lbase = pb + 224;
    const int npairs = NTOK * 8 - p0, per = (npairs + (int)gridDim.x - 1) / (int)gridDim.x, lo = p0 + (int)blockIdx.x * per, hi = min(lo + per, NTOK * 8);
#pragma unroll 1
    for (int c0 = lo; c0 < hi; c0 += NTHREADS) {
        if (F.tid < 64) lcnt[F.tid] = 0;
        __syncthreads();
        const int p = c0 + F.tid; const bool ok = p < hi; int e = 0, lrank = 0;
        if (ok) { e = TOPI[p]; lrank = atomicAdd((int*)(lcnt + e), 1); }
        __syncthreads();
        if (F.tid < 64) { const int c = lcnt[F.tid]; lbase[F.tid] = pb[F.tid] + (c ? (int)atomicAdd(F.ctl + CW_CUR + (DRY ? 1024 : 0) + L * 64 + F.tid, (unsigned)c) : 0); }
        __syncthreads();
        if (ok) { const int dest = lbase[e] + lrank; POS[p] = dest; ROWTOK[dest] = p >> 3; ROWW[dest] = TOPW[p]; }
        __syncthreads();
    }
    if (blockIdx.x < 64) {
        const int e = blockIdx.x, base = pb[e], cnt = pb[65 + e], pad = (cnt + 255) & ~255;
        for (int r = cnt + F.tid; r < pad; r += NTHREADS) { ROWTOK[base + r] = NCTX; ROWW[base + r] = 0.f; }
        for (int tl = F.tid; tl < pad / 256; tl += NTHREADS) TILEE[base / 256 + tl] = e;
    }
    if (blockIdx.x == 64 && F.tid == 0 && !DRY) F.ctl[CW_NT + L] = (unsigned)(pb[64] / 256);
    __syncthreads();
}

struct ListSched {
    const LAS gg::Unit* tab; int n;
    __device__ __forceinline__ bool next(int i, gg::Unit& u) const {
        if (i >= n) return false;
        const LAS unsigned* p = (const LAS unsigned*)(tab + i); unsigned w[10];
#pragma unroll
        for (int k = 0; k < 10; ++k) w[k] = (unsigned)__builtin_amdgcn_readfirstlane((int)p[k]);
        u.a = (const char*)(((unsigned long long)w[1] << 32) | w[0]); u.b = (const char*)(((unsigned long long)w[3] << 32) | w[2]); u.b2 = (const char*)(((unsigned long long)w[5] << 32) | w[4]);
        u.pm = (int)w[6]; u.pn = (int)w[7]; u.gofs = (int)w[8]; u.x = (int)w[9]; return true; }
};
static_assert(sizeof(gg::Unit) == 40, "Unit layout");

struct EpiSwiglu {
    static constexpr bool PERM = true;
    bf16_t* ACT; LAS unsigned char* lds;
    __device__ __forceinline__ void operator()(const gg::Acc& acc, const gg::Unit& u, int wr, int wc, int fr, int fq) const {
        const int row0 = u.pm * 256 + wr * 64 + fr, col0 = u.pn * 128 + wc * 32 + 8 * fq;
        const LAS float* wl = (const LAS float*)(lds + u.gofs + 8192);
#pragma unroll
        for (int ai = 0; ai < 2; ++ai)
#pragma unroll
            for (int m = 0; m < 4; ++m) { const int row = row0 + ai * 128 + m * 16; const float w = wl[wr * 64 + fr + ai * 128 + m * 16];
                const f32x4 g0 = acc[ai][0][m][0], g1 = acc[ai][0][m][1], u0 = acc[ai][1][m][0], u1 = acc[ai][1][m][1];
                u32x4 o; o.x = pk2(siluf_(g0[0]) * u0[0] * w, siluf_(g0[1]) * u0[1] * w); o.y = pk2(siluf_(g0[2]) * u0[2] * w, siluf_(g0[3]) * u0[3] * w);
                o.z = pk2(siluf_(g1[0]) * u1[0] * w, siluf_(g1[1]) * u1[1] * w); o.w = pk2(siluf_(g1[2]) * u1[2] * w, siluf_(g1[3]) * u1[3] * w);
                *(u32x4*)(ACT + (size_t)row * 256 + col0) = o; }
    }
};
struct EpiBf16 {
    static constexpr bool PERM = true;
    bf16_t* O; int ldc;
    __device__ __forceinline__ void operator()(const gg::Acc& acc, const gg::Unit& u, int wr, int wc, int fr, int fq) const {
        const int row0 = u.pm * 256 + wr * 64 + fr, col0 = u.pn * 256 + wc * 32 + 8 * fq;
#pragma unroll
        for (int ai = 0; ai < 2; ++ai)
#pragma unroll
            for (int m = 0; m < 4; ++m) { bf16_t* rp = O + (size_t)(row0 + ai * 128 + m * 16) * ldc + col0;
#pragma unroll
                for (int bj = 0; bj < 2; ++bj) { const f32x4 v0 = acc[ai][bj][m][0], v1 = acc[ai][bj][m][1];
                    u32x4 o; o.x = pk2(v0[0], v0[1]); o.y = pk2(v0[2], v0[3]); o.z = pk2(v1[0], v1[1]); o.w = pk2(v1[2], v1[3]);
                    *(u32x4*)(rp + bj * 128) = o; } }
    }
};

__device__ __forceinline__ unsigned pk4_fp8(float a, float b, float c, float d) { int w = __builtin_amdgcn_cvt_pk_fp8_f32(a, b, 0, false); w = __builtin_amdgcn_cvt_pk_fp8_f32(c, d, w, true); return (unsigned)w; }
struct EpiFp8 {
    static constexpr bool PERM = true;
    unsigned char* O; int rmask;
    __device__ __forceinline__ void operator()(const gg::Acc& acc, const gg::Unit& u, int wr, int wc, int fr, int fq) const {
        const int row0 = (u.pm * 256 + wr * 64 + fr) & rmask, col0 = u.pn * 256 + wc * 32 + 8 * fq;
#pragma unroll
        for (int ai = 0; ai < 2; ++ai)
#pragma unroll
            for (int m = 0; m < 4; ++m) { unsigned char* rp = O + (size_t)((row0 + ai * 128 + m * 16) & rmask) * 1024 + col0;
#pragma unroll
                for (int bj = 0; bj < 2; ++bj) { const f32x4 v0 = acc[ai][bj][m][0], v1 = acc[ai][bj][m][1];
                    u32x2 o; o.x = pk4_fp8(v0[0], v0[1], v0[2], v0[3]); o.y = pk4_fp8(v1[0], v1[1], v1[2], v1[3]);
                    *(u32x2*)(rp + bj * 128) = o; } }
    }
};
template <int L>
__device__ __forceinline__ void moe_gateup_phase(Frame& F, const Args& a) {
    const int ntr = (int)F.ctl[CW_NT + L]; constexpr int s0 = (L == 3) ? 1 : 0; const int nsh = 65 - s0, nunits = (ntr + nsh) * 2;
    gg::Unit* tab = (gg::Unit*)(F.lds + LDS_TAB); LAS int* idx = (LAS int*)(F.lds + LDS_TAB + 512);
    const int* ROWTOK = (const int*)(a.ws + WS_ROWTOK); const int* TILEE = (const int*)(a.ws + WS_TILEE); const float* ROWW = (const float*)(a.ws + WS_ROWW);
    const char* Wgu = (const char*)(a.ws + WS_MOE + L * MOE_STRIDE + MOE_GU); const char* Wsh = (const char*)(a.ws + WS_MOE + L * MOE_STRIDE + MOE_SHGU);
    int nmine = 0;
    for (int i = 0; i < 8; ++i) { const int Lq = i * (int)gridDim.x + (int)blockIdx.x; if (Lq >= nunits) break; nmine = i + 1;
        int uidx; { const int q8 = nunits / 8, r8 = nunits % 8, xcd = Lq % 8, off = Lq / 8; uidx = (xcd < r8 ? xcd * (q8 + 1) : r8 * (q8 + 1) + (xcd - r8) * q8) + off; }
        const int tile = uidx >> 1, pn = uidx & 1; const bool routed = tile < ntr;
        const int rowtile = routed ? tile : (SH_BASE / 256 + s0 + (tile - ntr));
        if (F.tid == 0) { gg::Unit u; u.a = (const char*)(a.ws + WS_U); u.b = routed ? Wgu + ((size_t)TILEE[tile] * 512 + pn * 256) * 2048 : Wsh + (size_t)(pn * 256) * 2048; u.b2 = nullptr;
            u.pm = rowtile; u.pn = pn; u.gofs = LDS_TAB + 512 + i * 1024; u.x = 0; tab[i] = u; }
        if (F.tid < 256) { idx[i * 256 + F.tid] = ROWTOK[rowtile * 256 + F.tid]; ((LAS float*)(F.lds + LDS_TAB + 512 + 8192))[i * 256 + F.tid] = ROWW[rowtile * 256 + F.tid]; }
    }
    __syncthreads();
    ListSched S{(const LAS gg::Unit*)(F.lds + LDS_TAB), nmine}; EpiSwiglu E{(bf16_t*)(a.ws + WS_ACT), F.lds};
    gg::gemm_phase<EpiSwiglu, ListSched, true, false>(F.lds + LDS_STAGE, gg::Dims{1024, 1024, 1024, 0, 0}, S, E);
}
struct EpiFp8S {
    static constexpr bool PERM = true;
    unsigned char* O; LAS unsigned char* slab;
    __device__ __forceinline__ void operator()(const gg::Acc& acc, const gg::Unit& u, int wr, int wc, int fr, int fq) const {
        int t = threadIdx.x; asm volatile("" : "+v"(t));
        const int rrow = t >> 4, rchunk = t & 15;
#pragma unroll
        for (int ai = 0; ai < 2; ++ai)
#pragma unroll
            for (int m = 0; m < 4; ++m) { const int sidx = ai * 4 + m; LAS unsigned char* sb = slab + (sidx & 1) * (32 * 264);
#pragma unroll
                for (int bj = 0; bj < 2; ++bj) { const f32x4 v0 = acc[ai][bj][m][0], v1 = acc[ai][bj][m][1];
                    u32x2 o; o.x = pk4_fp8(v0[0], v0[1], v0[2], v0[3]); o.y = pk4_fp8(v1[0], v1[1], v1[2], v1[3]);
                    *(LAS u32x2*)(sb + (wr * 16 + fr) * 264 + wc * 32 + 8 * fq + bj * 128) = o; }
                __builtin_amdgcn_s_waitcnt(0xc07f); __builtin_amdgcn_s_barrier();
                const u32x4 v = { *(const LAS unsigned*)(sb + rrow * 264 + rchunk * 16), *(const LAS unsigned*)(sb + rrow * 264 + rchunk * 16 + 4), *(const LAS unsigned*)(sb + rrow * 264 + rchunk * 16 + 8), *(const LAS unsigned*)(sb + rrow * 264 + rchunk * 16 + 12) };
                const int grow = u.pm * 256 + (rrow >> 4) * 64 + (rrow & 15) + ai * 128 + m * 16;
                *(u32x4*)(O + (size_t)grow * 1024 + u.pn * 256 + rchunk * 16) = v; }
    }
};
template <int L, int MODE = 0>
__device__ __forceinline__ void moe_down_phase(Frame& F, const Args& a) {
    constexpr bool DRY = MODE == 1;
    const int ntr = (int)F.ctl[CW_NT + L]; constexpr int s0 = (L == 3) ? 1 : 0; const int nsh = 65 - s0, nunits = (ntr + nsh) * 4;
    gg::Unit* tab = (gg::Unit*)(F.lds + LDS_TAB);
    const int* TILEE = (const int*)(a.ws + WS_TILEE);
    const char* Wdn = (const char*)(a.ws + WS_MOE + L * MOE_STRIDE + MOE_DN); const char* Wsh = (const char*)(a.ws + WS_MOE + L * MOE_STRIDE + MOE_SHDN);
    int nmine = 0;
    for (int i = 0; i < 12; ++i) { const int Lq = i * (int)gridDim.x + (int)blockIdx.x; if (Lq >= nunits) break; nmine = i + 1;
        int uidx; { const int q8 = nunits / 8, r8 = nunits % 8, xcd = Lq % 8, off = Lq / 8; uidx = (xcd < r8 ? xcd * (q8 + 1) : r8 * (q8 + 1) + (xcd - r8) * q8) + off; }
        const int tile = uidx >> 2, pn = uidx & 3; const bool routed = tile < ntr;
        const int rowtile = routed ? tile : (SH_BASE / 256 + s0 + (tile - ntr));
        if (F.tid == 0) { gg::Unit u; u.a = (const char*)(a.ws + WS_ACT) + (size_t)rowtile * 256 * 512; u.b = routed ? Wdn + ((size_t)TILEE[tile] * 1024 + pn * 256) * 512 : Wsh + (size_t)(pn * 256) * 512; u.b2 = nullptr;
            u.pm = rowtile; u.pn = pn; u.gofs = 0; u.x = 0; tab[i] = u; }
    }
    __syncthreads();
    ListSched S{(const LAS gg::Unit*)(F.lds + LDS_TAB), nmine};
    if (MODE == 3 || MODE == 4) { EpiFp8S E{(unsigned char*)(a.ws + (MODE == 3 ? WS_DUMMY : WS_OUT)), F.lds + LDS_TAB + 2048};
        gg::gemm_phase<EpiFp8S, ListSched, false, false>(F.lds + LDS_STAGE, gg::Dims{256, 256, 256, 0, 0}, S, E); }
    else { EpiFp8 E{(unsigned char*)(a.ws + (MODE == 0 ? WS_OUT : WS_DUMMY)), DRY ? 63 : 0x7fffffff};
        gg::gemm_phase<EpiFp8, ListSched, false, false>(F.lds + LDS_STAGE, gg::Dims{256, 256, 256, 0, 0}, S, E); }
}

__device__ __forceinline__ int xcd_remap(int L, int n) { const int q8 = n / 8, r8 = n % 8, xcd = L % 8, off = L / 8; return (xcd < r8 ? xcd * (q8 + 1) : r8 * (q8 + 1) + (xcd - r8) * q8) + off; }
__device__ __forceinline__ float gelu_tanh(float x) { const float z = 0.7978845608028654f * (x + 0.044715f * x * x * x); return x * (1.0f - __builtin_amdgcn_rcpf(1.0f + __expf(2.0f * z))); }
struct EpiLruIn {
    static constexpr bool PERM = true;
    bf16_t* GB; bf16_t* RNN;
    __device__ __forceinline__ void operator()(const gg::Acc& acc, const gg::Unit& u, int wr, int wc, int fr, int fq) const {
        const bool isg = u.pn < 4; bf16_t* O = isg ? GB : RNN;
        const int row0 = u.pm * 256 + wr * 64 + fr, col0 = (u.pn & 3) * 256 + wc * 32 + 8 * fq;
#pragma unroll
        for (int ai = 0; ai < 2; ++ai)
#pragma unroll
            for (int m = 0; m < 4; ++m) { bf16_t* rp = O + (size_t)(row0 + ai * 128 + m * 16) * 1024 + col0;
#pragma unroll
                for (int bj = 0; bj < 2; ++bj) { f32x4 v0 = acc[ai][bj][m][0], v1 = acc[ai][bj][m][1];
                    if (isg) {
#pragma unroll
                        for (int e = 0; e < 4; ++e) { v0[e] = gelu_tanh(v0[e]); v1[e] = gelu_tanh(v1[e]); } }
                    u32x4 o; o.x = pk2(v0[0], v0[1]); o.y = pk2(v0[2], v0[3]); o.z = pk2(v1[0], v1[1]); o.w = pk2(v1[2], v1[3]);
                    *(u32x4*)(rp + bj * 128) = o; } }
    }
};
template <bool REV>
__device__ __forceinline__ void lru_scan16(const float (&a)[4], const float (&b)[4], float (&h)[4], float& hc, float& at, int lane) {
    const int q = lane >> 4;
    float Ar[4], Br[4]; float A = 1.0f, B = 0.0f;
#pragma unroll
    for (int ri = 0; ri < 4; ++ri) { const int r = REV ? 3 - ri : ri; B = a[r] * B + b[r]; A = a[r] * A; Ar[r] = A; Br[r] = B; }
    float As = A, Bs = B;
    { const float pA = REV ? __shfl_down(As, 16) : __shfl_up(As, 16), pB = REV ? __shfl_down(Bs, 16) : __shfl_up(Bs, 16); const bool on = REV ? (q <= 2) : (q >= 1); if (on) { Bs = As * pB + Bs; As = As * pA; } }
    { const float pA = REV ? __shfl_down(As, 32) : __shfl_up(As, 32), pB = REV ? __shfl_down(Bs, 32) : __shfl_up(Bs, 32); const bool on = REV ? (q <= 1) : (q >= 2); if (on) { Bs = As * pB + Bs; As = As * pA; } }
    float eA = REV ? __shfl_down(As, 16) : __shfl_up(As, 16), eB = REV ? __shfl_down(Bs, 16) : __shfl_up(Bs, 16);
    const bool first = REV ? (q == 3) : (q == 0); if (first) { eA = 1.0f; eB = 0.0f; }
    const float Hin = eA * hc + eB;
#pragma unroll
    for (int r = 0; r < 4; ++r) h[r] = Ar[r] * Hin + Br[r];
    const int src = (REV ? 0 : 48) + (lane & 15);
    const float tA = __shfl(As, src), tB = __shfl(Bs, src);
    hc = tA * hc + tB; at *= tA;
}
template <bool SUMMARY>
__device__ __forceinline__ void lru_scan_phase(Frame& F, const Args& a) {
    const bf16_t* RNN = (const bf16_t*)(a.ws + WS_MX1); const bf16_t* GB = (const bf16_t*)(a.ws + WS_MX0); bf16_t* A2 = (bf16_t*)(a.ws + WS_MX2);
    float* SUMM = (float*)(a.ws + WS_MX3); const float* CARRY = (const float*)(a.ws + WS_MX4);
    const bf16_t* Wg = (const bf16_t*)(a.ws + WS_W_LRU_GATE);
    const float* cw = a.in[9]; const float* cb = a.in[10]; const float* gbias = a.in[12]; const float* lam = a.in[13];
    LAS unsigned char* xt = F.lds + LDS_STAGE + F.wave * 17408;
    LAS unsigned char* ot = xt + 9216;
    const int lane = F.lane, c16 = lane & 15, q = lane >> 4, cg = lane & 7, rg = lane >> 3;
#pragma unroll 1
    for (int task = F.gw; task < (NTOK / 64) * 16; task += F.ngw) {
        const int k = task >> 4;
        const int t0 = 64 * k, slo = (k < 4) ? 0 : NCTX, shi = (k < 4) ? NCTX : NTOK;
        {
            const int blk = task & 15, ch0 = blk * 64;
            {
                float w[4][8], bsv[8];
#pragma unroll
                for (int e = 0; e < 8; ++e) { bsv[e] = cb[ch0 + 8 * cg + e];
#pragma unroll
                    for (int j = 0; j < 4; ++j) w[j][e] = cw[j * 1024 + ch0 + 8 * cg + e]; }
#pragma unroll 1
                for (int ps = 0; ps < 2; ++ps) {
                    const int rq = rg + 8 * ps;
                    float xin[7][8];
#pragma unroll
                    for (int rr = 0; rr < 7; ++rr) { const int t = t0 + 4 * rq - 1 + rr; u32x4 v = {0u, 0u, 0u, 0u};
                        if (t >= slo && t < shi) v = *(const u32x4*)(RNN + (size_t)t * 1024 + ch0 + 8 * cg);
                        xin[rr][0] = bflo(v.x); xin[rr][1] = bfhi(v.x); xin[rr][2] = bflo(v.y); xin[rr][3] = bfhi(v.y); xin[rr][4] = bflo(v.z); xin[rr][5] = bfhi(v.z); xin[rr][6] = bflo(v.w); xin[rr][7] = bfhi(v.w); }
#pragma unroll
                    for (int r = 0; r < 4; ++r) { float o[8];
#pragma unroll
                        for (int e = 0; e < 8; ++e) o[e] = bsv[e] + w[0][e] * xin[r][e] + w[1][e] * xin[r + 1][e] + w[2][e] * xin[r + 2][e] + w[3][e] * xin[r + 3][e];
                        u32x4 pk; pk.x = pk2(o[0], o[1]); pk.y = pk2(o[2], o[3]); pk.z = pk2(o[4], o[5]); pk.w = pk2(o[6], o[7]);
                        *(LAS u32x4*)(xt + (4 * rq + r) * 144 + 16 * cg) = pk; }
                }
            }
            asm volatile("s_waitcnt lgkmcnt(0)" ::: "memory");
            bf16x8 Af[4][2];
#pragma unroll
            for (int T = 0; T < 4; ++T)
#pragma unroll
                for (int ks = 0; ks < 2; ++ks) Af[T][ks] = *(const LAS bf16x8*)(xt + (16 * T + c16) * 144 + (32 * ks + 8 * q) * 2);
#pragma unroll
            for (int g4 = 0; g4 < 4; ++g4) {
                const int ch = ch0 + 16 * g4 + c16;
                float xv[4][4];
#pragma unroll
                for (int T = 0; T < 4; ++T)
#pragma unroll
                    for (int r = 0; r < 4; ++r) xv[T][r] = bf2f(*(const LAS unsigned short*)(xt + (16 * T + 4 * q + r) * 144 + (16 * g4 + c16) * 2));
                float hsum[4][4];
#pragma unroll
                for (int d = 0; d < 2; ++d) {
                    f32x4 acc[2][4];
#pragma unroll
                    for (int gt = 0; gt < 2; ++gt) {
                        const bf16_t* wp = Wg + ((size_t)((d * 2 + gt) * 16 + blk) * 64 + 16 * g4 + c16) * 64 + 8 * q;
                        const bf16x8 b0 = *(const bf16x8*)wp, b1 = *(const bf16x8*)(wp + 32);
#pragma unroll
                        for (int T = 0; T < 4; ++T) { f32x4 z = {0.f, 0.f, 0.f, 0.f};
                            z = __builtin_amdgcn_mfma_f32_16x16x32_bf16(Af[T][0], b0, z, 0, 0, 0);
                            acc[gt][T] = __builtin_amdgcn_mfma_f32_16x16x32_bf16(Af[T][1], b1, z, 0, 0, 0); }
                    }
                    const float gb0 = gbias[(d * 2 + 0) * 1024 + ch], gb1 = gbias[(d * 2 + 1) * 1024 + ch];
                    const float lm = lam[d * 1024 + ch]; const float sp = log1pf(__expf(-lm));
                    float hc = 0.0f, at = 1.0f;
                    if (!SUMMARY) hc = CARRY[((size_t)d * 260 + k) * 1024 + ch];
#pragma unroll
                    for (int Ti = 0; Ti < 4; ++Ti) {
                        const int T = d ? 3 - Ti : Ti;
                        float av[4], bv[4], hv[4];
#pragma unroll
                        for (int r = 0; r < 4; ++r) { const float rgate = sigmoidf_(acc[0][T][r] + gb0), ig = sigmoidf_(acc[1][T][r] + gb1);
                            const float la = -8.0f * rgate * sp; const float aa = __expf(la); av[r] = aa; bv[r] = __builtin_amdgcn_sqrtf(fmaxf(1.0f - aa * aa, 0.f)) * ig * xv[T][r]; }
                        if (d == 0) lru_scan16<false>(av, bv, hv, hc, at, lane); else lru_scan16<true>(av, bv, hv, hc, at, lane);
                        if (!SUMMARY) {
#pragma unroll
                            for (int r = 0; r < 4; ++r) hsum[T][r] = (d == 0) ? hv[r] : hsum[T][r] + hv[r]; }
                    }
                    if (SUMMARY) { if (q == 0) { SUMM[((size_t)d * 260 + k) * 1024 + ch] = at; SUMM[((size_t)(2 + d) * 260 + k) * 1024 + ch] = hc; } }
                }
                if (!SUMMARY) {
#pragma unroll
                    for (int T = 0; T < 4; ++T)
#pragma unroll
                        for (int r = 0; r < 4; ++r) *(LAS unsigned short*)(ot + (16 * T + 4 * q + r) * 128 + (16 * g4 + c16) * 2) = (unsigned short)f2bf(hsum[T][r]);
                }
            }
            if (!SUMMARY) {
                asm volatile("s_waitcnt lgkmcnt(0)" ::: "memory");
#pragma unroll
                for (int r = 0; r < 8; ++r) { const int row = 8 * rg + r; const u32x4 hv = *(const LAS u32x4*)(ot + row * 128 + 16 * cg);
                    const u32x4 gv = *(const u32x4*)(GB + (size_t)(t0 + row) * 1024 + ch0 + 8 * cg);
                    u32x4 o; o.x = pk2(bflo(hv.x) * bflo(gv.x), bfhi(hv.x) * bfhi(gv.x)); o.y = pk2(bflo(hv.y) * bflo(gv.y), bfhi(hv.y) * bfhi(gv.y));
                    o.z = pk2(bflo(hv.z) * bflo(gv.z), bfhi(hv.z) * bfhi(gv.z)); o.w = pk2(bflo(hv.w) * bflo(gv.w), bfhi(hv.w) * bfhi(gv.w));
                    *(u32x4*)(A2 + (size_t)(t0 + row) * 1024 + ch0 + 8 * cg) = o; }
            }
            asm volatile("s_waitcnt lgkmcnt(0)" ::: "memory");
        }
    }
}
__device__ __forceinline__ void lru_carry_phase(Frame& F, const Args& a) {
    const float* SUMM = (const float*)(a.ws + WS_MX3); float* CARRY = (float*)(a.ws + WS_MX4);
    const int gid = blockIdx.x * NTHREADS + F.tid; if (gid >= 2048) return;
    const int d = gid >> 10, c = gid & 1023; float h = 0.0f;
    const float* At = SUMM + (size_t)d * 260 * 1024 + c; const float* He = SUMM + (size_t)(2 + d) * 260 * 1024 + c; float* Cy = CARRY + (size_t)d * 260 * 1024 + c;
#pragma unroll 1
    for (int b = 0; b < 10; ++b) {
        float av[26], hv[26]; int kk[26];
#pragma unroll
        for (int j = 0; j < 26; ++j) { const int st = b * 26 + j; kk[j] = d == 0 ? st : (st < 4 ? 3 - st : 263 - st); av[j] = At[(size_t)kk[j] * 1024]; hv[j] = He[(size_t)kk[j] * 1024]; }
#pragma unroll
        for (int j = 0; j < 26; ++j) { Cy[(size_t)kk[j] * 1024] = h; h = av[j] * h + hv[j]; }
    }
}
__device__ __forceinline__ void lru_in_gemm_phase(Frame& F, const Args& a) {
    gg::DenseSched S; S.init((const bf16_t*)(a.ws + WS_U), (const bf16_t*)(a.ws + WS_W_LRU_IN), NTOK, 2048, 1024, 1024);
    EpiLruIn E{(bf16_t*)(a.ws + WS_MX0), (bf16_t*)(a.ws + WS_MX1)};
    gg::gemm_phase<EpiLruIn, gg::DenseSched, false, false>(F.lds + LDS_STAGE, gg::Dims{1024, 1024, 1024, 0, 0}, S, E);
}
__device__ __forceinline__ void dense_gemm_bf16(Frame& F, const bf16_t* A, const bf16_t* Bt, bf16_t* O, int M, int N, int K) {
    gg::DenseSched S; S.init(A, Bt, M, N, K, K);
    EpiBf16 E{O, N};
    gg::gemm_phase<EpiBf16, gg::DenseSched, false, false>(F.lds + LDS_STAGE, gg::Dims{K, K, K, 0, 0}, S, E);
}

constexpr size_t RT_QR = WS_SCR, RT_KR = WS_SCR + 33 * MiB, RT_V = WS_SCR + 66 * MiB, RT_SG = WS_SCR + 132 * MiB, RT_ACAT = WS_SCR + 198 * MiB, RT_KTD = WS_SCR + 301 * MiB,
                 RT_VT = WS_SCR + 367 * MiB, RT_ST = WS_SCR + 433 * MiB, RT_O = WS_SCR + 564 * MiB, RT_A3 = RT_V, RT_END = WS_SCR + 630 * MiB;
constexpr int NBLK = NTOK / 256;
struct EpiBf16X {
    static constexpr bool PERM = true;
    bf16_t* O; int ldc;
    __device__ __forceinline__ void operator()(const gg::Acc& acc, const gg::Unit& u, int wr, int wc, int fr, int fq) const {
#pragma unroll
        for (int ai = 0; ai < 2; ++ai)
#pragma unroll
            for (int m = 0; m < 4; ++m) { bf16_t* rp = O + (size_t)(unsigned)u.x + (size_t)(ai * 128 + wr * 64 + m * 16 + fr) * ldc + wc * 32 + 8 * fq;
#pragma unroll
                for (int bj = 0; bj < 2; ++bj) { const f32x4 v0 = acc[ai][bj][m][0], v1 = acc[ai][bj][m][1];
                    u32x4 o; o.x = pk2(v0[0], v0[1]); o.y = pk2(v0[2], v0[3]); o.z = pk2(v1[0], v1[1]); o.w = pk2(v1[2], v1[3]);
                    *(u32x4*)(rp + bj * 128) = o; } }
    }
};
__device__ __forceinline__ float log_sigmoid(float x) { return -(fmaxf(-x, 0.f) + log1pf(__expf(-fabsf(x)))); }
struct EpiRetIn {
    static constexpr bool PERM = true;
    bf16_t *QR, *KR, *V, *SG, *ACAT; const float* rope; const float* decay;
    __device__ __forceinline__ void operator()(const gg::Acc& acc, const gg::Unit& u, int wr, int wc, int fr, int fq) const {
        const int pn = u.pn, row0 = u.pm * 256 + wr * 64 + fr, cx = wc * 32 + 8 * fq;
        if (pn < 8) {
            const int h = pn & 3; const bool isq = pn < 4;
            const float lg0 = log_sigmoid(decay[h]), lg1 = log_sigmoid(decay[4 + h]);
#pragma unroll
            for (int ai = 0; ai < 2; ++ai)
#pragma unroll
                for (int m = 0; m < 4; ++m) {
                    const int row = row0 + ai * 128 + m * 16, i = row & 255, b = row >> 8;
                    f32x4 lo[2] = {acc[ai][0][m][0], acc[ai][0][m][1]}, hi[2] = {acc[ai][1][m][0], acc[ai][1][m][1]};
                    if (row >= NCTX) {
                        const int tl = row - NCTX, pp = (wc < 2) ? (tl >> 6) : (tl & 63), i0 = (wc & 1) * 32 + 8 * fq;
                        const float* cp = rope + pp * 64 + i0; const float* sp = cp + 256 * 64;
#pragma unroll
                        for (int n = 0; n < 2; ++n) { const f32x4 c = *(const f32x4*)(cp + 4 * n), sn = *(const f32x4*)(sp + 4 * n);
                            const f32x4 l2 = lo[n] * c - hi[n] * sn, h2 = hi[n] * c + lo[n] * sn; lo[n] = l2; hi[n] = h2; }
                    }
                    if (isq) {
                        u32x4 o; o.x = pk2(lo[0][0], lo[0][1]); o.y = pk2(lo[0][2], lo[0][3]); o.z = pk2(lo[1][0], lo[1][1]); o.w = pk2(lo[1][2], lo[1][3]);
                        *(u32x4*)(QR + (size_t)row * 1024 + h * 256 + cx) = o;
                        o.x = pk2(hi[0][0], hi[0][1]); o.y = pk2(hi[0][2], hi[0][3]); o.z = pk2(hi[1][0], hi[1][1]); o.w = pk2(hi[1][2], hi[1][3]);
                        *(u32x4*)(QR + (size_t)row * 1024 + h * 256 + 128 + cx) = o;
                        bf16_t* ac = ACAT + ((size_t)(b * 4 + h) * 256 + i) * 768 + 256 + cx;
#pragma unroll
                        for (int d = 0; d < 2; ++d) { const float f = d ? __expf((float)(256 - i) * lg1) : __expf((float)(i + 1) * lg0);
                            o.x = pk2(lo[0][0] * f, lo[0][1] * f); o.y = pk2(lo[0][2] * f, lo[0][3] * f); o.z = pk2(lo[1][0] * f, lo[1][1] * f); o.w = pk2(lo[1][2] * f, lo[1][3] * f);
                            *(u32x4*)(ac + d * 256) = o;
                            o.x = pk2(hi[0][0] * f, hi[0][1] * f); o.y = pk2(hi[0][2] * f, hi[0][3] * f); o.z = pk2(hi[1][0] * f, hi[1][1] * f); o.w = pk2(hi[1][2] * f, hi[1][3] * f);
                            *(u32x4*)(ac + d * 256 + 128) = o; }
                    } else {
                        const float f = 0.0625f;
                        u32x4 o; o.x = pk2(lo[0][0] * f, lo[0][1] * f); o.y = pk2(lo[0][2] * f, lo[0][3] * f); o.z = pk2(lo[1][0] * f, lo[1][1] * f); o.w = pk2(lo[1][2] * f, lo[1][3] * f);
                        *(u32x4*)(KR + (size_t)row * 1024 + h * 256 + cx) = o;
                        o.x = pk2(hi[0][0] * f, hi[0][1] * f); o.y = pk2(hi[0][2] * f, hi[0][3] * f); o.z = pk2(hi[1][0] * f, hi[1][1] * f); o.w = pk2(hi[1][2] * f, hi[1][3] * f);
                        *(u32x4*)(KR + (size_t)row * 1024 + h * 256 + 128 + cx) = o;
                    }
                }
        } else {
            const bool isv = pn < 16; bf16_t* O = isv ? V : SG; const int col0 = ((pn - 8) & 7) * 256 + cx;
#pragma unroll
            for (int ai = 0; ai < 2; ++ai)
#pragma unroll
                for (int m = 0; m < 4; ++m) { bf16_t* rp = O + (size_t)(row0 + ai * 128 + m * 16) * 2048 + col0;
#pragma unroll
                    for (int bj = 0; bj < 2; ++bj) { f32x4 v0 = acc[ai][bj][m][0], v1 = acc[ai][bj][m][1];
                        if (!isv) {
#pragma unroll
                            for (int e = 0; e < 4; ++e) { v0[e] = siluf_(v0[e]); v1[e] = siluf_(v1[e]); } }
                        u32x4 o; o.x = pk2(v0[0], v0[1]); o.y = pk2(v0[2], v0[3]); o.z = pk2(v1[0], v1[1]); o.w = pk2(v1[2], v1[3]);
                        *(u32x4*)(rp + bj * 128) = o; } }
        }
    }
};
__device__ __forceinline__ void ret_in_gemm_phase(Frame& F, const Args& a) {
    gg::DenseSched S; S.init((const bf16_t*)(a.ws + WS_U), (const bf16_t*)(a.ws + WS_W_RET_IN), NTOK, 6144, 1024, 1024);
    EpiRetIn E{(bf16_t*)(a.ws + RT_QR), (bf16_t*)(a.ws + RT_KR), (bf16_t*)(a.ws + RT_V), (bf16_t*)(a.ws + RT_SG), (bf16_t*)(a.ws + RT_ACAT), (const float*)(a.ws + WS_ROPE), a.in[32]};
    gg::gemm_phase<EpiRetIn, gg::DenseSched, false, false>(F.lds + LDS_STAGE, gg::Dims{1024, 1024, 1024, 0, 0}, S, E);
}
__device__ __forceinline__ void tr64_bf16(const bf16_t* src, int ld_src, bf16_t* dst, int ld_dst, LAS unsigned char* scr, int lane, float lgam, int mode, int t0) {
    const int cg = lane & 7, rg = lane >> 3;
#pragma unroll
    for (int k = 0; k < 8; ++k) { const int t = rg + 8 * k; const u32x4 v = *(const u32x4*)(src + (size_t)t * ld_src + 8 * cg);
        float f = 1.0f; if (mode) { const int i = (t0 + t) & 255; f = __expf((float)(mode == 1 ? 255 - i : i) * lgam); }
        const unsigned w[4] = {v.x, v.y, v.z, v.w};
#pragma unroll
        for (int e = 0; e < 4; ++e) { *(LAS unsigned short*)(scr + (8 * cg + 2 * e) * 144 + t * 2) = (unsigned short)f2bf(bflo(w[e]) * f); *(LAS unsigned short*)(scr + (8 * cg + 2 * e + 1) * 144 + t * 2) = (unsigned short)f2bf(bfhi(w[e]) * f); } }
    asm volatile("s_waitcnt lgkmcnt(0)" ::: "memory");
#pragma unroll
    for (int k = 0; k < 8; ++k) { const int c = rg + 8 * k; const u32x4 v = *(const LAS u32x4*)(scr + c * 144 + 16 * cg); *(u32x4*)(dst + (size_t)c * ld_dst + 8 * cg) = v; }
    asm volatile("s_waitcnt lgkmcnt(0)" ::: "memory");
}
__device__ __forceinline__ void ret_transpose_phase(Frame& F, const Args& a) {
    const bf16_t* KR = (const bf16_t*)(a.ws + RT_KR); const bf16_t* V = (const bf16_t*)(a.ws + RT_V); bf16_t* KTD = (bf16_t*)(a.ws + RT_KTD); bf16_t* VT = (bf16_t*)(a.ws + RT_VT);
    LAS unsigned char* scr = F.lds + LDS_STAGE + F.wave * 9216;
    const float* decay = a.in[32];
    constexpr int NT = NTOK / 64;
    for (int it = F.gw; it < NT * (32 + 32); it += F.ngw) {
        const int tt = it % NT, cc = it / NT, t0 = tt * 64;
        if (cc < 32) { const int d = cc >> 4, c0 = (cc & 15) * 64, h = c0 >> 8; const float lg = log_sigmoid(decay[d * 4 + h]);
            tr64_bf16(KR + (size_t)t0 * 1024 + c0, 1024, KTD + ((size_t)d * 1024 + c0) * NTOK + t0, NTOK, scr, F.lane, lg, d ? 2 : 1, t0); }
        else { const int c0 = (cc - 32) * 64; tr64_bf16(V + (size_t)t0 * 2048 + c0, 2048, VT + (size_t)c0 * NTOK + t0, NTOK, scr, F.lane, 0.f, 0, t0); }
    }
}
struct RetKvSched {
    const char* VT; const char* KTD; int G, c;
    __device__ __forceinline__ bool next(int i, gg::Unit& u) const {
        const int L0 = i * G + c; if (L0 >= NBLK * 16) return false; const int L = xcd_remap(L0, NBLK * 16);
        const int dvt = L & 1, d = (L >> 1) & 1, h = (L >> 2) & 3, b = L >> 4;
        u.a = VT + ((size_t)(512 * h + 256 * dvt) * NTOK + 256 * b) * 2; u.b = KTD + ((size_t)(d * 1024 + 256 * h) * NTOK + 256 * b) * 2; u.b2 = nullptr;
        u.pm = 0; u.pn = 0; u.gofs = 0; u.x = ((b * 4 + h) * 512 + 256 * dvt) * 512 + 256 * d; return true; }
};
__device__ __forceinline__ void ret_kv_phase(Frame& F, const Args& a) {
    RetKvSched S{(const char*)(a.ws + RT_VT), (const char*)(a.ws + RT_KTD), (int)gridDim.x, (int)blockIdx.x};
    EpiBf16X E{(bf16_t*)(a.ws + RT_ST), 512};
    gg::gemm_phase<EpiBf16X, RetKvSched, false, false>(F.lds + LDS_STAGE, gg::Dims{256, NTOK, NTOK, 0, 0}, S, E);
}
template <bool DRY = false>
__device__ __forceinline__ void ret_prefix_phase(Frame& F, const Args& a) {
    bf16_t* ST = (bf16_t*)(a.ws + (DRY ? WS_DUMMY : RT_ST)); const float* decay = a.in[32];
    for (int gid = blockIdx.x * NTHREADS + F.tid; gid < 4 * 512 * 2 * 32; gid += gridDim.x * NTHREADS) {
        const int dk8 = gid & 31, d = (gid >> 5) & 1, dv = (gid >> 6) & 511, h = gid >> 15;
        const float gb = __expf(256.0f * log_sigmoid(decay[d * 4 + h]));
        float s[8];
#pragma unroll
        for (int e = 0; e < 8; ++e) s[e] = 0.f;
#define RT_BLK(st_) (((d == 0) || (st_) == 0) ? (st_) : (NBLK - (st_)))
#define RT_PTR(st_) ((u32x4*)(ST + ((size_t)(RT_BLK(st_) * 4 + h) * 512 + dv) * 512 + d * 256 + 8 * dk8))
        u32x4 kb[4];
#pragma unroll
        for (int j = 0; j < 4; ++j) kb[j] = *RT_PTR(j);
#pragma unroll 1
        for (int base = 0; base < 68; base += 4) {
#pragma unroll
            for (int j = 0; j < 4; ++j) { const int step = base + j; if (step < NBLK) {
                u32x4* p = RT_PTR(step); const u32x4 kv = kb[j];
                if (step + 4 < NBLK) kb[j] = *RT_PTR(step + 4);
                u32x4 o; o.x = pk2(s[0], s[1]); o.y = pk2(s[2], s[3]); o.z = pk2(s[4], s[5]); o.w = pk2(s[6], s[7]); *p = o;
                s[0] = s[0] * gb + bflo(kv.x); s[1] = s[1] * gb + bfhi(kv.x); s[2] = s[2] * gb + bflo(kv.y); s[3] = s[3] * gb + bfhi(kv.y);
                s[4] = s[4] * gb + bflo(kv.z); s[5] = s[5] * gb + bfhi(kv.z); s[6] = s[6] * gb + bflo(kv.w); s[7] = s[7] * gb + bfhi(kv.w); } }
        }
#undef RT_BLK
#undef RT_PTR
    }
    bf16_t* ACAT = (bf16_t*)(a.ws + (DRY ? WS_DUMMY + 140 * MiB : RT_ACAT));
    for (int gid = blockIdx.x * NTHREADS + F.tid; gid < NBLK * 4 * 256 * 32; gid += gridDim.x * NTHREADS) {
        const int j0 = (gid & 31) * 8, i = (gid >> 5) & 255, bh = gid >> 13, h = bh & 3;
        const float lg0 = log_sigmoid(decay[h]), lg1 = log_sigmoid(decay[4 + h]);
        u32x4* p = (u32x4*)(ACAT + ((size_t)bh * 256 + i) * 768 + j0);
        const u32x4 v = *p; const unsigned w[4] = {v.x, v.y, v.z, v.w}; unsigned o[4];
#pragma unroll
        for (int e = 0; e < 4; ++e) { const int ja = j0 + 2 * e, jb = ja + 1;
            const float wa = ((i >= ja) ? __expf((float)(i - ja) * lg0) : 0.f) + ((ja >= i) ? __expf((float)(ja - i) * lg1) : 0.f);
            const float wb = ((i >= jb) ? __expf((float)(i - jb) * lg0) : 0.f) + ((jb >= i) ? __expf((float)(jb - i) * lg1) : 0.f);
            o[e] = pk2(bflo(w[e]) * wa, bfhi(w[e]) * wb); }
        *p = (u32x4){o[0], o[1], o[2], o[3]};
    }
}
struct RetPSched {
    const char* QR; const char* KR; int G, c;
    __device__ __forceinline__ bool next(int i, gg::Unit& u) const {
        const int L0 = i * G + c; if (L0 >= NBLK * 4) return false; const int L = xcd_remap(L0, NBLK * 4);
        const int h = L & 3, b = L >> 2;
        u.a = QR + ((size_t)256 * b * 1024 + 256 * h) * 2; u.b = KR + ((size_t)256 * b * 1024 + 256 * h) * 2; u.b2 = nullptr;
        u.pm = b; u.pn = h; u.gofs = 0; u.x = (b * 4 + h) * 256 * 768; return true; }
};
__device__ __forceinline__ void ret_p_phase(Frame& F, const Args& a) {
    RetPSched S{(const char*)(a.ws + RT_QR), (const char*)(a.ws + RT_KR), (int)gridDim.x, (int)blockIdx.x};
    EpiBf16X E{(bf16_t*)(a.ws + RT_ACAT), 768};
    gg::gemm_phase<EpiBf16X, RetPSched, false, false>(F.lds + LDS_STAGE, gg::Dims{256, 1024, 1024, 0, 0}, S, E);
}
struct RetOSched {
    const char* ACAT; const char* VT; const char* ST; int G, c;
    __device__ __forceinline__ bool next(int i, gg::Unit& u) const {
        const int L0 = i * G + c; if (L0 >= NBLK * 8) return false; const int L = xcd_remap(L0, NBLK * 8);
        const int dvt = L & 1, h = (L >> 1) & 3, b = L >> 3;
        u.a = ACAT + (size_t)(b * 4 + h) * 256 * 768 * 2; u.b = VT + ((size_t)(512 * h + 256 * dvt) * NTOK + 256 * b) * 2; u.b2 = ST + ((size_t)((b * 4 + h) * 512 + 256 * dvt) * 512) * 2;
        u.pm = 0; u.pn = 0; u.gofs = 0; u.x = 256 * b * 2048 + 512 * h + 256 * dvt; return true; }
};
__device__ __forceinline__ void ret_o_phase(Frame& F, const Args& a) {
    RetOSched S{(const char*)(a.ws + RT_ACAT), (const char*)(a.ws + RT_VT), (const char*)(a.ws + RT_ST), (int)gridDim.x, (int)blockIdx.x};
    EpiBf16X E{(bf16_t*)(a.ws + RT_O), 2048};
    gg::gemm_phase<EpiBf16X, RetOSched, false, true>(F.lds + LDS_STAGE, gg::Dims{768, 768, NTOK, 4, 512}, S, E);
}
__device__ __forceinline__ void ret_readout_phase(Frame& F, const Args& a) {
    const bf16_t* O = (const bf16_t*)(a.ws + RT_O); const bf16_t* SG = (const bf16_t*)(a.ws + RT_SG); bf16_t* A3 = (bf16_t*)(a.ws + RT_A3);
    const float* gg_ = a.in[33]; const float* gb_ = a.in[34];
    const int lane = F.lane;
    for (int t = F.gw; t < NTOK; t += F.ngw) {
        float v[32]; float s = 0.f;
#pragma unroll
        for (int k = 0; k < 4; ++k) { const u32x4 w = *(const u32x4*)(O + (size_t)t * 2048 + 32 * lane + 8 * k);
            v[8 * k] = bflo(w.x); v[8 * k + 1] = bfhi(w.x); v[8 * k + 2] = bflo(w.y); v[8 * k + 3] = bfhi(w.y); v[8 * k + 4] = bflo(w.z); v[8 * k + 5] = bfhi(w.z); v[8 * k + 6] = bflo(w.w); v[8 * k + 7] = bfhi(w.w); }
#pragma unroll
        for (int e = 0; e < 32; ++e) s += v[e];
#pragma unroll
        for (int o = 1; o < 16; o <<= 1) s += __shfl_xor(s, o);
        const float mean = s * (1.0f / 512.0f); float q = 0.f;
#pragma unroll
        for (int e = 0; e < 32; ++e) { v[e] -= mean; q += v[e] * v[e]; }
#pragma unroll
        for (int o = 1; o < 16; o <<= 1) q += __shfl_xor(q, o);
        const float rstd = 1.0f / sqrtf(q * (1.0f / 512.0f) + LN_EPS);
#pragma unroll
        for (int k = 0; k < 4; ++k) { const u32x4 g = *(const u32x4*)(SG + (size_t)t * 2048 + 32 * lane + 8 * k); const unsigned gw[4] = {g.x, g.y, g.z, g.w}; unsigned ow[4];
#pragma unroll
            for (int e = 0; e < 4; ++e) { const int c = 32 * lane + 8 * k + 2 * e;
                const float y0 = (v[8 * k + 2 * e] * rstd * gg_[c] + gb_[c]) * bflo(gw[e]), y1 = (v[8 * k + 2 * e + 1] * rstd * gg_[c + 1] + gb_[c + 1]) * bfhi(gw[e]); ow[e] = pk2(y0, y1); }
            *(u32x4*)(A3 + (size_t)t * 2048 + 32 * lane + 8 * k) = (u32x4){ow[0], ow[1], ow[2], ow[3]}; }
    }
}

constexpr size_t HG_Q = WS_SCR, HG_F = WS_SCR + 33 * MiB, HG_V = WS_SCR + 99 * MiB, HG_G = WS_SCR + 132 * MiB, HG_O = WS_SCR + 165 * MiB, HG_S = WS_SCR + 231 * MiB, HG_D = WS_SCR + 297 * MiB, HG_A4 = HG_Q;
struct EpiHgrnIn {
    static constexpr bool PERM = true;
    bf16_t *Q, *Fp, *V, *G;
    __device__ __forceinline__ void operator()(const gg::Acc& acc, const gg::Unit& u, int wr, int wc, int fr, int fq) const {
        const int grp = u.pn >> 2; const bool act = (grp == 0 || grp == 4);
        bf16_t* O = grp == 0 ? Q : grp == 1 ? Fp : grp == 2 ? Fp + (size_t)NTOK * 1024 : grp == 3 ? V : G;
        const int row0 = u.pm * 256 + wr * 64 + fr, col0 = (u.pn & 3) * 256 + wc * 32 + 8 * fq;
#pragma unroll
        for (int ai = 0; ai < 2; ++ai)
#pragma unroll
            for (int m = 0; m < 4; ++m) { bf16_t* rp = O + (size_t)(row0 + ai * 128 + m * 16) * 1024 + col0;
#pragma unroll
                for (int bj = 0; bj < 2; ++bj) { f32x4 v0 = acc[ai][bj][m][0], v1 = acc[ai][bj][m][1];
                    if (act) {
#pragma unroll
                        for (int e = 0; e < 4; ++e) { v0[e] = siluf_(v0[e]); v1[e] = siluf_(v1[e]); } }
                    u32x4 o; o.x = pk2(v0[0], v0[1]); o.y = pk2(v0[2], v0[3]); o.z = pk2(v1[0], v1[1]); o.w = pk2(v1[2], v1[3]);
                    *(u32x4*)(rp + bj * 128) = o; } }
    }
};
__device__ __forceinline__ void hgrn_in_gemm_phase(Frame& F, const Args& a) {
    gg::DenseSched S; S.init((const bf16_t*)(a.ws + WS_U), (const bf16_t*)(a.ws + WS_W_HGRN_IN), NTOK, 5120, 1024, 1024);
    EpiHgrnIn E{(bf16_t*)(a.ws + HG_Q), (bf16_t*)(a.ws + HG_F), (bf16_t*)(a.ws + HG_V), (bf16_t*)(a.ws + HG_G)};
    gg::gemm_phase<EpiHgrnIn, gg::DenseSched, false, false>(F.lds + LDS_STAGE, gg::Dims{1024, 1024, 1024, 0, 0}, S, E);
}
typedef short v4s16 __attribute__((ext_vector_type(4)));
__device__ __forceinline__ bf16x8 lds_tr_frag(LAS unsigned char* tile, int stride, int r0, int c0, int lane) {
    const int g = lane >> 4, qq = (lane & 15) >> 2, p = lane & 3;
    LAS unsigned char* a0 = tile + (r0 + 8 * g + qq) * stride + (c0 + 4 * p) * 2;
    const v4s16 x = __builtin_amdgcn_ds_read_tr16_b64_v4i16((LAS v4s16*)a0), y = __builtin_amdgcn_ds_read_tr16_b64_v4i16((LAS v4s16*)(a0 + 4 * stride));
    return (bf16x8){x[0], x[1], x[2], x[3], y[0], y[1], y[2], y[3]};
}
__device__ __forceinline__ bf16x8 lds_row_frag(LAS unsigned char* tile, int stride, int row, int k0) { return *(const LAS bf16x8*)(tile + row * stride + k0 * 2); }
constexpr int HS = 272, HPS = 144;
template <int PASS>
__device__ __forceinline__ void hgrn_chunk_phase(Frame& F, const Args& a) {
    const bf16_t* Qb = (const bf16_t*)(a.ws + HG_Q); const bf16_t* Fb = (const bf16_t*)(a.ws + HG_F); const bf16_t* Vb = (const bf16_t*)(a.ws + HG_V);
    bf16_t* Ob = (bf16_t*)(a.ws + HG_O); float* Sb = (float*)(a.ws + HG_S); float* Db = (float*)(a.ws + HG_D);
    const float* LBV = (const float*)(a.ws + WS_LBV); const float* bfp = a.in[37];
    LAS unsigned char* QH = F.lds + LDS_STAGE; LAS unsigned char* KH = QH + 17408; LAS unsigned char* KB = QH + 34816; LAS unsigned char* VV = QH + 52224;
    LAS unsigned char* PP = QH + 69632; LAS unsigned char* SS = QH + 78848; LAS float* DEC = (LAS float*)(QH + 113664); LAS float* TOT = (LAS float*)(QH + 114176);
    const int tid = F.tid, lane = F.lane, w = F.wave, k = tid & 127, tg = tid >> 7, c16 = lane & 15, q4 = lane >> 4;
    const int lrow = tid >> 3, c8 = tid & 7;
    u32x4 rF[2], rV[2], rQ[2];
#define HG_ISSUE(unit_, bi_) do { const int d_ = (unit_) & 1, h_ = ((unit_) >> 1) & 7, seg_ = (unit_) >> 4; const int tr_ = (seg_ * 4 + (d_ ? 3 - (bi_) : (bi_))) * 64; \
        const size_t o_ = (size_t)(tr_ + (d_ ? 63 - lrow : lrow)) * 1024 + h_ * 128 + 8 * c8; const bf16_t* Fd_ = Fb + (size_t)d_ * NTOK * 1024; \
        rF[0] = *(const u32x4*)(Fd_ + o_); rF[1] = *(const u32x4*)(Fd_ + o_ + 64); rV[0] = *(const u32x4*)(Vb + o_); rV[1] = *(const u32x4*)(Vb + o_ + 64); \
        if (PASS) { rQ[0] = *(const u32x4*)(Qb + o_); rQ[1] = *(const u32x4*)(Qb + o_ + 64); } } while (0)
    if ((int)blockIdx.x < 65 * 16) HG_ISSUE((int)blockIdx.x, 0);
#pragma unroll 1
    for (int unit = blockIdx.x; unit < 65 * 16; unit += gridDim.x) {
        const int d = unit & 1, h = (unit >> 1) & 7, seg = unit >> 4, ch = h * 128 + k;
        const float lbv = LBV[ch], bfv = bfp[d * 1024 + ch];
        const bf16_t* Fd = Fb + (size_t)d * NTOK * 1024;
        f32x4 accS[8]; float dseg = 1.0f;
        float* Su = Sb + (size_t)unit * 16384;
#pragma unroll
        for (int kt = 0; kt < 8; ++kt)
#pragma unroll
            for (int r = 0; r < 4; ++r) accS[kt][r] = PASS ? Su[(16 * kt + 4 * q4 + r) * 128 + 16 * w + c16] : 0.f;
        if (PASS) {
#pragma unroll
            for (int kt = 0; kt < 8; ++kt)
#pragma unroll
                for (int r = 0; r < 4; ++r) *(LAS unsigned short*)(SS + (16 * kt + 4 * q4 + r) * HS + (16 * w + c16) * 2) = (unsigned short)f2bf(accS[kt][r]);
        }
#pragma unroll 1
        for (int bi = 0; bi < 4; ++bi) {
            const int trow0 = (seg * 4 + (d ? 3 - bi : bi)) * 64;
            { const int lo_ = lrow * HS + 16 * c8;
              *(LAS u32x4*)(KB + lo_) = rF[0]; *(LAS u32x4*)(KB + lo_ + 128) = rF[1]; *(LAS u32x4*)(VV + lo_) = rV[0]; *(LAS u32x4*)(VV + lo_ + 128) = rV[1];
              if (PASS) { *(LAS u32x4*)(QH + lo_) = rQ[0]; *(LAS u32x4*)(QH + lo_ + 128) = rQ[1]; } }
            { const int nu = bi < 3 ? unit : unit + (int)gridDim.x, nb = bi < 3 ? bi + 1 : 0; if (nu < 65 * 16) HG_ISSUE(nu, nb); }
            __syncthreads();
            float lfc[16]; float run = 0.f;
#pragma unroll
            for (int ii = 0; ii < 16; ++ii) { const int i = tg * 16 + ii;
                const float fp = bf2f(*(const LAS unsigned short*)(KB + i * HS + k * 2)); const float f = lbv + (1.0f - lbv) * sigmoidf_(fp + bfv);
                run += __logf(f); lfc[ii] = run; }
            TOT[tg * 128 + k] = run;
            __syncthreads();
            float off = 0.f, btot = 0.f;
#pragma unroll
            for (int g2 = 0; g2 < 4; ++g2) { const float tv = TOT[g2 * 128 + k]; btot += tv; if (g2 < tg) off += tv; }
#pragma unroll
            for (int ii = 0; ii < 16; ++ii) { const int i = tg * 16 + ii; const float B = off + lfc[ii];
                const float lf = lfc[ii] - (ii ? lfc[ii - 1] : 0.f); const float kkv = 1.0f - __expf(lf);
                *(LAS unsigned short*)(KB + i * HS + k * 2) = (unsigned short)f2bf(kkv * __expf(btot - B));
                if (PASS) { const float qv = bf2f(*(const LAS unsigned short*)(QH + i * HS + k * 2));
                            *(LAS unsigned short*)(QH + i * HS + k * 2) = (unsigned short)f2bf(qv * __expf(B));
                            *(LAS unsigned short*)(KH + i * HS + k * 2) = (unsigned short)f2bf(kkv * __expf(fminf(-B, 80.0f))); }
                if ((ii & 3) == 3) asm volatile("" ::: "memory"); }
            if (tg == 0) { const float e = __expf(btot); DEC[k] = e; dseg *= e; }
            __syncthreads();
            f32x4 ao[4];
            if (PASS) {
#pragma unroll
                for (int s2 = 0; s2 < 2; ++s2) { const int it = w >> 1, jt = 2 * (w & 1) + s2; f32x4 sc = {0.f, 0.f, 0.f, 0.f};
#pragma unroll
                    for (int ks = 0; ks < 4; ++ks) sc = __builtin_amdgcn_mfma_f32_16x16x32_bf16(lds_row_frag(QH, HS, 16 * it + c16, 32 * ks + 8 * q4), lds_row_frag(KH, HS, 16 * jt + c16, 32 * ks + 8 * q4), sc, 0, 0, 0);
#pragma unroll
                    for (int r = 0; r < 4; ++r) { const int i = 16 * it + 4 * q4 + r, j = 16 * jt + c16; *(LAS unsigned short*)(PP + i * HPS + j * 2) = (unsigned short)f2bf(j <= i ? sc[r] : 0.f); } }
                __syncthreads();
#pragma unroll
                for (int it = 0; it < 4; ++it) ao[it] = (f32x4){0.f, 0.f, 0.f, 0.f};
            }
            bf16x8 vf[2];
#pragma unroll
            for (int ks = 0; ks < 2; ++ks) vf[ks] = lds_tr_frag(VV, HS, 32 * ks, 16 * w, lane);
            if (PASS) {
#pragma unroll
                for (int ks = 0; ks < 2; ++ks)
#pragma unroll
                    for (int it = 0; it < 4; ++it) ao[it] = __builtin_amdgcn_mfma_f32_16x16x32_bf16(lds_row_frag(PP, HPS, 16 * it + c16, 32 * ks + 8 * q4), vf[ks], ao[it], 0, 0, 0);
#pragma unroll 1
                for (int ks = 0; ks < 4; ++ks) { const bf16x8 sf = lds_tr_frag(SS, HS, 32 * ks, 16 * w, lane);
#pragma unroll
                    for (int it = 0; it < 4; ++it) ao[it] = __builtin_amdgcn_mfma_f32_16x16x32_bf16(lds_row_frag(QH, HS, 16 * it + c16, 32 * ks + 8 * q4), sf, ao[it], 0, 0, 0); }
            }
#pragma unroll
            for (int kt = 0; kt < 8; ++kt) {
#pragma unroll
                for (int r = 0; r < 4; ++r) accS[kt][r] *= DEC[16 * kt + 4 * q4 + r];
#pragma unroll
                for (int ks = 0; ks < 2; ++ks) accS[kt] = __builtin_amdgcn_mfma_f32_16x16x32_bf16(lds_tr_frag(KB, HS, 32 * ks, 16 * kt, lane), vf[ks], accS[kt], 0, 0, 0);
            }
            __syncthreads();
            if (PASS) {
#pragma unroll
                for (int kt = 0; kt < 8; ++kt)
#pragma unroll
                    for (int r = 0; r < 4; ++r) *(LAS unsigned short*)(SS + (16 * kt + 4 * q4 + r) * HS + (16 * w + c16) * 2) = (unsigned short)f2bf(accS[kt][r]);
#pragma unroll
                for (int it = 0; it < 4; ++it)
#pragma unroll
                    for (int r = 0; r < 4; ++r) *(LAS unsigned short*)(KH + (16 * it + 4 * q4 + r) * HS + (16 * w + c16) * 2) = (unsigned short)f2bf(ao[it][r]);
                __syncthreads();
                bf16_t* Od = Ob + (size_t)d * NTOK * 1024;
#pragma unroll
                for (int cc = 0; cc < 2; ++cc) { const int row = tid >> 3, chunk = (tid & 7) + 8 * cc, t = trow0 + (d ? 63 - row : row);
                    *(u32x4*)(Od + (size_t)t * 1024 + h * 128 + 8 * chunk) = *(const LAS u32x4*)(KH + row * HS + 16 * chunk); }
            }
        }
        if (!PASS) {
#pragma unroll
            for (int kt = 0; kt < 8; ++kt)
#pragma unroll
                for (int r = 0; r < 4; ++r) Su[(16 * kt + 4 * q4 + r) * 128 + 16 * w + c16] = accS[kt][r];
            if (tg == 0) Db[(size_t)unit * 128 + k] = dseg;
        }
        __syncthreads();
    }
}
#undef HG_ISSUE
template <bool DRY = false>
__device__ __forceinline__ void hgrn_prefix_phase(Frame& F, const Args& a) {
    float* Sb = (float*)(a.ws + (DRY ? WS_DUMMY : HG_S)); const float* Db = (const float*)(a.ws + HG_D);
    for (int gid = blockIdx.x * NTHREADS + F.tid; gid < 16 * 4096; gid += gridDim.x * NTHREADS) {
        const int hd = gid >> 12, e4 = gid & 4095, krow = e4 >> 5, d = hd & 1;
        f32x4 s = {0.f, 0.f, 0.f, 0.f};
#define HG_SEG(st_) (((d == 0) || (st_) == 0) ? (st_) : 65 - (st_))
        f32x4 lb[4]; float db[4];
#pragma unroll
        for (int j = 0; j < 4; ++j) { const int u2 = HG_SEG(j) * 16 + hd; lb[j] = *((const f32x4*)(Sb + (size_t)u2 * 16384) + e4); db[j] = Db[(size_t)u2 * 128 + krow]; }
#pragma unroll 1
        for (int base = 0; base < 68; base += 4) {
#pragma unroll
            for (int j = 0; j < 4; ++j) { const int step = base + j; if (step < 65) {
                const int unit = HG_SEG(step) * 16 + hd; f32x4* p = (f32x4*)(Sb + (size_t)unit * 16384) + e4; const f32x4 loc = lb[j]; const float dec = db[j];
                if (step + 4 < 65) { const int u2 = HG_SEG(step + 4) * 16 + hd; lb[j] = *((const f32x4*)(Sb + (size_t)u2 * 16384) + e4); db[j] = Db[(size_t)u2 * 128 + krow]; }
                *p = s; s = s * dec + loc; } }
        }
#undef HG_SEG
    }
}
__device__ __forceinline__ void hgrn_readout_phase(Frame& F, const Args& a) {
    const bf16_t* O0 = (const bf16_t*)(a.ws + HG_O); const bf16_t* O1 = O0 + (size_t)NTOK * 1024; const bf16_t* G = (const bf16_t*)(a.ws + HG_G); bf16_t* A4 = (bf16_t*)(a.ws + HG_A4);
    const float* ng = a.in[39]; const int lane = F.lane;
    float gn[8];
#pragma unroll
    for (int e = 0; e < 8; ++e) gn[e] = ng[(8 * lane + e) & 127];
    for (int t = F.gw; t < NTOK; t += F.ngw) {
        float o[16], g[16]; ldrow_bf16(O0 + (size_t)t * 1024, lane, o); addrow_bf16(O1 + (size_t)t * 1024, lane, o); ldrow_bf16(G + (size_t)t * 1024, lane, g);
#pragma unroll
        for (int j = 0; j < 2; ++j) { float q = 0.f;
#pragma unroll
            for (int e = 0; e < 8; ++e) q += o[8 * j + e] * o[8 * j + e];
#pragma unroll
            for (int m = 1; m < 16; m <<= 1) q += __shfl_xor(q, m);
            const float rs = 1.0f / sqrtf(q * (1.0f / 128.0f) + LN_EPS);
#pragma unroll
            for (int e = 0; e < 8; ++e) o[8 * j + e] = o[8 * j + e] * rs * gn[e] * g[8 * j + e]; }
        strow_bf16(A4 + (size_t)t * 1024, lane, o);
    }
}

constexpr size_t RW_XM = WS_SCR, RW_WW = WS_SCR, RW_AA = WS_SCR + 131 * MiB, RW_R = WS_SCR + 196 * MiB, RW_K = WS_SCR + 229 * MiB, RW_V = WS_SCR + 262 * MiB, RW_L1 = WS_SCR + 295 * MiB,
                 RW_G = WS_SCR + 321 * MiB, RW_REC = WS_SCR + 354 * MiB, RW_PQ = WS_SCR + (RWKV_CHUNKED ? 354 : 0) * MiB, RW_SST = WS_SCR + (RWKV_CHUNKED ? 420 : 64) * MiB, RW_O = WS_SCR + 745 * MiB, RW_A5 = WS_SCR, RW_Y = WS_SCR + 812 * MiB, RW_END = WS_SCR + 880 * MiB;
constexpr int RECB = 768;
typedef _Float16 h2_t __attribute__((ext_vector_type(2)));
typedef _Float16 h8_t __attribute__((ext_vector_type(8)));
__device__ __forceinline__ void rwkv_xm_phase(Frame& F, const Args& a) {
    const bf16_t* U = (const bf16_t*)(a.ws + WS_U); bf16_t* XM = (bf16_t*)(a.ws + RW_XM); const float* mu = a.in[15];
    for (int t = F.gw; t < NTOK; t += F.ngw) {
        float u[16], sh[16]; ldrow_bf16(U + (size_t)t * D, F.lane, u);
        const bool hasp = (t != 0 && t != NCTX), hasn = (t != NCTX - 1 && t != NTOK - 1);
        { u32x4 pv = {0u, 0u, 0u, 0u}, nv = {0u, 0u, 0u, 0u};
          if (hasp) pv = *(const u32x4*)(U + (size_t)(t - 1) * D + 8 * F.lane);
          if (hasn) nv = *(const u32x4*)(U + (size_t)(t + 1) * D + 512 + 8 * F.lane);
          sh[0] = bflo(pv.x); sh[1] = bfhi(pv.x); sh[2] = bflo(pv.y); sh[3] = bfhi(pv.y); sh[4] = bflo(pv.z); sh[5] = bfhi(pv.z); sh[6] = bflo(pv.w); sh[7] = bfhi(pv.w);
          sh[8] = bflo(nv.x); sh[9] = bfhi(nv.x); sh[10] = bflo(nv.y); sh[11] = bfhi(nv.y); sh[12] = bflo(nv.z); sh[13] = bfhi(nv.z); sh[14] = bflo(nv.w); sh[15] = bfhi(nv.w); }
#pragma unroll 1
        for (int c = 0; c < 6; ++c) { float m[16], o[16]; ldrow_f32(mu + c * D, F.lane, m);
#pragma unroll
            for (int e = 0; e < 16; ++e) o[e] = u[e] + (sh[e] - u[e]) * m[e];
            strow_bf16(XM + ((size_t)c * NTOK + t) * D, F.lane, o); }
    }
}
struct RwkvInSched {
    const char* XM; const char* Win; const char* Wl1; int G, c;
    __device__ __forceinline__ bool next(int i, gg::Unit& u) const {
        const int L0 = i * G + c; if (L0 >= 975) return false; const int L = xcd_remap(L0, 975);
        int g, pm, pn;
        if (L < 780) { g = L / 260; const int r = L % 260; pm = r >> 2; pn = r & 3; u.b = Win + ((size_t)g * 1024 + pn * 256) * 2048; }
        else { const int r = L - 780; g = 3 + r / 65; pm = r % 65; pn = 0; u.b = Wl1 + (size_t)(g - 3) * 256 * 2048; }
        u.a = XM + ((size_t)g * NTOK + pm * 256) * 2048; u.b2 = nullptr; u.pm = pm; u.pn = pn; u.gofs = 0; u.x = g; return true; }
};
struct EpiRwkvIn {
    static constexpr bool PERM = true;
    bf16_t* RKV; bf16_t* L1;
    __device__ __forceinline__ void operator()(const gg::Acc& acc, const gg::Unit& u, int wr, int wc, int fr, int fq) const {
        const int g = u.x; const bool lora = g >= 3;
        bf16_t* O = lora ? L1 + (size_t)(g - 3) * NTOK * 256 : RKV + (size_t)g * (33 * MiB / 2); const int ldc = lora ? 256 : 1024;
        const int row0 = u.pm * 256 + wr * 64 + fr, col0 = u.pn * 256 + wc * 32 + 8 * fq;
#pragma unroll
        for (int ai = 0; ai < 2; ++ai)
#pragma unroll
            for (int m = 0; m < 4; ++m) { bf16_t* rp = O + (size_t)(row0 + ai * 128 + m * 16) * ldc + col0;
#pragma unroll
                for (int bj = 0; bj < 2; ++bj) { f32x4 v0 = acc[ai][bj][m][0], v1 = acc[ai][bj][m][1];
                    if (g == 3) {
#pragma unroll
                        for (int e = 0; e < 4; ++e) { v0[e] = 1.0f - 2.0f * __builtin_amdgcn_rcpf(1.0f + __expf(2.0f * v0[e])); v1[e] = 1.0f - 2.0f * __builtin_amdgcn_rcpf(1.0f + __expf(2.0f * v1[e])); } }
                    if (g == 5) {
#pragma unroll
                        for (int e = 0; e < 4; ++e) { v0[e] = sigmoidf_(v0[e]); v1[e] = sigmoidf_(v1[e]); } }
                    u32x4 o; o.x = pk2(v0[0], v0[1]); o.y = pk2(v0[2], v0[3]); o.z = pk2(v1[0], v1[1]); o.w = pk2(v1[2], v1[3]);
                    *(u32x4*)(rp + bj * 128) = o; } }
    }
};
__device__ __forceinline__ void rwkv_in_gemm_phase(Frame& F, const Args& a) {
    RwkvInSched S{(const char*)(a.ws + RW_XM), (const char*)(a.ws + WS_W_RWKV_IN), (const char*)(a.ws + WS_W_RWKV_L1), (int)gridDim.x, (int)blockIdx.x};
    EpiRwkvIn E{(bf16_t*)(a.ws + RW_R), (bf16_t*)(a.ws + RW_L1)};
    gg::gemm_phase<EpiRwkvIn, RwkvInSched, false, false>(F.lds + LDS_STAGE, gg::Dims{1024, 1024, 1024, 0, 0}, S, E);
}
struct RwkvL2Sched {
    const char* L1; const char* W2; int G, c;
    __device__ __forceinline__ bool next(int i, gg::Unit& u) const {
        const int L0 = i * G + c; if (L0 >= 1300) return false; const int L = xcd_remap(L0, 1300);
        const int g = L / 260, r = L % 260, pm = r >> 2, pn = r & 3, src = g >> 1;
        u.a = L1 + ((size_t)src * NTOK + pm * 256) * 512; u.b = W2 + ((size_t)g * 1024 + pn * 256) * 512; u.b2 = nullptr; u.pm = pm; u.pn = pn; u.gofs = 0; u.x = g; return true; }
};
struct EpiRwkvL2 {
    static constexpr bool PERM = true;
    float* WW; bf16_t* AA; bf16_t* GG;
    __device__ __forceinline__ void operator()(const gg::Acc& acc, const gg::Unit& u, int wr, int wc, int fr, int fq) const {
        const int g = u.x, z = g & 1; const int row0 = u.pm * 256 + wr * 64 + fr, col0 = u.pn * 256 + wc * 32 + 8 * fq;
        float* wbase = WW + (size_t)z * NTOK * 1024; bf16_t* obase = g < 4 ? AA + (size_t)z * NTOK * 1024 : GG;
#pragma unroll
        for (int ai = 0; ai < 2; ++ai)
#pragma unroll
            for (int m = 0; m < 4; ++m) { const size_t ro = (size_t)(row0 + ai * 128 + m * 16) * 1024 + col0;
#pragma unroll
                for (int bj = 0; bj < 2; ++bj) { const f32x4 v0 = acc[ai][bj][m][0], v1 = acc[ai][bj][m][1];
                    if (g < 2) { float* wp = wbase + ro + bj * 128; *(f32x4*)wp = v0; *(f32x4*)(wp + 4) = v1; }
                    else { u32x4 o; o.x = pk2(v0[0], v0[1]); o.y = pk2(v0[2], v0[3]); o.z = pk2(v1[0], v1[1]); o.w = pk2(v1[2], v1[3]); *(u32x4*)(obase + ro + bj * 128) = o; } } }
    }
};
__device__ __forceinline__ void rwkv_l2_gemm_phase(Frame& F, const Args& a) {
    RwkvL2Sched S{(const char*)(a.ws + RW_L1), (const char*)(a.ws + WS_W_RWKV_WL2), (int)gridDim.x, (int)blockIdx.x};
    EpiRwkvL2 E{(float*)(a.ws + RW_WW), (bf16_t*)(a.ws + RW_AA), (bf16_t*)(a.ws + RW_G)};
    gg::gemm_phase<EpiRwkvL2, RwkvL2Sched, false, false>(F.lds + LDS_STAGE, gg::Dims{256, 256, 256, 0, 0}, S, E);
}
__device__ __forceinline__ int rwkv_row(int z, int n) { return z == 0 ? n : (n < NCTX ? NCTX - 1 - n : NTOK - 1 + NCTX - n); }
__device__ __forceinline__ void rwkv_rec_phase(Frame& F, const Args& a) {
    const bf16_t* R = (const bf16_t*)(a.ws + RW_R); const bf16_t* K = (const bf16_t*)(a.ws + RW_K); const bf16_t* V = (const bf16_t*)(a.ws + RW_V);
    const float* WW = (const float*)(a.ws + RW_WW); const bf16_t* AA = (const bf16_t*)(a.ws + RW_AA); unsigned char* REC = a.ws + RW_REC;
    const int lane = F.lane;
    float kkw[16], kaw[16]; ldrow_f32(a.in[25], lane, kkw); ldrow_f32(a.in[26], lane, kaw);
#pragma unroll 1
    for (int t = F.gw; t < NTOK; t += F.ngw) {
        float k[16], r[16], v[16], kk[16];
        ldrow_bf16(K + (size_t)t * 1024, lane, k); ldrow_bf16(R + (size_t)t * 1024, lane, r); ldrow_bf16(V + (size_t)t * 1024, lane, v);
#pragma unroll
        for (int j = 0; j < 2; ++j) { float ss = 0.f;
#pragma unroll
            for (int e = 0; e < 8; ++e) { kk[8 * j + e] = k[8 * j + e] * kkw[8 * j + e]; ss += kk[8 * j + e] * kk[8 * j + e]; }
#pragma unroll
            for (int m = 1; m < 8; m <<= 1) ss += __shfl_xor(ss, m);
            const float rn = __builtin_amdgcn_rsqf(ss + 1e-12f);
#pragma unroll
            for (int e = 0; e < 8; ++e) kk[8 * j + e] *= rn; }
#pragma unroll
        for (int z = 0; z < 2; ++z) {
            float ap[16], wp[16], a0v[16], w0v[16];
            ldrow_bf16(AA + ((size_t)z * NTOK + t) * 1024, lane, ap); ldrow_f32(WW + ((size_t)z * NTOK + t) * 1024, lane, wp); ldrow_f32(a.in[20] + z * 1024, lane, a0v); ldrow_f32(a.in[17] + z * 1024, lane, w0v);
            const int n = (z == 0) ? t : (t < NCTX ? NCTX - 1 - t : NTOK - 1 + NCTX - t);
#pragma unroll
            for (int j = 0; j < 2; ++j) {
                const int col = 8 * lane + 512 * j, hh = col >> 6, cin = col & 63;
                h8_t ow, okk, ob, okt, orr, ov;
#pragma unroll
                for (int e = 0; e < 8; ++e) { const int x = 8 * j + e; const float av = sigmoidf_(a0v[x] + ap[x]), wv = __expf(-0.6065306597126334f * sigmoidf_(w0v[x] + wp[x]));
                    ow[e] = (_Float16)wv; okk[e] = (_Float16)kk[x]; ob[e] = (_Float16)(av * kk[x]); okt[e] = (_Float16)(k[x] * (1.0f + (av - 1.0f) * kaw[x])); orr[e] = (_Float16)r[x]; ov[e] = (_Float16)v[x]; }
                unsigned char* rec = REC + ((size_t)(z * 16 + hh) * NTOK + n) * RECB + cin * 2;
                *(h8_t*)(rec) = ow; *(h8_t*)(rec + 128) = okk; *(h8_t*)(rec + 256) = ob; *(h8_t*)(rec + 384) = okt; *(h8_t*)(rec + 512) = orr; *(h8_t*)(rec + 640) = ov;
            }
        }
    }
}
__device__ __forceinline__ float quad_sum(float x) {
    x += __builtin_bit_cast(float, __builtin_amdgcn_mov_dpp(__builtin_bit_cast(int, x), 0xB1, 0xF, 0xF, true));
    x += __builtin_bit_cast(float, __builtin_amdgcn_mov_dpp(__builtin_bit_cast(int, x), 0x4E, 0xF, 0xF, true));
    return x;
}
template <bool VTERM, bool OUT>
__device__ __forceinline__ void rwkv_scan_task(const unsigned char* rec, LAS unsigned char* buf, int lane, h2_t (&S)[4][8], bf16_t* Ozh, int z, int n0, int nck) {
    const int v_lo = lane >> 2, kq = lane & 3;
#define RW_DMA(ck_, bsel_) do { _Pragma("unroll") for (int m = 0; m < 6; ++m) \
        __builtin_amdgcn_global_load_lds((const unsigned*)(rec + (size_t)(ck_) * 8 * RECB + (size_t)(lane + 64 * m) * 16), (LAS unsigned*)(buf + (bsel_) * 6144 + m * 1024), 16, 0, 0); } while (0)
    RW_DMA(0, 0);
#pragma unroll 1
    for (int ck = 0; ck < nck; ++ck) {
        if (ck < nck - 1) { RW_DMA(ck + 1, (ck + 1) & 1); asm volatile("s_waitcnt vmcnt(6)" ::: "memory"); }
        else asm volatile("s_waitcnt vmcnt(0)" ::: "memory");
        const LAS unsigned char* cb = buf + (ck & 1) * 6144;
#pragma unroll 2
        for (int st = 0; st < 8; ++st) {
            const LAS unsigned char* b = cb + st * RECB + kq * 32;
            h2_t kk[8], wv[8], bv[8], kt[8], rv[8];
            { const h8_t x0 = *(const LAS h8_t*)(b + 128), x1 = *(const LAS h8_t*)(b + 128 + 16);
#pragma unroll
              for (int p2 = 0; p2 < 4; ++p2) { kk[p2] = (h2_t){x0[2 * p2], x0[2 * p2 + 1]}; kk[4 + p2] = (h2_t){x1[2 * p2], x1[2 * p2 + 1]}; } }
            float sa[4];
#pragma unroll
            for (int i = 0; i < 4; ++i) { float a0 = 0.f, a1 = 0.f;
#pragma unroll
                for (int p2 = 0; p2 < 8; p2 += 2) { a0 = __builtin_amdgcn_fdot2(S[i][p2], kk[p2], a0, false); a1 = __builtin_amdgcn_fdot2(S[i][p2 + 1], kk[p2 + 1], a1, false); }
                sa[i] = quad_sum(a0 + a1); }
            { const h8_t x0 = *(const LAS h8_t*)(b), x1 = *(const LAS h8_t*)(b + 16), y0 = *(const LAS h8_t*)(b + 256), y1 = *(const LAS h8_t*)(b + 256 + 16);
#pragma unroll
              for (int p2 = 0; p2 < 4; ++p2) { wv[p2] = (h2_t){x0[2 * p2], x0[2 * p2 + 1]}; wv[4 + p2] = (h2_t){x1[2 * p2], x1[2 * p2 + 1]}; bv[p2] = (h2_t){y0[2 * p2], y0[2 * p2 + 1]}; bv[4 + p2] = (h2_t){y1[2 * p2], y1[2 * p2 + 1]}; } }
            if (VTERM) { const h8_t x0 = *(const LAS h8_t*)(b + 384), x1 = *(const LAS h8_t*)(b + 384 + 16);
#pragma unroll
              for (int p2 = 0; p2 < 4; ++p2) { kt[p2] = (h2_t){x0[2 * p2], x0[2 * p2 + 1]}; kt[4 + p2] = (h2_t){x1[2 * p2], x1[2 * p2 + 1]}; } }
            if (OUT) { const h8_t x0 = *(const LAS h8_t*)(b + 512), x1 = *(const LAS h8_t*)(b + 512 + 16);
#pragma unroll
              for (int p2 = 0; p2 < 4; ++p2) { rv[p2] = (h2_t){x0[2 * p2], x0[2 * p2 + 1]}; rv[4 + p2] = (h2_t){x1[2 * p2], x1[2 * p2 + 1]}; } }
            float oi[4];
#pragma unroll
            for (int i = 0; i < 4; ++i) {
                const _Float16 nsa = (_Float16)(-sa[i]); const h2_t nsa2 = {nsa, nsa};
                h2_t vv2 = {(_Float16)0, (_Float16)0};
                if (VTERM) { const _Float16 vh = *(const LAS _Float16*)(cb + st * RECB + 640 + (16 * i + v_lo) * 2); vv2 = (h2_t){vh, vh}; }
                float o0 = 0.f, o1 = 0.f;
#pragma unroll
                for (int p2 = 0; p2 < 8; ++p2) {
                    h2_t t = nsa2 * bv[p2]; if (VTERM) t = __builtin_elementwise_fma(vv2, kt[p2], t);
                    S[i][p2] = __builtin_elementwise_fma(S[i][p2], wv[p2], t);
                    if (OUT) { if (p2 & 1) o1 = __builtin_amdgcn_fdot2(S[i][p2], rv[p2], o1, false); else o0 = __builtin_amdgcn_fdot2(S[i][p2], rv[p2], o0, false); } }
                if (OUT) oi[i] = quad_sum(o0 + o1);
            }
            if (OUT) { const float o = kq == 0 ? oi[0] : kq == 1 ? oi[1] : kq == 2 ? oi[2] : oi[3];
                Ozh[(size_t)rwkv_row(z, n0 + ck * 8 + st) * 1024 + 16 * kq + v_lo] = (unsigned short)f2bf(o); }
        }
    }
#undef RW_DMA
}
#define RW_STORE_STATE(dst_) do { _Pragma("unroll") for (int i = 0; i < 4; ++i) _Pragma("unroll") for (int p4 = 0; p4 < 4; ++p4) \
        *(f32x4*)((dst_) + (16 * i + v_lo) * 64 + 16 * kq + 4 * p4) = (f32x4){(float)S[i][2 * p4][0], (float)S[i][2 * p4][1], (float)S[i][2 * p4 + 1][0], (float)S[i][2 * p4 + 1][1]}; } while (0)
template <int KIND>
__device__ __forceinline__ void rwkv_scan_phase(Frame& F, const Args& a) {
    const unsigned char* REC = a.ws + RW_REC; float* PQ = (float*)(a.ws + RW_PQ); float* SST = (float*)(a.ws + RW_SST); bf16_t* O = (bf16_t*)(a.ws + RW_O); bf16_t* Y = (bf16_t*)(a.ws + RW_Y);
    LAS unsigned char* buf = F.lds + LDS_STAGE + F.wave * 12288;
    const int lane = F.lane, v_lo = lane >> 2, kq = lane & 3;
#pragma unroll 1
    for (int task = F.gw; task < 2048; task += F.ngw) {
        const int zh = task & 31, z = zh >> 4, h = zh & 15, sidx = task >> 5;
        h2_t S[4][8];
#pragma unroll
        for (int i = 0; i < 4; ++i)
#pragma unroll
            for (int p2 = 0; p2 < 8; ++p2) S[i][p2] = (h2_t){(_Float16)0.f, (_Float16)0.f};
        if (sidx == 0) {
            rwkv_scan_task<true, true>(REC + (size_t)zh * NTOK * RECB, buf, lane, S, O + (size_t)z * NTOK * 1024 + h * 64, z, 0, 64);
            float* dst = SST + ((size_t)zh * 65 + 2) * 4096; RW_STORE_STATE(dst);
        } else {
            const int s = sidx + 1; const unsigned char* rec = REC + ((size_t)zh * NTOK + (size_t)s * 256) * RECB;
            rwkv_scan_task<true, true>(rec, buf, lane, S, O + (size_t)z * NTOK * 1024 + h * 64, z, s * 256, 32);
            { float* dst = PQ + ((size_t)zh * 64 + (s - 1)) * 8192 + 4096; RW_STORE_STATE(dst); }
#pragma unroll
            for (int i = 0; i < 4; ++i)
#pragma unroll
                for (int p2 = 0; p2 < 8; ++p2) { const int key = 16 * kq + 2 * p2, vr = 16 * i + v_lo; S[i][p2] = (h2_t){(_Float16)(vr == key ? 1.0f : 0.f), (_Float16)(vr == key + 1 ? 1.0f : 0.f)}; }
            asm volatile("s_waitcnt lgkmcnt(0)" ::: "memory");
            rwkv_scan_task<false, true>(rec, buf, lane, S, Y + (size_t)z * NTOK * 1024 + h * 64, z, s * 256, 32);
            { float* dst = PQ + ((size_t)zh * 64 + (s - 1)) * 8192; RW_STORE_STATE(dst); }
        }
        asm volatile("s_waitcnt lgkmcnt(0)" ::: "memory");
    }
}
constexpr int CK_TS = 144, CK_YS = 272;
constexpr int CK_AH = 0, CK_BH = 9216, CK_KH = 18432, CK_RH = 27648, CK_VV = 36864, CK_BB = 46080, CK_KB = 55296, CK_NM = 64512, CK_MAK = 73728, CK_MRB = 82944, CK_MRK = 92160,
              CK_YY = 101376, CK_SS = 118784, CK_DEC = 137216, CK_TOT = 137472, CK_TD = 139776, CK_TMP = 141824, CK_CT = 150016;
__device__ __forceinline__ void rwkv_chunk_phase(Frame& F, const Args& a) {
    float* PQ = (float*)(a.ws + RW_PQ); float* SST = (float*)(a.ws + RW_SST);
    LAS unsigned char* L = F.lds + LDS_STAGE;
    LAS float* DEC = (LAS float*)(L + CK_DEC); LAS float* TOT = (LAS float*)(L + CK_TOT); LAS float* CT = (LAS float*)(L + CK_CT);
    const int tid = F.tid, lane = F.lane, w = F.wave, c16 = lane & 15, q = lane >> 4;
    const int si = tid >> 3, c8 = tid & 7;
    const bool zset = w >= 4;
#pragma unroll 1
    for (int unit = blockIdx.x; unit < 2048; unit += gridDim.x) {
        const int zh = unit & 31, z = zh >> 4, h = zh & 15, sidx = unit >> 5;
        const int n0 = sidx == 0 ? 0 : (sidx + 1) * 256, nblk = sidx == 0 ? 8 : 4; const bool use_p = sidx != 0;
        if (tid < 64) { CT[tid] = a.in[25][h * 64 + tid]; CT[64 + tid] = a.in[26][h * 64 + tid]; CT[128 + tid] = a.in[20][z * 1024 + h * 64 + tid]; CT[192 + tid] = a.in[17][z * 1024 + h * 64 + tid]; }
        f32x4 accS[4];
#pragma unroll
        for (int kt = 0; kt < 4; ++kt)
#pragma unroll
            for (int r = 0; r < 4; ++r) { const float v0 = (!zset && (16 * w + 4 * q + r) == (16 * kt + c16)) ? 1.0f : 0.f; accS[kt][r] = v0;
                *(LAS unsigned short*)(L + CK_SS + (16 * w + 4 * q + r) * CK_TS + (16 * kt + c16) * 2) = (unsigned short)f2bf(v0); }
        __syncthreads();
        u32x4 pkx, pax, prx, pvx; f32x4 pw0, pw1;
#define CK_PREFETCH(blk_) do { int _t = threadIdx.x; asm volatile("" : "+v"(_t)); const int _trow = rwkv_row(z, n0 + (blk_) * 64 + (_t >> 3)); const unsigned _go = (unsigned)(_trow * 1024 + h * 64 + 8 * (_t & 7)) * 2u; \
            const unsigned char* _w = a.ws; const unsigned _zo = (unsigned)z * (unsigned)(NTOK * 1024 * 2); \
            pkx = *(const u32x4*)(_w + RW_K + _go); pax = *(const u32x4*)(_w + RW_AA + _zo + _go); prx = *(const u32x4*)(_w + RW_R + _go); pvx = *(const u32x4*)(_w + RW_V + _go); \
            pw0 = *(const f32x4*)(_w + RW_WW + 2u * _zo + 2u * _go); pw1 = *(const f32x4*)(_w + RW_WW + 2u * _zo + 2u * _go + 16u); } while (0)
        CK_PREFETCH(0);
#pragma unroll 1
        for (int blk = 0; blk < nblk; ++blk) {
            int tid_o = threadIdx.x; asm volatile("" : "+v"(tid_o));
            const int lane = tid_o & 63, c16 = lane & 15, q = lane >> 4, si = tid_o >> 3, c8 = tid_o & 7;
            float lw[8], kkv[8], bv[8], ktv[8]; u32x4 rx, vx;
            {
                const u32x4 kx = pkx, ax = pax; rx = prx; vx = pvx; const f32x4 wx0 = pw0, wx1 = pw1;
                const float kf[8] = {bflo(kx.x), bfhi(kx.x), bflo(kx.y), bfhi(kx.y), bflo(kx.z), bfhi(kx.z), bflo(kx.w), bfhi(kx.w)};
                const float af[8] = {bflo(ax.x), bfhi(ax.x), bflo(ax.y), bfhi(ax.y), bflo(ax.z), bfhi(ax.z), bflo(ax.w), bfhi(ax.w)};
                const float wf[8] = {wx0[0], wx0[1], wx0[2], wx0[3], wx1[0], wx1[1], wx1[2], wx1[3]};
                const f32x4 c0a = *(const LAS f32x4*)(CT + 8 * c8), c0b = *(const LAS f32x4*)(CT + 8 * c8 + 4);
                float ss = 0.f;
#pragma unroll
                for (int e = 0; e < 8; ++e) { const float kkw = e < 4 ? c0a[e] : c0b[e - 4]; kkv[e] = kf[e] * kkw; ss += kkv[e] * kkv[e]; }
                ss += __shfl_xor(ss, 1); ss += __shfl_xor(ss, 2); ss += __shfl_xor(ss, 4);
                const float rn = __builtin_amdgcn_rsqf(ss + 1e-12f);
                asm volatile("" ::: "memory");
                const f32x4 c1a = *(const LAS f32x4*)(CT + 64 + 8 * c8), c1b = *(const LAS f32x4*)(CT + 64 + 8 * c8 + 4);
                const f32x4 c2a = *(const LAS f32x4*)(CT + 128 + 8 * c8), c2b = *(const LAS f32x4*)(CT + 128 + 8 * c8 + 4), c3a = *(const LAS f32x4*)(CT + 192 + 8 * c8), c3b = *(const LAS f32x4*)(CT + 192 + 8 * c8 + 4);
#pragma unroll
                for (int e = 0; e < 8; ++e) { const float kaw = e < 4 ? c1a[e] : c1b[e - 4], a0e = e < 4 ? c2a[e] : c2b[e - 4], w0e = e < 4 ? c3a[e] : c3b[e - 4];
                    const float av = sigmoidf_(a0e + af[e]); kkv[e] *= rn; bv[e] = av * kkv[e]; ktv[e] = kf[e] * (1.0f + (av - 1.0f) * kaw);
                    lw[e] = -0.6065306597126334f * sigmoidf_(w0e + wf[e]); }
            }
            float G[8];
#pragma unroll
            for (int e = 0; e < 8; ++e) { float x = lw[e]; float y = __shfl_up(x, 8); if (lane >= 8) x += y; y = __shfl_up(x, 16); if (lane >= 16) x += y; y = __shfl_up(x, 32); if (lane >= 32) x += y; G[e] = x; }
            if (lane >= 56) { *(LAS f32x4*)(TOT + w * 64 + 8 * c8) = (f32x4){G[0], G[1], G[2], G[3]}; *(LAS f32x4*)(TOT + w * 64 + 8 * c8 + 4) = (f32x4){G[4], G[5], G[6], G[7]}; }
            __syncthreads();
            {
                float tot[8];
#pragma unroll
                for (int e = 0; e < 8; ++e) tot[e] = 0.f;
#pragma unroll
                for (int ww = 0; ww < 8; ++ww) { const f32x4 t0 = *(const LAS f32x4*)(TOT + ww * 64 + 8 * c8), t1 = *(const LAS f32x4*)(TOT + ww * 64 + 8 * c8 + 4);
#pragma unroll
                    for (int e = 0; e < 8; ++e) { const float tv = e < 4 ? t0[e] : t1[e - 4]; tot[e] += tv; if (ww < w) G[e] += tv; } }
                if (si == 0) { *(LAS f32x4*)(DEC + 8 * c8) = (f32x4){__expf(tot[0]), __expf(tot[1]), __expf(tot[2]), __expf(tot[3])}; *(LAS f32x4*)(DEC + 8 * c8 + 4) = (f32x4){__expf(tot[4]), __expf(tot[5]), __expf(tot[6]), __expf(tot[7])}; }
                const unsigned rw4[4] = {rx.x, rx.y, rx.z, rx.w}; const int to = si * CK_TS + 16 * c8;
                *(LAS u32x4*)(L + CK_VV + to) = vx;
#pragma unroll
                for (int e2 = 0; e2 < 4; ++e2) { float o7[6][2];
#pragma unroll
                    for (int hh = 0; hh < 2; ++hh) { const int e = 2 * e2 + hh; const float Ge = G[e]; const float rve = hh ? bfhi(rw4[e2]) : bflo(rw4[e2]);
                        const float eg = __expf(Ge), egm = __expf(Ge - lw[e]), eng = __expf(fminf(-Ge, 80.0f)), etg = __expf(tot[e] - Ge);
                        o7[0][hh] = -kkv[e] * egm; o7[1][hh] = bv[e] * eng; o7[2][hh] = ktv[e] * eng; o7[3][hh] = rve * eg; o7[4][hh] = bv[e] * etg; o7[5][hh] = ktv[e] * etg; }
                    *(LAS unsigned*)(L + CK_AH + to + 4 * e2) = pk2(o7[0][0], o7[0][1]); *(LAS unsigned*)(L + CK_BH + to + 4 * e2) = pk2(o7[1][0], o7[1][1]); *(LAS unsigned*)(L + CK_KH + to + 4 * e2) = pk2(o7[2][0], o7[2][1]);
                    *(LAS unsigned*)(L + CK_RH + to + 4 * e2) = pk2(o7[3][0], o7[3][1]); *(LAS unsigned*)(L + CK_BB + to + 4 * e2) = pk2(o7[4][0], o7[4][1]); *(LAS unsigned*)(L + CK_KB + to + 4 * e2) = pk2(o7[5][0], o7[5][1]); }
                if (blk + 1 < nblk) CK_PREFETCH(blk + 1);
            }
            __syncthreads();
            { const int it = w >> 1;
              bf16x8 fa[2], fr[2];
#pragma unroll
              for (int ks = 0; ks < 2; ++ks) { fa[ks] = lds_row_frag(L + CK_AH, CK_TS, 16 * it + c16, 32 * ks + 8 * q); fr[ks] = lds_row_frag(L + CK_RH, CK_TS, 16 * it + c16, 32 * ks + 8 * q); }
#pragma unroll 1
              for (int s2 = 0; s2 < 2; ++s2) { const int jt = 2 * (w & 1) + s2; f32x4 n0v = {0.f, 0.f, 0.f, 0.f}, n1v = n0v, n2v = n0v, n3v = n0v;
#pragma unroll
                  for (int ks = 0; ks < 2; ++ks) { const bf16x8 fb = lds_row_frag(L + CK_BH, CK_TS, 16 * jt + c16, 32 * ks + 8 * q), fk = lds_row_frag(L + CK_KH, CK_TS, 16 * jt + c16, 32 * ks + 8 * q);
                      n0v = __builtin_amdgcn_mfma_f32_16x16x32_bf16(fa[ks], fb, n0v, 0, 0, 0); n1v = __builtin_amdgcn_mfma_f32_16x16x32_bf16(fa[ks], fk, n1v, 0, 0, 0);
                      n2v = __builtin_amdgcn_mfma_f32_16x16x32_bf16(fr[ks], fb, n2v, 0, 0, 0); n3v = __builtin_amdgcn_mfma_f32_16x16x32_bf16(fr[ks], fk, n3v, 0, 0, 0); }
#pragma unroll
                  for (int r = 0; r < 4; ++r) { const int i = 16 * it + 4 * q + r, j = 16 * jt + c16, o = i * CK_TS + j * 2;
                      n0v[r] = j < i ? n0v[r] : 0.f;
                      *(LAS unsigned short*)(L + CK_NM + o) = (unsigned short)f2bf(n0v[r]); *(LAS unsigned short*)(L + CK_MAK + o) = (unsigned short)f2bf(j < i ? n1v[r] : 0.f);
                      *(LAS unsigned short*)(L + CK_MRB + o) = (unsigned short)f2bf(j <= i ? n2v[r] : 0.f); *(LAS unsigned short*)(L + CK_MRK + o) = (unsigned short)f2bf(j <= i ? n3v[r] : 0.f); }
                  if (jt == it) {
                      LAS unsigned char* tp = L + CK_TMP + w * 1024; LAS unsigned char* tt = tp + 512;
                      f32x4 P = n0v, T = n0v;
#pragma unroll
                      for (int r = 0; r < 4; ++r) T[r] += (4 * q + r == c16) ? 1.0f : 0.f;
#pragma unroll
                      for (int pw = 0; pw < 3; ++pw) {
#pragma unroll
                          for (int r = 0; r < 4; ++r) { *(LAS unsigned short*)(tp + (4 * q + r) * 32 + c16 * 2) = (unsigned short)f2bf(P[r]); *(LAS unsigned short*)(tt + (4 * q + r) * 32 + c16 * 2) = (unsigned short)f2bf(T[r]); }
                          bf16x4 pb; pb[0] = (short)f2bf(P[0]); pb[1] = (short)f2bf(P[1]); pb[2] = (short)f2bf(P[2]); pb[3] = (short)f2bf(P[3]);
                          const bf16x4 pa = *(const LAS bf16x4*)(tp + c16 * 32 + 8 * q), ta = *(const LAS bf16x4*)(tt + c16 * 32 + 8 * q);
                          f32x4 zero = {0.f, 0.f, 0.f, 0.f};
                          P = __builtin_amdgcn_mfma_f32_16x16x16bf16_1k(pa, pb, zero, 0, 0, 0);
                          bf16x4 pn; pn[0] = (short)f2bf(P[0]); pn[1] = (short)f2bf(P[1]); pn[2] = (short)f2bf(P[2]); pn[3] = (short)f2bf(P[3]);
                          T = __builtin_amdgcn_mfma_f32_16x16x16bf16_1k(ta, pn, T, 0, 0, 0);
                      }
#pragma unroll
                      for (int r = 0; r < 4; ++r) *(LAS unsigned short*)(L + CK_TD + it * 512 + (4 * q + r) * 32 + c16 * 2) = (unsigned short)f2bf(T[r]);
                  } } }
            __syncthreads();
            const bool active = zset || use_p;
            if (active) {
                f32x4 yv[4];
#pragma unroll
                for (int it = 0; it < 4; ++it) yv[it] = (f32x4){0.f, 0.f, 0.f, 0.f};
                bf16x8 sb[2];
#pragma unroll
                for (int ks = 0; ks < 2; ++ks) { sb[ks] = lds_row_frag(L + CK_SS, CK_TS, 16 * w + c16, 32 * ks + 8 * q);
#pragma unroll
                    for (int it = 0; it < 4; ++it) yv[it] = __builtin_amdgcn_mfma_f32_16x16x32_bf16(lds_row_frag(L + CK_AH, CK_TS, 16 * it + c16, 32 * ks + 8 * q), sb[ks], yv[it], 0, 0, 0); }
                bf16x8 vb[2];
                if (zset) {
#pragma unroll
                    for (int ks = 0; ks < 2; ++ks) { vb[ks] = lds_tr_frag(L + CK_VV, CK_TS, 32 * ks, 16 * (w - 4), lane);
#pragma unroll
                        for (int it = 0; it < 4; ++it) yv[it] = __builtin_amdgcn_mfma_f32_16x16x32_bf16(lds_row_frag(L + CK_MAK, CK_TS, 16 * it + c16, 32 * ks + 8 * q), vb[ks], yv[it], 0, 0, 0); } }
                asm volatile("" ::: "memory");
                bf16x4 ub[4];
#pragma unroll
                for (int b = 0; b < 4; ++b) { f32x4 acc = yv[b];
#pragma unroll
                    for (int c = 0; c < 4; ++c) if (c < b) acc = __builtin_amdgcn_mfma_f32_16x16x16bf16_1k(*(const LAS bf16x4*)(L + CK_NM + (16 * b + c16) * CK_TS + (16 * c + 4 * q) * 2), ub[c], acc, 0, 0, 0);
                    bf16x4 ab; ab[0] = (short)f2bf(acc[0]); ab[1] = (short)f2bf(acc[1]); ab[2] = (short)f2bf(acc[2]); ab[3] = (short)f2bf(acc[3]);
                    const f32x4 zero = {0.f, 0.f, 0.f, 0.f};
                    const f32x4 ubf = __builtin_amdgcn_mfma_f32_16x16x16bf16_1k(*(const LAS bf16x4*)(L + CK_TD + b * 512 + c16 * 32 + 8 * q), ab, zero, 0, 0, 0);
                    ub[b][0] = (short)f2bf(ubf[0]); ub[b][1] = (short)f2bf(ubf[1]); ub[b][2] = (short)f2bf(ubf[2]); ub[b][3] = (short)f2bf(ubf[3]); }
                asm volatile("" ::: "memory");
                { int q3 = lane >> 4, c3 = lane & 15; asm volatile("" : "+v"(q3), "+v"(c3));
                  unsigned char* dstb = a.ws + (zset ? RW_O : RW_Y); const unsigned dco = ((unsigned)z * (unsigned)(NTOK * 1024) + (unsigned)(h * 64 + 16 * (w & 3) + c3)) * 2u;
#pragma unroll
                  for (int it = 0; it < 4; ++it) { f32x4 ov = {0.f, 0.f, 0.f, 0.f};
#pragma unroll
                      for (int ks = 0; ks < 2; ++ks) ov = __builtin_amdgcn_mfma_f32_16x16x32_bf16(lds_row_frag(L + CK_RH, CK_TS, 16 * it + c16, 32 * ks + 8 * q), sb[ks], ov, 0, 0, 0);
#pragma unroll
                      for (int c = 0; c < 4; ++c) if (c <= it) ov = __builtin_amdgcn_mfma_f32_16x16x16bf16_1k(*(const LAS bf16x4*)(L + CK_MRB + (16 * it + c16) * CK_TS + (16 * c + 4 * q) * 2), ub[c], ov, 0, 0, 0);
                      if (zset) {
#pragma unroll
                          for (int ks = 0; ks < 2; ++ks) ov = __builtin_amdgcn_mfma_f32_16x16x32_bf16(lds_row_frag(L + CK_MRK, CK_TS, 16 * it + c16, 32 * ks + 8 * q), vb[ks], ov, 0, 0, 0); }
#pragma unroll
                      for (int r = 0; r < 4; ++r) *(unsigned short*)(dstb + dco + (unsigned)rwkv_row(z, n0 + blk * 64 + 16 * it + 4 * q3 + r) * 2048u) = (unsigned short)f2bf(ov[r]);
                      asm volatile("" ::: "memory"); } }
                asm volatile("" ::: "memory");
#pragma unroll
                for (int kt = 0; kt < 4; ++kt) { const float dc = DEC[16 * kt + c16];
#pragma unroll
                    for (int r = 0; r < 4; ++r) accS[kt][r] *= dc;
#pragma unroll
                    for (int c = 0; c < 4; ++c) { const int g = lane >> 4, qq = (lane & 15) >> 2, pp = lane & 3;
                        const v4s16 bt = __builtin_amdgcn_ds_read_tr16_b64_v4i16((LAS v4s16*)(L + CK_BB + (16 * c + 4 * g + qq) * CK_TS + (16 * kt + 4 * pp) * 2));
                        accS[kt] = __builtin_amdgcn_mfma_f32_16x16x16bf16_1k(ub[c], (bf16x4){bt[0], bt[1], bt[2], bt[3]}, accS[kt], 0, 0, 0); } }
                if (zset) {
#pragma unroll
                    for (int ks = 0; ks < 2; ++ks) { const bf16x8 va = vb[ks];
#pragma unroll
                        for (int kt = 0; kt < 4; ++kt) accS[kt] = __builtin_amdgcn_mfma_f32_16x16x32_bf16(va, lds_tr_frag(L + CK_KB, CK_TS, 32 * ks, 16 * kt, lane), accS[kt], 0, 0, 0); } }
            }
            __syncthreads();
            if (active) {
#pragma unroll
                for (int kt = 0; kt < 4; ++kt)
#pragma unroll
                    for (int r = 0; r < 4; ++r) *(LAS unsigned short*)(L + CK_SS + (16 * w + 4 * q + r) * CK_TS + (16 * kt + c16) * 2) = (unsigned short)f2bf(accS[kt][r]);
            }
        }
        { float* dst = sidx == 0 ? (zset ? SST + ((size_t)zh * 65 + 2) * 4096 : nullptr) : PQ + ((size_t)zh * 64 + sidx) * 8192 + (zset ? 4096 : 0);
          if (dst) { int q2 = lane >> 4, c2 = lane & 15; asm volatile("" : "+v"(q2), "+v"(c2));
#pragma unroll
              for (int kt = 0; kt < 4; ++kt)
#pragma unroll
                  for (int r = 0; r < 4; ++r) dst[(16 * (w & 3) + 4 * q2 + r) * 64 + 16 * kt + c2] = accS[kt][r]; } }
        __syncthreads();
    }
}
__device__ __forceinline__ void rwkv_corr_phase(Frame& F, const Args& a) {
    const float* SST = (const float*)(a.ws + RW_SST); bf16_t* O = (bf16_t*)(a.ws + RW_O); const bf16_t* Y = (const bf16_t*)(a.ws + RW_Y);
    const int lane = F.lane, c16 = lane & 15, q = lane >> 4;
#pragma unroll 1
    for (int task = F.gw; task < 2016; task += F.ngw) {
        const int zh = task & 31, z = zh >> 4, h = zh & 15, s = (task >> 5) + 2;
        const float* Ss = SST + ((size_t)zh * 65 + s) * 4096;
        bf16x8 Sf[4][2];
#pragma unroll
        for (int vt = 0; vt < 4; ++vt)
#pragma unroll
            for (int ks = 0; ks < 2; ++ks) { const f32x4 x0 = *(const f32x4*)(Ss + (16 * vt + c16) * 64 + 32 * ks + 8 * q), x1 = *(const f32x4*)(Ss + (16 * vt + c16) * 64 + 32 * ks + 8 * q + 4);
                bf16x8 f; f[0] = (short)f2bf(x0[0]); f[1] = (short)f2bf(x0[1]); f[2] = (short)f2bf(x0[2]); f[3] = (short)f2bf(x0[3]); f[4] = (short)f2bf(x1[0]); f[5] = (short)f2bf(x1[1]); f[6] = (short)f2bf(x1[2]); f[7] = (short)f2bf(x1[3]); Sf[vt][ks] = f; }
        const bf16_t* Yz = Y + (size_t)z * NTOK * 1024 + h * 64; bf16_t* Oz = O + (size_t)z * NTOK * 1024 + h * 64;
#pragma unroll 2
        for (int T = 0; T < 16; ++T) {
            const size_t row = (size_t)rwkv_row(z, s * 256 + 16 * T + c16) * 1024;
            const bf16x8 y0 = *(const bf16x8*)(Yz + row + 8 * q), y1 = *(const bf16x8*)(Yz + row + 32 + 8 * q);
#pragma unroll
            for (int vt = 0; vt < 4; ++vt) { f32x4 d = {0.f, 0.f, 0.f, 0.f};
                d = __builtin_amdgcn_mfma_f32_16x16x32_bf16(Sf[vt][0], y0, d, 0, 0, 0); d = __builtin_amdgcn_mfma_f32_16x16x32_bf16(Sf[vt][1], y1, d, 0, 0, 0);
                u32x2* op = (u32x2*)(Oz + row + 16 * vt + 4 * q); const u32x2 old = *op;
                u32x2 nw; nw.x = pk2(bflo(old.x) + d[0], bfhi(old.x) + d[1]); nw.y = pk2(bflo(old.y) + d[2], bfhi(old.y) + d[3]); *op = nw; }
        }
    }
}
__device__ __forceinline__ void rwkv_prefix_phase(Frame& F, const Args& a) {
    const float* PQ = (const float*)(a.ws + RW_PQ); float* SST = (float*)(a.ws + RW_SST);
    if (blockIdx.x >= 128) return;
    const int zh = blockIdx.x >> 2, r0 = (blockIdx.x & 3) * 16, tid = F.tid, vl = tid >> 5, v = r0 + vl, c0 = (tid & 31) * 2;
    LAS float* Sl = (LAS float*)(F.lds + LDS_STAGE); LAS float* Pl = Sl + 16 * 68;
    { const float* s1 = SST + ((size_t)zh * 65 + 2) * 4096 + r0 * 64;
      for (int i = tid; i < 1024; i += NTHREADS) Sl[(i >> 6) * 68 + (i & 63)] = s1[i]; }
    f32x4 pn0, pn1; f32x2 qn;
    { const float* Pg = PQ + ((size_t)zh * 64 + 1) * 8192; pn0 = *(const f32x4*)(Pg + 4 * tid); pn1 = *(const f32x4*)(Pg + 4 * (tid + 512)); qn = *(const f32x2*)(Pg + 4096 + v * 64 + c0); }
#pragma unroll 1
    for (int s = 2; s < 64; ++s) {
        __syncthreads();
        *(LAS f32x4*)(Pl + 4 * tid) = pn0; *(LAS f32x4*)(Pl + 4 * (tid + 512)) = pn1;
        float a0 = qn[0], a1 = qn[1];
        if (s < 63) { const float* Pg = PQ + ((size_t)zh * 64 + s) * 8192; pn0 = *(const f32x4*)(Pg + 4 * tid); pn1 = *(const f32x4*)(Pg + 4 * (tid + 512)); qn = *(const f32x2*)(Pg + 4096 + v * 64 + c0); }
        __syncthreads();
#pragma unroll 16
        for (int k = 0; k < 64; ++k) { const float sv = Sl[vl * 68 + k]; const f32x2 pp = *(const LAS f32x2*)(Pl + k * 64 + c0); a0 += sv * pp[0]; a1 += sv * pp[1]; }
        __syncthreads();
        *(f32x2*)(SST + ((size_t)zh * 65 + s + 1) * 4096 + v * 64 + c0) = (f32x2){a0, a1};
        Sl[vl * 68 + c0] = a0; Sl[vl * 68 + c0 + 1] = a1;
    }
}
__device__ __forceinline__ void rwkv_readout_phase(Frame& F, const Args& a) {
    const bf16_t* O0 = (const bf16_t*)(a.ws + RW_O); const bf16_t* O1 = O0 + (size_t)NTOK * 1024; const bf16_t* R = (const bf16_t*)(a.ws + RW_R); const bf16_t* K = (const bf16_t*)(a.ws + RW_K);
    const bf16_t* V = (const bf16_t*)(a.ws + RW_V); const bf16_t* A0 = (const bf16_t*)(a.ws + RW_AA); const bf16_t* A1 = A0 + (size_t)NTOK * 1024; const bf16_t* G = (const bf16_t*)(a.ws + RW_G);
    bf16_t* A5 = (bf16_t*)(a.ws + RW_A5); const int lane = F.lane;
    float ka[16], rk[16], lg[16], lb[16], ab0[16], ab1[16]; ldrow_f32(a.in[20], lane, ab0); ldrow_f32(a.in[20] + 1024, lane, ab1); ldrow_f32(a.in[26], lane, ka); ldrow_f32(a.in[27], lane, rk); ldrow_f32(a.in[28], lane, lg); ldrow_f32(a.in[29], lane, lb);
    for (int t = F.gw; t < NTOK; t += F.ngw) {
        float o[16], r[16], k[16], v[16], a0[16], a1[16], g[16];
        ldrow_bf16(O0 + (size_t)t * 1024, lane, o); addrow_bf16(O1 + (size_t)t * 1024, lane, o); ldrow_bf16(R + (size_t)t * 1024, lane, r); ldrow_bf16(K + (size_t)t * 1024, lane, k);
        ldrow_bf16(V + (size_t)t * 1024, lane, v); ldrow_bf16(A0 + (size_t)t * 1024, lane, a0); ldrow_bf16(A1 + (size_t)t * 1024, lane, a1); ldrow_bf16(G + (size_t)t * 1024, lane, g);
#pragma unroll
        for (int j = 0; j < 2; ++j) { float s = 0.f, bn = 0.f;
#pragma unroll
            for (int e = 0; e < 8; ++e) { const int x = 8 * j + e; s += o[x]; bn += r[x] * k[x] * rk[x] * (2.0f + (sigmoidf_(a0[x] + ab0[x]) + sigmoidf_(a1[x] + ab1[x]) - 2.0f) * ka[x]); }
#pragma unroll
            for (int m = 1; m < 8; m <<= 1) { s += __shfl_xor(s, m); bn += __shfl_xor(bn, m); }
            const float mean = s * (1.0f / 64.0f); float q = 0.f;
#pragma unroll
            for (int e = 0; e < 8; ++e) { o[8 * j + e] -= mean; q += o[8 * j + e] * o[8 * j + e]; }
#pragma unroll
            for (int m = 1; m < 8; m <<= 1) q += __shfl_xor(q, m);
            const float rs = 1.0f / sqrtf(q * (1.0f / 64.0f) + 64e-5f);
#pragma unroll
            for (int e = 0; e < 8; ++e) { const int x = 8 * j + e; o[x] = (o[x] * rs * lg[x] + lb[x] + bn * v[x]) * g[x]; } }
        strow_bf16(A5 + (size_t)t * 1024, lane, o);
    }
}

__device__ __forceinline__ void zero_y_phase(Frame& F, const Args& a) {
    u32x4* y = (u32x4*)(a.ws + WS_MX5); const u32x4 z = {0u, 0u, 0u, 0u};
    for (size_t i = (size_t)blockIdx.x * NTHREADS + F.tid; i < (size_t)NTOK * D / 8; i += (size_t)gridDim.x * NTHREADS) y[i] = z;
}

__device__ __forceinline__ Frame mk_frame(const Args& a, unsigned char* lds_raw) {
    Frame F; int tid = threadIdx.x; asm volatile("" : "+v"(tid));
    F.lds = (LAS unsigned char*)lds_raw; F.misc = (volatile LAS unsigned*)(F.lds + LDS_MISC);
    F.tid = tid; F.lane = tid & 63; F.wave = __builtin_amdgcn_readfirstlane(tid >> 6);
    F.ws = a.ws; F.ctl = (unsigned*)(a.ws + WS_CTL);
    F.gw = blockIdx.x * NWAVES + F.wave; F.ngw = gridDim.x * NWAVES; F.tacc = 0;
    return F;
}
__global__ void __launch_bounds__(NTHREADS, 2) fwd_kernel(Args a) {
    extern __shared__ __attribute__((aligned(16))) unsigned char lds_raw[];
    if (threadIdx.x < 64) ((volatile LAS unsigned*)((LAS unsigned char*)lds_raw + LDS_MISC))[threadIdx.x] = 0u;
    __syncthreads();
    (void)xcd_barrier_post((unsigned*)(a.ws + WS_CTL) + CW_BAR, (volatile LAS unsigned*)((LAS unsigned char*)lds_raw + LDS_MISC) + 8);
    int phase = 0;
    unsigned long long pacc = 0; bool pmark = false, pmarkd = false; unsigned long long tstart_ = 0; if (TPROBE) tstart_ = __builtin_amdgcn_s_memrealtime();
#define PMARK(g) do { if (TPROBE) pmark = ((TPROBE >> (g)) & 1) != 0; } while (0)
#define PDUR(g) do { if (TPROBE) pmarkd = ((TPROBE >> (g)) & 1) != 0; } while (0)
#define PHASE(body) do { if (phase >= a.ph_lo && phase < a.ph_hi) { unsigned long long tp0_ = 0; if (TPROBE) tp0_ = __builtin_amdgcn_s_memrealtime(); { Frame F = mk_frame(a, lds_raw); body; if (TPROBE & (1 << 29)) pacc += F.tacc; } \
        unsigned long long t0_ = 0; if (TPROBE) t0_ = __builtin_amdgcn_s_memrealtime(); \
        if (phase + 1 < a.ph_hi) { XcdBarrier bar; bar.bar = (unsigned*)(a.ws + WS_CTL) + CW_BAR; bar.x = xb_xcc_id(); bar.st = (volatile LAS unsigned*)((LAS unsigned char*)lds_raw + LDS_MISC) + 8; xcd_barrier(bar); } \
        if (TPROBE) { if (pmark) pacc += __builtin_amdgcn_s_memrealtime() - t0_; pmark = false; if (pmarkd) pacc += __builtin_amdgcn_s_memrealtime() - tp0_; pmarkd = false; if ((TPROBE & (1 << 28)) && phase == 2) pacc += __builtin_amdgcn_s_memrealtime() - tstart_; } } ++phase; } while (0)

#define PHASED(bit, body) do { PHASE(body); if (DUP & (bit)) PHASE(body); } while (0)
    PHASED(1, p0_phase(F, a));
    PHASE(p1a_phase(F, a));
    PHASE(p1b_phase(F, a));

#define MOE_LAYER(L) do { \
    if (EN_MOE) { PHASE({ PMARK(7); PDUR(8); moe_route_phase<L>(F, a); if (L < 3) bg_slot<(L == 0 ? EV_ROUTE0 : L == 1 ? EV_ROUTE1 : EV_ROUTE2)>(F, a); }); if (DUP & (1 << 20)) PHASE((moe_route_phase<L, true>(F, a))); PHASE({ PDUR(9); moe_dispatch_phase<L>(F, a); }); if (DUP & (1 << 26)) PHASE((moe_dispatch_phase<L, true>(F, a))); PHASED(2, { PDUR(10); moe_gateup_phase<L>(F, a); }); PHASE((moe_down_phase<L, 4>(F, a))); if (DUP & 4) PHASE({ PDUR(11); (moe_down_phase<L, DOWN_PROBE_MODE>(F, a)); }); } \
    PHASE({ PDUR(12); (ln_phase<L, 1>(F, a)); }); if (DUP & (1 << 21)) PHASE((ln_phase<L, 1, true>(F, a))); } while (0)

    if (EN_LRU) {
        PHASED(65536, { PMARK(0); lru_in_gemm_phase(F, a); bg_slot<EV_LRU_IN>(F, a); });
        PHASED(131072, { PMARK(2); lru_scan_phase<true>(F, a); bg_slot<EV_S1>(F, a); });
        PHASED(1 << 24, { lru_carry_phase(F, a); bg_slot<EV_CARRY>(F, a); });
        PHASED(131072, { PMARK(2); lru_scan_phase<false>(F, a); bg_slot<EV_S3>(F, a); });
        PHASED(1 << 25, { PMARK(0); dense_gemm_bf16(F, (const bf16_t*)(a.ws + WS_MX2), (const bf16_t*)(a.ws + WS_W_LRU_OUT), (bf16_t*)(a.ws + WS_MX5), NTOK, 1024, 1024); bg_slot<EV_LRU_OUT>(F, a); });
    } else PHASE(zero_y_phase(F, a));
    PHASE({ bg_catch<EV_C0>(F, a); (ln_phase<0, 0>(F, a)); }); if (DUP & (1 << 22)) PHASE((ln_phase<0, 0, true>(F, a)));
    MOE_LAYER(0);
    if (EN_RWKV) {
        PHASED(64, rwkv_xm_phase(F, a));
        PHASED(128, { rwkv_in_gemm_phase(F, a); bg_slot<EV_RW_IN>(F, a); });
        PHASED(256, { rwkv_l2_gemm_phase(F, a); bg_slot<EV_RW_L2>(F, a); });
#if !RWKV_CHUNKED
        PHASED(8, rwkv_rec_phase(F, a));
#endif
#if RWKV_CHUNKED
        PHASED(16, { PMARK(3); rwkv_chunk_phase(F, a); bg_slot<EV_RW_CHUNK>(F, a); });
#else
        PHASED(16, rwkv_scan_phase<0>(F, a));
#endif
        PHASED(1 << 24, { rwkv_prefix_phase(F, a); bg_slot<EV_RW_PREFIX>(F, a); });
        PHASE(rwkv_corr_phase(F, a));
        PHASED(1 << 23, rwkv_readout_phase(F, a));
        PHASED(1 << 25, { PMARK(0); dense_gemm_bf16(F, (const bf16_t*)(a.ws + RW_A5), (const bf16_t*)(a.ws + WS_W_RWKV_OUT), (bf16_t*)(a.ws + WS_MX5), NTOK, 1024, 1024); bg_slot<EV_RW_OUT>(F, a); });
    } else PHASE(zero_y_phase(F, a));
    PHASE({ bg_catch<EV_C1>(F, a); (ln_phase<1, 0>(F, a)); }); if (DUP & (1 << 22)) PHASE((ln_phase<1, 0, true>(F, a)));
    MOE_LAYER(1);
    if (EN_RET) {
        PHASED(4096, { PMARK(0); ret_in_gemm_phase(F, a); bg_slot<EV_RET_IN>(F, a); });
        PHASED(8192, { ret_p_phase(F, a); ret_transpose_phase(F, a); bg_slot<EV_RET_P>(F, a); });
        PHASED(16384, { ret_kv_phase(F, a); bg_slot<EV_RET_KV>(F, a); });
        PHASE(ret_prefix_phase<false>(F, a)); if (DUP & (1 << 27)) PHASE(ret_prefix_phase<true>(F, a));
        PHASED(32768, { PMARK(6); ret_o_phase(F, a); bg_slot<EV_RET_O>(F, a); });
        PHASED(1 << 23, ret_readout_phase(F, a));
        PHASED(1 << 25, { PMARK(1); dense_gemm_bf16(F, (const bf16_t*)(a.ws + RT_A3), (const bf16_t*)(a.ws + WS_W_RET_OUT), (bf16_t*)(a.ws + WS_MX5), NTOK, 1024, 2048); bg_slot<EV_RET_OUT>(F, a); });
    } else PHASE(zero_y_phase(F, a));
    PHASE({ bg_catch<EV_C2>(F, a); (ln_phase<2, 0>(F, a)); }); if (DUP & (1 << 22)) PHASE((ln_phase<2, 0, true>(F, a)));
    MOE_LAYER(2);
    if (EN_HGRN) {
        PHASED(2048, { PMARK(0); hgrn_in_gemm_phase(F, a); bg_slot<EV_HG_IN>(F, a); });
        PHASED(512, { PMARK(4); hgrn_chunk_phase<0>(F, a); bg_slot<EV_HG_C0>(F, a); });
        PHASE({ hgrn_prefix_phase<false>(F, a); bg_slot<EV_HG_PREFIX>(F, a); }); if (DUP & (1 << 27)) PHASE(hgrn_prefix_phase<true>(F, a));
        PHASED(1024, { PMARK(5); hgrn_chunk_phase<1>(F, a); bg_slot<EV_HG_C1>(F, a); });
        PHASED(1 << 23, hgrn_readout_phase(F, a));
        PHASED(1 << 25, dense_gemm_bf16(F, (const bf16_t*)(a.ws + HG_A4) + (size_t)NCTX * 1024, (const bf16_t*)(a.ws + WS_W_HGRN_OUT), (bf16_t*)(a.ws + WS_MX5) + (size_t)NCTX * 1024, SEQ, 1024, 1024));
    } else PHASE(zero_y_phase(F, a));
    PHASE({ bg_catch<EV_C3>(F, a); (ln_phase<3, 0>(F, a)); }); if (DUP & (1 << 22)) PHASE((ln_phase<3, 0, true>(F, a)));
    MOE_LAYER(3);
    if (TPROBE) { if (blockIdx.x == 200 && threadIdx.x == 0) { const unsigned long long ts = __builtin_amdgcn_s_memrealtime(); while (__builtin_amdgcn_s_memrealtime() - ts < pacc * 20ull) __builtin_amdgcn_s_sleep(8); } }
}

extern "C" void kernel_launch(void* const* d_in, const int* in_sizes, int n_in, void* d_out, int out_size, void* d_ws, size_t ws_size, hipStream_t stream) {
    static int grid = 0;
    if (grid == 0) {
        if (n_in != 47 || out_size != SEQ * D || ws_size < WS_END) { fprintf(stderr, "kernel_launch: unexpected shapes (n_in %d out %d ws %zu need %zu)\n", n_in, out_size, ws_size, (size_t)WS_END); grid = -1; return; }
        int dev = 0, cus = 0, per_cu = 0;
        (void)hipGetDevice(&dev); (void)hipDeviceGetAttribute(&cus, hipDeviceAttributeMultiprocessorCount, dev);
        if (hipFuncSetAttribute((const void*)fwd_kernel, hipFuncAttributeMaxDynamicSharedMemorySize, LDS_BYTES) != hipSuccess) { fprintf(stderr, "kernel_launch: hipFuncSetAttribute failed\n"); grid = -1; return; }
        (void)hipOccupancyMaxActiveBlocksPerMultiprocessor(&per_cu, (const void*)fwd_kernel, NTHREADS, LDS_BYTES);
        (void)hipGetLastError();
        if (per_cu < 1) fprintf(stderr, "kernel_launch: occupancy query says %d blocks per CU\n", per_cu);
        grid = cus;
    }
    if (grid < 0) return;
    (void)hipMemsetAsync((char*)d_ws + WS_CTL, 0, CTL_BYTES, stream);
    Args a; memset(&a, 0, sizeof(a));
    for (int i = 0; i < 47; ++i) a.in[i] = (const float*)d_in[i];
    a.out = (float*)d_out; a.ws = (unsigned char*)d_ws; a.ph_lo = 0; a.ph_hi = 1000;
    hipLaunchKernelGGL(fwd_kernel, dim3(grid), dim3(NTHREADS), LDS_BYTES, stream, a);
}
```

```cpp
#include <hip/hip_runtime.h>
#include <stdint.h>
#include <stdio.h>
#include <string.h>

#define LAS __attribute__((address_space(3)))
#define GAS __attribute__((address_space(1)))
typedef unsigned short bf16_t;
typedef short bf16x8 __attribute__((ext_vector_type(8)));
typedef short bf16x4 __attribute__((ext_vector_type(4)));
typedef float f32x4 __attribute__((ext_vector_type(4)));
typedef float f32x2 __attribute__((ext_vector_type(2)));
typedef unsigned u32x4 __attribute__((ext_vector_type(4)));
typedef unsigned u32x2 __attribute__((ext_vector_type(2)));

constexpr int D = 1024, SEQ = 16384, NCTX = 256, NTOK = SEQ + NCTX;
constexpr int NE = 64, TOPK = 8, EDIM = 256;
constexpr float ALPHA = 1.681792830507429f;
constexpr float LN_EPS = 1e-5f;
constexpr int NTHREADS = 512, NWAVES = 8;

#ifndef TPROBE
#define TPROBE 0
#endif
#define BQ(q) ((TPROBE & 0xFF) ? 0 : (q))
#ifndef DUP
#define DUP 0
#define DOWN_PROBE_MODE 3
#endif
#ifndef RWKV_CHUNKED
#define RWKV_CHUNKED 1
#endif
#ifndef EN_LRU
#define EN_LRU 1
#endif
#ifndef EN_RWKV
#define EN_RWKV 1
#endif
#ifndef EN_RET
#define EN_RET 1
#endif
#ifndef EN_HGRN
#define EN_HGRN 1
#endif
#ifndef EN_MOE
#define EN_MOE 1
#endif

__device__ __forceinline__ unsigned f2bf(float f) { unsigned u = __builtin_bit_cast(unsigned, f); return (u + 0x7fffu + ((u >> 16) & 1u)) >> 16; }
__device__ __forceinline__ float bf2f(unsigned b) { return __builtin_bit_cast(float, b << 16); }
__device__ __forceinline__ unsigned pk2(float lo, float hi) { unsigned r; asm volatile("v_cvt_pk_bf16_f32 %0, %1, %2" : "=v"(r) : "v"(lo), "v"(hi)); return r; }
__device__ __forceinline__ float bflo(unsigned w) { return __builtin_bit_cast(float, w << 16); }
__device__ __forceinline__ float bfhi(unsigned w) { return __builtin_bit_cast(float, w & 0xffff0000u); }
__device__ __forceinline__ float sigmoidf_(float x) { return __builtin_amdgcn_rcpf(1.0f + __expf(-x)); }
__device__ __forceinline__ float siluf_(float x) { return x * __builtin_amdgcn_rcpf(1.0f + __expf(-x)); }
__device__ __forceinline__ float wave_sum(float v) {
#pragma unroll
    for (int o = 1; o < 64; o <<= 1) v += __shfl_xor(v, o);
    return v;
}

#define XB_TMO      128
#define XB_XCNT(j)  (256  + 64 * (j))
#define XB_XSUB(j)  (1280 + 64 * (j))
#define XB_XGEN(j)  (2304 + 64 * (j))
#define XB_TOP      3328
#define XB_TOPGEN   3392
#define XCD_BAR_WORDS 3456
#define XB_SPIN_CAP (1u << 22)
__device__ __forceinline__ unsigned xb_ld(unsigned* p)              { return __hip_atomic_load(p, __ATOMIC_RELAXED, __HIP_MEMORY_SCOPE_AGENT); }
__device__ __forceinline__ unsigned xb_add(unsigned* p, unsigned v) { return __hip_atomic_fetch_add(p, v, __ATOMIC_RELAXED, __HIP_MEMORY_SCOPE_AGENT); }
__device__ __forceinline__ unsigned xb_xcc_id() { return (unsigned)__builtin_amdgcn_s_getreg((3 << 11) | 20) & 0xFu; }
#define XB_SPIN(cond, bar) do { unsigned _sp = 0; while (cond) { __builtin_amdgcn_s_sleep(1); \
    if ((++_sp & 255u) == 0u) { if (xb_ld(&(bar)[XB_TMO])) break; if (_sp > XB_SPIN_CAP) { atomicAdd(&(bar)[XB_TMO], 1u); break; } } } } while (0)
struct XcdBarrier { unsigned* bar; unsigned x; volatile LAS unsigned* st; };
__device__ __forceinline__ XcdBarrier xcd_barrier_post(unsigned* bar, volatile LAS unsigned* st) {
    XcdBarrier b; b.bar = bar; b.x = xb_xcc_id(); b.st = st;
    if (threadIdx.x == 0) (void)xb_add(&bar[XB_XCNT(b.x)], 1u);
    return b;
}
__device__ __forceinline__ void xcd_barrier_complete(unsigned* bar, unsigned x, unsigned& nloc, unsigned& nx) {
    const unsigned G = gridDim.x * gridDim.y * gridDim.z;
    unsigned sum, cnt, mine, sp = 0u;
    for (;;) {
        sum = 0u; cnt = 0u; mine = 0u;
#pragma unroll
        for (unsigned j = 0; j < 16; ++j) { const unsigned c = xb_ld(&bar[XB_XCNT(j)]); sum += c; cnt += (c > 0u) ? 1u : 0u; mine = (j == x) ? c : mine; }
        if (sum == G) break;
        __builtin_amdgcn_s_sleep(1);
        if ((++sp & 255u) == 0u) { if (xb_ld(&bar[XB_TMO])) break; if (sp > XB_SPIN_CAP) { atomicAdd(&bar[XB_TMO], 1u); break; } }
    }
    nloc = mine > 0u ? mine : 1u; nx = cnt > 0u ? cnt : 1u;
}
__device__ __forceinline__ void xcd_barrier(const XcdBarrier& b) {
    asm volatile("s_waitcnt vmcnt(0)" ::: "memory");
    __syncthreads();
    if (threadIdx.x == 0) {
        unsigned* bar = b.bar;
        __builtin_amdgcn_s_waitcnt(0);
        unsigned nloc = b.st[0], nx = b.st[1];
        if (nloc == 0u) { xcd_barrier_complete(bar, b.x, nloc, nx); b.st[0] = nloc; b.st[1] = nx; }
        const unsigned old = xb_add(&bar[XB_XSUB(b.x)], 1u);
        const unsigned gen = old / nloc;
        if (old + 1u == (gen + 1u) * nloc) {
            __builtin_amdgcn_fence(__ATOMIC_RELEASE, "agent");
            asm volatile("s_waitcnt vmcnt(0)" ::: "memory");
            const unsigned og = xb_add(&bar[XB_TOP], 1u);
            const unsigned tg = og / nx;
            if (og + 1u == (tg + 1u) * nx) xb_add(&bar[XB_TOPGEN], 1u);
            else XB_SPIN(xb_ld(&bar[XB_TOPGEN]) == tg, bar);
            __builtin_amdgcn_fence(__ATOMIC_ACQUIRE, "agent");
            xb_add(&bar[XB_XGEN(b.x)], 1u);
            asm volatile("s_waitcnt vmcnt(0)" ::: "memory");
        } else {
            XB_SPIN(xb_ld(&bar[XB_XGEN(b.x)]) == gen, bar);
            __builtin_amdgcn_fence(__ATOMIC_ACQUIRE, "agent");
            asm volatile("s_waitcnt vmcnt(0)" ::: "memory");
        }
    }
    __syncthreads();
}

namespace gg {
constexpr int BM = 256, BK = 64, HALF = 128, HTB = HALF * BK * 2, STAGE_BYTES = 8 * HTB;
__device__ __forceinline__ int lds_byte(int r, int c) { const int st = (r >> 4) * 2 + (c >> 5), rr = r & 15, cc = c & 31, ob = rr * 64 + cc * 2; return st * 1024 + (ob ^ (((ob >> 9) & 1) << 5)); }
__device__ __forceinline__ void stage_rc(int b, int& R, int& C) { const int st = b / 1024, sb = b % 1024, swz = sb ^ (((sb >> 9) & 1) << 5); R = (st >> 1) * 16 + swz / 64; C = (st & 1) * 32 + (swz % 64) / 2; }
__device__ __forceinline__ int perm32(int rho) { const int n = rho >> 4, i = rho & 15; return 8 * (i >> 2) + 4 * n + (i & 3); }

struct Unit { const char* a; const char* b; const char* b2; int pm, pn, gofs, x; };
struct Dims { int K, lda, ldb, kseg, ldb2; };

typedef f32x4 Acc[2][2][4][2];

template <class Epi, class Sched, bool GATHER, bool SEGB>
__device__ __forceinline__ void gemm_phase(LAS unsigned char* lds, const Dims dm, const Sched& S, const Epi& E) {
    const int tid = threadIdx.x, wid = __builtin_amdgcn_readfirstlane(tid >> 6), lane = tid & 63, wr = wid >> 2, wc = wid & 3, fr = lane & 15, fq = lane >> 4;
    const int K = dm.K, nt = K / BK;
    unsigned voffB[2], voffB2[2], cAo[2][2], nAo[2][2]; int gR[2], gC[2];
    const unsigned hstepA = (unsigned)HALF * dm.lda * 2u, hstepB = (unsigned)HALF * dm.ldb * 2u, hstepB2 = (unsigned)HALF * dm.ldb2 * 2u;
#pragma unroll
    for (int i = 0; i < 2; ++i) { int R, C; stage_rc(tid * 16 + i * 8192, R, C); const int Rb = Epi::PERM ? ((R & ~31) + perm32(R & 31)) : R;
        gR[i] = R; gC[i] = C * 2; voffB[i] = (unsigned)(Rb * dm.ldb + C) * 2u; voffB2[i] = SEGB ? (unsigned)(Rb * dm.ldb2 + C) * 2u : 0u;
        cAo[0][i] = (unsigned)(R * dm.lda + C) * 2u; cAo[1][i] = cAo[0][i] + hstepA; }
    const unsigned ldsw = (unsigned)wid * 1024u;
    const int aoff = lds_byte(wr * 64 + fr, fq * 8), boff = lds_byte(wc * 32 + fr, fq * 8);
#define GG_SA(b, h) (((b) * 2 + (h)) * HTB)
#define GG_SB(b, h) ((4 + (b) * 2 + (h)) * HTB)
#define GG_STAGE(bufoff, gbase, voff) do { _Pragma("unroll") for (int _i = 0; _i < 2; ++_i) \
        __builtin_amdgcn_global_load_lds((const unsigned*)((const char*)(gbase) + (voff)[_i]), (LAS unsigned*)(lds + (bufoff) + ldsw + _i * 8192), 16, 0, 0); } while (0)
#define GG_LDA(dst, b, h) do { _Pragma("unroll") for (int m = 0; m < 4; ++m) _Pragma("unroll") for (int k = 0; k < 2; ++k) dst[m][k] = *(const LAS bf16x8*)(lds + GG_SA(b, h) + aoff + m * 2048 + k * 1024); } while (0)
#define GG_LDB(dst, b, h) do { _Pragma("unroll") for (int n = 0; n < 2; ++n) _Pragma("unroll") for (int k = 0; k < 2; ++k) dst[n][k] = *(const LAS bf16x8*)(lds + GG_SB(b, h) + boff + n * 2048 + k * 1024); } while (0)
#define GG_MMA(ai, bj, At, Bt) do { __builtin_amdgcn_s_setprio(1); _Pragma("unroll") for (int m = 0; m < 4; ++m) _Pragma("unroll") for (int n = 0; n < 2; ++n) _Pragma("unroll") for (int k = 0; k < 2; ++k) \
        acc[ai][bj][m][n] = __builtin_amdgcn_mfma_f32_16x16x32_bf16(Bt[n][k], At[m][k], acc[ai][bj][m][n], 0, 0, 0); __builtin_amdgcn_s_setprio(0); } while (0)
#define GG_WAIT_V(n) asm volatile("s_waitcnt vmcnt(" #n ")" ::: "memory")
#define GG_WAIT_L(n) asm volatile("s_waitcnt lgkmcnt(" #n ")" ::: "memory")
#define GG_BAR __builtin_amdgcn_s_barrier()
#define GG_SCHED __builtin_amdgcn_sched_barrier(0)
#define GG_BSRC(u, kt) ((SEGB && (kt) >= dm.kseg) ? (u).b2 + (size_t)((kt) - dm.kseg) * 128 : (u).b + (size_t)(kt) * 128)
#define GG_STAGE_B(bufoff, u, kt, h) do { const bool _s2 = SEGB && (kt) >= dm.kseg; \
        const char* _bp = _s2 ? (u).b2 + (size_t)((kt) - dm.kseg) * 128 + (h) * hstepB2 : (u).b + (size_t)(kt) * 128 + (h) * hstepB; \
        unsigned _vo[2]; _vo[0] = _s2 ? voffB2[0] : voffB[0]; _vo[1] = _s2 ? voffB2[1] : voffB[1]; GG_STAGE(bufoff, _bp, _vo); } while (0)
#define GG_GOFF(u, dst) do { if (GATHER) { const LAS int* _ix = (const LAS int*)(lds + (u).gofs); _Pragma("unroll") for (int _h = 0; _h < 2; ++_h) _Pragma("unroll") for (int _i = 0; _i < 2; ++_i) \
        dst[_h][_i] = (unsigned)_ix[_h * 128 + gR[_i]] * (unsigned)(dm.lda * 2) + (unsigned)gC[_i]; } } while (0)
    Unit cur, nxt; int ui = 0;
    if (!S.next(0, cur)) return;
    Acc acc;
#pragma unroll
    for (int a = 0; a < 2; ++a)
#pragma unroll
        for (int b = 0; b < 2; ++b)
#pragma unroll
            for (int m = 0; m < 4; ++m)
#pragma unroll
                for (int n = 0; n < 2; ++n) acc[a][b][m][n] = (f32x4){0.f, 0.f, 0.f, 0.f};
    bf16x8 At[4][2], B0[2][2], B1[2][2];
    GG_GOFF(cur, cAo);
    GG_STAGE_B(GG_SB(0, 0), cur, 0, 0); GG_STAGE(GG_SA(0, 0), cur.a, cAo[0]); GG_STAGE_B(GG_SB(0, 1), cur, 0, 1); GG_STAGE(GG_SA(0, 1), cur.a, cAo[1]);
    if (wr == 1) GG_BAR;
    GG_WAIT_V(4); GG_BAR;
    GG_STAGE_B(GG_SB(1, 0), cur, 1, 0); GG_STAGE(GG_SA(1, 0), cur.a + 128, cAo[0]); GG_STAGE_B(GG_SB(1, 1), cur, 1, 1);
    GG_WAIT_V(6); GG_BAR;
    for (;;) {
        const bool has_next = S.next(ui + 1, nxt);
        if (!has_next) nxt = cur;
        if (GATHER) { if (has_next) { GG_GOFF(nxt, nAo); } else {
#pragma unroll
            for (int h = 0; h < 2; ++h)
#pragma unroll
                for (int i = 0; i < 2; ++i) nAo[h][i] = cAo[h][i]; } }
        for (int t = 0; t < nt; t += 2) {
            const bool last = (t == nt - 2);
            const char* a1 = cur.a + (size_t)(t + 1) * 128;
            const char* a2 = last ? nxt.a : cur.a + (size_t)(t + 2) * 128;
            const char* a3 = a2 + 128;
            unsigned o2[2][2];
#pragma unroll
            for (int h = 0; h < 2; ++h)
#pragma unroll
                for (int i = 0; i < 2; ++i) o2[h][i] = (GATHER && last) ? nAo[h][i] : cAo[h][i];
            const int k2 = last ? 0 : t + 2, k3 = k2 + 1;
            struct { const char* b; const char* b2; } bu; bu.b = last ? nxt.b : cur.b; bu.b2 = last ? nxt.b2 : cur.b2;
            GG_LDB(B0, 0, 0); GG_SCHED; GG_LDA(At, 0, 0); GG_STAGE(GG_SA(1, 1), a1, cAo[1]);
            GG_WAIT_L(8); GG_BAR; GG_WAIT_L(0); GG_MMA(0, 0, At, B0); GG_BAR; GG_SCHED;
            GG_LDB(B1, 0, 1); GG_STAGE_B(GG_SB(0, 0), bu, k2, 0);
            GG_BAR; GG_WAIT_L(0); GG_MMA(0, 1, At, B1); GG_BAR;
            GG_LDA(At, 0, 1); GG_STAGE(GG_SA(0, 0), a2, o2[0]);
            GG_BAR; GG_WAIT_L(0); GG_MMA(1, 0, At, B0); GG_BAR; GG_SCHED;
            GG_STAGE_B(GG_SB(0, 1), bu, k2, 1);
            GG_WAIT_V(6); GG_BAR; GG_MMA(1, 1, At, B1); GG_BAR;
            GG_LDB(B0, 1, 0); GG_SCHED; GG_LDA(At, 1, 0); GG_STAGE(GG_SA(0, 1), a2, o2[1]);
            GG_WAIT_L(8); GG_BAR; GG_WAIT_L(0); GG_MMA(0, 0, At, B0); GG_BAR; GG_SCHED;
            GG_LDB(B1, 1, 1); GG_STAGE_B(GG_SB(1, 0), bu, k3, 0);
            GG_BAR; GG_WAIT_L(0); GG_MMA(0, 1, At, B1); GG_BAR;
            GG_LDA(At, 1, 1); GG_STAGE(GG_SA(1, 0), a3, o2[0]);
            GG_BAR; GG_WAIT_L(0); GG_MMA(1, 0, At, B0); GG_BAR; GG_SCHED;
            GG_STAGE_B(GG_SB(1, 1), bu, k3, 1);
            GG_WAIT_V(6); GG_BAR; GG_MMA(1, 1, At, B1); GG_BAR;
        }
        E(acc, cur, wr, wc, fr, fq);
        if (!has_next) break;
#pragma unroll
        for (int a = 0; a < 2; ++a)
#pragma unroll
            for (int b = 0; b < 2; ++b)
#pragma unroll
                for (int m = 0; m < 4; ++m)
#pragma unroll
                    for (int n = 0; n < 2; ++n) acc[a][b][m][n] = (f32x4){0.f, 0.f, 0.f, 0.f};
        cur = nxt; ++ui;
        if (GATHER) {
#pragma unroll
            for (int h = 0; h < 2; ++h)
#pragma unroll
                for (int i = 0; i < 2; ++i) cAo[h][i] = nAo[h][i]; }
    }
    GG_WAIT_V(0);
    if (wr == 0) GG_BAR;
    GG_BAR;
#undef GG_SA
#undef GG_SB
#undef GG_STAGE
#undef GG_LDA
#undef GG_LDB
#undef GG_MMA
#undef GG_WAIT_V
#undef GG_WAIT_L
#undef GG_BAR
#undef GG_SCHED
#undef GG_BSRC
#undef GG_STAGE_B
#undef GG_GOFF
}

struct DenseSched {
    const char* A; const char* Bt; int nM, nN, G, c; unsigned astep, bstep;
    __device__ __forceinline__ void init(const bf16_t* A_, const bf16_t* Bt_, int M, int N, int lda, int ldb) {
        A = (const char*)A_; Bt = (const char*)Bt_; nM = M / 256; nN = N / 256; G = gridDim.x; c = blockIdx.x; astep = 256u * lda * 2u; bstep = 256u * ldb * 2u; }
    __device__ __forceinline__ bool next(int i, Unit& u) const {
        const int L = i * G + c, nwg = nM * nN; if (L >= nwg) return false;
        int wgid; { const int q = nwg / 8, r = nwg % 8, xcd = L % 8, off = L / 8; wgid = (xcd < r ? xcd * (q + 1) : r * (q + 1) + (xcd - r) * q) + off; }
        const int nig = 8 * nN, gid = wgid / nig, fm = gid * 8, gsz = (nM - fm) < 8 ? (nM - fm) : 8;
        u.pm = fm + ((wgid % nig) % gsz); u.pn = (wgid % nig) / gsz;
        u.a = A + (size_t)u.pm * astep; u.b = Bt + (size_t)u.pn * bstep; u.b2 = nullptr; u.gofs = 0; u.x = 0; return true; }
};
}

constexpr size_t MiB = 1u << 20;
constexpr size_t WS_CTL = 0, CTL_BYTES = 1 * MiB;
constexpr int CW_BAR = 4096, CW_CNT = 8192, CW_CUR = 8192 + 256, CW_NT = 8192 + 512;
constexpr size_t WS_MODP = 1 * MiB, WS_MOD = 3 * MiB, WS_ROPE = 3 * MiB + 256 * 1024, WS_LBV = 3 * MiB + 512 * 1024;
constexpr size_t WS_W_LRU_IN = 4 * MiB, WS_W_LRU_OUT = 8 * MiB, WS_W_LRU_GATE = 10 * MiB;
constexpr size_t WS_W_RWKV_IN = 11 * MiB, WS_W_RWKV_L1 = 17 * MiB, WS_W_RWKV_OUT = 20 * MiB, WS_W_RWKV_WL2 = 556 * MiB;
constexpr size_t WS_W_RET_IN = 22 * MiB, WS_W_RET_OUT = 34 * MiB, WS_W_HGRN_IN = 38 * MiB, WS_W_HGRN_OUT = 48 * MiB;
constexpr size_t WS_MOE = 50 * MiB, MOE_STRIDE = 100 * MiB, MOE_GU = 0, MOE_DN = 64 * MiB, MOE_SHGU = 96 * MiB, MOE_SHDN = 97 * MiB, MOE_RT = 97 * MiB + 512 * 1024;
constexpr size_t WS_H = 450 * MiB, WS_U = 515 * MiB;
constexpr size_t WS_TOPI = 548 * MiB, WS_TOPW = 549 * MiB, WS_POS = 550 * MiB, WS_ROWTOK = 551 * MiB, WS_ROWW = 552 * MiB, WS_TILEE = 553 * MiB;
constexpr size_t WS_SCR = 560 * MiB;
constexpr size_t WS_ULO = WS_SCR + 760 * MiB;
constexpr size_t WS_DUMMY = 1500 * MiB;
constexpr int SH_BASE = 149504;
constexpr int NROWS_SORT = SH_BASE + NTOK;
constexpr size_t WS_ACT = WS_SCR, WS_OUT = WS_SCR + 82 * MiB;
constexpr size_t WS_END = WS_SCR + 880 * MiB;
constexpr size_t WS_MX0 = WS_SCR, WS_MX1 = WS_SCR + 33 * MiB, WS_MX2 = WS_SCR + 66 * MiB, WS_MX3 = WS_SCR + 99 * MiB, WS_MX4 = WS_SCR + 132 * MiB, WS_MX5 = WS_SCR + 165 * MiB;

constexpr int LDS_STAGE = 0, LDS_TAB = 131072, LDS_TAB_BYTES = 20480, LDS_MISC = LDS_TAB + LDS_TAB_BYTES, LDS_BYTES = 155648;

struct Args { const float* in[47]; float* out; unsigned char* ws; int ph_lo, ph_hi; };

struct Frame {
    LAS unsigned char* lds; volatile LAS unsigned* misc; unsigned* ctl; unsigned char* ws;
    int tid, lane, wave, gw, ngw;
    unsigned long long tacc;
};

struct TrJob { const float* src; bf16_t* dst; int ld_src, K, N, ld_dst, nb, sbs, dbs, mode, start; };
constexpr int MAXJOBS = 64;
__device__ __forceinline__ void tr_item(const TrJob& J, int item, LAS unsigned char* scr, int lane) {
    const int nblk = (J.N + 63) >> 6, kblk = J.K >> 6, per = nblk * kblk, bi = item / per, r = item - bi * per, kb = r / nblk, nb = r - kb * nblk, k0 = 64 * kb, n0 = 64 * nb;
    int c0 = n0;
    if (J.mode == 1) { const int pn = n0 >> 8, j = n0 & 255; c0 = (j < 128) ? (128 * pn + j) : (256 + 128 * pn + (j - 128)); }
    const float* W = J.src + (size_t)bi * J.sbs + (size_t)k0 * J.ld_src + c0; bf16_t* WT = J.dst + (size_t)bi * J.dbs + (size_t)n0 * J.ld_dst + k0;
    const int cq = lane & 15, rq = lane >> 4;
    const bool nok = (n0 + 4 * cq) < J.N;
    f32x4 v[16];
#pragma unroll
    for (int i = 0; i < 16; ++i) { v[i] = (f32x4){0.f, 0.f, 0.f, 0.f}; if (nok) v[i] = *(const f32x4*)(W + (size_t)(4 * i + rq) * J.ld_src + 4 * cq); }
#pragma unroll
    for (int i = 0; i < 16; ++i) { const int kk = 4 * i + rq;
#pragma unroll
        for (int e = 0; e < 4; ++e) { float x = v[i][e]; if (J.mode == 3) x = x - bf2f(f2bf(x)); *(LAS unsigned short*)(scr + (4 * cq + e) * 144 + kk * 2) = (unsigned short)f2bf(x); } }
    asm volatile("s_waitcnt lgkmcnt(0)" ::: "memory");
    const int ch = lane & 7, nr = lane >> 3;
#pragma unroll
    for (int j = 0; j < 8; ++j) { const int n = nr + 8 * j; if (n0 + n < J.N) *(u32x4*)(WT + (size_t)n * J.ld_dst + 8 * ch) = *(const LAS u32x4*)(scr + n * 144 + 16 * ch); }
    asm volatile("s_waitcnt lgkmcnt(0)" ::: "memory");
}
__device__ __forceinline__ void ldrow_f32(const float* row, int lane, float (&v)[16]) {
#pragma unroll
    for (int j = 0; j < 2; ++j) { const f32x4 a = *(const f32x4*)(row + 8 * lane + 512 * j), b = *(const f32x4*)(row + 8 * lane + 512 * j + 4);
        v[8 * j + 0] = a.x; v[8 * j + 1] = a.y; v[8 * j + 2] = a.z; v[8 * j + 3] = a.w; v[8 * j + 4] = b.x; v[8 * j + 5] = b.y; v[8 * j + 6] = b.z; v[8 * j + 7] = b.w; }
}
__device__ __forceinline__ void strow_f32(float* row, int lane, const float (&v)[16]) {
#pragma unroll
    for (int j = 0; j < 2; ++j) { *(f32x4*)(row + 8 * lane + 512 * j) = (f32x4){v[8 * j], v[8 * j + 1], v[8 * j + 2], v[8 * j + 3]}; *(f32x4*)(row + 8 * lane + 512 * j + 4) = (f32x4){v[8 * j + 4], v[8 * j + 5], v[8 * j + 6], v[8 * j + 7]}; }
}
__device__ __forceinline__ void ldrow_bf16(const bf16_t* row, int lane, float (&v)[16]) {
#pragma unroll
    for (int j = 0; j < 2; ++j) { const u32x4 a = *(const u32x4*)(row + 8 * lane + 512 * j);
        v[8 * j + 0] = bflo(a.x); v[8 * j + 1] = bfhi(a.x); v[8 * j + 2] = bflo(a.y); v[8 * j + 3] = bfhi(a.y); v[8 * j + 4] = bflo(a.z); v[8 * j + 5] = bfhi(a.z); v[8 * j + 6] = bflo(a.w); v[8 * j + 7] = bfhi(a.w); }
}
__device__ __forceinline__ void addrow_bf16(const bf16_t* row, int lane, float (&v)[16]) {
#pragma unroll
    for (int j = 0; j < 2; ++j) { const u32x4 a = *(const u32x4*)(row + 8 * lane + 512 * j);
        v[8 * j + 0] += bflo(a.x); v[8 * j + 1] += bfhi(a.x); v[8 * j + 2] += bflo(a.y); v[8 * j + 3] += bfhi(a.y); v[8 * j + 4] += bflo(a.z); v[8 * j + 5] += bfhi(a.z); v[8 * j + 6] += bflo(a.w); v[8 * j + 7] += bfhi(a.w); }
}
__device__ __forceinline__ void addrow_fp8(const unsigned char* row, int lane, float (&v)[16]) {
    typedef float f2v __attribute__((ext_vector_type(2)));
#pragma unroll
    for (int j = 0; j < 2; ++j) { const u32x2 a = *(const u32x2*)(row + 8 * lane + 512 * j);
        const f2v p0 = __builtin_amdgcn_cvt_pk_f32_fp8((int)a.x, false), p1 = __builtin_amdgcn_cvt_pk_f32_fp8((int)a.x, true), p2 = __builtin_amdgcn_cvt_pk_f32_fp8((int)a.y, false), p3 = __builtin_amdgcn_cvt_pk_f32_fp8((int)a.y, true);
        v[8 * j + 0] += p0[0]; v[8 * j + 1] += p0[1]; v[8 * j + 2] += p1[0]; v[8 * j + 3] += p1[1]; v[8 * j + 4] += p2[0]; v[8 * j + 5] += p2[1]; v[8 * j + 6] += p3[0]; v[8 * j + 7] += p3[1]; }
}
__device__ __forceinline__ void strow_bf16(bf16_t* row, int lane, const float (&v)[16]) {
#pragma unroll
    for (int j = 0; j < 2; ++j) { u32x4 o; o.x = pk2(v[8 * j], v[8 * j + 1]); o.y = pk2(v[8 * j + 2], v[8 * j + 3]); o.z = pk2(v[8 * j + 4], v[8 * j + 5]); o.w = pk2(v[8 * j + 6], v[8 * j + 7]);
        *(u32x4*)(row + 8 * lane + 512 * j) = o; }
}

#define add(src_, wsoff_, ld_src_, K_, N_, ld_dst_, nb_, sbs_, dbs_, mode_) do { TrJob J; J.src = (src_); J.dst = (bf16_t*)(a.ws + (wsoff_)); J.ld_src = (ld_src_); J.K = (K_); J.N = (N_); J.ld_dst = (ld_dst_); \
            J.nb = (nb_); J.sbs = (sbs_); J.dbs = (dbs_); J.mode = (mode_); J.start = start; jobs[n] = J; start += (nb_) * ((K_) / 64) * (((N_) + 63) / 64); ++n; } while (0)
__device__ __forceinline__ void add_moe_jobs(TrJob* jobs, int& n, int& start, const Args& a, int l) {
    const size_t mb = WS_MOE + l * MOE_STRIDE;
    add(a.in[43] + (size_t)l * 64 * 1024 * 512, mb + MOE_GU, 512, 1024, 512, 1024, 64, 1024 * 512, 512 * 1024, 1);
    add(a.in[44] + (size_t)l * 64 * 256 * 1024, mb + MOE_DN, 1024, 256, 1024, 256, 64, 256 * 1024, 1024 * 256, 0);
    add(a.in[45] + (size_t)l * 1024 * 512, mb + MOE_SHGU, 512, 1024, 512, 1024, 1, 0, 0, 1);
    add(a.in[46] + (size_t)l * 256 * 1024, mb + MOE_SHDN, 1024, 256, 1024, 256, 1, 0, 0, 0);
    add(a.in[41] + (size_t)l * 1024 * 64, mb + MOE_RT, 64, 1024, 64, 1024, 1, 0, 0, 2);
    add(a.in[41] + (size_t)l * 1024 * 64, mb + MOE_RT + 64 * 1024 * 2, 64, 1024, 64, 1024, 1, 0, 0, 3);
}
constexpr int BG_PER_LAYER = 12512, BG_NJOBS = 28, BG_E0 = 12512, BG_E1 = 27072, BG_E2 = 41120, BG_TOTAL = 53632;
constexpr int BG_NW = 8;
__device__ __forceinline__ void bg_convert(Frame& F, const Args& a, int lo, int hi, int first, int stride, bool active = true) {
    if (lo >= hi) return;
    __syncthreads();
    TrJob* jobs = (TrJob*)(F.lds + LDS_TAB);
    if (F.tid == 0) { int n = 0, start = 0;
        add_moe_jobs(jobs, n, start, a, 0);
        add_moe_jobs(jobs, n, start, a, 1);
        add(a.in[31], WS_W_RET_IN, 6144, 1024, 6144, 1024, 1, 0, 0, 0);
        add(a.in[35], WS_W_RET_OUT, 1024, 2048, 1024, 2048, 1, 0, 0, 0);
        add_moe_jobs(jobs, n, start, a, 2);
        add(a.in[36], WS_W_HGRN_IN, 5120, 1024, 5120, 1024, 1, 0, 0, 0);
        add(a.in[40], WS_W_HGRN_OUT, 1024, 1024, 1024, 1024, 1, 0, 0, 0);
        add_moe_jobs(jobs, n, start, a, 3);
        { TrJob J = jobs[n - 1]; J.start = start; J.nb = 0; jobs[n] = J; } }
    __syncthreads();
    LAS unsigned char* scr = F.lds + LDS_STAGE + F.wave * 16384;
    if (active) for (int it = lo + first; it < hi; it += stride) {
        int j = 0; while (j + 1 < BG_NJOBS && jobs[j + 1].start <= it) ++j;
        const TrJob J = jobs[j];
        tr_item(J, it - J.start, scr, F.lane);
    }
    __syncthreads();
}
enum BgEv { EV_LRU_IN, EV_S1, EV_CARRY, EV_S3, EV_LRU_OUT, EV_C0, EV_ROUTE0, EV_RW_IN, EV_RW_L2, EV_RW_CHUNK, EV_RW_PREFIX, EV_RW_OUT, EV_C1, EV_ROUTE1,
            EV_RET_IN, EV_RET_P, EV_RET_KV, EV_RET_O, EV_RET_OUT, EV_C2, EV_ROUTE2, EV_HG_IN, EV_HG_C0, EV_HG_PREFIX, EV_HG_C1, EV_C3 };
template <int EV>
__device__ __forceinline__ void bg_range(int G, int& lo, int& hi, int& nidle, int& rem) {
    int ptr = 0; lo = hi = 0; nidle = 0; rem = 0;
#define BG_SLOT(e, rem_, q) if (EV >= (e)) { const int r_ = (rem_), ni_ = G > r_ ? G - r_ : 0; lo = ptr; hi = min(ptr + ((q) * ni_ * 8) / 2, BG_TOTAL); ptr = hi; nidle = ni_; rem = r_; }
#define BG_CATCH(e, end_) if (EV >= (e)) { lo = ptr; hi = max(ptr, (end_)); ptr = hi; nidle = 0; rem = 0; }
    BG_SLOT(EV_LRU_IN, 520 % G, BQ(3)) BG_SLOT(EV_S1, 8, BQ(7)) BG_SLOT(EV_CARRY, 4, 0) BG_SLOT(EV_S3, 8, BQ(7)) BG_SLOT(EV_LRU_OUT, 260 % G, BQ(3)) BG_CATCH(EV_C0, BG_E0)
    BG_SLOT(EV_ROUTE0, 1040 % G, 0) BG_SLOT(EV_RW_IN, 975 % G, 0) BG_SLOT(EV_RW_L2, 1300 % G, 0) BG_SLOT(EV_RW_CHUNK, 32, BQ(7)) BG_SLOT(EV_RW_PREFIX, 128, 0) BG_SLOT(EV_RW_OUT, 260 % G, BQ(3)) BG_CATCH(EV_C1, BG_E1)
    BG_SLOT(EV_ROUTE1, 1040 % G, 0) BG_SLOT(EV_RET_IN, 1560 % G, BQ(3)) BG_SLOT(EV_RET_P, 260 % G, 0) BG_SLOT(EV_RET_KV, 1040 % G, 0) BG_SLOT(EV_RET_O, 520 % G, BQ(3)) BG_SLOT(EV_RET_OUT, 260 % G, BQ(7)) BG_CATCH(EV_C2, BG_E2)
    BG_SLOT(EV_ROUTE2, 1040 % G, 0) BG_SLOT(EV_HG_IN, 1300 % G, BQ(3)) BG_SLOT(EV_HG_C0, 1040 % G, BQ(3)) BG_SLOT(EV_HG_PREFIX, 128, 0) BG_SLOT(EV_HG_C1, 1040 % G, BQ(7)) BG_CATCH(EV_C3, BG_TOTAL)
#undef BG_SLOT
#undef BG_CATCH
}
template <int EV>
__device__ __forceinline__ void bg_slot(Frame& F, const Args& a) {
    int lo, hi, nidle, rem; bg_range<EV>((int)gridDim.x, lo, hi, nidle, rem);
    const int c = (int)blockIdx.x;
    if (nidle > 0 && c >= rem) { unsigned long long t0 = 0; if (TPROBE) t0 = __builtin_amdgcn_s_memrealtime(); bg_convert(F, a, lo, hi, (c - rem) * BG_NW + F.wave, nidle * BG_NW, F.wave < BG_NW); if (TPROBE) F.tacc += __builtin_amdgcn_s_memrealtime() - t0; }
}
template <int EV>
__device__ __forceinline__ void bg_catch(Frame& F, const Args& a) {
    int lo, hi, nidle, rem; bg_range<EV>((int)gridDim.x, lo, hi, nidle, rem);
    bg_convert(F, a, lo, hi, F.gw, F.ngw);
}

__device__ __forceinline__ void p0_phase(Frame& F, const Args& a) {
    TrJob* jobs = (TrJob*)(F.lds + LDS_TAB);
    int* njobs = (int*)(F.lds + LDS_TAB + MAXJOBS * sizeof(TrJob));
    if (F.tid == 0) {
        int n = 0, start = 0;
        add(a.in[8], WS_W_LRU_IN, 2048, 1024, 2048, 1024, 1, 0, 0, 0);
        add(a.in[14], WS_W_LRU_OUT, 1024, 1024, 1024, 1024, 1, 0, 0, 0);
        add(a.in[11], WS_W_LRU_GATE, 64, 64, 64, 64, 64, 4096, 4096, 0);
        add(a.in[16], WS_W_RWKV_IN, 1024, 1024, 1024, 1024, 3, 1024 * 1024, 1024 * 1024, 0);
        add(a.in[18], WS_W_RWKV_L1, 64, 1024, 64, 1024, 2, 1024 * 64, 64 * 1024, 0);
        add(a.in[21], WS_W_RWKV_L1 + 256 * 1024 * 2, 64, 1024, 64, 1024, 2, 1024 * 64, 64 * 1024, 0);
        add(a.in[23], WS_W_RWKV_L1 + 512 * 1024 * 2, 128, 1024, 128, 1024, 1, 0, 0, 0);
        add(a.in[19], WS_W_RWKV_WL2, 1024, 64, 1024, 256, 1, 0, 0, 0);
        add(a.in[19] + 64 * 1024, WS_W_RWKV_WL2 + (size_t)(1 * 1024 * 256 + 64) * 2, 1024, 64, 1024, 256, 1, 0, 0, 0);
        add(a.in[22], WS_W_RWKV_WL2 + (size_t)(2 * 1024 * 256) * 2, 1024, 64, 1024, 256, 1, 0, 0, 0);
        add(a.in[22] + 64 * 1024, WS_W_RWKV_WL2 + (size_t)(3 * 1024 * 256 + 64) * 2, 1024, 64, 1024, 256, 1, 0, 0, 0);
        add(a.in[24], WS_W_RWKV_WL2 + (size_t)(4 * 1024 * 256) * 2, 1024, 128, 1024, 256, 1, 0, 0, 0);
        add(a.in[30], WS_W_RWKV_OUT, 1024, 1024, 1024, 1024, 1, 0, 0, 0);
        { TrJob J = jobs[n - 1]; J.start = start; J.nb = 0; jobs[n] = J; }
        *njobs = n;
#undef add
    }
    __syncthreads();
    const int nj = *njobs, total = jobs[nj].start;
    LAS unsigned char* scr = F.lds + LDS_STAGE + F.wave * 16384;
    for (int it = F.gw; it < total; it += F.ngw) {
        int j = 0; while (j + 1 < nj && jobs[j + 1].start <= it) ++j;
        const TrJob J = jobs[j];
        tr_item(J, it - J.start, scr, F.lane);
    }
    { u32x4* z = (u32x4*)(a.ws + WS_W_RWKV_L1); const u32x4 zero = {0u, 0u, 0u, 0u};
      for (int i = blockIdx.x * NTHREADS + F.tid; i < 3 * 128 * 128; i += gridDim.x * NTHREADS) { const int blk = i / (128 * 128), r = i % (128 * 128); z[(size_t)(blk * 256 + 128) * 128 + r] = zero; } }
    { u32x4* z = (u32x4*)(a.ws + WS_W_RWKV_WL2); const u32x4 zero = {0u, 0u, 0u, 0u};
      for (int i = blockIdx.x * NTHREADS + F.tid; i < 5 * 1024 * 32; i += gridDim.x * NTHREADS) { const int g = i / (1024 * 32), c8 = (i & 31) * 8;
          const int lo = (g == 1 || g == 3) ? 64 : 0, hi = (g == 4) ? 128 : lo + 64; if (c8 < lo || c8 >= hi) z[i] = zero; } }
    const float* cvec = a.in[1]; const float* ccvec = a.in[3]; const float* adaw = a.in[4];
    float* modp = (float*)(a.ws + WS_MODP);
    for (int it = F.wave * (int)gridDim.x + (int)blockIdx.x; it < 4 * 24 * 8; it += F.ngw) {
        const int s = it & 7, cb = (it >> 3) % 24, l = it / 192, j = cb * 256 + 4 * F.lane;
        const float* W = adaw + ((size_t)l * 1024 + s * 128) * 6144 + j;
        f32x4 al = {0.f, 0.f, 0.f, 0.f}, ac = {0.f, 0.f, 0.f, 0.f};
#pragma unroll 16
        for (int k = 0; k < 128; ++k) { const f32x4 w = *(const f32x4*)(W + (size_t)k * 6144); const float sl = siluf_(cvec[s * 128 + k]), sc = siluf_(ccvec[s * 128 + k]); al += sl * w; ac += sc * w; }
        *(f32x4*)(modp + ((size_t)(s * 4 + l) * 2 + 0) * 6144 + j) = al; *(f32x4*)(modp + ((size_t)(s * 4 + l) * 2 + 1) * 6144 + j) = ac;
    }
    { const int gt = blockIdx.x * NTHREADS + F.tid, ngt = gridDim.x * NTHREADS;
      float* rope = (float*)(a.ws + WS_ROPE);
      for (int i = gt; i < 256 * 64; i += ngt) { const int p = i >> 6, f = i & 63; const double ang = (double)p * pow(10000.0, -(double)f / 64.0); rope[i] = (float)cos(ang); rope[256 * 64 + i] = (float)sin(ang); }
      float* lbv = (float*)(a.ws + WS_LBV); const float* hl = a.in[38];
      for (int i = gt; i < 1024; i += ngt) { const float x0 = hl[i], x1 = hl[1024 + i], x2 = hl[2048 + i], x3 = hl[3072 + i]; const float m = fmaxf(fmaxf(x0, x1), fmaxf(x2, x3));
          const float e0 = expf(x0 - m), e1 = expf(x1 - m), e2 = expf(x2 - m), e3 = expf(x3 - m); lbv[i] = (e1 + e2 + e3) / (e0 + e1 + e2 + e3); } }
}
__device__ __forceinline__ void p1a_phase(Frame& F, const Args& a) {
    const float* modp = (const float*)(a.ws + WS_MODP); float* mod = (float*)(a.ws + WS_MOD); const float* adab = a.in[5];
    const int gt = blockIdx.x * NTHREADS + F.tid, ngt = gridDim.x * NTHREADS;
    for (int i = gt; i < 4 * 2 * 6144; i += ngt) { const int j = i % 6144, l = i / (2 * 6144);
        float s = adab[l * 6144 + j];
#pragma unroll
        for (int sl = 0; sl < 8; ++sl) s += modp[(size_t)sl * 4 * 2 * 6144 + i];
        mod[i] = s; }
}
__device__ __forceinline__ const float* modptr(const unsigned char* ws, int l, int kind, int which) { return (const float*)(ws + WS_MOD) + ((size_t)(l * 2 + kind) * 6 + which) * 1024; }
__device__ __forceinline__ void p1b_phase(Frame& F, const Args& a) {
    bf16_t* H = (bf16_t*)(a.ws + WS_H); bf16_t* U = (bf16_t*)(a.ws + WS_U);
    { int* ROWTOK = (int*)(a.ws + WS_ROWTOK); float* ROWW = (float*)(a.ws + WS_ROWW);
      for (int t = blockIdx.x * NTHREADS + F.tid; t < NTOK; t += gridDim.x * NTHREADS) { ROWTOK[SH_BASE + t] = t; ROWW[SH_BASE + t] = 1.0f; } }
    for (int t = F.gw; t < NTOK; t += F.ngw) {
        const int kind = t < NCTX ? 1 : 0; const float* src = kind ? a.in[2] + (size_t)t * D : a.in[0] + (size_t)(t - NCTX) * D;
        float v[16], m0[16], m1[16]; ldrow_f32(src, F.lane, v); ldrow_f32(modptr(a.ws, 0, kind, 0), F.lane, m0); ldrow_f32(modptr(a.ws, 0, kind, 1), F.lane, m1);
        strow_bf16(H + (size_t)t * D, F.lane, v);
#pragma unroll
        for (int e = 0; e < 16; ++e) v[e] = v[e] * (1.0f + m1[e]) + m0[e];
        strow_bf16(U + (size_t)t * D, F.lane, v);
    }
}

template <int L, int MODE, bool DRY = false>
__device__ __forceinline__ void ln_phase(Frame& F, const Args& a) {
    bf16_t* H = (bf16_t*)(a.ws + WS_H); bf16_t* U = (bf16_t*)(a.ws + WS_U);
    bf16_t* Hw = DRY ? (bf16_t*)(a.ws + WS_DUMMY) : H; bf16_t* Uw = DRY ? (bf16_t*)(a.ws + WS_DUMMY + 70 * MiB) : U; float* outw = DRY ? (float*)(a.ws + WS_DUMMY) : a.out;
    const bf16_t* Y = (const bf16_t*)(a.ws + WS_MX5); const unsigned char* OUT = (const unsigned char*)(a.ws + WS_OUT); const int* POS = (const int*)(a.ws + WS_POS);
    const float* lg = a.in[6] + (size_t)(L * 2 + MODE) * D; const float* lb = a.in[7] + (size_t)(L * 2 + MODE) * D;
    constexpr bool LASTL = (L == 3);
#pragma unroll 1
    for (int kind = 0; kind < 2; ++kind) {
        if (LASTL && kind == 1) break;
        float mg[16], g[16], b[16], msh[16], msc[16];
        ldrow_f32(modptr(a.ws, L, kind, MODE == 0 ? 2 : 5), F.lane, mg); ldrow_f32(lg, F.lane, g); ldrow_f32(lb, F.lane, b);
        if (MODE == 0) { ldrow_f32(modptr(a.ws, L, kind, 3), F.lane, msh); ldrow_f32(modptr(a.ws, L, kind, 4), F.lane, msc); }
        else if (!LASTL) { ldrow_f32(modptr(a.ws, (L + 1) & 3, kind, 0), F.lane, msh); ldrow_f32(modptr(a.ws, (L + 1) & 3, kind, 1), F.lane, msc); }
        const int t0 = kind ? 0 : NCTX, t1 = kind ? NCTX : NTOK;
#pragma unroll 1
        for (int t = t0 + F.gw; t < t1; t += F.ngw) {
            float h[16], y[16];
            ldrow_bf16(H + (size_t)t * D, F.lane, h);
            if (MODE == 0) ldrow_bf16(Y + (size_t)t * D, F.lane, y);
            else if (!EN_MOE) {
#pragma unroll
                for (int e = 0; e < 16; ++e) y[e] = 0.f;
            } else {
                int p = 0; if (F.lane < 8) p = POS[t * 8 + F.lane];
#pragma unroll
                for (int e = 0; e < 16; ++e) y[e] = 0.f;
                addrow_fp8(OUT + (size_t)(SH_BASE + t) * D, F.lane, y);
#pragma unroll
                for (int s = 0; s < 8; ++s) { const int r = __builtin_amdgcn_readlane(p, s); addrow_fp8(OUT + (size_t)r * D, F.lane, y); }
            }
            float s = 0.f;
#pragma unroll
            for (int e = 0; e < 16; ++e) { h[e] = ALPHA * h[e] + mg[e] * y[e]; s += h[e]; }
            const float mean = wave_sum(s) * (1.0f / D); float q = 0.f;
#pragma unroll
            for (int e = 0; e < 16; ++e) { h[e] -= mean; q += h[e] * h[e]; }
            const float rstd = 1.0f / sqrtf(wave_sum(q) * (1.0f / D) + LN_EPS);
#pragma unroll
            for (int e = 0; e < 16; ++e) h[e] = h[e] * rstd * g[e] + b[e];
            if (MODE == 1 && LASTL) { strow_f32(outw + (size_t)(t - NCTX) * D, F.lane, h); }
            else {
                strow_bf16(Hw + (size_t)t * D, F.lane, h);
#pragma unroll
                for (int e = 0; e < 16; ++e) h[e] = h[e] * (1.0f + msc[e]) + msh[e];
                strow_bf16(Uw + (size_t)t * D, F.lane, h);

            }
        }
    }
}

template <int L, bool DRY = false>
__device__ __forceinline__ void moe_route_phase(Frame& F, const Args& a) {
    const bf16_t* U = (const bf16_t*)(a.ws + WS_U); const bf16_t* ULO = (const bf16_t*)(a.ws + WS_ULO);
    const bf16_t* Rhi = (const bf16_t*)(a.ws + WS_MOE + L * MOE_STRIDE + MOE_RT); const bf16_t* Rlo = Rhi + 64 * 1024;
    const float* bias = a.in[42] + L * 64;
    int* TOPI = (int*)(a.ws + (DRY ? WS_DUMMY : WS_TOPI)); float* TOPW = (float*)(a.ws + (DRY ? WS_DUMMY + 4 * MiB : WS_TOPW));
    LAS float* part = (LAS float*)(F.lds + LDS_STAGE);
    const int lane = F.lane, r16 = lane & 15, q = lane >> 4, w = F.wave;
    bf16x8 Bh[4][4], Bl[4][4];
#pragma unroll
    for (int n = 0; n < 4; ++n)
#pragma unroll
        for (int ks = 0; ks < 4; ++ks) { const size_t o = (size_t)(16 * n + r16) * 1024 + 128 * w + 32 * ks + 8 * q; Bh[n][ks] = *(const bf16x8*)(Rhi + o); Bl[n][ks] = *(const bf16x8*)(Rlo + o); }
    const int g0 = (L == 3) ? NCTX / 16 : 0;
    int cnt_e = 0;
    const float mybias = bias[lane];
    bf16x8 Ahn[4];
    if (g0 + (int)blockIdx.x < NTOK / 16) { const size_t ao = (size_t)((g0 + (int)blockIdx.x) * 16 + r16) * D + 128 * w + 8 * q;
#pragma unroll
        for (int ks = 0; ks < 4; ++ks) Ahn[ks] = *(const bf16x8*)(U + ao + 32 * ks); }
#pragma unroll 1
    for (int grp = g0 + blockIdx.x; grp < NTOK / 16; grp += gridDim.x) {
        bf16x8 Ah[4];
#pragma unroll
        for (int ks = 0; ks < 4; ++ks) Ah[ks] = Ahn[ks];
        if (grp + (int)gridDim.x < NTOK / 16) { const size_t ao = (size_t)((grp + (int)gridDim.x) * 16 + r16) * D + 128 * w + 8 * q;
#pragma unroll
            for (int ks = 0; ks < 4; ++ks) Ahn[ks] = *(const bf16x8*)(U + ao + 32 * ks); }
        f32x4 acc[4];
#pragma unroll
        for (int n = 0; n < 4; ++n) { acc[n] = (f32x4){0.f, 0.f, 0.f, 0.f};
#pragma unroll
            for (int ks = 0; ks < 4; ++ks) {
                acc[n] = __builtin_amdgcn_mfma_f32_16x16x32_bf16(Ah[ks], Bh[n][ks], acc[n], 0, 0, 0);
                acc[n] = __builtin_amdgcn_mfma_f32_16x16x32_bf16(Ah[ks], Bl[n][ks], acc[n], 0, 0, 0); } }
        __syncthreads();
#pragma unroll
        for (int n = 0; n < 4; ++n)
#pragma unroll
            for (int r = 0; r < 4; ++r) part[(w * 16 + 4 * q + r) * 64 + 16 * n + r16] = acc[n][r];
        __syncthreads();
#pragma unroll 1
        for (int rr = 0; rr < 2; ++rr) {
            const int row = 2 * w + rr, t = grp * 16 + row;
            float lgt = 0.f;
#pragma unroll
            for (int ww = 0; ww < 8; ++ww) lgt += part[(ww * 16 + row) * 64 + lane];
            const float sc = sigmoidf_(lgt);
            const float ch = sc + mybias;
            float m1 = -INFINITY, m2 = -INFINITY;
#pragma unroll
            for (int j = 0; j < 8; ++j) { const float v = __shfl(ch, (lane & ~7) + j); if (v > m1) { m2 = m1; m1 = v; } else if (v > m2) m2 = v; }
            const float gs = m1 + m2; const int g = lane >> 3;
            int grank = 0;
#pragma unroll
            for (int gg2 = 0; gg2 < 8; ++gg2) { const float v = __shfl(gs, 8 * gg2); grank += (v > gs || (v == gs && gg2 < g)) ? 1 : 0; }
            const bool sel = grank < 4;
            const float chm = sel ? ch : -INFINITY;
            int rank = 0;
#pragma unroll
            for (int e2 = 0; e2 < 64; ++e2) { const float v = __builtin_bit_cast(float, __builtin_amdgcn_readlane(__builtin_bit_cast(int, chm), e2)); rank += (v > chm || (v == chm && e2 < lane)) ? 1 : 0; }
            const bool chosen = sel && rank < 8;
            const float wsum = wave_sum(chosen ? sc : 0.f);
            const unsigned long long bal = __ballot(chosen);
            const int slot = __popcll(bal & ((1ull << lane) - 1ull));
            if (chosen) { TOPI[t * 8 + slot] = lane; TOPW[t * 8 + slot] = 2.5f * sc / wsum; cnt_e++; }
        }
    }
    if (cnt_e && !DRY) atomicAdd(F.ctl + CW_CNT + L * 64 + lane, (unsigned)cnt_e);
}

template <int L, bool DRY = false>
__device__ __forceinline__ void moe_dispatch_phase(Frame& F, const Args& a) {
    LAS int* pb = (LAS int*)(F.lds + LDS_TAB);
    if (F.wave == 0) {
        const int cnt = (int)F.ctl[CW_CNT + L * 64 + F.lane]; const int pad = (cnt + 255) & ~255;
        int inc = pad;
#pragma unroll
        for (int o = 1; o < 64; o <<= 1) { const int v = __shfl_up(inc, o); if (F.lane >= o) inc += v; }
        pb[F.lane] = inc - pad; pb[65 + F.lane] = cnt; if (F.lane == 63) pb[64] = inc;
    }
    __syncthreads();
    const int* TOPI = (const int*)(a.ws + WS_TOPI); const float* TOPW = (const float*)(a.ws + WS_TOPW);
    int* POS = (int*)(a.ws + (DRY ? WS_DUMMY : WS_POS)); int* ROWTOK = (int*)(a.ws + (DRY ? WS_DUMMY + 2 * MiB : WS_ROWTOK)); float* ROWW = (float*)(a.ws + (DRY ? WS_DUMMY + 4 * MiB : WS_ROWW)); int* TILEE = (int*)(a.ws + (DRY ? WS_DUMMY + 6 * MiB : WS_TILEE));
    const int p0 = (L == 3) ? NCTX * 8 : 0;
    LAS int* lcnt = pb + 160; LAS int* lbase = pb + 224;
    const int npairs = NTOK * 8 - p0, per = (npairs + (int)gridDim.x - 1) / (int)gridDim.x, lo = p0 + (int)blockIdx.x * per, hi = min(lo + per, NTOK * 8);
#pragma unroll 1
    for (int c0 = lo; c0 < hi; c0 += NTHREADS) {
        if (F.tid < 64) lcnt[F.tid] = 0;
        __syncthreads();
        const int p = c0 + F.tid; const bool ok = p < hi; int e = 0, lrank = 0;
        if (ok) { e = TOPI[p]; lrank = atomicAdd((int*)(lcnt + e), 1); }
        __syncthreads();
        if (F.tid < 64) { const int c = lcnt[F.tid]; lbase[F.tid] = pb[F.tid] + (c ? (int)atomicAdd(F.ctl + CW_CUR + (DRY ? 1024 : 0) + L * 64 + F.tid, (unsigned)c) : 0); }
        __syncthreads();
        if (ok) { const int dest = lbase[e] + lrank; POS[p] = dest; ROWTOK[dest] = p >> 3; ROWW[dest] = TOPW[p]; }
        __syncthreads();
    }
    if (blockIdx.x < 64) {
        const int e = blockIdx.x, base = pb[e], cnt = pb[65 + e], pad = (cnt + 255) & ~255;
        for (int r = cnt + F.tid; r < pad; r += NTHREADS) { ROWTOK[base + r] = NCTX; ROWW[base + r] = 0.f; }
        for (int tl = F.tid; tl < pad / 256; tl += NTHREADS) TILEE[base / 256 + tl] = e;
    }
    if (blockIdx.x == 64 && F.tid == 0 && !DRY) F.ctl[CW_NT + L] = (unsigned)(pb[64] / 256);
    __syncthreads();
}

struct ListSched {
    const LAS gg::Unit* tab; int n;
    __device__ __forceinline__ bool next(int i, gg::Unit& u) const {
        if (i >= n) return false;
        const LAS unsigned* p = (const LAS unsigned*)(tab + i); unsigned w[10];
#pragma unroll
        for (int k = 0; k < 10; ++k) w[k] = (unsigned)__builtin_amdgcn_readfirstlane((int)p[k]);
        u.a = (const char*)(((unsigned long long)w[1] << 32) | w[0]); u.b = (const char*)(((unsigned long long)w[3] << 32) | w[2]); u.b2 = (const char*)(((unsigned long long)w[5] << 32) | w[4]);
        u.pm = (int)w[6]; u.pn = (int)w[7]; u.gofs = (int)w[8]; u.x = (int)w[9]; return true; }
};
static_assert(sizeof(gg::Unit) == 40, "Unit layout");

struct EpiSwiglu {
    static constexpr bool PERM = true;
    bf16_t* ACT; LAS unsigned char* lds;
    __device__ __forceinline__ void operator()(const gg::Acc& acc, const gg::Unit& u, int wr, int wc, int fr, int fq) const {
        const int row0 = u.pm * 256 + wr * 64 + fr, col0 = u.pn * 128 + wc * 32 + 8 * fq;
        const LAS float* wl = (const LAS float*)(lds + u.gofs + 8192);
#pragma unroll
        for (int ai = 0; ai < 2; ++ai)
#pragma unroll
            for (int m = 0; m < 4; ++m) { const int row = row0 + ai * 128 + m * 16; const float w = wl[wr * 64 + fr + ai * 128 + m * 16];
                const f32x4 g0 = acc[ai][0][m][0], g1 = acc[ai][0][m][1], u0 = acc[ai][1][m][0], u1 = acc[ai][1][m][1];
                u32x4 o; o.x = pk2(siluf_(g0[0]) * u0[0] * w, siluf_(g0[1]) * u0[1] * w); o.y = pk2(siluf_(g0[2]) * u0[2] * w, siluf_(g0[3]) * u0[3] * w);
                o.z = pk2(siluf_(g1[0]) * u1[0] * w, siluf_(g1[1]) * u1[1] * w); o.w = pk2(siluf_(g1[2]) * u1[2] * w, siluf_(g1[3]) * u1[3] * w);
                *(u32x4*)(ACT + (size_t)row * 256 + col0) = o; }
    }
};
struct EpiBf16 {
    static constexpr bool PERM = true;
    bf16_t* O; int ldc;
    __device__ __forceinline__ void operator()(const gg::Acc& acc, const gg::Unit& u, int wr, int wc, int fr, int fq) const {
        const int row0 = u.pm * 256 + wr * 64 + fr, col0 = u.pn * 256 + wc * 32 + 8 * fq;
#pragma unroll
        for (int ai = 0; ai < 2; ++ai)
#pragma unroll
            for (int m = 0; m < 4; ++m) { bf16_t* rp = O + (size_t)(row0 + ai * 128 + m * 16) * ldc + col0;
#pragma unroll
                for (int bj = 0; bj < 2; ++bj) { const f32x4 v0 = acc[ai][bj][m][0], v1 = acc[ai][bj][m][1];
                    u32x4 o; o.x = pk2(v0[0], v0[1]); o.y = pk2(v0[2], v0[3]); o.z = pk2(v1[0], v1[1]); o.w = pk2(v1[2], v1[3]);
                    *(u32x4*)(rp + bj * 128) = o; } }
    }
};

__device__ __forceinline__ unsigned pk4_fp8(float a, float b, float c, float d) { int w = __builtin_amdgcn_cvt_pk_fp8_f32(a, b, 0, false); w = __builtin_amdgcn_cvt_pk_fp8_f32(c, d, w, true); return (unsigned)w; }
struct EpiFp8 {
    static constexpr bool PERM = true;
    unsigned char* O; int rmask;
    __device__ __forceinline__ void operator()(const gg::Acc& acc, const gg::Unit& u, int wr, int wc, int fr, int fq) const {
        const int row0 = (u.pm * 256 + wr * 64 + fr) & rmask, col0 = u.pn * 256 + wc * 32 + 8 * fq;
#pragma unroll
        for (int ai = 0; ai < 2; ++ai)
#pragma unroll
            for (int m = 0; m < 4; ++m) { unsigned char* rp = O + (size_t)((row0 + ai * 128 + m * 16) & rmask) * 1024 + col0;
#pragma unroll
                for (int bj = 0; bj < 2; ++bj) { const f32x4 v0 = acc[ai][bj][m][0], v1 = acc[ai][bj][m][1];
                    u32x2 o; o.x = pk4_fp8(v0[0], v0[1], v0[2], v0[3]); o.y = pk4_fp8(v1[0], v1[1], v1[2], v1[3]);
                    *(u32x2*)(rp + bj * 128) = o; } }
    }
};
template <int L>
__device__ __forceinline__ void moe_gateup_phase(Frame& F, const Args& a) {
    const int ntr = (int)F.ctl[CW_NT + L]; constexpr int s0 = (L == 3) ? 1 : 0; const int nsh = 65 - s0, nunits = (ntr + nsh) * 2;
    gg::Unit* tab = (gg::Unit*)(F.lds + LDS_TAB); LAS int* idx = (LAS int*)(F.lds + LDS_TAB + 512);
    const int* ROWTOK = (const int*)(a.ws + WS_ROWTOK); const int* TILEE = (const int*)(a.ws + WS_TILEE); const float* ROWW = (const float*)(a.ws + WS_ROWW);
    const char* Wgu = (const char*)(a.ws + WS_MOE + L * MOE_STRIDE + MOE_GU); const char* Wsh = (const char*)(a.ws + WS_MOE + L * MOE_STRIDE + MOE_SHGU);
    int nmine = 0;
    for (int i = 0; i < 8; ++i) { const int Lq = i * (int)gridDim.x + (int)blockIdx.x; if (Lq >= nunits) break; nmine = i + 1;
        int uidx; { const int q8 = nunits / 8, r8 = nunits % 8, xcd = Lq % 8, off = Lq / 8; uidx = (xcd < r8 ? xcd * (q8 + 1) : r8 * (q8 + 1) + (xcd - r8) * q8) + off; }
        const int tile = uidx >> 1, pn = uidx & 1; const bool routed = tile < ntr;
        const int rowtile = routed ? tile : (SH_BASE / 256 + s0 + (tile - ntr));
        if (F.tid == 0) { gg::Unit u; u.a = (const char*)(a.ws + WS_U); u.b = routed ? Wgu + ((size_t)TILEE[tile] * 512 + pn * 256) * 2048 : Wsh + (size_t)(pn * 256) * 2048; u.b2 = nullptr;
            u.pm = rowtile; u.pn = pn; u.gofs = LDS_TAB + 512 + i * 1024; u.x = 0; tab[i] = u; }
        if (F.tid < 256) { idx[i * 256 + F.tid] = ROWTOK[rowtile * 256 + F.tid]; ((LAS float*)(F.lds + LDS_TAB + 512 + 8192))[i * 256 + F.tid] = ROWW[rowtile * 256 + F.tid]; }
    }
    __syncthreads();
    ListSched S{(const LAS gg::Unit*)(F.lds + LDS_TAB), nmine}; EpiSwiglu E{(bf16_t*)(a.ws + WS_ACT), F.lds};
    gg::gemm_phase<EpiSwiglu, ListSched, true, false>(F.lds + LDS_STAGE, gg::Dims{1024, 1024, 1024, 0, 0}, S, E);
}
struct EpiFp8S {
    static constexpr bool PERM = true;
    unsigned char* O; LAS unsigned char* slab;
    __device__ __forceinline__ void operator()(const gg::Acc& acc, const gg::Unit& u, int wr, int wc, int fr, int fq) const {
        int t = threadIdx.x; asm volatile("" : "+v"(t));
        const int rrow = t >> 4, rchunk = t & 15;
#pragma unroll
        for (int ai = 0; ai < 2; ++ai)
#pragma unroll
            for (int m = 0; m < 4; ++m) { const int sidx = ai * 4 + m; LAS unsigned char* sb = slab + (sidx & 1) * (32 * 264);
#pragma unroll
                for (int bj = 0; bj < 2; ++bj) { const f32x4 v0 = acc[ai][bj][m][0], v1 = acc[ai][bj][m][1];
                    u32x2 o; o.x = pk4_fp8(v0[0], v0[1], v0[2], v0[3]); o.y = pk4_fp8(v1[0], v1[1], v1[2], v1[3]);
                    *(LAS u32x2*)(sb + (wr * 16 + fr) * 264 + wc * 32 + 8 * fq + bj * 128) = o; }
                __builtin_amdgcn_s_waitcnt(0xc07f); __builtin_amdgcn_s_barrier();
                const u32x4 v = { *(const LAS unsigned*)(sb + rrow * 264 + rchunk * 16), *(const LAS unsigned*)(sb + rrow * 264 + rchunk * 16 + 4), *(const LAS unsigned*)(sb + rrow * 264 + rchunk * 16 + 8), *(const LAS unsigned*)(sb + rrow * 264 + rchunk * 16 + 12) };
                const int grow = u.pm * 256 + (rrow >> 4) * 64 + (rrow & 15) + ai * 128 + m * 16;
                *(u32x4*)(O + (size_t)grow * 1024 + u.pn * 256 + rchunk * 16) = v; }
    }
};
template <int L, int MODE = 0>
__device__ __forceinline__ void moe_down_phase(Frame& F, const Args& a) {
    constexpr bool DRY = MODE == 1;
    const int ntr = (int)F.ctl[CW_NT + L]; constexpr int s0 = (L == 3) ? 1 : 0; const int nsh = 65 - s0, nunits = (ntr + nsh) * 4;
    gg::Unit* tab = (gg::Unit*)(F.lds + LDS_TAB);
    const int* TILEE = (const int*)(a.ws + WS_TILEE);
    const char* Wdn = (const char*)(a.ws + WS_MOE + L * MOE_STRIDE + MOE_DN); const char* Wsh = (const char*)(a.ws + WS_MOE + L * MOE_STRIDE + MOE_SHDN);
    int nmine = 0;
    for (int i = 0; i < 12; ++i) { const int Lq = i * (int)gridDim.x + (int)blockIdx.x; if (Lq >= nunits) break; nmine = i + 1;
        int uidx; { const int q8 = nunits / 8, r8 = nunits % 8, xcd = Lq % 8, off = Lq / 8; uidx = (xcd < r8 ? xcd * (q8 + 1) : r8 * (q8 + 1) + (xcd - r8) * q8) + off; }
        const int tile = uidx >> 2, pn = uidx & 3; const bool routed = tile < ntr;
        const int rowtile = routed ? tile : (SH_BASE / 256 + s0 + (tile - ntr));
        if (F.tid == 0) { gg::Unit u; u.a = (const char*)(a.ws + WS_ACT) + (size_t)rowtile * 256 * 512; u.b = routed ? Wdn + ((size_t)TILEE[tile] * 1024 + pn * 256) * 512 : Wsh + (size_t)(pn * 256) * 512; u.b2 = nullptr;
            u.pm = rowtile; u.pn = pn; u.gofs = 0; u.x = 0; tab[i] = u; }
    }
    __syncthreads();
    ListSched S{(const LAS gg::Unit*)(F.lds + LDS_TAB), nmine};
    if (MODE == 3 || MODE == 4) { EpiFp8S E{(unsigned char*)(a.ws + (MODE == 3 ? WS_DUMMY : WS_OUT)), F.lds + LDS_TAB + 2048};
        gg::gemm_phase<EpiFp8S, ListSched, false, false>(F.lds + LDS_STAGE, gg::Dims{256, 256, 256, 0, 0}, S, E); }
    else { EpiFp8 E{(unsigned char*)(a.ws + (MODE == 0 ? WS_OUT : WS_DUMMY)), DRY ? 63 : 0x7fffffff};
        gg::gemm_phase<EpiFp8, ListSched, false, false>(F.lds + LDS_STAGE, gg::Dims{256, 256, 256, 0, 0}, S, E); }
}

__device__ __forceinline__ int xcd_remap(int L, int n) { const int q8 = n / 8, r8 = n % 8, xcd = L % 8, off = L / 8; return (xcd < r8 ? xcd * (q8 + 1) : r8 * (q8 + 1) + (xcd - r8) * q8) + off; }
__device__ __forceinline__ float gelu_tanh(float x) { const float z = 0.7978845608028654f * (x + 0.044715f * x * x * x); return x * (1.0f - __builtin_amdgcn_rcpf(1.0f + __expf(2.0f * z))); }
struct EpiLruIn {
    static constexpr bool PERM = true;
    bf16_t* GB; bf16_t* RNN;
    __device__ __forceinline__ void operator()(const gg::Acc& acc, const gg::Unit& u, int wr, int wc, int fr, int fq) const {
        const bool isg = u.pn < 4; bf16_t* O = isg ? GB : RNN;
        const int row0 = u.pm * 256 + wr * 64 + fr, col0 = (u.pn & 3) * 256 + wc * 32 + 8 * fq;
#pragma unroll
        for (int ai = 0; ai < 2; ++ai)
#pragma unroll
            for (int m = 0; m < 4; ++m) { bf16_t* rp = O + (size_t)(row0 + ai * 128 + m * 16) * 1024 + col0;
#pragma unroll
                for (int bj = 0; bj < 2; ++bj) { f32x4 v0 = acc[ai][bj][m][0], v1 = acc[ai][bj][m][1];
                    if (isg) {
#pragma unroll
                        for (int e = 0; e < 4; ++e) { v0[e] = gelu_tanh(v0[e]); v1[e] = gelu_tanh(v1[e]); } }
                    u32x4 o; o.x = pk2(v0[0], v0[1]); o.y = pk2(v0[2], v0[3]); o.z = pk2(v1[0], v1[1]); o.w = pk2(v1[2], v1[3]);
                    *(u32x4*)(rp + bj * 128) = o; } }
    }
};
template <bool REV>
__device__ __forceinline__ void lru_scan16(const float (&a)[4], const float (&b)[4], float (&h)[4], float& hc, float& at, int lane) {
    const int q = lane >> 4;
    float Ar[4], Br[4]; float A = 1.0f, B = 0.0f;
#pragma unroll
    for (int ri = 0; ri < 4; ++ri) { const int r = REV ? 3 - ri : ri; B = a[r] * B + b[r]; A = a[r] * A; Ar[r] = A; Br[r] = B; }
    float As = A, Bs = B;
    { const float pA = REV ? __shfl_down(As, 16) : __shfl_up(As, 16), pB = REV ? __shfl_down(Bs, 16) : __shfl_up(Bs, 16); const bool on = REV ? (q <= 2) : (q >= 1); if (on) { Bs = As * pB + Bs; As = As * pA; } }
    { const float pA = REV ? __shfl_down(As, 32) : __shfl_up(As, 32), pB = REV ? __shfl_down(Bs, 32) : __shfl_up(Bs, 32); const bool on = REV ? (q <= 1) : (q >= 2); if (on) { Bs = As * pB + Bs; As = As * pA; } }
    float eA = REV ? __shfl_down(As, 16) : __shfl_up(As, 16), eB = REV ? __shfl_down(Bs, 16) : __shfl_up(Bs, 16);
    const bool first = REV ? (q == 3) : (q == 0); if (first) { eA = 1.0f; eB = 0.0f; }
    const float Hin = eA * hc + eB;
#pragma unroll
    for (int r = 0; r < 4; ++r) h[r] = Ar[r] * Hin + Br[r];
    const int src = (REV ? 0 : 48) + (lane & 15);
    const float tA = __shfl(As, src), tB = __shfl(Bs, src);
    hc = tA * hc + tB; at *= tA;
}
template <bool SUMMARY>
__device__ __forceinline__ void lru_scan_phase(Frame& F, const Args& a) {
    const bf16_t* RNN = (const bf16_t*)(a.ws + WS_MX1); const bf16_t* GB = (const bf16_t*)(a.ws + WS_MX0); bf16_t* A2 = (bf16_t*)(a.ws + WS_MX2);
    float* SUMM = (float*)(a.ws + WS_MX3); const float* CARRY = (const float*)(a.ws + WS_MX4);
    const bf16_t* Wg = (const bf16_t*)(a.ws + WS_W_LRU_GATE);
    const float* cw = a.in[9]; const float* cb = a.in[10]; const float* gbias = a.in[12]; const float* lam = a.in[13];
    LAS unsigned char* xt = F.lds + LDS_STAGE + F.wave * 17408;
    LAS unsigned char* ot = xt + 9216;
    const int lane = F.lane, c16 = lane & 15, q = lane >> 4, cg = lane & 7, rg = lane >> 3;
#pragma unroll 1
    for (int task = F.gw; task < (NTOK / 64) * 16; task += F.ngw) {
        const int k = task >> 4;
        const int t0 = 64 * k, slo = (k < 4) ? 0 : NCTX, shi = (k < 4) ? NCTX : NTOK;
        {
            const int blk = task & 15, ch0 = blk * 64;
            {
                float w[4][8], bsv[8];
#pragma unroll
                for (int e = 0; e < 8; ++e) { bsv[e] = cb[ch0 + 8 * cg + e];
#pragma unroll
                    for (int j = 0; j < 4; ++j) w[j][e] = cw[j * 1024 + ch0 + 8 * cg + e]; }
#pragma unroll 1
                for (int ps = 0; ps < 2; ++ps) {
                    const int rq = rg + 8 * ps;
                    float xin[7][8];
#pragma unroll
                    for (int rr = 0; rr < 7; ++rr) { const int t = t0 + 4 * rq - 1 + rr; u32x4 v = {0u, 0u, 0u, 0u};
                        if (t >= slo && t < shi) v = *(const u32x4*)(RNN + (size_t)t * 1024 + ch0 + 8 * cg);
                        xin[rr][0] = bflo(v.x); xin[rr][1] = bfhi(v.x); xin[rr][2] = bflo(v.y); xin[rr][3] = bfhi(v.y); xin[rr][4] = bflo(v.z); xin[rr][5] = bfhi(v.z); xin[rr][6] = bflo(v.w); xin[rr][7] = bfhi(v.w); }
#pragma unroll
                    for (int r = 0; r < 4; ++r) { float o[8];
#pragma unroll
                        for (int e = 0; e < 8; ++e) o[e] = bsv[e] + w[0][e] * xin[r][e] + w[1][e] * xin[r + 1][e] + w[2][e] * xin[r + 2][e] + w[3][e] * xin[r + 3][e];
                        u32x4 pk; pk.x = pk2(o[0], o[1]); pk.y = pk2(o[2], o[3]); pk.z = pk2(o[4], o[5]); pk.w = pk2(o[6], o[7]);
                        *(LAS u32x4*)(xt + (4 * rq + r) * 144 + 16 * cg) = pk; }
                }
            }
            asm volatile("s_waitcnt lgkmcnt(0)" ::: "memory");
            bf16x8 Af[4][2];
#pragma unroll
            for (int T = 0; T < 4; ++T)
#pragma unroll
                for (int ks = 0; ks < 2; ++ks) Af[T][ks] = *(const LAS bf16x8*)(xt + (16 * T + c16) * 144 + (32 * ks + 8 * q) * 2);
#pragma unroll
            for (int g4 = 0; g4 < 4; ++g4) {
                const int ch = ch0 + 16 * g4 + c16;
                float xv[4][4];
#pragma unroll
                for (int T = 0; T < 4; ++T)
#pragma unroll
                    for (int r = 0; r < 4; ++r) xv[T][r] = bf2f(*(const LAS unsigned short*)(xt + (16 * T + 4 * q + r) * 144 + (16 * g4 + c16) * 2));
                float hsum[4][4];
#pragma unroll
                for (int d = 0; d < 2; ++d) {
                    f32x4 acc[2][4];
#pragma unroll
                    for (int gt = 0; gt < 2; ++gt) {
                        const bf16_t* wp = Wg + ((size_t)((d * 2 + gt) * 16 + blk) * 64 + 16 * g4 + c16) * 64 + 8 * q;
                        const bf16x8 b0 = *(const bf16x8*)wp, b1 = *(const bf16x8*)(wp + 32);
#pragma unroll
                        for (int T = 0; T < 4; ++T) { f32x4 z = {0.f, 0.f, 0.f, 0.f};
                            z = __builtin_amdgcn_mfma_f32_16x16x32_bf16(Af[T][0], b0, z, 0, 0, 0);
                            acc[gt][T] = __builtin_amdgcn_mfma_f32_16x16x32_bf16(Af[T][1], b1, z, 0, 0, 0); }
                    }
                    const float gb0 = gbias[(d * 2 + 0) * 1024 + ch], gb1 = gbias[(d * 2 + 1) * 1024 + ch];
                    const float lm = lam[d * 1024 + ch]; const float sp = log1pf(__expf(-lm));
                    float hc = 0.0f, at = 1.0f;
                    if (!SUMMARY) hc = CARRY[((size_t)d * 260 + k) * 1024 + ch];
#pragma unroll
                    for (int Ti = 0; Ti < 4; ++Ti) {
                        const int T = d ? 3 - Ti : Ti;
                        float av[4], bv[4], hv[4];
#pragma unroll
                        for (int r = 0; r < 4; ++r) { const float rgate = sigmoidf_(acc[0][T][r] + gb0), ig = sigmoidf_(acc[1][T][r] + gb1);
                            const float la = -8.0f * rgate * sp; const float aa = __expf(la); av[r] = aa; bv[r] = __builtin_amdgcn_sqrtf(fmaxf(1.0f - aa * aa, 0.f)) * ig * xv[T][r]; }
                        if (d == 0) lru_scan16<false>(av, bv, hv, hc, at, lane); else lru_scan16<true>(av, bv, hv, hc, at, lane);
                        if (!SUMMARY) {
#pragma unroll
                            for (int r = 0; r < 4; ++r) hsum[T][r] = (d == 0) ? hv[r] : hsum[T][r] + hv[r]; }
                    }
                    if (SUMMARY) { if (q == 0) { SUMM[((size_t)d * 260 + k) * 1024 + ch] = at; SUMM[((size_t)(2 + d) * 260 + k) * 1024 + ch] = hc; } }
                }
                if (!SUMMARY) {
#pragma unroll
                    for (int T = 0; T < 4; ++T)
#pragma unroll
                        for (int r = 0; r < 4; ++r) *(LAS unsigned short*)(ot + (16 * T + 4 * q + r) * 128 + (16 * g4 + c16) * 2) = (unsigned short)f2bf(hsum[T][r]);
                }
            }
            if (!SUMMARY) {
                asm volatile("s_waitcnt lgkmcnt(0)" ::: "memory");
#pragma unroll
                for (int r = 0; r < 8; ++r) { const int row = 8 * rg + r; const u32x4 hv = *(const LAS u32x4*)(ot + row * 128 + 16 * cg);
                    const u32x4 gv = *(const u32x4*)(GB + (size_t)(t0 + row) * 1024 + ch0 + 8 * cg);
                    u32x4 o; o.x = pk2(bflo(hv.x) * bflo(gv.x), bfhi(hv.x) * bfhi(gv.x)); o.y = pk2(bflo(hv.y) * bflo(gv.y), bfhi(hv.y) * bfhi(gv.y));
                    o.z = pk2(bflo(hv.z) * bflo(gv.z), bfhi(hv.z) * bfhi(gv.z)); o.w = pk2(bflo(hv.w) * bflo(gv.w), bfhi(hv.w) * bfhi(gv.w));
                    *(u32x4*)(A2 + (size_t)(t0 + row) * 1024 + ch0 + 8 * cg) = o; }
            }
            asm volatile("s_waitcnt lgkmcnt(0)" ::: "memory");
        }
    }
}
__device__ __forceinline__ void lru_carry_phase(Frame& F, const Args& a) {
    const float* SUMM = (const float*)(a.ws + WS_MX3); float* CARRY = (float*)(a.ws + WS_MX4);
    const int gid = blockIdx.x * NTHREADS + F.tid; if (gid >= 2048) return;
    const int d = gid >> 10, c = gid & 1023; float h = 0.0f;
    const float* At = SUMM + (size_t)d * 260 * 1024 + c; const float* He = SUMM + (size_t)(2 + d) * 260 * 1024 + c; float* Cy = CARRY + (size_t)d * 260 * 1024 + c;
#pragma unroll 1
    for (int b = 0; b < 10; ++b) {
        float av[26], hv[26]; int kk[26];
#pragma unroll
        for (int j = 0; j < 26; ++j) { const int st = b * 26 + j; kk[j] = d == 0 ? st : (st < 4 ? 3 - st : 263 - st); av[j] = At[(size_t)kk[j] * 1024]; hv[j] = He[(size_t)kk[j] * 1024]; }
#pragma unroll
        for (int j = 0; j < 26; ++j) { Cy[(size_t)kk[j] * 1024] = h; h = av[j] * h + hv[j]; }
    }
}
__device__ __forceinline__ void lru_in_gemm_phase(Frame& F, const Args& a) {
    gg::DenseSched S; S.init((const bf16_t*)(a.ws + WS_U), (const bf16_t*)(a.ws + WS_W_LRU_IN), NTOK, 2048, 1024, 1024);
    EpiLruIn E{(bf16_t*)(a.ws + WS_MX0), (bf16_t*)(a.ws + WS_MX1)};
    gg::gemm_phase<EpiLruIn, gg::DenseSched, false, false>(F.lds + LDS_STAGE, gg::Dims{1024, 1024, 1024, 0, 0}, S, E);
}
__device__ __forceinline__ void dense_gemm_bf16(Frame& F, const bf16_t* A, const bf16_t* Bt, bf16_t* O, int M, int N, int K) {
    gg::DenseSched S; S.init(A, Bt, M, N, K, K);
    EpiBf16 E{O, N};
    gg::gemm_phase<EpiBf16, gg::DenseSched, false, false>(F.lds + LDS_STAGE, gg::Dims{K, K, K, 0, 0}, S, E);
}

constexpr size_t RT_QR = WS_SCR, RT_KR = WS_SCR + 33 * MiB, RT_V = WS_SCR + 66 * MiB, RT_SG = WS_SCR + 132 * MiB, RT_ACAT = WS_SCR + 198 * MiB, RT_KTD = WS_SCR + 301 * MiB,
                 RT_VT = WS_SCR + 367 * MiB, RT_ST = WS_SCR + 433 * MiB, RT_O = WS_SCR + 564 * MiB, RT_A3 = RT_V, RT_END = WS_SCR + 630 * MiB;
constexpr int NBLK = NTOK / 256;
struct EpiBf16X {
    static constexpr bool PERM = true;
    bf16_t* O; int ldc;
    __device__ __forceinline__ void operator()(const gg::Acc& acc, const gg::Unit& u, int wr, int wc, int fr, int fq) const {
#pragma unroll
        for (int ai = 0; ai < 2; ++ai)
#pragma unroll
            for (int m = 0; m < 4; ++m) { bf16_t* rp = O + (size_t)(unsigned)u.x + (size_t)(ai * 128 + wr * 64 + m * 16 + fr) * ldc + wc * 32 + 8 * fq;
#pragma unroll
                for (int bj = 0; bj < 2; ++bj) { const f32x4 v0 = acc[ai][bj][m][0], v1 = acc[ai][bj][m][1];
                    u32x4 o; o.x = pk2(v0[0], v0[1]); o.y = pk2(v0[2], v0[3]); o.z = pk2(v1[0], v1[1]); o.w = pk2(v1[2], v1[3]);
                    *(u32x4*)(rp + bj * 128) = o; } }
    }
};
__device__ __forceinline__ float log_sigmoid(float x) { return -(fmaxf(-x, 0.f) + log1pf(__expf(-fabsf(x)))); }
struct EpiRetIn {
    static constexpr bool PERM = true;
    bf16_t *QR, *KR, *V, *SG, *ACAT; const float* rope; const float* decay;
    __device__ __forceinline__ void operator()(const gg::Acc& acc, const gg::Unit& u, int wr, int wc, int fr, int fq) const {
        const int pn = u.pn, row0 = u.pm * 256 + wr * 64 + fr, cx = wc * 32 + 8 * fq;
        if (pn < 8) {
            const int h = pn & 3; const bool isq = pn < 4;
            const float lg0 = log_sigmoid(decay[h]), lg1 = log_sigmoid(decay[4 + h]);
#pragma unroll
            for (int ai = 0; ai < 2; ++ai)
#pragma unroll
                for (int m = 0; m < 4; ++m) {
                    const int row = row0 + ai * 128 + m * 16, i = row & 255, b = row >> 8;
                    f32x4 lo[2] = {acc[ai][0][m][0], acc[ai][0][m][1]}, hi[2] = {acc[ai][1][m][0], acc[ai][1][m][1]};
                    if (row >= NCTX) {
                        const int tl = row - NCTX, pp = (wc < 2) ? (tl >> 6) : (tl & 63), i0 = (wc & 1) * 32 + 8 * fq;
                        const float* cp = rope + pp * 64 + i0; const float* sp = cp + 256 * 64;
#pragma unroll
                        for (int n = 0; n < 2; ++n) { const f32x4 c = *(const f32x4*)(cp + 4 * n), sn = *(const f32x4*)(sp + 4 * n);
                            const f32x4 l2 = lo[n] * c - hi[n] * sn, h2 = hi[n] * c + lo[n] * sn; lo[n] = l2; hi[n] = h2; }
                    }
                    if (isq) {
                        u32x4 o; o.x = pk2(lo[0][0], lo[0][1]); o.y = pk2(lo[0][2], lo[0][3]); o.z = pk2(lo[1][0], lo[1][1]); o.w = pk2(lo[1][2], lo[1][3]);
                        *(u32x4*)(QR + (size_t)row * 1024 + h * 256 + cx) = o;
                        o.x = pk2(hi[0][0], hi[0][1]); o.y = pk2(hi[0][2], hi[0][3]); o.z = pk2(hi[1][0], hi[1][1]); o.w = pk2(hi[1][2], hi[1][3]);
                        *(u32x4*)(QR + (size_t)row * 1024 + h * 256 + 128 + cx) = o;
                        bf16_t* ac = ACAT + ((size_t)(b * 4 + h) * 256 + i) * 768 + 256 + cx;
#pragma unroll
                        for (int d = 0; d < 2; ++d) { const float f = d ? __expf((float)(256 - i) * lg1) : __expf((float)(i + 1) * lg0);
                            o.x = pk2(lo[0][0] * f, lo[0][1] * f); o.y = pk2(lo[0][2] * f, lo[0][3] * f); o.z = pk2(lo[1][0] * f, lo[1][1] * f); o.w = pk2(lo[1][2] * f, lo[1][3] * f);
                            *(u32x4*)(ac + d * 256) = o;
                            o.x = pk2(hi[0][0] * f, hi[0][1] * f); o.y = pk2(hi[0][2] * f, hi[0][3] * f); o.z = pk2(hi[1][0] * f, hi[1][1] * f); o.w = pk2(hi[1][2] * f, hi[1][3] * f);
                            *(u32x4*)(ac + d * 256 + 128) = o; }
                    } else {
                        const float f = 0.0625f;
                        u32x4 o; o.x = pk2(lo[0][0] * f, lo[0][1] * f); o.y = pk2(lo[0][2] * f, lo[0][3] * f); o.z = pk2(lo[1][0] * f, lo[1][1] * f); o.w = pk2(lo[1][2] * f, lo[1][3] * f);
                        *(u32x4*)(KR + (size_t)row * 1024 + h * 256 + cx) = o;
                        o.x = pk2(hi[0][0] * f, hi[0][1] * f); o.y = pk2(hi[0][2] * f, hi[0][3] * f); o.z = pk2(hi[1][0] * f, hi[1][1] * f); o.w = pk2(hi[1][2] * f, hi[1][3] * f);
                        *(u32x4*)(KR + (size_t)row * 1024 + h * 256 + 128 + cx) = o;
                    }
                }
        } else {
            const bool isv = pn < 16; bf16_t* O = isv ? V : SG; const int col0 = ((pn - 8) & 7) * 256 + cx;
#pragma unroll
            for (int ai = 0; ai < 2; ++ai)
#pragma unroll
                for (int m = 0; m < 4; ++m) { bf16_t* rp = O + (size_t)(row0 + ai * 128 + m * 16) * 2048 + col0;
#pragma unroll
                    for (int bj = 0; bj < 2; ++bj) { f32x4 v0 = acc[ai][bj][m][0], v1 = acc[ai][bj][m][1];
                        if (!isv) {
#pragma unroll
                            for (int e = 0; e < 4; ++e) { v0[e] = siluf_(v0[e]); v1[e] = siluf_(v1[e]); } }
                        u32x4 o; o.x = pk2(v0[0], v0[1]); o.y = pk2(v0[2], v0[3]); o.z = pk2(v1[0], v1[1]); o.w = pk2(v1[2], v1[3]);
                        *(u32x4*)(rp + bj * 128) = o; } }
        }
    }
};
__device__ __forceinline__ void ret_in_gemm_phase(Frame& F, const Args& a) {
    gg::DenseSched S; S.init((const bf16_t*)(a.ws + WS_U), (const bf16_t*)(a.ws + WS_W_RET_IN), NTOK, 6144, 1024, 1024);
    EpiRetIn E{(bf16_t*)(a.ws + RT_QR), (bf16_t*)(a.ws + RT_KR), (bf16_t*)(a.ws + RT_V), (bf16_t*)(a.ws + RT_SG), (bf16_t*)(a.ws + RT_ACAT), (const float*)(a.ws + WS_ROPE), a.in[32]};
    gg::gemm_phase<EpiRetIn, gg::DenseSched, false, false>(F.lds + LDS_STAGE, gg::Dims{1024, 1024, 1024, 0, 0}, S, E);
}
__device__ __forceinline__ void tr64_bf16(const bf16_t* src, int ld_src, bf16_t* dst, int ld_dst, LAS unsigned char* scr, int lane, float lgam, int mode, int t0) {
    const int cg = lane & 7, rg = lane >> 3;
#pragma unroll
    for (int k = 0; k < 8; ++k) { const int t = rg + 8 * k; const u32x4 v = *(const u32x4*)(src + (size_t)t * ld_src + 8 * cg);
        float f = 1.0f; if (mode) { const int i = (t0 + t) & 255; f = __expf((float)(mode == 1 ? 255 - i : i) * lgam); }
        const unsigned w[4] = {v.x, v.y, v.z, v.w};
#pragma unroll
        for (int e = 0; e < 4; ++e) { *(LAS unsigned short*)(scr + (8 * cg + 2 * e) * 144 + t * 2) = (unsigned short)f2bf(bflo(w[e]) * f); *(LAS unsigned short*)(scr + (8 * cg + 2 * e + 1) * 144 + t * 2) = (unsigned short)f2bf(bfhi(w[e]) * f); } }
    asm volatile("s_waitcnt lgkmcnt(0)" ::: "memory");
#pragma unroll
    for (int k = 0; k < 8; ++k) { const int c = rg + 8 * k; const u32x4 v = *(const LAS u32x4*)(scr + c * 144 + 16 * cg); *(u32x4*)(dst + (size_t)c * ld_dst + 8 * cg) = v; }
    asm volatile("s_waitcnt lgkmcnt(0)" ::: "memory");
}
__device__ __forceinline__ void ret_transpose_phase(Frame& F, const Args& a) {
    const bf16_t* KR = (const bf16_t*)(a.ws + RT_KR); const bf16_t* V = (const bf16_t*)(a.ws + RT_V); bf16_t* KTD = (bf16_t*)(a.ws + RT_KTD); bf16_t* VT = (bf16_t*)(a.ws + RT_VT);
    LAS unsigned char* scr = F.lds + LDS_STAGE + F.wave * 9216;
    const float* decay = a.in[32];
    constexpr int NT = NTOK / 64;
    for (int it = F.gw; it < NT * (32 + 32); it += F.ngw) {
        const int tt = it % NT, cc = it / NT, t0 = tt * 64;
        if (cc < 32) { const int d = cc >> 4, c0 = (cc & 15) * 64, h = c0 >> 8; const float lg = log_sigmoid(decay[d * 4 + h]);
            tr64_bf16(KR + (size_t)t0 * 1024 + c0, 1024, KTD + ((size_t)d * 1024 + c0) * NTOK + t0, NTOK, scr, F.lane, lg, d ? 2 : 1, t0); }
        else { const int c0 = (cc - 32) * 64; tr64_bf16(V + (size_t)t0 * 2048 + c0, 2048, VT + (size_t)c0 * NTOK + t0, NTOK, scr, F.lane, 0.f, 0, t0); }
    }
}
struct RetKvSched {
    const char* VT; const char* KTD; int G, c;
    __device__ __forceinline__ bool next(int i, gg::Unit& u) const {
        const int L0 = i * G + c; if (L0 >= NBLK * 16) return false; const int L = xcd_remap(L0, NBLK * 16);
        const int dvt = L & 1, d = (L >> 1) & 1, h = (L >> 2) & 3, b = L >> 4;
        u.a = VT + ((size_t)(512 * h + 256 * dvt) * NTOK + 256 * b) * 2; u.b = KTD + ((size_t)(d * 1024 + 256 * h) * NTOK + 256 * b) * 2; u.b2 = nullptr;
        u.pm = 0; u.pn = 0; u.gofs = 0; u.x = ((b * 4 + h) * 512 + 256 * dvt) * 512 + 256 * d; return true; }
};
__device__ __forceinline__ void ret_kv_phase(Frame& F, const Args& a) {
    RetKvSched S{(const char*)(a.ws + RT_VT), (const char*)(a.ws + RT_KTD), (int)gridDim.x, (int)blockIdx.x};
    EpiBf16X E{(bf16_t*)(a.ws + RT_ST), 512};
    gg::gemm_phase<EpiBf16X, RetKvSched, false, false>(F.lds + LDS_STAGE, gg::Dims{256, NTOK, NTOK, 0, 0}, S, E);
}
template <bool DRY = false>
__device__ __forceinline__ void ret_prefix_phase(Frame& F, const Args& a) {
    bf16_t* ST = (bf16_t*)(a.ws + (DRY ? WS_DUMMY : RT_ST)); const float* decay = a.in[32];
    for (int gid = blockIdx.x * NTHREADS + F.tid; gid < 4 * 512 * 2 * 32; gid += gridDim.x * NTHREADS) {
        const int dk8 = gid & 31, d = (gid >> 5) & 1, dv = (gid >> 6) & 511, h = gid >> 15;
        const float gb = __expf(256.0f * log_sigmoid(decay[d * 4 + h]));
        float s[8];
#pragma unroll
        for (int e = 0; e < 8; ++e) s[e] = 0.f;
#define RT_BLK(st_) (((d == 0) || (st_) == 0) ? (st_) : (NBLK - (st_)))
#define RT_PTR(st_) ((u32x4*)(ST + ((size_t)(RT_BLK(st_) * 4 + h) * 512 + dv) * 512 + d * 256 + 8 * dk8))
        u32x4 kb[4];
#pragma unroll
        for (int j = 0; j < 4; ++j) kb[j] = *RT_PTR(j);
#pragma unroll 1
        for (int base = 0; base < 68; base += 4) {
#pragma unroll
            for (int j = 0; j < 4; ++j) { const int step = base + j; if (step < NBLK) {
                u32x4* p = RT_PTR(step); const u32x4 kv = kb[j];
                if (step + 4 < NBLK) kb[j] = *RT_PTR(step + 4);
                u32x4 o; o.x = pk2(s[0], s[1]); o.y = pk2(s[2], s[3]); o.z = pk2(s[4], s[5]); o.w = pk2(s[6], s[7]); *p = o;
                s[0] = s[0] * gb + bflo(kv.x); s[1] = s[1] * gb + bfhi(kv.x); s[2] = s[2] * gb + bflo(kv.y); s[3] = s[3] * gb + bfhi(kv.y);
                s[4] = s[4] * gb + bflo(kv.z); s[5] = s[5] * gb + bfhi(kv.z); s[6] = s[6] * gb + bflo(kv.w); s[7] = s[7] * gb + bfhi(kv.w); } }
        }
#undef RT_BLK
#undef RT_PTR
    }
    bf16_t* ACAT = (bf16_t*)(a.ws + (DRY ? WS_DUMMY + 140 * MiB : RT_ACAT));
    for (int gid = blockIdx.x * NTHREADS + F.tid; gid < NBLK * 4 * 256 * 32; gid += gridDim.x * NTHREADS) {
        const int j0 = (gid & 31) * 8, i = (gid >> 5) & 255, bh = gid >> 13, h = bh & 3;
        const float lg0 = log_sigmoid(decay[h]), lg1 = log_sigmoid(decay[4 + h]);
        u32x4* p = (u32x4*)(ACAT + ((size_t)bh * 256 + i) * 768 + j0);
        const u32x4 v = *p; const unsigned w[4] = {v.x, v.y, v.z, v.w}; unsigned o[4];
#pragma unroll
        for (int e = 0; e < 4; ++e) { const int ja = j0 + 2 * e, jb = ja + 1;
            const float wa = ((i >= ja) ? __expf((float)(i - ja) * lg0) : 0.f) + ((ja >= i) ? __expf((float)(ja - i) * lg1) : 0.f);
            const float wb = ((i >= jb) ? __expf((float)(i - jb) * lg0) : 0.f) + ((jb >= i) ? __expf((float)(jb - i) * lg1) : 0.f);
            o[e] = pk2(bflo(w[e]) * wa, bfhi(w[e]) * wb); }
        *p = (u32x4){o[0], o[1], o[2], o[3]};
    }
}
struct RetPSched {
    const char* QR; const char* KR; int G, c;
    __device__ __forceinline__ bool next(int i, gg::Unit& u) const {
        const int L0 = i * G + c; if (L0 >= NBLK * 4) return false; const int L = xcd_remap(L0, NBLK * 4);
        const int h = L & 3, b = L >> 2;
        u.a = QR + ((size_t)256 * b * 1024 + 256 * h) * 2; u.b = KR + ((size_t)256 * b * 1024 + 256 * h) * 2; u.b2 = nullptr;
        u.pm = b; u.pn = h; u.gofs = 0; u.x = (b * 4 + h) * 256 * 768; return true; }
};
__device__ __forceinline__ void ret_p_phase(Frame& F, const Args& a) {
    RetPSched S{(const char*)(a.ws + RT_QR), (const char*)(a.ws + RT_KR), (int)gridDim.x, (int)blockIdx.x};
    EpiBf16X E{(bf16_t*)(a.ws + RT_ACAT), 768};
    gg::gemm_phase<EpiBf16X, RetPSched, false, false>(F.lds + LDS_STAGE, gg::Dims{256, 1024, 1024, 0, 0}, S, E);
}
struct RetOSched {
    const char* ACAT; const char* VT; const char* ST; int G, c;
    __device__ __forceinline__ bool next(int i, gg::Unit& u) const {
        const int L0 = i * G + c; if (L0 >= NBLK * 8) return false; const int L = xcd_remap(L0, NBLK * 8);
        const int dvt = L & 1, h = (L >> 1) & 3, b = L >> 3;
        u.a = ACAT + (size_t)(b * 4 + h) * 256 * 768 * 2; u.b = VT + ((size_t)(512 * h + 256 * dvt) * NTOK + 256 * b) * 2; u.b2 = ST + ((size_t)((b * 4 + h) * 512 + 256 * dvt) * 512) * 2;
        u.pm = 0; u.pn = 0; u.gofs = 0; u.x = 256 * b * 2048 + 512 * h + 256 * dvt; return true; }
};
__device__ __forceinline__ void ret_o_phase(Frame& F, const Args& a) {
    RetOSched S{(const char*)(a.ws + RT_ACAT), (const char*)(a.ws + RT_VT), (const char*)(a.ws + RT_ST), (int)gridDim.x, (int)blockIdx.x};
    EpiBf16X E{(bf16_t*)(a.ws + RT_O), 2048};
    gg::gemm_phase<EpiBf16X, RetOSched, false, true>(F.lds + LDS_STAGE, gg::Dims{768, 768, NTOK, 4, 512}, S, E);
}
__device__ __forceinline__ void ret_readout_phase(Frame& F, const Args& a) {
    const bf16_t* O = (const bf16_t*)(a.ws + RT_O); const bf16_t* SG = (const bf16_t*)(a.ws + RT_SG); bf16_t* A3 = (bf16_t*)(a.ws + RT_A3);
    const float* gg_ = a.in[33]; const float* gb_ = a.in[34];
    const int lane = F.lane;
    for (int t = F.gw; t < NTOK; t += F.ngw) {
        float v[32]; float s = 0.f;
#pragma unroll
        for (int k = 0; k < 4; ++k) { const u32x4 w = *(const u32x4*)(O + (size_t)t * 2048 + 32 * lane + 8 * k);
            v[8 * k] = bflo(w.x); v[8 * k + 1] = bfhi(w.x); v[8 * k + 2] = bflo(w.y); v[8 * k + 3] = bfhi(w.y); v[8 * k + 4] = bflo(w.z); v[8 * k + 5] = bfhi(w.z); v[8 * k + 6] = bflo(w.w); v[8 * k + 7] = bfhi(w.w); }
#pragma unroll
        for (int e = 0; e < 32; ++e) s += v[e];
#pragma unroll
        for (int o = 1; o < 16; o <<= 1) s += __shfl_xor(s, o);
        const float mean = s * (1.0f / 512.0f); float q = 0.f;
#pragma unroll
        for (int e = 0; e < 32; ++e) { v[e] -= mean; q += v[e] * v[e]; }
#pragma unroll
        for (int o = 1; o < 16; o <<= 1) q += __shfl_xor(q, o);
        const float rstd = 1.0f / sqrtf(q * (1.0f / 512.0f) + LN_EPS);
#pragma unroll
        for (int k = 0; k < 4; ++k) { const u32x4 g = *(const u32x4*)(SG + (size_t)t * 2048 + 32 * lane + 8 * k); const unsigned gw[4] = {g.x, g.y, g.z, g.w}; unsigned ow[4];
#pragma unroll
            for (int e = 0; e < 4; ++e) { const int c = 32 * lane + 8 * k + 2 * e;
                const float y0 = (v[8 * k + 2 * e] * rstd * gg_[c] + gb_[c]) * bflo(gw[e]), y1 = (v[8 * k + 2 * e + 1] * rstd * gg_[c + 1] + gb_[c + 1]) * bfhi(gw[e]); ow[e] = pk2(y0, y1); }
            *(u32x4*)(A3 + (size_t)t * 2048 + 32 * lane + 8 * k) = (u32x4){ow[0], ow[1], ow[2], ow[3]}; }
    }
}

constexpr size_t HG_Q = WS_SCR, HG_F = WS_SCR + 33 * MiB, HG_V = WS_SCR + 99 * MiB, HG_G = WS_SCR + 132 * MiB, HG_O = WS_SCR + 165 * MiB, HG_S = WS_SCR + 231 * MiB, HG_D = WS_SCR + 297 * MiB, HG_A4 = HG_Q;
struct EpiHgrnIn {
    static constexpr bool PERM = true;
    bf16_t *Q, *Fp, *V, *G;
    __device__ __forceinline__ void operator()(const gg::Acc& acc, const gg::Unit& u, int wr, int wc, int fr, int fq) const {
        const int grp = u.pn >> 2; const bool act = (grp == 0 || grp == 4);
        bf16_t* O = grp == 0 ? Q : grp == 1 ? Fp : grp == 2 ? Fp + (size_t)NTOK * 1024 : grp == 3 ? V : G;
        const int row0 = u.pm * 256 + wr * 64 + fr, col0 = (u.pn & 3) * 256 + wc * 32 + 8 * fq;
#pragma unroll
        for (int ai = 0; ai < 2; ++ai)
#pragma unroll
            for (int m = 0; m < 4; ++m) { bf16_t* rp = O + (size_t)(row0 + ai * 128 + m * 16) * 1024 + col0;
#pragma unroll
                for (int bj = 0; bj < 2; ++bj) { f32x4 v0 = acc[ai][bj][m][0], v1 = acc[ai][bj][m][1];
                    if (act) {
#pragma unroll
                        for (int e = 0; e < 4; ++e) { v0[e] = siluf_(v0[e]); v1[e] = siluf_(v1[e]); } }
                    u32x4 o; o.x = pk2(v0[0], v0[1]); o.y = pk2(v0[2], v0[3]); o.z = pk2(v1[0], v1[1]); o.w = pk2(v1[2], v1[3]);
                    *(u32x4*)(rp + bj * 128) = o; } }
    }
};
__device__ __forceinline__ void hgrn_in_gemm_phase(Frame& F, const Args& a) {
    gg::DenseSched S; S.init((const bf16_t*)(a.ws + WS_U), (const bf16_t*)(a.ws + WS_W_HGRN_IN), NTOK, 5120, 1024, 1024);
    EpiHgrnIn E{(bf16_t*)(a.ws + HG_Q), (bf16_t*)(a.ws + HG_F), (bf16_t*)(a.ws + HG_V), (bf16_t*)(a.ws + HG_G)};
    gg::gemm_phase<EpiHgrnIn, gg::DenseSched, false, false>(F.lds + LDS_STAGE, gg::Dims{1024, 1024, 1024, 0, 0}, S, E);
}
typedef short v4s16 __attribute__((ext_vector_type(4)));
__device__ __forceinline__ bf16x8 lds_tr_frag(LAS unsigned char* tile, int stride, int r0, int c0, int lane) {
    const int g = lane >> 4, qq = (lane & 15) >> 2, p = lane & 3;
    LAS unsigned char* a0 = tile + (r0 + 8 * g + qq) * stride + (c0 + 4 * p) * 2;
    const v4s16 x = __builtin_amdgcn_ds_read_tr16_b64_v4i16((LAS v4s16*)a0), y = __builtin_amdgcn_ds_read_tr16_b64_v4i16((LAS v4s16*)(a0 + 4 * stride));
    return (bf16x8){x[0], x[1], x[2], x[3], y[0], y[1], y[2], y[3]};
}
__device__ __forceinline__ bf16x8 lds_row_frag(LAS unsigned char* tile, int stride, int row, int k0) { return *(const LAS bf16x8*)(tile + row * stride + k0 * 2); }
constexpr int HS = 272, HPS = 144;
template <int PASS>
__device__ __forceinline__ void hgrn_chunk_phase(Frame& F, const Args& a) {
    const bf16_t* Qb = (const bf16_t*)(a.ws + HG_Q); const bf16_t* Fb = (const bf16_t*)(a.ws + HG_F); const bf16_t* Vb = (const bf16_t*)(a.ws + HG_V);
    bf16_t* Ob = (bf16_t*)(a.ws + HG_O); float* Sb = (float*)(a.ws + HG_S); float* Db = (float*)(a.ws + HG_D);
    const float* LBV = (const float*)(a.ws + WS_LBV); const float* bfp = a.in[37];
    LAS unsigned char* QH = F.lds + LDS_STAGE; LAS unsigned char* KH = QH + 17408; LAS unsigned char* KB = QH + 34816; LAS unsigned char* VV = QH + 52224;
    LAS unsigned char* PP = QH + 69632; LAS unsigned char* SS = QH + 78848; LAS float* DEC = (LAS float*)(QH + 113664); LAS float* TOT = (LAS float*)(QH + 114176);
    const int tid = F.tid, lane = F.lane, w = F.wave, k = tid & 127, tg = tid >> 7, c16 = lane & 15, q4 = lane >> 4;
    const int lrow = tid >> 3, c8 = tid & 7;
    u32x4 rF[2], rV[2], rQ[2];
#define HG_ISSUE(unit_, bi_) do { const int d_ = (unit_) & 1, h_ = ((unit_) >> 1) & 7, seg_ = (unit_) >> 4; const int tr_ = (seg_ * 4 + (d_ ? 3 - (bi_) : (bi_))) * 64; \
        const size_t o_ = (size_t)(tr_ + (d_ ? 63 - lrow : lrow)) * 1024 + h_ * 128 + 8 * c8; const bf16_t* Fd_ = Fb + (size_t)d_ * NTOK * 1024; \
        rF[0] = *(const u32x4*)(Fd_ + o_); rF[1] = *(const u32x4*)(Fd_ + o_ + 64); rV[0] = *(const u32x4*)(Vb + o_); rV[1] = *(const u32x4*)(Vb + o_ + 64); \
        if (PASS) { rQ[0] = *(const u32x4*)(Qb + o_); rQ[1] = *(const u32x4*)(Qb + o_ + 64); } } while (0)
    if ((int)blockIdx.x < 65 * 16) HG_ISSUE((int)blockIdx.x, 0);
#pragma unroll 1
    for (int unit = blockIdx.x; unit < 65 * 16; unit += gridDim.x) {
        const int d = unit & 1, h = (unit >> 1) & 7, seg = unit >> 4, ch = h * 128 + k;
        const float lbv = LBV[ch], bfv = bfp[d * 1024 + ch];
        const bf16_t* Fd = Fb + (size_t)d * NTOK * 1024;
        f32x4 accS[8]; float dseg = 1.0f;
        float* Su = Sb + (size_t)unit * 16384;
#pragma unroll
        for (int kt = 0; kt < 8; ++kt)
#pragma unroll
            for (int r = 0; r < 4; ++r) accS[kt][r] = PASS ? Su[(16 * kt + 4 * q4 + r) * 128 + 16 * w + c16] : 0.f;
        if (PASS) {
#pragma unroll
            for (int kt = 0; kt < 8; ++kt)
#pragma unroll
                for (int r = 0; r < 4; ++r) *(LAS unsigned short*)(SS + (16 * kt + 4 * q4 + r) * HS + (16 * w + c16) * 2) = (unsigned short)f2bf(accS[kt][r]);
        }
#pragma unroll 1
        for (int bi = 0; bi < 4; ++bi) {
            const int trow0 = (seg * 4 + (d ? 3 - bi : bi)) * 64;
            { const int lo_ = lrow * HS + 16 * c8;
              *(LAS u32x4*)(KB + lo_) = rF[0]; *(LAS u32x4*)(KB + lo_ + 128) = rF[1]; *(LAS u32x4*)(VV + lo_) = rV[0]; *(LAS u32x4*)(VV + lo_ + 128) = rV[1];
              if (PASS) { *(LAS u32x4*)(QH + lo_) = rQ[0]; *(LAS u32x4*)(QH + lo_ + 128) = rQ[1]; } }
            { const int nu = bi < 3 ? unit : unit + (int)gridDim.x, nb = bi < 3 ? bi + 1 : 0; if (nu < 65 * 16) HG_ISSUE(nu, nb); }
            __syncthreads();
            float lfc[16]; float run = 0.f;
#pragma unroll
            for (int ii = 0; ii < 16; ++ii) { const int i = tg * 16 + ii;
                const float fp = bf2f(*(const LAS unsigned short*)(KB + i * HS + k * 2)); const float f = lbv + (1.0f - lbv) * sigmoidf_(fp + bfv);
                run += __logf(f); lfc[ii] = run; }
            TOT[tg * 128 + k] = run;
            __syncthreads();
            float off = 0.f, btot = 0.f;
#pragma unroll
            for (int g2 = 0; g2 < 4; ++g2) { const float tv = TOT[g2 * 128 + k]; btot += tv; if (g2 < tg) off += tv; }
#pragma unroll
            for (int ii = 0; ii < 16; ++ii) { const int i = tg * 16 + ii; const float B = off + lfc[ii];
                const float lf = lfc[ii] - (ii ? lfc[ii - 1] : 0.f); const float kkv = 1.0f - __expf(lf);
                *(LAS unsigned short*)(KB + i * HS + k * 2) = (unsigned short)f2bf(kkv * __expf(btot - B));
                if (PASS) { const float qv = bf2f(*(const LAS unsigned short*)(QH + i * HS + k * 2));
                            *(LAS unsigned short*)(QH + i * HS + k * 2) = (unsigned short)f2bf(qv * __expf(B));
                            *(LAS unsigned short*)(KH + i * HS + k * 2) = (unsigned short)f2bf(kkv * __expf(fminf(-B, 80.0f))); }
                if ((ii & 3) == 3) asm volatile("" ::: "memory"); }
            if (tg == 0) { const float e = __expf(btot); DEC[k] = e; dseg *= e; }
            __syncthreads();
            f32x4 ao[4];
            if (PASS) {
#pragma unroll
                for (int s2 = 0; s2 < 2; ++s2) { const int it = w >> 1, jt = 2 * (w & 1) + s2; f32x4 sc = {0.f, 0.f, 0.f, 0.f};
#pragma unroll
                    for (int ks = 0; ks < 4; ++ks) sc = __builtin_amdgcn_mfma_f32_16x16x32_bf16(lds_row_frag(QH, HS, 16 * it + c16, 32 * ks + 8 * q4), lds_row_frag(KH, HS, 16 * jt + c16, 32 * ks + 8 * q4), sc, 0, 0, 0);
#pragma unroll
                    for (int r = 0; r < 4; ++r) { const int i = 16 * it + 4 * q4 + r, j = 16 * jt + c16; *(LAS unsigned short*)(PP + i * HPS + j * 2) = (unsigned short)f2bf(j <= i ? sc[r] : 0.f); } }
                __syncthreads();
#pragma unroll
                for (int it = 0; it < 4; ++it) ao[it] = (f32x4){0.f, 0.f, 0.f, 0.f};
            }
            bf16x8 vf[2];
#pragma unroll
            for (int ks = 0; ks < 2; ++ks) vf[ks] = lds_tr_frag(VV, HS, 32 * ks, 16 * w, lane);
            if (PASS) {
#pragma unroll
                for (int ks = 0; ks < 2; ++ks)
#pragma unroll
                    for (int it = 0; it < 4; ++it) ao[it] = __builtin_amdgcn_mfma_f32_16x16x32_bf16(lds_row_frag(PP, HPS, 16 * it + c16, 32 * ks + 8 * q4), vf[ks], ao[it], 0, 0, 0);
#pragma unroll 1
                for (int ks = 0; ks < 4; ++ks) { const bf16x8 sf = lds_tr_frag(SS, HS, 32 * ks, 16 * w, lane);
#pragma unroll
                    for (int it = 0; it < 4; ++it) ao[it] = __builtin_amdgcn_mfma_f32_16x16x32_bf16(lds_row_frag(QH, HS, 16 * it + c16, 32 * ks + 8 * q4), sf, ao[it], 0, 0, 0); }
            }
#pragma unroll
            for (int kt = 0; kt < 8; ++kt) {
#pragma unroll
                for (int r = 0; r < 4; ++r) accS[kt][r] *= DEC[16 * kt + 4 * q4 + r];
#pragma unroll
                for (int ks = 0; ks < 2; ++ks) accS[kt] = __builtin_amdgcn_mfma_f32_16x16x32_bf16(lds_tr_frag(KB, HS, 32 * ks, 16 * kt, lane), vf[ks], accS[kt], 0, 0, 0);
            }
            __syncthreads();
            if (PASS) {
#pragma unroll
                for (int kt = 0; kt < 8; ++kt)
#pragma unroll
                    for (int r = 0; r < 4; ++r) *(LAS unsigned short*)(SS + (16 * kt + 4 * q4 + r) * HS + (16 * w + c16) * 2) = (unsigned short)f2bf(accS[kt][r]);
#pragma unroll
                for (int it = 0; it < 4; ++it)
#pragma unroll
                    for (int r = 0; r < 4; ++r) *(LAS unsigned short*)(KH + (16 * it + 4 * q4 + r) * HS + (16 * w + c16) * 2) = (unsigned short)f2bf(ao[it][r]);
                __syncthreads();
                bf16_t* Od = Ob + (size_t)d * NTOK * 1024;
#pragma unroll
                for (int cc = 0; cc < 2; ++cc) { const int row = tid >> 3, chunk = (tid & 7) + 8 * cc, t = trow0 + (d ? 63 - row : row);
                    *(u32x4*)(Od + (size_t)t * 1024 + h * 128 + 8 * chunk) = *(const LAS u32x4*)(KH + row * HS + 16 * chunk); }
            }
        }
        if (!PASS) {
#pragma unroll
            for (int kt = 0; kt < 8; ++kt)
#pragma unroll
                for (int r = 0; r < 4; ++r) Su[(16 * kt + 4 * q4 + r) * 128 + 16 * w + c16] = accS[kt][r];
            if (tg == 0) Db[(size_t)unit * 128 + k] = dseg;
        }
        __syncthreads();
    }
}
#undef HG_ISSUE
template <bool DRY = false>
__device__ __forceinline__ void hgrn_prefix_phase(Frame& F, const Args& a) {
    float* Sb = (float*)(a.ws + (DRY ? WS_DUMMY : HG_S)); const float* Db = (const float*)(a.ws + HG_D);
    for (int gid = blockIdx.x * NTHREADS + F.tid; gid < 16 * 4096; gid += gridDim.x * NTHREADS) {
        const int hd = gid >> 12, e4 = gid & 4095, krow = e4 >> 5, d = hd & 1;
        f32x4 s = {0.f, 0.f, 0.f, 0.f};
#define HG_SEG(st_) (((d == 0) || (st_) == 0) ? (st_) : 65 - (st_))
        f32x4 lb[4]; float db[4];
#pragma unroll
        for (int j = 0; j < 4; ++j) { const int u2 = HG_SEG(j) * 16 + hd; lb[j] = *((const f32x4*)(Sb + (size_t)u2 * 16384) + e4); db[j] = Db[(size_t)u2 * 128 + krow]; }
#pragma unroll 1
        for (int base = 0; base < 68; base += 4) {
#pragma unroll
            for (int j = 0; j < 4; ++j) { const int step = base + j; if (step < 65) {
                const int unit = HG_SEG(step) * 16 + hd; f32x4* p = (f32x4*)(Sb + (size_t)unit * 16384) + e4; const f32x4 loc = lb[j]; const float dec = db[j];
                if (step + 4 < 65) { const int u2 = HG_SEG(step + 4) * 16 + hd; lb[j] = *((const f32x4*)(Sb + (size_t)u2 * 16384) + e4); db[j] = Db[(size_t)u2 * 128 + krow]; }
                *p = s; s = s * dec + loc; } }
        }
#undef HG_SEG
    }
}
__device__ __forceinline__ void hgrn_readout_phase(Frame& F, const Args& a) {
    const bf16_t* O0 = (const bf16_t*)(a.ws + HG_O); const bf16_t* O1 = O0 + (size_t)NTOK * 1024; const bf16_t* G = (const bf16_t*)(a.ws + HG_G); bf16_t* A4 = (bf16_t*)(a.ws + HG_A4);
    const float* ng = a.in[39]; const int lane = F.lane;
    float gn[8];
#pragma unroll
    for (int e = 0; e < 8; ++e) gn[e] = ng[(8 * lane + e) & 127];
    for (int t = F.gw; t < NTOK; t += F.ngw) {
        float o[16], g[16]; ldrow_bf16(O0 + (size_t)t * 1024, lane, o); addrow_bf16(O1 + (size_t)t * 1024, lane, o); ldrow_bf16(G + (size_t)t * 1024, lane, g);
#pragma unroll
        for (int j = 0; j < 2; ++j) { float q = 0.f;
#pragma unroll
            for (int e = 0; e < 8; ++e) q += o[8 * j + e] * o[8 * j + e];
#pragma unroll
            for (int m = 1; m < 16; m <<= 1) q += __shfl_xor(q, m);
            const float rs = 1.0f / sqrtf(q * (1.0f / 128.0f) + LN_EPS);
#pragma unroll
            for (int e = 0; e < 8; ++e) o[8 * j + e] = o[8 * j + e] * rs * gn[e] * g[8 * j + e]; }
        strow_bf16(A4 + (size_t)t * 1024, lane, o);
    }
}

constexpr size_t RW_XM = WS_SCR, RW_WW = WS_SCR, RW_AA = WS_SCR + 131 * MiB, RW_R = WS_SCR + 196 * MiB, RW_K = WS_SCR + 229 * MiB, RW_V = WS_SCR + 262 * MiB, RW_L1 = WS_SCR + 295 * MiB,
                 RW_G = WS_SCR + 321 * MiB, RW_REC = WS_SCR + 354 * MiB, RW_PQ = WS_SCR + (RWKV_CHUNKED ? 354 : 0) * MiB, RW_SST = WS_SCR + (RWKV_CHUNKED ? 420 : 64) * MiB, RW_O = WS_SCR + 745 * MiB, RW_A5 = WS_SCR, RW_Y = WS_SCR + 812 * MiB, RW_END = WS_SCR + 880 * MiB;
constexpr int RECB = 768;
typedef _Float16 h2_t __attribute__((ext_vector_type(2)));
typedef _Float16 h8_t __attribute__((ext_vector_type(8)));
__device__ __forceinline__ void rwkv_xm_phase(Frame& F, const Args& a) {
    const bf16_t* U = (const bf16_t*)(a.ws + WS_U); bf16_t* XM = (bf16_t*)(a.ws + RW_XM); const float* mu = a.in[15];
    for (int t = F.gw; t < NTOK; t += F.ngw) {
        float u[16], sh[16]; ldrow_bf16(U + (size_t)t * D, F.lane, u);
        const bool hasp = (t != 0 && t != NCTX), hasn = (t != NCTX - 1 && t != NTOK - 1);
        { u32x4 pv = {0u, 0u, 0u, 0u}, nv = {0u, 0u, 0u, 0u};
          if (hasp) pv = *(const u32x4*)(U + (size_t)(t - 1) * D + 8 * F.lane);
          if (hasn) nv = *(const u32x4*)(U + (size_t)(t + 1) * D + 512 + 8 * F.lane);
          sh[0] = bflo(pv.x); sh[1] = bfhi(pv.x); sh[2] = bflo(pv.y); sh[3] = bfhi(pv.y); sh[4] = bflo(pv.z); sh[5] = bfhi(pv.z); sh[6] = bflo(pv.w); sh[7] = bfhi(pv.w);
          sh[8] = bflo(nv.x); sh[9] = bfhi(nv.x); sh[10] = bflo(nv.y); sh[11] = bfhi(nv.y); sh[12] = bflo(nv.z); sh[13] = bfhi(nv.z); sh[14] = bflo(nv.w); sh[15] = bfhi(nv.w); }
#pragma unroll 1
        for (int c = 0; c < 6; ++c) { float m[16], o[16]; ldrow_f32(mu + c * D, F.lane, m);
#pragma unroll
            for (int e = 0; e < 16; ++e) o[e] = u[e] + (sh[e] - u[e]) * m[e];
            strow_bf16(XM + ((size_t)c * NTOK + t) * D, F.lane, o); }
    }
}
struct RwkvInSched {
    const char* XM; const char* Win; const char* Wl1; int G, c;
    __device__ __forceinline__ bool next(int i, gg::Unit& u) const {
        const int L0 = i * G + c; if (L0 >= 975) return false; const int L = xcd_remap(L0, 975);
        int g, pm, pn;
        if (L < 780) { g = L / 260; const int r = L % 260; pm = r >> 2; pn = r & 3; u.b = Win + ((size_t)g * 1024 + pn * 256) * 2048; }
        else { const int r = L - 780; g = 3 + r / 65; pm = r % 65; pn = 0; u.b = Wl1 + (size_t)(g - 3) * 256 * 2048; }
        u.a = XM + ((size_t)g * NTOK + pm * 256) * 2048; u.b2 = nullptr; u.pm = pm; u.pn = pn; u.gofs = 0; u.x = g; return true; }
};
struct EpiRwkvIn {
    static constexpr bool PERM = true;
    bf16_t* RKV; bf16_t* L1;
    __device__ __forceinline__ void operator()(const gg::Acc& acc, const gg::Unit& u, int wr, int wc, int fr, int fq) const {
        const int g = u.x; const bool lora = g >= 3;
        bf16_t* O = lora ? L1 + (size_t)(g - 3) * NTOK * 256 : RKV + (size_t)g * (33 * MiB / 2); const int ldc = lora ? 256 : 1024;
        const int row0 = u.pm * 256 + wr * 64 + fr, col0 = u.pn * 256 + wc * 32 + 8 * fq;
#pragma unroll
        for (int ai = 0; ai < 2; ++ai)
#pragma unroll
            for (int m = 0; m < 4; ++m) { bf16_t* rp = O + (size_t)(row0 + ai * 128 + m * 16) * ldc + col0;
#pragma unroll
                for (int bj = 0; bj < 2; ++bj) { f32x4 v0 = acc[ai][bj][m][0], v1 = acc[ai][bj][m][1];
                    if (g == 3) {
#pragma unroll
                        for (int e = 0; e < 4; ++e) { v0[e] = 1.0f - 2.0f * __builtin_amdgcn_rcpf(1.0f + __expf(2.0f * v0[e])); v1[e] = 1.0f - 2.0f * __builtin_amdgcn_rcpf(1.0f + __expf(2.0f * v1[e])); } }
                    if (g == 5) {
#pragma unroll
                        for (int e = 0; e < 4; ++e) { v0[e] = sigmoidf_(v0[e]); v1[e] = sigmoidf_(v1[e]); } }
                    u32x4 o; o.x = pk2(v0[0], v0[1]); o.y = pk2(v0[2], v0[3]); o.z = pk2(v1[0], v1[1]); o.w = pk2(v1[2], v1[3]);
                    *(u32x4*)(rp + bj * 128) = o; } }
    }
};
__device__ __forceinline__ void rwkv_in_gemm_phase(Frame& F, const Args& a) {
    RwkvInSched S{(const char*)(a.ws + RW_XM), (const char*)(a.ws + WS_W_RWKV_IN), (const char*)(a.ws + WS_W_RWKV_L1), (int)gridDim.x, (int)blockIdx.x};
    EpiRwkvIn E{(bf16_t*)(a.ws + RW_R), (bf16_t*)(a.ws + RW_L1)};
    gg::gemm_phase<EpiRwkvIn, RwkvInSched, false, false>(F.lds + LDS_STAGE, gg::Dims{1024, 1024, 1024, 0, 0}, S, E);
}
struct RwkvL2Sched {
    const char* L1; const char* W2; int G, c;
    __device__ __forceinline__ bool next(int i, gg::Unit& u) const {
        const int L0 = i * G + c; if (L0 >= 1300) return false; const int L = xcd_remap(L0, 1300);
        const int g = L / 260, r = L % 260, pm = r >> 2, pn = r & 3, src = g >> 1;
        u.a = L1 + ((size_t)src * NTOK + pm * 256) * 512; u.b = W2 + ((size_t)g * 1024 + pn * 256) * 512; u.b2 = nullptr; u.pm = pm; u.pn = pn; u.gofs = 0; u.x = g; return true; }
};
struct EpiRwkvL2 {
    static constexpr bool PERM = true;
    float* WW; bf16_t* AA; bf16_t* GG;
    __device__ __forceinline__ void operator()(const gg::Acc& acc, const gg::Unit& u, int wr, int wc, int fr, int fq) const {
        const int g = u.x, z = g & 1; const int row0 = u.pm * 256 + wr * 64 + fr, col0 = u.pn * 256 + wc * 32 + 8 * fq;
        float* wbase = WW + (size_t)z * NTOK * 1024; bf16_t* obase = g < 4 ? AA + (size_t)z * NTOK * 1024 : GG;
#pragma unroll
        for (int ai = 0; ai < 2; ++ai)
#pragma unroll
            for (int m = 0; m < 4; ++m) { const size_t ro = (size_t)(row0 + ai * 128 + m * 16) * 1024 + col0;
#pragma unroll
                for (int bj = 0; bj < 2; ++bj) { const f32x4 v0 = acc[ai][bj][m][0], v1 = acc[ai][bj][m][1];
                    if (g < 2) { float* wp = wbase + ro + bj * 128; *(f32x4*)wp = v0; *(f32x4*)(wp + 4) = v1; }
                    else { u32x4 o; o.x = pk2(v0[0], v0[1]); o.y = pk2(v0[2], v0[3]); o.z = pk2(v1[0], v1[1]); o.w = pk2(v1[2], v1[3]); *(u32x4*)(obase + ro + bj * 128) = o; } } }
    }
};
__device__ __forceinline__ void rwkv_l2_gemm_phase(Frame& F, const Args& a) {
    RwkvL2Sched S{(const char*)(a.ws + RW_L1), (const char*)(a.ws + WS_W_RWKV_WL2), (int)gridDim.x, (int)blockIdx.x};
    EpiRwkvL2 E{(float*)(a.ws + RW_WW), (bf16_t*)(a.ws + RW_AA), (bf16_t*)(a.ws + RW_G)};
    gg::gemm_phase<EpiRwkvL2, RwkvL2Sched, false, false>(F.lds + LDS_STAGE, gg::Dims{256, 256, 256, 0, 0}, S, E);
}
__device__ __forceinline__ int rwkv_row(int z, int n) { return z == 0 ? n : (n < NCTX ? NCTX - 1 - n : NTOK - 1 + NCTX - n); }
__device__ __forceinline__ void rwkv_rec_phase(Frame& F, const Args& a) {
    const bf16_t* R = (const bf16_t*)(a.ws + RW_R); const bf16_t* K = (const bf16_t*)(a.ws + RW_K); const bf16_t* V = (const bf16_t*)(a.ws + RW_V);
    const float* WW = (const float*)(a.ws + RW_WW); const bf16_t* AA = (const bf16_t*)(a.ws + RW_AA); unsigned char* REC = a.ws + RW_REC;
    const int lane = F.lane;
    float kkw[16], kaw[16]; ldrow_f32(a.in[25], lane, kkw); ldrow_f32(a.in[26], lane, kaw);
#pragma unroll 1
    for (int t = F.gw; t < NTOK; t += F.ngw) {
        float k[16], r[16], v[16], kk[16];
        ldrow_bf16(K + (size_t)t * 1024, lane, k); ldrow_bf16(R + (size_t)t * 1024, lane, r); ldrow_bf16(V + (size_t)t * 1024, lane, v);
#pragma unroll
        for (int j = 0; j < 2; ++j) { float ss = 0.f;
#pragma unroll
            for (int e = 0; e < 8; ++e) { kk[8 * j + e] = k[8 * j + e] * kkw[8 * j + e]; ss += kk[8 * j + e] * kk[8 * j + e]; }
#pragma unroll
            for (int m = 1; m < 8; m <<= 1) ss += __shfl_xor(ss, m);
            const float rn = __builtin_amdgcn_rsqf(ss + 1e-12f);
#pragma unroll
            for (int e = 0; e < 8; ++e) kk[8 * j + e] *= rn; }
#pragma unroll
        for (int z = 0; z < 2; ++z) {
            float ap[16], wp[16], a0v[16], w0v[16];
            ldrow_bf16(AA + ((size_t)z * NTOK + t) * 1024, lane, ap); ldrow_f32(WW + ((size_t)z * NTOK + t) * 1024, lane, wp); ldrow_f32(a.in[20] + z * 1024, lane, a0v); ldrow_f32(a.in[17] + z * 1024, lane, w0v);
            const int n = (z == 0) ? t : (t < NCTX ? NCTX - 1 - t : NTOK - 1 + NCTX - t);
#pragma unroll
            for (int j = 0; j < 2; ++j) {
                const int col = 8 * lane + 512 * j, hh = col >> 6, cin = col & 63;
                h8_t ow, okk, ob, okt, orr, ov;
#pragma unroll
                for (int e = 0; e < 8; ++e) { const int x = 8 * j + e; const float av = sigmoidf_(a0v[x] + ap[x]), wv = __expf(-0.6065306597126334f * sigmoidf_(w0v[x] + wp[x]));
                    ow[e] = (_Float16)wv; okk[e] = (_Float16)kk[x]; ob[e] = (_Float16)(av * kk[x]); okt[e] = (_Float16)(k[x] * (1.0f + (av - 1.0f) * kaw[x])); orr[e] = (_Float16)r[x]; ov[e] = (_Float16)v[x]; }
                unsigned char* rec = REC + ((size_t)(z * 16 + hh) * NTOK + n) * RECB + cin * 2;
                *(h8_t*)(rec) = ow; *(h8_t*)(rec + 128) = okk; *(h8_t*)(rec + 256) = ob; *(h8_t*)(rec + 384) = okt; *(h8_t*)(rec + 512) = orr; *(h8_t*)(rec + 640) = ov;
            }
        }
    }
}
__device__ __forceinline__ float quad_sum(float x) {
    x += __builtin_bit_cast(float, __builtin_amdgcn_mov_dpp(__builtin_bit_cast(int, x), 0xB1, 0xF, 0xF, true));
    x += __builtin_bit_cast(float, __builtin_amdgcn_mov_dpp(__builtin_bit_cast(int, x), 0x4E, 0xF, 0xF, true));
    return x;
}
template <bool VTERM, bool OUT>
__device__ __forceinline__ void rwkv_scan_task(const unsigned char* rec, LAS unsigned char* buf, int lane, h2_t (&S)[4][8], bf16_t* Ozh, int z, int n0, int nck) {
    const int v_lo = lane >> 2, kq = lane & 3;
#define RW_DMA(ck_, bsel_) do { _Pragma("unroll") for (int m = 0; m < 6; ++m) \
        __builtin_amdgcn_global_load_lds((const unsigned*)(rec + (size_t)(ck_) * 8 * RECB + (size_t)(lane + 64 * m) * 16), (LAS unsigned*)(buf + (bsel_) * 6144 + m * 1024), 16, 0, 0); } while (0)
    RW_DMA(0, 0);
#pragma unroll 1
    for (int ck = 0; ck < nck; ++ck) {
        if (ck < nck - 1) { RW_DMA(ck + 1, (ck + 1) & 1); asm volatile("s_waitcnt vmcnt(6)" ::: "memory"); }
        else asm volatile("s_waitcnt vmcnt(0)" ::: "memory");
        const LAS unsigned char* cb = buf + (ck & 1) * 6144;
#pragma unroll 2
        for (int st = 0; st < 8; ++st) {
            const LAS unsigned char* b = cb + st * RECB + kq * 32;
            h2_t kk[8], wv[8], bv[8], kt[8], rv[8];
            { const h8_t x0 = *(const LAS h8_t*)(b + 128), x1 = *(const LAS h8_t*)(b + 128 + 16);
#pragma unroll
              for (int p2 = 0; p2 < 4; ++p2) { kk[p2] = (h2_t){x0[2 * p2], x0[2 * p2 + 1]}; kk[4 + p2] = (h2_t){x1[2 * p2], x1[2 * p2 + 1]}; } }
            float sa[4];
#pragma unroll
            for (int i = 0; i < 4; ++i) { float a0 = 0.f, a1 = 0.f;
#pragma unroll
                for (int p2 = 0; p2 < 8; p2 += 2) { a0 = __builtin_amdgcn_fdot2(S[i][p2], kk[p2], a0, false); a1 = __builtin_amdgcn_fdot2(S[i][p2 + 1], kk[p2 + 1], a1, false); }
                sa[i] = quad_sum(a0 + a1); }
            { const h8_t x0 = *(const LAS h8_t*)(b), x1 = *(const LAS h8_t*)(b + 16), y0 = *(const LAS h8_t*)(b + 256), y1 = *(const LAS h8_t*)(b + 256 + 16);
#pragma unroll
              for (int p2 = 0; p2 < 4; ++p2) { wv[p2] = (h2_t){x0[2 * p2], x0[2 * p2 + 1]}; wv[4 + p2] = (h2_t){x1[2 * p2], x1[2 * p2 + 1]}; bv[p2] = (h2_t){y0[2 * p2], y0[2 * p2 + 1]}; bv[4 + p2] = (h2_t){y1[2 * p2], y1[2 * p2 + 1]}; } }
            if (VTERM) { const h8_t x0 = *(const LAS h8_t*)(b + 384), x1 = *(const LAS h8_t*)(b + 384 + 16);
#pragma unroll
              for (int p2 = 0; p2 < 4; ++p2) { kt[p2] = (h2_t){x0[2 * p2], x0[2 * p2 + 1]}; kt[4 + p2] = (h2_t){x1[2 * p2], x1[2 * p2 + 1]}; } }
            if (OUT) { const h8_t x0 = *(const LAS h8_t*)(b + 512), x1 = *(const LAS h8_t*)(b + 512 + 16);
#pragma unroll
              for (int p2 = 0; p2 < 4; ++p2) { rv[p2] = (h2_t){x0[2 * p2], x0[2 * p2 + 1]}; rv[4 + p2] = (h2_t){x1[2 * p2], x1[2 * p2 + 1]}; } }
            float oi[4];
#pragma unroll
            for (int i = 0; i < 4; ++i) {
                const _Float16 nsa = (_Float16)(-sa[i]); const h2_t nsa2 = {nsa, nsa};
                h2_t vv2 = {(_Float16)0, (_Float16)0};
                if (VTERM) { const _Float16 vh = *(const LAS _Float16*)(cb + st * RECB + 640 + (16 * i + v_lo) * 2); vv2 = (h2_t){vh, vh}; }
                float o0 = 0.f, o1 = 0.f;
#pragma unroll
                for (int p2 = 0; p2 < 8; ++p2) {
                    h2_t t = nsa2 * bv[p2]; if (VTERM) t = __builtin_elementwise_fma(vv2, kt[p2], t);
                    S[i][p2] = __builtin_elementwise_fma(S[i][p2], wv[p2], t);
                    if (OUT) { if (p2 & 1) o1 = __builtin_amdgcn_fdot2(S[i][p2], rv[p2], o1, false); else o0 = __builtin_amdgcn_fdot2(S[i][p2], rv[p2], o0, false); } }
                if (OUT) oi[i] = quad_sum(o0 + o1);
            }
            if (OUT) { const float o = kq == 0 ? oi[0] : kq == 1 ? oi[1] : kq == 2 ? oi[2] : oi[3];
                Ozh[(size_t)rwkv_row(z, n0 + ck * 8 + st) * 1024 + 16 * kq + v_lo] = (unsigned short)f2bf(o); }
        }
    }
#undef RW_DMA
}
#define RW_STORE_STATE(dst_) do { _Pragma("unroll") for (int i = 0; i < 4; ++i) _Pragma("unroll") for (int p4 = 0; p4 < 4; ++p4) \
        *(f32x4*)((dst_) + (16 * i + v_lo) * 64 + 16 * kq + 4 * p4) = (f32x4){(float)S[i][2 * p4][0], (float)S[i][2 * p4][1], (float)S[i][2 * p4 + 1][0], (float)S[i][2 * p4 + 1][1]}; } while (0)
template <int KIND>
__device__ __forceinline__ void rwkv_scan_phase(Frame& F, const Args& a) {
    const unsigned char* REC = a.ws + RW_REC; float* PQ = (float*)(a.ws + RW_PQ); float* SST = (float*)(a.ws + RW_SST); bf16_t* O = (bf16_t*)(a.ws + RW_O); bf16_t* Y = (bf16_t*)(a.ws + RW_Y);
    LAS unsigned char* buf = F.lds + LDS_STAGE + F.wave * 12288;
    const int lane = F.lane, v_lo = lane >> 2, kq = lane & 3;
#pragma unroll 1
    for (int task = F.gw; task < 2048; task += F.ngw) {
        const int zh = task & 31, z = zh >> 4, h = zh & 15, sidx = task >> 5;
        h2_t S[4][8];
#pragma unroll
        for (int i = 0; i < 4; ++i)
#pragma unroll
            for (int p2 = 0; p2 < 8; ++p2) S[i][p2] = (h2_t){(_Float16)0.f, (_Float16)0.f};
        if (sidx == 0) {
            rwkv_scan_task<true, true>(REC + (size_t)zh * NTOK * RECB, buf, lane, S, O + (size_t)z * NTOK * 1024 + h * 64, z, 0, 64);
            float* dst = SST + ((size_t)zh * 65 + 2) * 4096; RW_STORE_STATE(dst);
        } else {
            const int s = sidx + 1; const unsigned char* rec = REC + ((size_t)zh * NTOK + (size_t)s * 256) * RECB;
            rwkv_scan_task<true, true>(rec, buf, lane, S, O + (size_t)z * NTOK * 1024 + h * 64, z, s * 256, 32);
            { float* dst = PQ + ((size_t)zh * 64 + (s - 1)) * 8192 + 4096; RW_STORE_STATE(dst); }
#pragma unroll
            for (int i = 0; i < 4; ++i)
#pragma unroll
                for (int p2 = 0; p2 < 8; ++p2) { const int key = 16 * kq + 2 * p2, vr = 16 * i + v_lo; S[i][p2] = (h2_t){(_Float16)(vr == key ? 1.0f : 0.f), (_Float16)(vr == key + 1 ? 1.0f : 0.f)}; }
            asm volatile("s_waitcnt lgkmcnt(0)" ::: "memory");
            rwkv_scan_task<false, true>(rec, buf, lane, S, Y + (size_t)z * NTOK * 1024 + h * 64, z, s * 256, 32);
            { float* dst = PQ + ((size_t)zh * 64 + (s - 1)) * 8192; RW_STORE_STATE(dst); }
        }
        asm volatile("s_waitcnt lgkmcnt(0)" ::: "memory");
    }
}
constexpr int CK_TS = 144, CK_YS = 272;
constexpr int CK_AH = 0, CK_BH = 9216, CK_KH = 18432, CK_RH = 27648, CK_VV = 36864, CK_BB = 46080, CK_KB = 55296, CK_NM = 64512, CK_MAK = 73728, CK_MRB = 82944, CK_MRK = 92160,
              CK_YY = 101376, CK_SS = 118784, CK_DEC = 137216, CK_TOT = 137472, CK_TD = 139776, CK_TMP = 141824, CK_CT = 150016;
__device__ __forceinline__ void rwkv_chunk_phase(Frame& F, const Args& a) {
    float* PQ = (float*)(a.ws + RW_PQ); float* SST = (float*)(a.ws + RW_SST);
    LAS unsigned char* L = F.lds + LDS_STAGE;
    LAS float* DEC = (LAS float*)(L + CK_DEC); LAS float* TOT = (LAS float*)(L + CK_TOT); LAS float* CT = (LAS float*)(L + CK_CT);
    const int tid = F.tid, lane = F.lane, w = F.wave, c16 = lane & 15, q = lane >> 4;
    const int si = tid >> 3, c8 = tid & 7;
    const bool zset = w >= 4;
#pragma unroll 1
    for (int unit = blockIdx.x; unit < 2048; unit += gridDim.x) {
        const int zh = unit & 31, z = zh >> 4, h = zh & 15, sidx = unit >> 5;
        const int n0 = sidx == 0 ? 0 : (sidx + 1) * 256, nblk = sidx == 0 ? 8 : 4; const bool use_p = sidx != 0;
        if (tid < 64) { CT[tid] = a.in[25][h * 64 + tid]; CT[64 + tid] = a.in[26][h * 64 + tid]; CT[128 + tid] = a.in[20][z * 1024 + h * 64 + tid]; CT[192 + tid] = a.in[17][z * 1024 + h * 64 + tid]; }
        f32x4 accS[4];
#pragma unroll
        for (int kt = 0; kt < 4; ++kt)
#pragma unroll
            for (int r = 0; r < 4; ++r) { const float v0 = (!zset && (16 * w + 4 * q + r) == (16 * kt + c16)) ? 1.0f : 0.f; accS[kt][r] = v0;
                *(LAS unsigned short*)(L + CK_SS + (16 * w + 4 * q + r) * CK_TS + (16 * kt + c16) * 2) = (unsigned short)f2bf(v0); }
        __syncthreads();
        u32x4 pkx, pax, prx, pvx; f32x4 pw0, pw1;
#define CK_PREFETCH(blk_) do { int _t = threadIdx.x; asm volatile("" : "+v"(_t)); const int _trow = rwkv_row(z, n0 + (blk_) * 64 + (_t >> 3)); const unsigned _go = (unsigned)(_trow * 1024 + h * 64 + 8 * (_t & 7)) * 2u; \
            const unsigned char* _w = a.ws; const unsigned _zo = (unsigned)z * (unsigned)(NTOK * 1024 * 2); \
            pkx = *(const u32x4*)(_w + RW_K + _go); pax = *(const u32x4*)(_w + RW_AA + _zo + _go); prx = *(const u32x4*)(_w + RW_R + _go); pvx = *(const u32x4*)(_w + RW_V + _go); \
            pw0 = *(const f32x4*)(_w + RW_WW + 2u * _zo + 2u * _go); pw1 = *(const f32x4*)(_w + RW_WW + 2u * _zo + 2u * _go + 16u); } while (0)
        CK_PREFETCH(0);
#pragma unroll 1
        for (int blk = 0; blk < nblk; ++blk) {
            int tid_o = threadIdx.x; asm volatile("" : "+v"(tid_o));
            const int lane = tid_o & 63, c16 = lane & 15, q = lane >> 4, si = tid_o >> 3, c8 = tid_o & 7;
            float lw[8], kkv[8], bv[8], ktv[8]; u32x4 rx, vx;
            {
                const u32x4 kx = pkx, ax = pax; rx = prx; vx = pvx; const f32x4 wx0 = pw0, wx1 = pw1;
                const float kf[8] = {bflo(kx.x), bfhi(kx.x), bflo(kx.y), bfhi(kx.y), bflo(kx.z), bfhi(kx.z), bflo(kx.w), bfhi(kx.w)};
                const float af[8] = {bflo(ax.x), bfhi(ax.x), bflo(ax.y), bfhi(ax.y), bflo(ax.z), bfhi(ax.z), bflo(ax.w), bfhi(ax.w)};
                const float wf[8] = {wx0[0], wx0[1], wx0[2], wx0[3], wx1[0], wx1[1], wx1[2], wx1[3]};
                const f32x4 c0a = *(const LAS f32x4*)(CT + 8 * c8), c0b = *(const LAS f32x4*)(CT + 8 * c8 + 4);
                float ss = 0.f;
#pragma unroll
                for (int e = 0; e < 8; ++e) { const float kkw = e < 4 ? c0a[e] : c0b[e - 4]; kkv[e] = kf[e] * kkw; ss += kkv[e] * kkv[e]; }
                ss += __shfl_xor(ss, 1); ss += __shfl_xor(ss, 2); ss += __shfl_xor(ss, 4);
                const float rn = __builtin_amdgcn_rsqf(ss + 1e-12f);
                asm volatile("" ::: "memory");
                const f32x4 c1a = *(const LAS f32x4*)(CT + 64 + 8 * c8), c1b = *(const LAS f32x4*)(CT + 64 + 8 * c8 + 4);
                const f32x4 c2a = *(const LAS f32x4*)(CT + 128 + 8 * c8), c2b = *(const LAS f32x4*)(CT + 128 + 8 * c8 + 4), c3a = *(const LAS f32x4*)(CT + 192 + 8 * c8), c3b = *(const LAS f32x4*)(CT + 192 + 8 * c8 + 4);
#pragma unroll
                for (int e = 0; e < 8; ++e) { const float kaw = e < 4 ? c1a[e] : c1b[e - 4], a0e = e < 4 ? c2a[e] : c2b[e - 4], w0e = e < 4 ? c3a[e] : c3b[e - 4];
                    const float av = sigmoidf_(a0e + af[e]); kkv[e] *= rn; bv[e] = av * kkv[e]; ktv[e] = kf[e] * (1.0f + (av - 1.0f) * kaw);
                    lw[e] = -0.6065306597126334f * sigmoidf_(w0e + wf[e]); }
            }
            float G[8];
#pragma unroll
            for (int e = 0; e < 8; ++e) { float x = lw[e]; float y = __shfl_up(x, 8); if (lane >= 8) x += y; y = __shfl_up(x, 16); if (lane >= 16) x += y; y = __shfl_up(x, 32); if (lane >= 32) x += y; G[e] = x; }
            if (lane >= 56) { *(LAS f32x4*)(TOT + w * 64 + 8 * c8) = (f32x4){G[0], G[1], G[2], G[3]}; *(LAS f32x4*)(TOT + w * 64 + 8 * c8 + 4) = (f32x4){G[4], G[5], G[6], G[7]}; }
            __syncthreads();
            {
                float tot[8];
#pragma unroll
                for (int e = 0; e < 8; ++e) tot[e] = 0.f;
#pragma unroll
                for (int ww = 0; ww < 8; ++ww) { const f32x4 t0 = *(const LAS f32x4*)(TOT + ww * 64 + 8 * c8), t1 = *(const LAS f32x4*)(TOT + ww * 64 + 8 * c8 + 4);
#pragma unroll
                    for (int e = 0; e < 8; ++e) { const float tv = e < 4 ? t0[e] : t1[e - 4]; tot[e] += tv; if (ww < w) G[e] += tv; } }
                if (si == 0) { *(LAS f32x4*)(DEC + 8 * c8) = (f32x4){__expf(tot[0]), __expf(tot[1]), __expf(tot[2]), __expf(tot[3])}; *(LAS f32x4*)(DEC + 8 * c8 + 4) = (f32x4){__expf(tot[4]), __expf(tot[5]), __expf(tot[6]), __expf(tot[7])}; }
                const unsigned rw4[4] = {rx.x, rx.y, rx.z, rx.w}; const int to = si * CK_TS + 16 * c8;
                *(LAS u32x4*)(L + CK_VV + to) = vx;
#pragma unroll
                for (int e2 = 0; e2 < 4; ++e2) { float o7[6][2];
#pragma unroll
                    for (int hh = 0; hh < 2; ++hh) { const int e = 2 * e2 + hh; const float Ge = G[e]; const float rve = hh ? bfhi(rw4[e2]) : bflo(rw4[e2]);
                        const float eg = __expf(Ge), egm = __expf(Ge - lw[e]), eng = __expf(fminf(-Ge, 80.0f)), etg = __expf(tot[e] - Ge);
                        o7[0][hh] = -kkv[e] * egm; o7[1][hh] = bv[e] * eng; o7[2][hh] = ktv[e] * eng; o7[3][hh] = rve * eg; o7[4][hh] = bv[e] * etg; o7[5][hh] = ktv[e] * etg; }
                    *(LAS unsigned*)(L + CK_AH + to + 4 * e2) = pk2(o7[0][0], o7[0][1]); *(LAS unsigned*)(L + CK_BH + to + 4 * e2) = pk2(o7[1][0], o7[1][1]); *(LAS unsigned*)(L + CK_KH + to + 4 * e2) = pk2(o7[2][0], o7[2][1]);
                    *(LAS unsigned*)(L + CK_RH + to + 4 * e2) = pk2(o7[3][0], o7[3][1]); *(LAS unsigned*)(L + CK_BB + to + 4 * e2) = pk2(o7[4][0], o7[4][1]); *(LAS unsigned*)(L + CK_KB + to + 4 * e2) = pk2(o7[5][0], o7[5][1]); }
                if (blk + 1 < nblk) CK_PREFETCH(blk + 1);
            }
            __syncthreads();
            { const int it = w >> 1;
              bf16x8 fa[2], fr[2];
#pragma unroll
              for (int ks = 0; ks < 2; ++ks) { fa[ks] = lds_row_frag(L + CK_AH, CK_TS, 16 * it + c16, 32 * ks + 8 * q); fr[ks] = lds_row_frag(L + CK_RH, CK_TS, 16 * it + c16, 32 * ks + 8 * q); }
#pragma unroll 1
              for (int s2 = 0; s2 < 2; ++s2) { const int jt = 2 * (w & 1) + s2; f32x4 n0v = {0.f, 0.f, 0.f, 0.f}, n1v = n0v, n2v = n0v, n3v = n0v;
#pragma unroll
                  for (int ks = 0; ks < 2; ++ks) { const bf16x8 fb = lds_row_frag(L + CK_BH, CK_TS, 16 * jt + c16, 32 * ks + 8 * q), fk = lds_row_frag(L + CK_KH, CK_TS, 16 * jt + c16, 32 * ks + 8 * q);
                      n0v = __builtin_amdgcn_mfma_f32_16x16x32_bf16(fa[ks], fb, n0v, 0, 0, 0); n1v = __builtin_amdgcn_mfma_f32_16x16x32_bf16(fa[ks], fk, n1v, 0, 0, 0);
                      n2v = __builtin_amdgcn_mfma_f32_16x16x32_bf16(fr[ks], fb, n2v, 0, 0, 0); n3v = __builtin_amdgcn_mfma_f32_16x16x32_bf16(fr[ks], fk, n3v, 0, 0, 0); }
#pragma unroll
                  for (int r = 0; r < 4; ++r) { const int i = 16 * it + 4 * q + r, j = 16 * jt + c16, o = i * CK_TS + j * 2;
                      n0v[r] = j < i ? n0v[r] : 0.f;
                      *(LAS unsigned short*)(L + CK_NM + o) = (unsigned short)f2bf(n0v[r]); *(LAS unsigned short*)(L + CK_MAK + o) = (unsigned short)f2bf(j < i ? n1v[r] : 0.f);
                      *(LAS unsigned short*)(L + CK_MRB + o) = (unsigned short)f2bf(j <= i ? n2v[r] : 0.f); *(LAS unsigned short*)(L + CK_MRK + o) = (unsigned short)f2bf(j <= i ? n3v[r] : 0.f); }
                  if (jt == it) {
                      LAS unsigned char* tp = L + CK_TMP + w * 1024; LAS unsigned char* tt = tp + 512;
                      f32x4 P = n0v, T = n0v;
#pragma unroll
                      for (int r = 0; r < 4; ++r) T[r] += (4 * q + r == c16) ? 1.0f : 0.f;
#pragma unroll
                      for (int pw = 0; pw < 3; ++pw) {
#pragma unroll
                          for (int r = 0; r < 4; ++r) { *(LAS unsigned short*)(tp + (4 * q + r) * 32 + c16 * 2) = (unsigned short)f2bf(P[r]); *(LAS unsigned short*)(tt + (4 * q + r) * 32 + c16 * 2) = (unsigned short)f2bf(T[r]); }
                          bf16x4 pb; pb[0] = (short)f2bf(P[0]); pb[1] = (short)f2bf(P[1]); pb[2] = (short)f2bf(P[2]); pb[3] = (short)f2bf(P[3]);
                          const bf16x4 pa = *(const LAS bf16x4*)(tp + c16 * 32 + 8 * q), ta = *(const LAS bf16x4*)(tt + c16 * 32 + 8 * q);
                          f32x4 zero = {0.f, 0.f, 0.f, 0.f};
                          P = __builtin_amdgcn_mfma_f32_16x16x16bf16_1k(pa, pb, zero, 0, 0, 0);
                          bf16x4 pn; pn[0] = (short)f2bf(P[0]); pn[1] = (short)f2bf(P[1]); pn[2] = (short)f2bf(P[2]); pn[3] = (short)f2bf(P[3]);
                          T = __builtin_amdgcn_mfma_f32_16x16x16bf16_1k(ta, pn, T, 0, 0, 0);
                      }
#pragma unroll
                      for (int r = 0; r < 4; ++r) *(LAS unsigned short*)(L + CK_TD + it * 512 + (4 * q + r) * 32 + c16 * 2) = (unsigned short)f2bf(T[r]);
                  } } }
            __syncthreads();
            const bool active = zset || use_p;
            if (active) {
                f32x4 yv[4];
#pragma unroll
                for (int it = 0; it < 4; ++it) yv[it] = (f32x4){0.f, 0.f, 0.f, 0.f};
                bf16x8 sb[2];
#pragma unroll
                for (int ks = 0; ks < 2; ++ks) { sb[ks] = lds_row_frag(L + CK_SS, CK_TS, 16 * w + c16, 32 * ks + 8 * q);
#pragma unroll
                    for (int it = 0; it < 4; ++it) yv[it] = __builtin_amdgcn_mfma_f32_16x16x32_bf16(lds_row_frag(L + CK_AH, CK_TS, 16 * it + c16, 32 * ks + 8 * q), sb[ks], yv[it], 0, 0, 0); }
                bf16x8 vb[2];
                if (zset) {
#pragma unroll
                    for (int ks = 0; ks < 2; ++ks) { vb[ks] = lds_tr_frag(L + CK_VV, CK_TS, 32 * ks, 16 * (w - 4), lane);
#pragma unroll
                        for (int it = 0; it < 4; ++it) yv[it] = __builtin_amdgcn_mfma_f32_16x16x32_bf16(lds_row_frag(L + CK_MAK, CK_TS, 16 * it + c16, 32 * ks + 8 * q), vb[ks], yv[it], 0, 0, 0); } }
                asm volatile("" ::: "memory");
                bf16x4 ub[4];
#pragma unroll
                for (int b = 0; b < 4; ++b) { f32x4 acc = yv[b];
#pragma unroll
                    for (int c = 0; c < 4; ++c) if (c < b) acc = __builtin_amdgcn_mfma_f32_16x16x16bf16_1k(*(const LAS bf16x4*)(L + CK_NM + (16 * b + c16) * CK_TS + (16 * c + 4 * q) * 2), ub[c], acc, 0, 0, 0);
                    bf16x4 ab; ab[0] = (short)f2bf(acc[0]); ab[1] = (short)f2bf(acc[1]); ab[2] = (short)f2bf(acc[2]); ab[3] = (short)f2bf(acc[3]);
                    const f32x4 zero = {0.f, 0.f, 0.f, 0.f};
                    const f32x4 ubf = __builtin_amdgcn_mfma_f32_16x16x16bf16_1k(*(const LAS bf16x4*)(L + CK_TD + b * 512 + c16 * 32 + 8 * q), ab, zero, 0, 0, 0);
                    ub[b][0] = (short)f2bf(ubf[0]); ub[b][1] = (short)f2bf(ubf[1]); ub[b][2] = (short)f2bf(ubf[2]); ub[b][3] = (short)f2bf(ubf[3]); }
                asm volatile("" ::: "memory");
                { int q3 = lane >> 4, c3 = lane & 15; asm volatile("" : "+v"(q3), "+v"(c3));
                  unsigned char* dstb = a.ws + (zset ? RW_O : RW_Y); const unsigned dco = ((unsigned)z * (unsigned)(NTOK * 1024) + (unsigned)(h * 64 + 16 * (w & 3) + c3)) * 2u;
#pragma unroll
                  for (int it = 0; it < 4; ++it) { f32x4 ov = {0.f, 0.f, 0.f, 0.f};
#pragma unroll
                      for (int ks = 0; ks < 2; ++ks) ov = __builtin_amdgcn_mfma_f32_16x16x32_bf16(lds_row_frag(L + CK_RH, CK_TS, 16 * it + c16, 32 * ks + 8 * q), sb[ks], ov, 0, 0, 0);
#pragma unroll
                      for (int c = 0; c < 4; ++c) if (c <= it) ov = __builtin_amdgcn_mfma_f32_16x16x16bf16_1k(*(const LAS bf16x4*)(L + CK_MRB + (16 * it + c16) * CK_TS + (16 * c + 4 * q) * 2), ub[c], ov, 0, 0, 0);
                      if (zset) {
#pragma unroll
                          for (int ks = 0; ks < 2; ++ks) ov = __builtin_amdgcn_mfma_f32_16x16x32_bf16(lds_row_frag(L + CK_MRK, CK_TS, 16 * it + c16, 32 * ks + 8 * q), vb[ks], ov, 0, 0, 0); }
#pragma unroll
                      for (int r = 0; r < 4; ++r) *(unsigned short*)(dstb + dco + (unsigned)rwkv_row(z, n0 + blk * 64 + 16 * it + 4 * q3 + r) * 2048u) = (unsigned short)f2bf(ov[r]);
                      asm volatile("" ::: "memory"); } }
                asm volatile("" ::: "memory");
#pragma unroll
                for (int kt = 0; kt < 4; ++kt) { const float dc = DEC[16 * kt + c16];
#pragma unroll
                    for (int r = 0; r < 4; ++r) accS[kt][r] *= dc;
#pragma unroll
                    for (int c = 0; c < 4; ++c) { const int g = lane >> 4, qq = (lane & 15) >> 2, pp = lane & 3;
                        const v4s16 bt = __builtin_amdgcn_ds_read_tr16_b64_v4i16((LAS v4s16*)(L + CK_BB + (16 * c + 4 * g + qq) * CK_TS + (16 * kt + 4 * pp) * 2));
                        accS[kt] = __builtin_amdgcn_mfma_f32_16x16x16bf16_1k(ub[c], (bf16x4){bt[0], bt[1], bt[2], bt[3]}, accS[kt], 0, 0, 0); } }
                if (zset) {
#pragma unroll
                    for (int ks = 0; ks < 2; ++ks) { const bf16x8 va = vb[ks];
#pragma unroll
                        for (int kt = 0; kt < 4; ++kt) accS[kt] = __builtin_amdgcn_mfma_f32_16x16x32_bf16(va, lds_tr_frag(L + CK_KB, CK_TS, 32 * ks, 16 * kt, lane), accS[kt], 0, 0, 0); } }
            }
            __syncthreads();
            if (active) {
#pragma unroll
                for (int kt = 0; kt < 4; ++kt)
#pragma unroll
                    for (int r = 0; r < 4; ++r) *(LAS unsigned short*)(L + CK_SS + (16 * w + 4 * q + r) * CK_TS + (16 * kt + c16) * 2) = (unsigned short)f2bf(accS[kt][r]);
            }
        }
        { float* dst = sidx == 0 ? (zset ? SST + ((size_t)zh * 65 + 2) * 4096 : nullptr) : PQ + ((size_t)zh * 64 + sidx) * 8192 + (zset ? 4096 : 0);
          if (dst) { int q2 = lane >> 4, c2 = lane & 15; asm volatile("" : "+v"(q2), "+v"(c2));
#pragma unroll
              for (int kt = 0; kt < 4; ++kt)
#pragma unroll
                  for (int r = 0; r < 4; ++r) dst[(16 * (w & 3) + 4 * q2 + r) * 64 + 16 * kt + c2] = accS[kt][r]; } }
        __syncthreads();
    }
}
__device__ __forceinline__ void rwkv_corr_phase(Frame& F, const Args& a) {
    const float* SST = (const float*)(a.ws + RW_SST); bf16_t* O = (bf16_t*)(a.ws + RW_O); const bf16_t* Y = (const bf16_t*)(a.ws + RW_Y);
    const int lane = F.lane, c16 = lane & 15, q = lane >> 4;
#pragma unroll 1
    for (int task = F.gw; task < 2016; task += F.ngw) {
        const int zh = task & 31, z = zh >> 4, h = zh & 15, s = (task >> 5) + 2;
        const float* Ss = SST + ((size_t)zh * 65 + s) * 4096;
        bf16x8 Sf[4][2];
#pragma unroll
        for (int vt = 0; vt < 4; ++vt)
#pragma unroll
            for (int ks = 0; ks < 2; ++ks) { const f32x4 x0 = *(const f32x4*)(Ss + (16 * vt + c16) * 64 + 32 * ks + 8 * q), x1 = *(const f32x4*)(Ss + (16 * vt + c16) * 64 + 32 * ks + 8 * q + 4);
                bf16x8 f; f[0] = (short)f2bf(x0[0]); f[1] = (short)f2bf(x0[1]); f[2] = (short)f2bf(x0[2]); f[3] = (short)f2bf(x0[3]); f[4] = (short)f2bf(x1[0]); f[5] = (short)f2bf(x1[1]); f[6] = (short)f2bf(x1[2]); f[7] = (short)f2bf(x1[3]); Sf[vt][ks] = f; }
        const bf16_t* Yz = Y + (size_t)z * NTOK * 1024 + h * 64; bf16_t* Oz = O + (size_t)z * NTOK * 1024 + h * 64;
#pragma unroll 2
        for (int T = 0; T < 16; ++T) {
            const size_t row = (size_t)rwkv_row(z, s * 256 + 16 * T + c16) * 1024;
            const bf16x8 y0 = *(const bf16x8*)(Yz + row + 8 * q), y1 = *(const bf16x8*)(Yz + row + 32 + 8 * q);
#pragma unroll
            for (int vt = 0; vt < 4; ++vt) { f32x4 d = {0.f, 0.f, 0.f, 0.f};
                d = __builtin_amdgcn_mfma_f32_16x16x32_bf16(Sf[vt][0], y0, d, 0, 0, 0); d = __builtin_amdgcn_mfma_f32_16x16x32_bf16(Sf[vt][1], y1, d, 0, 0, 0);
                u32x2* op = (u32x2*)(Oz + row + 16 * vt + 4 * q); const u32x2 old = *op;
                u32x2 nw; nw.x = pk2(bflo(old.x) + d[0], bfhi(old.x) + d[1]); nw.y = pk2(bflo(old.y) + d[2], bfhi(old.y) + d[3]); *op = nw; }
        }
    }
}
__device__ __forceinline__ void rwkv_prefix_phase(Frame& F, const Args& a) {
    const float* PQ = (const float*)(a.ws + RW_PQ); float* SST = (float*)(a.ws + RW_SST);
    if (blockIdx.x >= 128) return;
    const int zh = blockIdx.x >> 2, r0 = (blockIdx.x & 3) * 16, tid = F.tid, vl = tid >> 5, v = r0 + vl, c0 = (tid & 31) * 2;
    LAS float* Sl = (LAS float*)(F.lds + LDS_STAGE); LAS float* Pl = Sl + 16 * 68;
    { const float* s1 = SST + ((size_t)zh * 65 + 2) * 4096 + r0 * 64;
      for (int i = tid; i < 1024; i += NTHREADS) Sl[(i >> 6) * 68 + (i & 63)] = s1[i]; }
    f32x4 pn0, pn1; f32x2 qn;
    { const float* Pg = PQ + ((size_t)zh * 64 + 1) * 8192; pn0 = *(const f32x4*)(Pg + 4 * tid); pn1 = *(const f32x4*)(Pg + 4 * (tid + 512)); qn = *(const f32x2*)(Pg + 4096 + v * 64 + c0); }
#pragma unroll 1
    for (int s = 2; s < 64; ++s) {
        __syncthreads();
        *(LAS f32x4*)(Pl + 4 * tid) = pn0; *(LAS f32x4*)(Pl + 4 * (tid + 512)) = pn1;
        float a0 = qn[0], a1 = qn[1];
        if (s < 63) { const float* Pg = PQ + ((size_t)zh * 64 + s) * 8192; pn0 = *(const f32x4*)(Pg + 4 * tid); pn1 = *(const f32x4*)(Pg + 4 * (tid + 512)); qn = *(const f32x2*)(Pg + 4096 + v * 64 + c0); }
        __syncthreads();
#pragma unroll 16
        for (int k = 0; k < 64; ++k) { const float sv = Sl[vl * 68 + k]; const f32x2 pp = *(const LAS f32x2*)(Pl + k * 64 + c0); a0 += sv * pp[0]; a1 += sv * pp[1]; }
        __syncthreads();
        *(f32x2*)(SST + ((size_t)zh * 65 + s + 1) * 4096 + v * 64 + c0) = (f32x2){a0, a1};
        Sl[vl * 68 + c0] = a0; Sl[vl * 68 + c0 + 1] = a1;
    }
}
__device__ __forceinline__ void rwkv_readout_phase(Frame& F, const Args& a) {
    const bf16_t* O0 = (const bf16_t*)(a.ws + RW_O); const bf16_t* O1 = O0 + (size_t)NTOK * 1024; const bf16_t* R = (const bf16_t*)(a.ws + RW_R); const bf16_t* K = (const bf16_t*)(a.ws + RW_K);
    const bf16_t* V = (const bf16_t*)(a.ws + RW_V); const bf16_t* A0 = (const bf16_t*)(a.ws + RW_AA); const bf16_t* A1 = A0 + (size_t)NTOK * 1024; const bf16_t* G = (const bf16_t*)(a.ws + RW_G);
    bf16_t* A5 = (bf16_t*)(a.ws + RW_A5); const int lane = F.lane;
    float ka[16], rk[16], lg[16], lb[16], ab0[16], ab1[16]; ldrow_f32(a.in[20], lane, ab0); ldrow_f32(a.in[20] + 1024, lane, ab1); ldrow_f32(a.in[26], lane, ka); ldrow_f32(a.in[27], lane, rk); ldrow_f32(a.in[28], lane, lg); ldrow_f32(a.in[29], lane, lb);
    for (int t = F.gw; t < NTOK; t += F.ngw) {
        float o[16], r[16], k[16], v[16], a0[16], a1[16], g[16];
        ldrow_bf16(O0 + (size_t)t * 1024, lane, o); addrow_bf16(O1 + (size_t)t * 1024, lane, o); ldrow_bf16(R + (size_t)t * 1024, lane, r); ldrow_bf16(K + (size_t)t * 1024, lane, k);
        ldrow_bf16(V + (size_t)t * 1024, lane, v); ldrow_bf16(A0 + (size_t)t * 1024, lane, a0); ldrow_bf16(A1 + (size_t)t * 1024, lane, a1); ldrow_bf16(G + (size_t)t * 1024, lane, g);
#pragma unroll
        for (int j = 0; j < 2; ++j) { float s = 0.f, bn = 0.f;
#pragma unroll
            for (int e = 0; e < 8; ++e) { const int x = 8 * j + e; s += o[x]; bn += r[x] * k[x] * rk[x] * (2.0f + (sigmoidf_(a0[x] + ab0[x]) + sigmoidf_(a1[x] + ab1[x]) - 2.0f) * ka[x]); }
#pragma unroll
            for (int m = 1; m < 8; m <<= 1) { s += __shfl_xor(s, m); bn += __shfl_xor(bn, m); }
            const float mean = s * (1.0f / 64.0f); float q = 0.f;
#pragma unroll
            for (int e = 0; e < 8; ++e) { o[8 * j + e] -= mean; q += o[8 * j + e] * o[8 * j + e]; }
#pragma unroll
            for (int m = 1; m < 8; m <<= 1) q += __shfl_xor(q, m);
            const float rs = 1.0f / sqrtf(q * (1.0f / 64.0f) + 64e-5f);
#pragma unroll
            for (int e = 0; e < 8; ++e) { const int x = 8 * j + e; o[x] = (o[x] * rs * lg[x] + lb[x] + bn * v[x]) * g[x]; } }
        strow_bf16(A5 + (size_t)t * 1024, lane, o);
    }
}

__device__ __forceinline__ void zero_y_phase(Frame& F, const Args& a) {
    u32x4* y = (u32x4*)(a.ws + WS_MX5); const u32x4 z = {0u, 0u, 0u, 0u};
    for (size_t i = (size_t)blockIdx.x * NTHREADS + F.tid; i < (size_t)NTOK * D / 8; i += (size_t)gridDim.x * NTHREADS) y[i] = z;
}

__device__ __forceinline__ Frame mk_frame(const Args& a, unsigned char* lds_raw) {
    Frame F; int tid = threadIdx.x; asm volatile("" : "+v"(tid));
    F.lds = (LAS unsigned char*)lds_raw; F.misc = (volatile LAS unsigned*)(F.lds + LDS_MISC);
    F.tid = tid; F.lane = tid & 63; F.wave = __builtin_amdgcn_readfirstlane(tid >> 6);
    F.ws = a.ws; F.ctl = (unsigned*)(a.ws + WS_CTL);
    F.gw = blockIdx.x * NWAVES + F.wave; F.ngw = gridDim.x * NWAVES; F.tacc = 0;
    return F;
}
__global__ void __launch_bounds__(NTHREADS, 2) fwd_kernel(Args a) {
    extern __shared__ __attribute__((aligned(16))) unsigned char lds_raw[];
    if (threadIdx.x < 64) ((volatile LAS unsigned*)((LAS unsigned char*)lds_raw + LDS_MISC))[threadIdx.x] = 0u;
    __syncthreads();
    (void)xcd_barrier_post((unsigned*)(a.ws + WS_CTL) + CW_BAR, (volatile LAS unsigned*)((LAS unsigned char*)lds_raw + LDS_MISC) + 8);
    int phase = 0;
    unsigned long long pacc = 0; bool pmark = false, pmarkd = false; unsigned long long tstart_ = 0; if (TPROBE) tstart_ = __builtin_amdgcn_s_memrealtime();
#define PMARK(g) do { if (TPROBE) pmark = ((TPROBE >> (g)) & 1) != 0; } while (0)
#define PDUR(g) do { if (TPROBE) pmarkd = ((TPROBE >> (g)) & 1) != 0; } while (0)
#define PHASE(body) do { if (phase >= a.ph_lo && phase < a.ph_hi) { unsigned long long tp0_ = 0; if (TPROBE) tp0_ = __builtin_amdgcn_s_memrealtime(); { Frame F = mk_frame(a, lds_raw); body; if (TPROBE & (1 << 29)) pacc += F.tacc; } \
        unsigned long long t0_ = 0; if (TPROBE) t0_ = __builtin_amdgcn_s_memrealtime(); \
        if (phase + 1 < a.ph_hi) { XcdBarrier bar; bar.bar = (unsigned*)(a.ws + WS_CTL) + CW_BAR; bar.x = xb_xcc_id(); bar.st = (volatile LAS unsigned*)((LAS unsigned char*)lds_raw + LDS_MISC) + 8; xcd_barrier(bar); } \
        if (TPROBE) { if (pmark) pacc += __builtin_amdgcn_s_memrealtime() - t0_; pmark = false; if (pmarkd) pacc += __builtin_amdgcn_s_memrealtime() - tp0_; pmarkd = false; if ((TPROBE & (1 << 28)) && phase == 2) pacc += __builtin_amdgcn_s_memrealtime() - tstart_; } } ++phase; } while (0)

#define PHASED(bit, body) do { PHASE(body); if (DUP & (bit)) PHASE(body); } while (0)
    PHASED(1, p0_phase(F, a));
    PHASE(p1a_phase(F, a));
    PHASE(p1b_phase(F, a));

#define MOE_LAYER(L) do { \
    if (EN_MOE) { PHASE({ PMARK(7); PDUR(8); moe_route_phase<L>(F, a); if (L < 3) bg_slot<(L == 0 ? EV_ROUTE0 : L == 1 ? EV_ROUTE1 : EV_ROUTE2)>(F, a); }); if (DUP & (1 << 20)) PHASE((moe_route_phase<L, true>(F, a))); PHASE({ PDUR(9); moe_dispatch_phase<L>(F, a); }); if (DUP & (1 << 26)) PHASE((moe_dispatch_phase<L, true>(F, a))); PHASED(2, { PDUR(10); moe_gateup_phase<L>(F, a); }); PHASE((moe_down_phase<L, 4>(F, a))); if (DUP & 4) PHASE({ PDUR(11); (moe_down_phase<L, DOWN_PROBE_MODE>(F, a)); }); } \
    PHASE({ PDUR(12); (ln_phase<L, 1>(F, a)); }); if (DUP & (1 << 21)) PHASE((ln_phase<L, 1, true>(F, a))); } while (0)

    if (EN_LRU) {
        PHASED(65536, { PMARK(0); lru_in_gemm_phase(F, a); bg_slot<EV_LRU_IN>(F, a); });
        PHASED(131072, { PMARK(2); lru_scan_phase<true>(F, a); bg_slot<EV_S1>(F, a); });
        PHASED(1 << 24, { lru_carry_phase(F, a); bg_slot<EV_CARRY>(F, a); });
        PHASED(131072, { PMARK(2); lru_scan_phase<false>(F, a); bg_slot<EV_S3>(F, a); });
        PHASED(1 << 25, { PMARK(0); dense_gemm_bf16(F, (const bf16_t*)(a.ws + WS_MX2), (const bf16_t*)(a.ws + WS_W_LRU_OUT), (bf16_t*)(a.ws + WS_MX5), NTOK, 1024, 1024); bg_slot<EV_LRU_OUT>(F, a); });
    } else PHASE(zero_y_phase(F, a));
    PHASE({ bg_catch<EV_C0>(F, a); (ln_phase<0, 0>(F, a)); }); if (DUP & (1 << 22)) PHASE((ln_phase<0, 0, true>(F, a)));
    MOE_LAYER(0);
    if (EN_RWKV) {
        PHASED(64, rwkv_xm_phase(F, a));
        PHASED(128, { rwkv_in_gemm_phase(F, a); bg_slot<EV_RW_IN>(F, a); });
        PHASED(256, { rwkv_l2_gemm_phase(F, a); bg_slot<EV_RW_L2>(F, a); });
#if !RWKV_CHUNKED
        PHASED(8, rwkv_rec_phase(F, a));
#endif
#if RWKV_CHUNKED
        PHASED(16, { PMARK(3); rwkv_chunk_phase(F, a); bg_slot<EV_RW_CHUNK>(F, a); });
#else
        PHASED(16, rwkv_scan_phase<0>(F, a));
#endif
        PHASED(1 << 24, { rwkv_prefix_phase(F, a); bg_slot<EV_RW_PREFIX>(F, a); });
        PHASE(rwkv_corr_phase(F, a));
        PHASED(1 << 23, rwkv_readout_phase(F, a));
        PHASED(1 << 25, { PMARK(0); dense_gemm_bf16(F, (const bf16_t*)(a.ws + RW_A5), (const bf16_t*)(a.ws + WS_W_RWKV_OUT), (bf16_t*)(a.ws + WS_MX5), NTOK, 1024, 1024); bg_slot<EV_RW_OUT>(F, a); });
    } else PHASE(zero_y_phase(F, a));
    PHASE({ bg_catch<EV_C1>(F, a); (ln_phase<1, 0>(F, a)); }); if (DUP & (1 << 22)) PHASE((ln_phase<1, 0, true>(F, a)));
    MOE_LAYER(1);
    if (EN_RET) {
        PHASED(4096, { PMARK(0); ret_in_gemm_phase(F, a); bg_slot<EV_RET_IN>(F, a); });
        PHASED(8192, { ret_p_phase(F, a); ret_transpose_phase(F, a); bg_slot<EV_RET_P>(F, a); });
        PHASED(16384, { ret_kv_phase(F, a); bg_slot<EV_RET_KV>(F, a); });
        PHASE(ret_prefix_phase<false>(F, a)); if (DUP & (1 << 27)) PHASE(ret_prefix_phase<true>(F, a));
        PHASED(32768, { PMARK(6); ret_o_phase(F, a); bg_slot<EV_RET_O>(F, a); });
        PHASED(1 << 23, ret_readout_phase(F, a));
        PHASED(1 << 25, { PMARK(1); dense_gemm_bf16(F, (const bf16_t*)(a.ws + RT_A3), (const bf16_t*)(a.ws + WS_W_RET_OUT), (bf16_t*)(a.ws + WS_MX5), NTOK, 1024, 2048); bg_slot<EV_RET_OUT>(F, a); });
    } else PHASE(zero_y_phase(F, a));
    PHASE({ bg_catch<EV_C2>(F, a); (ln_phase<2, 0>(F, a)); }); if (DUP & (1 << 22)) PHASE((ln_phase<2, 0, true>(F, a)));
    MOE_LAYER(2);
    if (EN_HGRN) {
        PHASED(2048, { PMARK(0); hgrn_in_gemm_phase(F, a); bg_slot<EV_HG_IN>(F, a); });
        PHASED(512, { PMARK(4); hgrn_chunk_phase<0>(F, a); bg_slot<EV_HG_C0>(F, a); });
        PHASE({ hgrn_prefix_phase<false>(F, a); bg_slot<EV_HG_PREFIX>(F, a); }); if (DUP & (1 << 27)) PHASE(hgrn_prefix_phase<true>(F, a));
        PHASED(1024, { PMARK(5); hgrn_chunk_phase<1>(F, a); bg_slot<EV_HG_C1>(F, a); });
        PHASED(1 << 23, hgrn_readout_phase(F, a));
        PHASED(1 << 25, dense_gemm_bf16(F, (const bf16_t*)(a.ws + HG_A4) + (size_t)NCTX * 1024, (const bf16_t*)(a.ws + WS_W_HGRN_OUT), (bf16_t*)(a.ws + WS_MX5) + (size_t)NCTX * 1024, SEQ, 1024, 1024));
    } else PHASE(zero_y_phase(F, a));
    PHASE({ bg_catch<EV_C3>(F, a); (ln_phase<3, 0>(F, a)); }); if (DUP & (1 << 22)) PHASE((ln_phase<3, 0, true>(F, a)));
    MOE_LAYER(3);
    if (TPROBE) { if (blockIdx.x == 200 && threadIdx.x == 0) { const unsigned long long ts = __builtin_amdgcn_s_memrealtime(); while (__builtin_amdgcn_s_memrealtime() - ts < pacc * 20ull) __builtin_amdgcn_s_sleep(8); } }
}

extern "C" void kernel_launch(void* const* d_in, const int* in_sizes, int n_in, void* d_out, int out_size, void* d_ws, size_t ws_size, hipStream_t stream) {
    static int grid = 0;
    if (grid == 0) {
        if (n_in != 47 || out_size != SEQ * D || ws_size < WS_END) { fprintf(stderr, "kernel_launch: unexpected shapes (n_in %d out %d ws %zu need %zu)\n", n_in, out_size, ws_size, (size_t)WS_END); grid = -1; return; }
        int dev = 0, cus = 0, per_cu = 0;
        (void)hipGetDevice(&dev); (void)hipDeviceGetAttribute(&cus, hipDeviceAttributeMultiprocessorCount, dev);
        if (hipFuncSetAttribute((const void*)fwd_kernel, hipFuncAttributeMaxDynamicSharedMemorySize, LDS_BYTES) != hipSuccess) { fprintf(stderr, "kernel_launch: hipFuncSetAttribute failed\n"); grid = -1; return; }
        (void)hipOccupancyMaxActiveBlocksPerMultiprocessor(&per_cu, (const void*)fwd_kernel, NTHREADS, LDS_BYTES);
        (void)hipGetLastError();
        if (per_cu < 1) fprintf(stderr, "kernel_launch: occupancy query says %d blocks per CU\n", per_cu);
        grid = cus;
    }
    if (grid < 0) return;
    (void)hipMemsetAsync((char*)d_ws + WS_CTL, 0, CTL_BYTES, stream);
    Args a; memset(&a, 0, sizeof(a));
    for (int i = 0; i < 47; ++i) a.in[i] = (const float*)d_in[i];
    a.out = (float*)d_out; a.ws = (unsigned char*)d_ws; a.ph_lo = 0; a.ph_hi = 1000;
    hipLaunchKernelGGL(fwd_kernel, dim3(grid), dim3(NTHREADS), LDS_BYTES, stream, a);
}
```

```cpp
#include <hip/hip_runtime.h>
#include <stdint.h>
#include <stdio.h>
#include <string.h>

#define LAS __attribute__((address_space(3)))
#define GAS __attribute__((address_space(1)))
typedef unsigned short bf16_t;
typedef short bf16x8 __attribute__((ext_vector_type(8)));
typedef short bf16x4 __attribute__((ext_vector_type(4)));
typedef float f32x4 __attribute__((ext_vector_type(4)));
typedef float f32x2 __attribute__((ext_vector_type(2)));
typedef unsigned u32x4 __attribute__((ext_vector_type(4)));
typedef unsigned u32x2 __attribute__((ext_vector_type(2)));

constexpr int D = 1024, SEQ = 16384, NCTX = 256, NTOK = SEQ + NCTX;
constexpr int NE = 64, TOPK = 8, EDIM = 256;
constexpr float ALPHA = 1.681792830507429f;
constexpr float LN_EPS = 1e-5f;
constexpr int NTHREADS = 512, NWAVES = 8;

#ifndef TPROBE
#define TPROBE 0
#endif
#define BQ(q) ((TPROBE & 0xFF) ? 0 : (q))
#ifndef DUP
#define DUP 0
#define DOWN_PROBE_MODE 3
#endif
#ifndef RWKV_CHUNKED
#define RWKV_CHUNKED 1
#endif
#ifndef EN_LRU
#define EN_LRU 1
#endif
#ifndef EN_RWKV
#define EN_RWKV 1
#endif
#ifndef EN_RET
#define EN_RET 1
#endif
#ifndef EN_HGRN
#define EN_HGRN 1
#endif
#ifndef EN_MOE
#define EN_MOE 1
#endif

__device__ __forceinline__ unsigned f2bf(float f) { unsigned u = __builtin_bit_cast(unsigned, f); return (u + 0x7fffu + ((u >> 16) & 1u)) >> 16; }
__device__ __forceinline__ float bf2f(unsigned b) { return __builtin_bit_cast(float, b << 16); }
__device__ __forceinline__ unsigned pk2(float lo, float hi) { unsigned r; asm volatile("v_cvt_pk_bf16_f32 %0, %1, %2" : "=v"(r) : "v"(lo), "v"(hi)); return r; }
__device__ __forceinline__ float bflo(unsigned w) { return __builtin_bit_cast(float, w << 16); }
__device__ __forceinline__ float bfhi(unsigned w) { return __builtin_bit_cast(float, w & 0xffff0000u); }
__device__ __forceinline__ float sigmoidf_(float x) { return __builtin_amdgcn_rcpf(1.0f + __expf(-x)); }
__device__ __forceinline__ float siluf_(float x) { return x * __builtin_amdgcn_rcpf(1.0f + __expf(-x)); }
__device__ __forceinline__ float wave_sum(float v) {
#pragma unroll
    for (int o = 1; o < 64; o <<= 1) v += __shfl_xor(v, o);
    return v;
}

#define XB_TMO      128
#define XB_XCNT(j)  (256  + 64 * (j))
#define XB_XSUB(j)  (1280 + 64 * (j))
#define XB_XGEN(j)  (2304 + 64 * (j))
#define XB_TOP      3328
#define XB_TOPGEN   3392
#define XCD_BAR_WORDS 3456
#define XB_SPIN_CAP (1u << 22)
__device__ __forceinline__ unsigned xb_ld(unsigned* p)              { return __hip_atomic_load(p, __ATOMIC_RELAXED, __HIP_MEMORY_SCOPE_AGENT); }
__device__ __forceinline__ unsigned xb_add(unsigned* p, unsigned v) { return __hip_atomic_fetch_add(p, v, __ATOMIC_RELAXED, __HIP_MEMORY_SCOPE_AGENT); }
__device__ __forceinline__ unsigned xb_xcc_id() { return (unsigned)__builtin_amdgcn_s_getreg((3 << 11) | 20) & 0xFu; }
#define XB_SPIN(cond, bar) do { unsigned _sp = 0; while (cond) { __builtin_amdgcn_s_sleep(1); \
    if ((++_sp & 255u) == 0u) { if (xb_ld(&(bar)[XB_TMO])) break; if (_sp > XB_SPIN_CAP) { atomicAdd(&(bar)[XB_TMO], 1u); break; } } } } while (0)
struct XcdBarrier { unsigned* bar; unsigned x; volatile LAS unsigned* st; };
__device__ __forceinline__ XcdBarrier xcd_barrier_post(unsigned* bar, volatile LAS unsigned* st) {
    XcdBarrier b; b.bar = bar; b.x = xb_xcc_id(); b.st = st;
    if (threadIdx.x == 0) (void)xb_add(&bar[XB_XCNT(b.x)], 1u);
    return b;
}
__device__ __forceinline__ void xcd_barrier_complete(unsigned* bar, unsigned x, unsigned& nloc, unsigned& nx) {
    const unsigned G = gridDim.x * gridDim.y * gridDim.z;
    unsigned sum, cnt, mine, sp = 0u;
    for (;;) {
        sum = 0u; cnt = 0u; mine = 0u;
#pragma unroll
        for (unsigned j = 0; j < 16; ++j) { const unsigned c = xb_ld(&bar[XB_XCNT(j)]); sum += c; cnt += (c > 0u) ? 1u : 0u; mine = (j == x) ? c : mine; }
        if (sum == G) break;
        __builtin_amdgcn_s_sleep(1);
        if ((++sp & 255u) == 0u) { if (xb_ld(&bar[XB_TMO])) break; if (sp > XB_SPIN_CAP) { atomicAdd(&bar[XB_TMO], 1u); break; } }
    }
    nloc = mine > 0u ? mine : 1u; nx = cnt > 0u ? cnt : 1u;
}
__device__ __forceinline__ void xcd_barrier(const XcdBarrier& b) {
    asm volatile("s_waitcnt vmcnt(0)" ::: "memory");
    __syncthreads();
    if (threadIdx.x == 0) {
        unsigned* bar = b.bar;
        __builtin_amdgcn_s_waitcnt(0);
        unsigned nloc = b.st[0], nx = b.st[1];
        if (nloc == 0u) { xcd_barrier_complete(bar, b.x, nloc, nx); b.st[0] = nloc; b.st[1] = nx; }
        const unsigned old = xb_add(&bar[XB_XSUB(b.x)], 1u);
        const unsigned gen = old / nloc;
        if (old + 1u == (gen + 1u) * nloc) {
            __builtin_amdgcn_fence(__ATOMIC_RELEASE, "agent");
            asm volatile("s_waitcnt vmcnt(0)" ::: "memory");
            const unsigned og = xb_add(&bar[XB_TOP], 1u);
            const unsigned tg = og / nx;
            if (og + 1u == (tg + 1u) * nx) xb_add(&bar[XB_TOPGEN], 1u);
            else XB_SPIN(xb_ld(&bar[XB_TOPGEN]) == tg, bar);
            __builtin_amdgcn_fence(__ATOMIC_ACQUIRE, "agent");
            xb_add(&bar[XB_XGEN(b.x)], 1u);
            asm volatile("s_waitcnt vmcnt(0)" ::: "memory");
        } else {
            XB_SPIN(xb_ld(&bar[XB_XGEN(b.x)]) == gen, bar);
            __builtin_amdgcn_fence(__ATOMIC_ACQUIRE, "agent");
            asm volatile("s_waitcnt vmcnt(0)" ::: "memory");
        }
    }
    __syncthreads();
}

namespace gg {
constexpr int BM = 256, BK = 64, HALF = 128, HTB = HALF * BK * 2, STAGE_BYTES = 8 * HTB;
__device__ __forceinline__ int lds_byte(int r, int c) { const int st = (r >> 4) * 2 + (c >> 5), rr = r & 15, cc = c & 31, ob = rr * 64 + cc * 2; return st * 1024 + (ob ^ (((ob >> 9) & 1) << 5)); }
__device__ __forceinline__ void stage_rc(int b, int& R, int& C) { const int st = b / 1024, sb = b % 1024, swz = sb ^ (((sb >> 9) & 1) << 5); R = (st >> 1) * 16 + swz / 64; C = (st & 1) * 32 + (swz % 64) / 2; }
__device__ __forceinline__ int perm32(int rho) { const int n = rho >> 4, i = rho & 15; return 8 * (i >> 2) + 4 * n + (i & 3); }

struct Unit { const char* a; const char* b; const char* b2; int pm, pn, gofs, x; };
struct Dims { int K, lda, ldb, kseg, ldb2; };

typedef f32x4 Acc[2][2][4][2];

template <class Epi, class Sched, bool GATHER, bool SEGB>
__device__ __forceinline__ void gemm_phase(LAS unsigned char* lds, const Dims dm, const Sched& S, const Epi& E) {
    const int tid = threadIdx.x, wid = __builtin_amdgcn_readfirstlane(tid >> 6), lane = tid & 63, wr = wid >> 2, wc = wid & 3, fr = lane & 15, fq = lane >> 4;
    const int K = dm.K, nt = K / BK;
    unsigned voffB[2], voffB2[2], cAo[2][2], nAo[2][2]; int gR[2], gC[2];
    const unsigned hstepA = (unsigned)HALF * dm.lda * 2u, hstepB = (unsigned)HALF * dm.ldb * 2u, hstepB2 = (unsigned)HALF * dm.ldb2 * 2u;
#pragma unroll
    for (int i = 0; i < 2; ++i) { int R, C; stage_rc(tid * 16 + i * 8192, R, C); const int Rb = Epi::PERM ? ((R & ~31) + perm32(R & 31)) : R;
        gR[i] = R; gC[i] = C * 2; voffB[i] = (unsigned)(Rb * dm.ldb + C) * 2u; voffB2[i] = SEGB ? (unsigned)(Rb * dm.ldb2 + C) * 2u : 0u;
        cAo[0][i] = (unsigned)(R * dm.lda + C) * 2u; cAo[1][i] = cAo[0][i] + hstepA; }
    const unsigned ldsw = (unsigned)wid * 1024u;
    const int aoff = lds_byte(wr * 64 + fr, fq * 8), boff = lds_byte(wc * 32 + fr, fq * 8);
#define GG_SA(b, h) (((b) * 2 + (h)) * HTB)
#define GG_SB(b, h) ((4 + (b) * 2 + (h)) * HTB)
#define GG_STAGE(bufoff, gbase, voff) do { _Pragma("unroll") for (int _i = 0; _i < 2; ++_i) \
        __builtin_amdgcn_global_load_lds((const unsigned*)((const char*)(gbase) + (voff)[_i]), (LAS unsigned*)(lds + (bufoff) + ldsw + _i * 8192), 16, 0, 0); } while (0)
#define GG_LDA(dst, b, h) do { _Pragma("unroll") for (int m = 0; m < 4; ++m) _Pragma("unroll") for (int k = 0; k < 2; ++k) dst[m][k] = *(const LAS bf16x8*)(lds + GG_SA(b, h) + aoff + m * 2048 + k * 1024); } while (0)
#define GG_LDB(dst, b, h) do { _Pragma("unroll") for (int n = 0; n < 2; ++n) _Pragma("unroll") for (int k = 0; k < 2; ++k) dst[n][k] = *(const LAS bf16x8*)(lds + GG_SB(b, h) + boff + n * 2048 + k * 1024); } while (0)
#define GG_MMA(ai, bj, At, Bt) do { __builtin_amdgcn_s_setprio(1); _Pragma("unroll") for (int m = 0; m < 4; ++m) _Pragma("unroll") for (int n = 0; n < 2; ++n) _Pragma("unroll") for (int k = 0; k < 2; ++k) \
        acc[ai][bj][m][n] = __builtin_amdgcn_mfma_f32_16x16x32_bf16(Bt[n][k], At[m][k], acc[ai][bj][m][n], 0, 0, 0); __builtin_amdgcn_s_setprio(0); } while (0)
#define GG_WAIT_V(n) asm volatile("s_waitcnt vmcnt(" #n ")" ::: "memory")
#define GG_WAIT_L(n) asm volatile("s_waitcnt lgkmcnt(" #n ")" ::: "memory")
#define GG_BAR __builtin_amdgcn_s_barrier()
#define GG_SCHED __builtin_amdgcn_sched_barrier(0)
#define GG_BSRC(u, kt) ((SEGB && (kt) >= dm.kseg) ? (u).b2 + (size_t)((kt) - dm.kseg) * 128 : (u).b + (size_t)(kt) * 128)
#define GG_STAGE_B(bufoff, u, kt, h) do { const bool _s2 = SEGB && (kt) >= dm.kseg; \
        const char* _bp = _s2 ? (u).b2 + (size_t)((kt) - dm.kseg) * 128 + (h) * hstepB2 : (u).b + (size_t)(kt) * 128 + (h) * hstepB; \
        unsigned _vo[2]; _vo[0] = _s2 ? voffB2[0] : voffB[0]; _vo[1] = _s2 ? voffB2[1] : voffB[1]; GG_STAGE(bufoff, _bp, _vo); } while (0)
#define GG_GOFF(u, dst) do { if (GATHER) { const LAS int* _ix = (const LAS int*)(lds + (u).gofs); _Pragma("unroll") for (int _h = 0; _h < 2; ++_h) _Pragma("unroll") for (int _i = 0; _i < 2; ++_i) \
        dst[_h][_i] = (unsigned)_ix[_h * 128 + gR[_i]] * (unsigned)(dm.lda * 2) + (unsigned)gC[_i]; } } while (0)
    Unit cur, nxt; int ui = 0;
    if (!S.next(0, cur)) return;
    Acc acc;
#pragma unroll
    for (int a = 0; a < 2; ++a)
#pragma unroll
        for (int b = 0; b < 2; ++b)
#pragma unroll
            for (int m = 0; m < 4; ++m)
#pragma unroll
                for (int n = 0; n < 2; ++n) acc[a][b][m][n] = (f32x4){0.f, 0.f, 0.f, 0.f};
    bf16x8 At[4][2], B0[2][2], B1[2][2];
    GG_GOFF(cur, cAo);
    GG_STAGE_B(GG_SB(0, 0), cur, 0, 0); GG_STAGE(GG_SA(0, 0), cur.a, cAo[0]); GG_STAGE_B(GG_SB(0, 1), cur, 0, 1); GG_STAGE(GG_SA(0, 1), cur.a, cAo[1]);
    if (wr == 1) GG_BAR;
    GG_WAIT_V(4); GG_BAR;
    GG_STAGE_B(GG_SB(1, 0), cur, 1, 0); GG_STAGE(GG_SA(1, 0), cur.a + 128, cAo[0]); GG_STAGE_B(GG_SB(1, 1), cur, 1, 1);
    GG_WAIT_V(6); GG_BAR;
    for (;;) {
        const bool has_next = S.next(ui + 1, nxt);
        if (!has_next) nxt = cur;
        if (GATHER) { if (has_next) { GG_GOFF(nxt, nAo); } else {
#pragma unroll
            for (int h = 0; h < 2; ++h)
#pragma unroll
                for (int i = 0; i < 2; ++i) nAo[h][i] = cAo[h][i]; } }
        for (int t = 0; t < nt; t += 2) {
            const bool last = (t == nt - 2);
            const char* a1 = cur.a + (size_t)(t + 1) * 128;
            const char* a2 = last ? nxt.a : cur.a + (size_t)(t + 2) * 128;
            const char* a3 = a2 + 128;
            unsigned o2[2][2];
#pragma unroll
            for (int h = 0; h < 2; ++h)
#pragma unroll
                for (int i = 0; i < 2; ++i) o2[h][i] = (GATHER && last) ? nAo[h][i] : cAo[h][i];
            const int k2 = last ? 0 : t + 2, k3 = k2 + 1;
            struct { const char* b; const char* b2; } bu; bu.b = last ? nxt.b : cur.b; bu.b2 = last ? nxt.b2 : cur.b2;
            GG_LDB(B0, 0, 0); GG_SCHED; GG_LDA(At, 0, 0); GG_STAGE(GG_SA(1, 1), a1, cAo[1]);
            GG_WAIT_L(8); GG_BAR; GG_WAIT_L(0); GG_MMA(0, 0, At, B0); GG_BAR; GG_SCHED;
            GG_LDB(B1, 0, 1); GG_STAGE_B(GG_SB(0, 0), bu, k2, 0);
            GG_BAR; GG_WAIT_L(0); GG_MMA(0, 1, At, B1); GG_BAR;
            GG_LDA(At, 0, 1); GG_STAGE(GG_SA(0, 0), a2, o2[0]);
            GG_BAR; GG_WAIT_L(0); GG_MMA(1, 0, At, B0); GG_BAR; GG_SCHED;
            GG_STAGE_B(GG_SB(0, 1), bu, k2, 1);
            GG_WAIT_V(6); GG_BAR; GG_MMA(1, 1, At, B1); GG_BAR;
            GG_LDB(B0, 1, 0); GG_SCHED; GG_LDA(At, 1, 0); GG_STAGE(GG_SA(0, 1), a2, o2[1]);
            GG_WAIT_L(8); GG_BAR; GG_WAIT_L(0); GG_MMA(0, 0, At, B0); GG_BAR; GG_SCHED;
            GG_LDB(B1, 1, 1); GG_STAGE_B(GG_SB(1, 0), bu, k3, 0);
            GG_BAR; GG_WAIT_L(0); GG_MMA(0, 1, At, B1); GG_BAR;
            GG_LDA(At, 1, 1); GG_STAGE(GG_SA(1, 0), a3, o2[0]);
            GG_BAR; GG_WAIT_L(0); GG_MMA(1, 0, At, B0); GG_BAR; GG_SCHED;
            GG_STAGE_B(GG_SB(1, 1), bu, k3, 1);
            GG_WAIT_V(6); GG_BAR; GG_MMA(1, 1, At, B1); GG_BAR;
        }
        E(acc, cur, wr, wc, fr, fq);
        if (!has_next) break;
#pragma unroll
        for (int a = 0; a < 2; ++a)
#pragma unroll
            for (int b = 0; b < 2; ++b)
#pragma unroll
                for (int m = 0; m < 4; ++m)
#pragma unroll
                    for (int n = 0; n < 2; ++n) acc[a][b][m][n] = (f32x4){0.f, 0.f, 0.f, 0.f};
        cur = nxt; ++ui;
        if (GATHER) {
#pragma unroll
            for (int h = 0; h < 2; ++h)
#pragma unroll
                for (int i = 0; i < 2; ++i) cAo[h][i] = nAo[h][i]; }
    }
    GG_WAIT_V(0);
    if (wr == 0) GG_BAR;
    GG_BAR;
#undef GG_SA
#undef GG_SB
#undef GG_STAGE
#undef GG_LDA
#undef GG_LDB
#undef GG_MMA
#undef GG_WAIT_V
#undef GG_WAIT_L
#undef GG_BAR
#undef GG_SCHED
#undef GG_BSRC
#undef GG_STAGE_B
#undef GG_GOFF
}

struct DenseSched {
    const char* A; const char* Bt; int nM, nN, G, c; unsigned astep, bstep;
    __device__ __forceinline__ void init(const bf16_t* A_, const bf16_t* Bt_, int M, int N, int lda, int ldb) {
        A = (const char*)A_; Bt = (const char*)Bt_; nM = M / 256; nN = N / 256; G = gridDim.x; c = blockIdx.x; astep = 256u * lda * 2u; bstep = 256u * ldb * 2u; }
    __device__ __forceinline__ bool next(int i, Unit& u) const {
        const int L = i * G + c, nwg = nM * nN; if (L >= nwg) return false;
        int wgid; { const int q = nwg / 8, r = nwg % 8, xcd = L % 8, off = L / 8; wgid = (xcd < r ? xcd * (q + 1) : r * (q + 1) + (xcd - r) * q) + off; }
        const int nig = 8 * nN, gid = wgid / nig, fm = gid * 8, gsz = (nM - fm) < 8 ? (nM - fm) : 8;
        u.pm = fm + ((wgid % nig) % gsz); u.pn = (wgid % nig) / gsz;
        u.a = A + (size_t)u.pm * astep; u.b = Bt + (size_t)u.pn * bstep; u.b2 = nullptr; u.gofs = 0; u.x = 0; return true; }
};
}

constexpr size_t MiB = 1u << 20;
constexpr size_t WS_CTL = 0, CTL_BYTES = 1 * MiB;
constexpr int CW_BAR = 4096, CW_CNT = 8192, CW_CUR = 8192 + 256, CW_NT = 8192 + 512;
constexpr size_t WS_MODP = 1 * MiB, WS_MOD = 3 * MiB, WS_ROPE = 3 * MiB + 256 * 1024, WS_LBV = 3 * MiB + 512 * 1024;
constexpr size_t WS_W_LRU_IN = 4 * MiB, WS_W_LRU_OUT = 8 * MiB, WS_W_LRU_GATE = 10 * MiB;
constexpr size_t WS_W_RWKV_IN = 11 * MiB, WS_W_RWKV_L1 = 17 * MiB, WS_W_RWKV_OUT = 20 * MiB, WS_W_RWKV_WL2 = 556 * MiB;
constexpr size_t WS_W_RET_IN = 22 * MiB, WS_W_RET_OUT = 34 * MiB, WS_W_HGRN_IN = 38 * MiB, WS_W_HGRN_OUT = 48 * MiB;
constexpr size_t WS_MOE = 50 * MiB, MOE_STRIDE = 100 * MiB, MOE_GU = 0, MOE_DN = 64 * MiB, MOE_SHGU = 96 * MiB, MOE_SHDN = 97 * MiB, MOE_RT = 97 * MiB + 512 * 1024;
constexpr size_t WS_H = 450 * MiB, WS_U = 515 * MiB;
constexpr size_t WS_TOPI = 548 * MiB, WS_TOPW = 549 * MiB, WS_POS = 550 * MiB, WS_ROWTOK = 551 * MiB, WS_ROWW = 552 * MiB, WS_TILEE = 553 * MiB;
constexpr size_t WS_SCR = 560 * MiB;
constexpr size_t WS_ULO = WS_SCR + 760 * MiB;
constexpr size_t WS_DUMMY = 1500 * MiB;
constexpr int SH_BASE = 149504;
constexpr int NROWS_SORT = SH_BASE + NTOK;
constexpr size_t WS_ACT = WS_SCR, WS_OUT = WS_SCR + 82 * MiB;
constexpr size_t WS_END = WS_SCR + 880 * MiB;
constexpr size_t WS_MX0 = WS_SCR, WS_MX1 = WS_SCR + 33 * MiB, WS_MX2 = WS_SCR + 66 * MiB, WS_MX3 = WS_SCR + 99 * MiB, WS_MX4 = WS_SCR + 132 * MiB, WS_MX5 = WS_SCR + 165 * MiB;

constexpr int LDS_STAGE = 0, LDS_TAB = 131072, LDS_TAB_BYTES = 20480, LDS_MISC = LDS_TAB + LDS_TAB_BYTES, LDS_BYTES = 155648;

struct Args { const float* in[47]; float* out; unsigned char* ws; int ph_lo, ph_hi; };

struct Frame {
    LAS unsigned char* lds; volatile LAS unsigned* misc; unsigned* ctl; unsigned char* ws;
    int tid, lane, wave, gw, ngw;
    unsigned long long tacc;
};

struct TrJob { const float* src; bf16_t* dst; int ld_src, K, N, ld_dst, nb, sbs, dbs, mode, start; };
constexpr int MAXJOBS = 64;
__device__ __forceinline__ void tr_item(const TrJob& J, int item, LAS unsigned char* scr, int lane) {
    const int nblk = (J.N + 63) >> 6, kblk = J.K >> 6, per = nblk * kblk, bi = item / per, r = item - bi * per, kb = r / nblk, nb = r - kb * nblk, k0 = 64 * kb, n0 = 64 * nb;
    int c0 = n0;
    if (J.mode == 1) { const int pn = n0 >> 8, j = n0 & 255; c0 = (j < 128) ? (128 * pn + j) : (256 + 128 * pn + (j - 128)); }
    const float* W = J.src + (size_t)bi * J.sbs + (size_t)k0 * J.ld_src + c0; bf16_t* WT = J.dst + (size_t)bi * J.dbs + (size_t)n0 * J.ld_dst + k0;
    const int cq = lane & 15, rq = lane >> 4;
    const bool nok = (n0 + 4 * cq) < J.N;
    f32x4 v[16];
#pragma unroll
    for (int i = 0; i < 16; ++i) { v[i] = (f32x4){0.f, 0.f, 0.f, 0.f}; if (nok) v[i] = *(const f32x4*)(W + (size_t)(4 * i + rq) * J.ld_src + 4 * cq); }
#pragma unroll
    for (int i = 0; i < 16; ++i) { const int kk = 4 * i + rq;
#pragma unroll
        for (int e = 0; e < 4; ++e) { float x = v[i][e]; if (J.mode == 3) x = x - bf2f(f2bf(x)); *(LAS unsigned short*)(scr + (4 * cq + e) * 144 + kk * 2) = (unsigned short)f2bf(x); } }
    asm volatile("s_waitcnt lgkmcnt(0)" ::: "memory");
    const int ch = lane & 7, nr = lane >> 3;
#pragma unroll
    for (int j = 0; j < 8; ++j) { const int n = nr + 8 * j; if (n0 + n < J.N) *(u32x4*)(WT + (size_t)n * J.ld_dst + 8 * ch) = *(const LAS u32x4*)(scr + n * 144 + 16 * ch); }
    asm volatile("s_waitcnt lgkmcnt(0)" ::: "memory");
}
__device__ __forceinline__ void ldrow_f32(const float* row, int lane, float (&v)[16]) {
#pragma unroll
    for (int j = 0; j < 2; ++j) { const f32x4 a = *(const f32x4*)(row + 8 * lane + 512 * j), b = *(const f32x4*)(row + 8 * lane + 512 * j + 4);
        v[8 * j + 0] = a.x; v[8 * j + 1] = a.y; v[8 * j + 2] = a.z; v[8 * j + 3] = a.w; v[8 * j + 4] = b.x; v[8 * j + 5] = b.y; v[8 * j + 6] = b.z; v[8 * j + 7] = b.w; }
}
__device__ __forceinline__ void strow_f32(float* row, int lane, const float (&v)[16]) {
#pragma unroll
    for (int j = 0; j < 2; ++j) { *(f32x4*)(row + 8 * lane + 512 * j) = (f32x4){v[8 * j], v[8 * j + 1], v[8 * j + 2], v[8 * j + 3]}; *(f32x4*)(row + 8 * lane + 512 * j + 4) = (f32x4){v[8 * j + 4], v[8 * j + 5], v[8 * j + 6], v[8 * j + 7]}; }
}
__device__ __forceinline__ void ldrow_bf16(const bf16_t* row, int lane, float (&v)[16]) {
#pragma unroll
    for (int j = 0; j < 2; ++j) { const u32x4 a = *(const u32x4*)(row + 8 * lane + 512 * j);
        v[8 * j + 0] = bflo(a.x); v[8 * j + 1] = bfhi(a.x); v[8 * j + 2] = bflo(a.y); v[8 * j + 3] = bfhi(a.y); v[8 * j + 4] = bflo(a.z); v[8 * j + 5] = bfhi(a.z); v[8 * j + 6] = bflo(a.w); v[8 * j + 7] = bfhi(a.w); }
}
__device__ __forceinline__ void addrow_bf16(const bf16_t* row, int lane, float (&v)[16]) {
#pragma unroll
    for (int j = 0; j < 2; ++j) { const u32x4 a = *(const u32x4*)(row + 8 * lane + 512 * j);
        v[8 * j + 0] += bflo(a.x); v[8 * j + 1] += bfhi(a.x); v[8 * j + 2] += bflo(a.y); v[8 * j + 3] += bfhi(a.y); v[8 * j + 4] += bflo(a.z); v[8 * j + 5] += bfhi(a.z); v[8 * j + 6] += bflo(a.w); v[8 * j + 7] += bfhi(a.w); }
}
__device__ __forceinline__ void addrow_fp8(const unsigned char* row, int lane, float (&v)[16]) {
    typedef float f2v __attribute__((ext_vector_type(2)));
#pragma unroll
    for (int j = 0; j < 2; ++j) { const u32x2 a = *(const u32x2*)(row + 8 * lane + 512 * j);
        const f2v p0 = __builtin_amdgcn_cvt_pk_f32_fp8((int)a.x, false), p1 = __builtin_amdgcn_cvt_pk_f32_fp8((int)a.x, true), p2 = __builtin_amdgcn_cvt_pk_f32_fp8((int)a.y, false), p3 = __builtin_amdgcn_cvt_pk_f32_fp8((int)a.y, true);
        v[8 * j + 0] += p0[0]; v[8 * j + 1] += p0[1]; v[8 * j + 2] += p1[0]; v[8 * j + 3] += p1[1]; v[8 * j + 4] += p2[0]; v[8 * j + 5] += p2[1]; v[8 * j + 6] += p3[0]; v[8 * j + 7] += p3[1]; }
}
__device__ __forceinline__ void strow_bf16(bf16_t* row, int lane, const float (&v)[16]) {
#pragma unroll
    for (int j = 0; j < 2; ++j) { u32x4 o; o.x = pk2(v[8 * j], v[8 * j + 1]); o.y = pk2(v[8 * j + 2], v[8 * j + 3]); o.z = pk2(v[8 * j + 4], v[8 * j + 5]); o.w = pk2(v[8 * j + 6], v[8 * j + 7]);
        *(u32x4*)(row + 8 * lane + 512 * j) = o; }
}

#define add(src_, wsoff_, ld_src_, K_, N_, ld_dst_, nb_, sbs_, dbs_, mode_) do { TrJob J; J.src = (src_); J.dst = (bf16_t*)(a.ws + (wsoff_)); J.ld_src = (ld_src_); J.K = (K_); J.N = (N_); J.ld_dst = (ld_dst_); \
            J.nb = (nb_); J.sbs = (sbs_); J.dbs = (dbs_); J.mode = (mode_); J.start = start; jobs[n] = J; start += (nb_) * ((K_) / 64) * (((N_) + 63) / 64); ++n; } while (0)
__device__ __forceinline__ void add_moe_jobs(TrJob* jobs, int& n, int& start, const Args& a, int l) {
    const size_t mb = WS_MOE + l * MOE_STRIDE;
    add(a.in[43] + (size_t)l * 64 * 1024 * 512, mb + MOE_GU, 512, 1024, 512, 1024, 64, 1024 * 512, 512 * 1024, 1);
    add(a.in[44] + (size_t)l * 64 * 256 * 1024, mb + MOE_DN, 1024, 256, 1024, 256, 64, 256 * 1024, 1024 * 256, 0);
    add(a.in[45] + (size_t)l * 1024 * 512, mb + MOE_SHGU, 512, 1024, 512, 1024, 1, 0, 0, 1);
    add(a.in[46] + (size_t)l * 256 * 1024, mb + MOE_SHDN, 1024, 256, 1024, 256, 1, 0, 0, 0);
    add(a.in[41] + (size_t)l * 1024 * 64, mb + MOE_RT, 64, 1024, 64, 1024, 1, 0, 0, 2);
    add(a.in[41] + (size_t)l * 1024 * 64, mb + MOE_RT + 64 * 1024 * 2, 64, 1024, 64, 1024, 1, 0, 0, 3);
}
constexpr int BG_PER_LAYER = 12512, BG_NJOBS = 28, BG_E0 = 12512, BG_E1 = 27072, BG_E2 = 41120, BG_TOTAL = 53632;
constexpr int BG_NW = 8;
__device__ __forceinline__ void bg_convert(Frame& F, const Args& a, int lo, int hi, int first, int stride, bool active = true) {
    if (lo >= hi) return;
    __syncthreads();
    TrJob* jobs = (TrJob*)(F.lds + LDS_TAB);
    if (F.tid == 0) { int n = 0, start = 0;
        add_moe_jobs(jobs, n, start, a, 0);
        add_moe_jobs(jobs, n, start, a, 1);
        add(a.in[31], WS_W_RET_IN, 6144, 1024, 6144, 1024, 1, 0, 0, 0);
        add(a.in[35], WS_W_RET_OUT, 1024, 2048, 1024, 2048, 1, 0, 0, 0);
        add_moe_jobs(jobs, n, start, a, 2);
        add(a.in[36], WS_W_HGRN_IN, 5120, 1024, 5120, 1024, 1, 0, 0, 0);
        add(a.in[40], WS_W_HGRN_OUT, 1024, 1024, 1024, 1024, 1, 0, 0, 0);
        add_moe_jobs(jobs, n, start, a, 3);
        { TrJob J = jobs[n - 1]; J.start = start; J.nb = 0; jobs[n] = J; } }
    __syncthreads();
    LAS unsigned char* scr = F.lds + LDS_STAGE + F.wave * 16384;
    if (active) for (int it = lo + first; it < hi; it += stride) {
        int j = 0; while (j + 1 < BG_NJOBS && jobs[j + 1].start <= it) ++j;
        const TrJob J = jobs[j];
        tr_item(J, it - J.start, scr, F.lane);
    }
    __syncthreads();
}
enum BgEv { EV_LRU_IN, EV_S1, EV_CARRY, EV_S3, EV_LRU_OUT, EV_C0, EV_ROUTE0, EV_RW_IN, EV_RW_L2, EV_RW_CHUNK, EV_RW_PREFIX, EV_RW_OUT, EV_C1, EV_ROUTE1,
            EV_RET_IN, EV_RET_P, EV_RET_KV, EV_RET_O, EV_RET_OUT, EV_C2, EV_ROUTE2, EV_HG_IN, EV_HG_C0, EV_HG_PREFIX, EV_HG_C1, EV_C3 };
template <int EV>
__device__ __forceinline__ void bg_range(int G, int& lo, int& hi, int& nidle, int& rem) {
    int ptr = 0; lo = hi = 0; nidle = 0; rem = 0;
#define BG_SLOT(e, rem_, q) if (EV >= (e)) { const int r_ = (rem_), ni_ = G > r_ ? G - r_ : 0; lo = ptr; hi = min(ptr + ((q) * ni_ * 8) / 2, BG_TOTAL); ptr = hi; nidle = ni_; rem = r_; }
#define BG_CATCH(e, end_) if (EV >= (e)) { lo = ptr; hi = max(ptr, (end_)); ptr = hi; nidle = 0; rem = 0; }
    BG_SLOT(EV_LRU_IN, 520 % G, BQ(3)) BG_SLOT(EV_S1, 8, BQ(7)) BG_SLOT(EV_CARRY, 4, 0) BG_SLOT(EV_S3, 8, BQ(7)) BG_SLOT(EV_LRU_OUT, 260 % G, BQ(3)) BG_CATCH(EV_C0, BG_E0)
    BG_SLOT(EV_ROUTE0, 1040 % G, 0) BG_SLOT(EV_RW_IN, 975 % G, 0) BG_SLOT(EV_RW_L2, 1300 % G, 0) BG_SLOT(EV_RW_CHUNK, 32, BQ(7)) BG_SLOT(EV_RW_PREFIX, 128, 0) BG_SLOT(EV_RW_OUT, 260 % G, BQ(3)) BG_CATCH(EV_C1, BG_E1)
    BG_SLOT(EV_ROUTE1, 1040 % G, 0) BG_SLOT(EV_RET_IN, 1560 % G, BQ(3)) BG_SLOT(EV_RET_P, 260 % G, 0) BG_SLOT(EV_RET_KV, 1040 % G, 0) BG_SLOT(EV_RET_O, 520 % G, BQ(3)) BG_SLOT(EV_RET_OUT, 260 % G, BQ(7)) BG_CATCH(EV_C2, BG_E2)
    BG_SLOT(EV_ROUTE2, 1040 % G, 0) BG_SLOT(EV_HG_IN, 1300 % G, BQ(3)) BG_SLOT(EV_HG_C0, 1040 % G, BQ(3)) BG_SLOT(EV_HG_PREFIX, 128, 0) BG_SLOT(EV_HG_C1, 1040 % G, BQ(7)) BG_CATCH(EV_C3, BG_TOTAL)
#undef BG_SLOT
#undef BG_CATCH
}
template <int EV>
__device__ __forceinline__ void bg_slot(Frame& F, const Args& a) {
    int lo, hi, nidle, rem; bg_range<EV>((int)gridDim.x, lo, hi, nidle, rem);
    const int c = (int)blockIdx.x;
    if (nidle > 0 && c >= rem) { unsigned long long t0 = 0; if (TPROBE) t0 = __builtin_amdgcn_s_memrealtime(); bg_convert(F, a, lo, hi, (c - rem) * BG_NW + F.wave, nidle * BG_NW, F.wave < BG_NW); if (TPROBE) F.tacc += __builtin_amdgcn_s_memrealtime() - t0; }
}
template <int EV>
__device__ __forceinline__ void bg_catch(Frame& F, const Args& a) {
    int lo, hi, nidle, rem; bg_range<EV>((int)gridDim.x, lo, hi, nidle, rem);
    bg_convert(F, a, lo, hi, F.gw, F.ngw);
}

__device__ __forceinline__ void p0_phase(Frame& F, const Args& a) {
    TrJob* jobs = (TrJob*)(F.lds + LDS_TAB);
    int* njobs = (int*)(F.lds + LDS_TAB + MAXJOBS * sizeof(TrJob));
    if (F.tid == 0) {
        int n = 0, start = 0;
        add(a.in[8], WS_W_LRU_IN, 2048, 1024, 2048, 1024, 1, 0, 0, 0);
        add(a.in[14], WS_W_LRU_OUT, 1024, 1024, 1024, 1024, 1, 0, 0, 0);
        add(a.in[11], WS_W_LRU_GATE, 64, 64, 64, 64, 64, 4096, 4096, 0);
        add(a.in[16], WS_W_RWKV_IN, 1024, 1024, 1024, 1024, 3, 1024 * 1024, 1024 * 1024, 0);
        add(a.in[18], WS_W_RWKV_L1, 64, 1024, 64, 1024, 2, 1024 * 64, 64 * 1024, 0);
        add(a.in[21], WS_W_RWKV_L1 + 256 * 1024 * 2, 64, 1024, 64, 1024, 2, 1024 * 64, 64 * 1024, 0);
        add(a.in[23], WS_W_RWKV_L1 + 512 * 1024 * 2, 128, 1024, 128, 1024, 1, 0, 0, 0);
        add(a.in[19], WS_W_RWKV_WL2, 1024, 64, 1024, 256, 1, 0, 0, 0);
        add(a.in[19] + 64 * 1024, WS_W_RWKV_WL2 + (size_t)(1 * 1024 * 256 + 64) * 2, 1024, 64, 1024, 256, 1, 0, 0, 0);
        add(a.in[22], WS_W_RWKV_WL2 + (size_t)(2 * 1024 * 256) * 2, 1024, 64, 1024, 256, 1, 0, 0, 0);
        add(a.in[22] + 64 * 1024, WS_W_RWKV_WL2 + (size_t)(3 * 1024 * 256 + 64) * 2, 1024, 64, 1024, 256, 1, 0, 0, 0);
        add(a.in[24], WS_W_RWKV_WL2 + (size_t)(4 * 1024 * 256) * 2, 1024, 128, 1024, 256, 1, 0, 0, 0);
        add(a.in[30], WS_W_RWKV_OUT, 1024, 1024, 1024, 1024, 1, 0, 0, 0);
        { TrJob J = jobs[n - 1]; J.start = start; J.nb = 0; jobs[n] = J; }
        *njobs = n;
#undef add
    }
    __syncthreads();
    const int nj = *njobs, total = jobs[nj].start;
    LAS unsigned char* scr = F.lds + LDS_STAGE + F.wave * 16384;
    for (int it = F.gw; it < total; it += F.ngw) {
        int j = 0; while (j + 1 < nj && jobs[j + 1].start <= it) ++j;
        const TrJob J = jobs[j];
        tr_item(J, it - J.start, scr, F.lane);
    }
    { u32x4* z = (u32x4*)(a.ws + WS_W_RWKV_L1); const u32x4 zero = {0u, 0u, 0u, 0u};
      for (int i = blockIdx.x * NTHREADS + F.tid; i < 3 * 128 * 128; i += gridDim.x * NTHREADS) { const int blk = i / (128 * 128), r = i % (128 * 128); z[(size_t)(blk * 256 + 128) * 128 + r] = zero; } }
    { u32x4* z = (u32x4*)(a.ws + WS_W_RWKV_WL2); const u32x4 zero = {0u, 0u, 0u, 0u};
      for (int i = blockIdx.x * NTHREADS + F.tid; i < 5 * 1024 * 32; i += gridDim.x * NTHREADS) { const int g = i / (1024 * 32), c8 = (i & 31) * 8;
          const int lo = (g == 1 || g == 3) ? 64 : 0, hi = (g == 4) ? 128 : lo + 64; if (c8 < lo || c8 >= hi) z[i] = zero; } }
    const float* cvec = a.in[1]; const float* ccvec = a.in[3]; const float* adaw = a.in[4];
    float* modp = (float*)(a.ws + WS_MODP);
    for (int it = F.wave * (int)gridDim.x + (int)blockIdx.x; it < 4 * 24 * 8; it += F.ngw) {
        const int s = it & 7, cb = (it >> 3) % 24, l = it / 192, j = cb * 256 + 4 * F.lane;
        const float* W = adaw + ((size_t)l * 1024 + s * 128) * 6144 + j;
        f32x4 al = {0.f, 0.f, 0.f, 0.f}, ac = {0.f, 0.f, 0.f, 0.f};
#pragma unroll 16
        for (int k = 0; k < 128; ++k) { const f32x4 w = *(const f32x4*)(W + (size_t)k * 6144); const float sl = siluf_(cvec[s * 128 + k]), sc = siluf_(ccvec[s * 128 + k]); al += sl * w; ac += sc * w; }
        *(f32x4*)(modp + ((size_t)(s * 4 + l) * 2 + 0) * 6144 + j) = al; *(f32x4*)(modp + ((size_t)(s * 4 + l) * 2 + 1) * 6144 + j) = ac;
    }
    { const int gt = blockIdx.x * NTHREADS + F.tid, ngt = gridDim.x * NTHREADS;
      float* rope = (float*)(a.ws + WS_ROPE);
      for (int i = gt; i < 256 * 64; i += ngt) { const int p = i >> 6, f = i & 63; const double ang = (double)p * pow(10000.0, -(double)f / 64.0); rope[i] = (float)cos(ang); rope[256 * 64 + i] = (float)sin(ang); }
      float* lbv = (float*)(a.ws + WS_LBV); const float* hl = a.in[38];
      for (int i = gt; i < 1024; i += ngt) { const float x0 = hl[i], x1 = hl[1024 + i], x2 = hl[2048 + i], x3 = hl[3072 + i]; const float m = fmaxf(fmaxf(x0, x1), fmaxf(x2, x3));
          const float e0 = expf(x0 - m), e1 = expf(x1 - m), e2 = expf(x2 - m), e3 = expf(x3 - m); lbv[i] = (e1 + e2 + e3) / (e0 + e1 + e2 + e3); } }
}
__device__ __forceinline__ void p1a_phase(Frame& F, const Args& a) {
    const float* modp = (const float*)(a.ws + WS_MODP); float* mod = (float*)(a.ws + WS_MOD); const float* adab = a.in[5];
    const int gt = blockIdx.x * NTHREADS + F.tid, ngt = gridDim.x * NTHREADS;
    for (int i = gt; i < 4 * 2 * 6144; i += ngt) { const int j = i % 6144, l = i / (2 * 6144);
        float s = adab[l * 6144 + j];
#pragma unroll
        for (int sl = 0; sl < 8; ++sl) s += modp[(size_t)sl * 4 * 2 * 6144 + i];
        mod[i] = s; }
}
__device__ __forceinline__ const float* modptr(const unsigned char* ws, int l, int kind, int which) { return (const float*)(ws + WS_MOD) + ((size_t)(l * 2 + kind) * 6 + which) * 1024; }
__device__ __forceinline__ void p1b_phase(Frame& F, const Args& a) {
    bf16_t* H = (bf16_t*)(a.ws + WS_H); bf16_t* U = (bf16_t*)(a.ws + WS_U);
    { int* ROWTOK = (int*)(a.ws + WS_ROWTOK); float* ROWW = (float*)(a.ws + WS_ROWW);
      for (int t = blockIdx.x * NTHREADS + F.tid; t < NTOK; t += gridDim.x * NTHREADS) { ROWTOK[SH_BASE + t] = t; ROWW[SH_BASE + t] = 1.0f; } }
    for (int t = F.gw; t < NTOK; t += F.ngw) {
        const int kind = t < NCTX ? 1 : 0; const float* src = kind ? a.in[2] + (size_t)t * D : a.in[0] + (size_t)(t - NCTX) * D;
        float v[16], m0[16], m1[16]; ldrow_f32(src, F.lane, v); ldrow_f32(modptr(a.ws, 0, kind, 0), F.lane, m0); ldrow_f32(modptr(a.ws, 0, kind, 1), F.lane, m1);
        strow_bf16(H + (size_t)t * D, F.lane, v);
#pragma unroll
        for (int e = 0; e < 16; ++e) v[e] = v[e] * (1.0f + m1[e]) + m0[e];
        strow_bf16(U + (size_t)t * D, F.lane, v);
    }
}

template <int L, int MODE, bool DRY = false>
__device__ __forceinline__ void ln_phase(Frame& F, const Args& a) {
    bf16_t* H = (bf16_t*)(a.ws + WS_H); bf16_t* U = (bf16_t*)(a.ws + WS_U);
    bf16_t* Hw = DRY ? (bf16_t*)(a.ws + WS_DUMMY) : H; bf16_t* Uw = DRY ? (bf16_t*)(a.ws + WS_DUMMY + 70 * MiB) : U; float* outw = DRY ? (float*)(a.ws + WS_DUMMY) : a.out;
    const bf16_t* Y = (const bf16_t*)(a.ws + WS_MX5); const unsigned char* OUT = (const unsigned char*)(a.ws + WS_OUT); const int* POS = (const int*)(a.ws + WS_POS);
    const float* lg = a.in[6] + (size_t)(L * 2 + MODE) * D; const float* lb = a.in[7] + (size_t)(L * 2 + MODE) * D;
    constexpr bool LASTL = (L == 3);
#pragma unroll 1
    for (int kind = 0; kind < 2; ++kind) {
        if (LASTL && kind == 1) break;
        float mg[16], g[16], b[16], msh[16], msc[16];
        ldrow_f32(modptr(a.ws, L, kind, MODE == 0 ? 2 : 5), F.lane, mg); ldrow_f32(lg, F.lane, g); ldrow_f32(lb, F.lane, b);
        if (MODE == 0) { ldrow_f32(modptr(a.ws, L, kind, 3), F.lane, msh); ldrow_f32(modptr(a.ws, L, kind, 4), F.lane, msc); }
        else if (!LASTL) { ldrow_f32(modptr(a.ws, (L + 1) & 3, kind, 0), F.lane, msh); ldrow_f32(modptr(a.ws, (L + 1) & 3, kind, 1), F.lane, msc); }
        const int t0 = kind ? 0 : NCTX, t1 = kind ? NCTX : NTOK;
#pragma unroll 1
        for (int t = t0 + F.gw; t < t1; t += F.ngw) {
            float h[16], y[16];
            ldrow_bf16(H + (size_t)t * D, F.lane, h);
            if (MODE == 0) ldrow_bf16(Y + (size_t)t * D, F.lane, y);
            else if (!EN_MOE) {
#pragma unroll
                for (int e = 0; e < 16; ++e) y[e] = 0.f;
            } else {
                int p = 0; if (F.lane < 8) p = POS[t * 8 + F.lane];
#pragma unroll
                for (int e = 0; e < 16; ++e) y[e] = 0.f;
                addrow_fp8(OUT + (size_t)(SH_BASE + t) * D, F.lane, y);
#pragma unroll
                for (int s = 0; s < 8; ++s) { const int r = __builtin_amdgcn_readlane(p, s); addrow_fp8(OUT + (size_t)r * D, F.lane, y); }
            }
            float s = 0.f;
#pragma unroll
            for (int e = 0; e < 16; ++e) { h[e] = ALPHA * h[e] + mg[e] * y[e]; s += h[e]; }
            const float mean = wave_sum(s) * (1.0f / D); float q = 0.f;
#pragma unroll
            for (int e = 0; e < 16; ++e) { h[e] -= mean; q += h[e] * h[e]; }
            const float rstd = 1.0f / sqrtf(wave_sum(q) * (1.0f / D) + LN_EPS);
#pragma unroll
            for (int e = 0; e < 16; ++e) h[e] = h[e] * rstd * g[e] + b[e];
            if (MODE == 1 && LASTL) { strow_f32(outw + (size_t)(t - NCTX) * D, F.lane, h); }
            else {
                strow_bf16(Hw + (size_t)t * D, F.lane, h);
#pragma unroll
                for (int e = 0; e < 16; ++e) h[e] = h[e] * (1.0f + msc[e]) + msh[e];
                strow_bf16(Uw + (size_t)t * D, F.lane, h);

            }
        }
    }
}

template <int L, bool DRY = false>
__device__ __forceinline__ void moe_route_phase(Frame& F, const Args& a) {
    const bf16_t* U = (const bf16_t*)(a.ws + WS_U); const bf16_t* ULO = (const bf16_t*)(a.ws + WS_ULO);
    const bf16_t* Rhi = (const bf16_t*)(a.ws + WS_MOE + L * MOE_STRIDE + MOE_RT); const bf16_t* Rlo = Rhi + 64 * 1024;
    const float* bias = a.in[42] + L * 64;
    int* TOPI = (int*)(a.ws + (DRY ? WS_DUMMY : WS_TOPI)); float* TOPW = (float*)(a.ws + (DRY ? WS_DUMMY + 4 * MiB : WS_TOPW));
    LAS float* part = (LAS float*)(F.lds + LDS_STAGE);
    const int lane = F.lane, r16 = lane & 15, q = lane >> 4, w = F.wave;
    bf16x8 Bh[4][4], Bl[4][4];
#pragma unroll
    for (int n = 0; n < 4; ++n)
#pragma unroll
        for (int ks = 0; ks < 4; ++ks) { const size_t o = (size_t)(16 * n + r16) * 1024 + 128 * w + 32 * ks + 8 * q; Bh[n][ks] = *(const bf16x8*)(Rhi + o); Bl[n][ks] = *(const bf16x8*)(Rlo + o); }
    const int g0 = (L == 3) ? NCTX / 16 : 0;
    int cnt_e = 0;
    const float mybias = bias[lane];
    bf16x8 Ahn[4];
    if (g0 + (int)blockIdx.x < NTOK / 16) { const size_t ao = (size_t)((g0 + (int)blockIdx.x) * 16 + r16) * D + 128 * w + 8 * q;
#pragma unroll
        for (int ks = 0; ks < 4; ++ks) Ahn[ks] = *(const bf16x8*)(U + ao + 32 * ks); }
#pragma unroll 1
    for (int grp = g0 + blockIdx.x; grp < NTOK / 16; grp += gridDim.x) {
        bf16x8 Ah[4];
#pragma unroll
        for (int ks = 0; ks < 4; ++ks) Ah[ks] = Ahn[ks];
        if (grp + (int)gridDim.x < NTOK / 16) { const size_t ao = (size_t)((grp + (int)gridDim.x) * 16 + r16) * D + 128 * w + 8 * q;
#pragma unroll
            for (int ks = 0; ks < 4; ++ks) Ahn[ks] = *(const bf16x8*)(U + ao + 32 * ks); }
        f32x4 acc[4];
#pragma unroll
        for (int n = 0; n < 4; ++n) { acc[n] = (f32x4){0.f, 0.f, 0.f, 0.f};
#pragma unroll
            for (int ks = 0; ks < 4; ++ks) {
                acc[n] = __builtin_amdgcn_mfma_f32_16x16x32_bf16(Ah[ks], Bh[n][ks], acc[n], 0, 0, 0);
                acc[n] = __builtin_amdgcn_mfma_f32_16x16x32_bf16(Ah[ks], Bl[n][ks], acc[n], 0, 0, 0); } }
        __syncthreads();
#pragma unroll
        for (int n = 0; n < 4; ++n)
#pragma unroll
            for (int r = 0; r < 4; ++r) part[(w * 16 + 4 * q + r) * 64 + 16 * n + r16] = acc[n][r];
        __syncthreads();
#pragma unroll 1
        for (int rr = 0; rr < 2; ++rr) {
            const int row = 2 * w + rr, t = grp * 16 + row;
            float lgt = 0.f;
#pragma unroll
            for (int ww = 0; ww < 8; ++ww) lgt += part[(ww * 16 + row) * 64 + lane];
            const float sc = sigmoidf_(lgt);
            const float ch = sc + mybias;
            float m1 = -INFINITY, m2 = -INFINITY;
#pragma unroll
            for (int j = 0; j < 8; ++j) { const float v = __shfl(ch, (lane & ~7) + j); if (v > m1) { m2 = m1; m1 = v; } else if (v > m2) m2 = v; }
            const float gs = m1 + m2; const int g = lane >> 3;
            int grank = 0;
#pragma unroll
            for (int gg2 = 0; gg2 < 8; ++gg2) { const float v = __shfl(gs, 8 * gg2); grank += (v > gs || (v == gs && gg2 < g)) ? 1 : 0; }
            const bool sel = grank < 4;
            const float chm = sel ? ch : -INFINITY;
            int rank = 0;
#pragma unroll
            for (int e2 = 0; e2 < 64; ++e2) { const float v = __builtin_bit_cast(float, __builtin_amdgcn_readlane(__builtin_bit_cast(int, chm), e2)); rank += (v > chm || (v == chm && e2 < lane)) ? 1 : 0; }
            const bool chosen = sel && rank < 8;
            const float wsum = wave_sum(chosen ? sc : 0.f);
            const unsigned long long bal = __ballot(chosen);
            const int slot = __popcll(bal & ((1ull << lane) - 1ull));
            if (chosen) { TOPI[t * 8 + slot] = lane; TOPW[t * 8 + slot] = 2.5f * sc / wsum; cnt_e++; }
        }
    }
    if (cnt_e && !DRY) atomicAdd(F.ctl + CW_CNT + L * 64 + lane, (unsigned)cnt_e);
}

template <int L, bool DRY = false>
__device__ __forceinline__ void moe_dispatch_phase(Frame& F, const Args& a) {
    LAS int* pb = (LAS int*)(F.lds + LDS_TAB);
    if (F.wave == 0) {
        const int cnt = (int)F.ctl[CW_CNT + L * 64 + F.lane]; const int pad = (cnt + 255) & ~255;
        int inc = pad;
#pragma unroll
        for (int o = 1; o < 64; o <<= 1) { const int v = __shfl_up(inc, o); if (F.lane >= o) inc += v; }
        pb[F.lane] = inc - pad; pb[65 + F.lane] = cnt; if (F.lane == 63) pb[64] = inc;
    }
    __syncthreads();
    const int* TOPI = (const int*)(a.ws + WS_TOPI); const float* TOPW = (const float*)(a.ws + WS_TOPW);
    int* POS = (int*)(a.ws + (DRY ? WS_DUMMY : WS_POS)); int* ROWTOK = (int*)(a.ws + (DRY ? WS_DUMMY + 2 * MiB : WS_ROWTOK)); float* ROWW = (float*)(a.ws + (DRY ? WS_DUMMY + 4 * MiB : WS_ROWW)); int* TILEE = (int*)(a.ws + (DRY ? WS_DUMMY + 6 * MiB : WS_TILEE));
    const int p0 = (L == 3) ? NCTX * 8 : 0;
    LAS int* lcnt = pb + 160; LAS int* lbase = pb + 224;
    const int npairs = NTOK * 8 - p0, per = (npairs + (int)gridDim.x - 1) / (int)gridDim.x, lo = p0 + (int)blockIdx.x * per, hi = min(lo + per, NTOK * 8);
#pragma unroll 1
    for (int c0 = lo; c0 < hi; c0 += NTHREADS) {
        if (F.tid < 64) lcnt[F.tid] = 0;
        __syncthreads();
        const int p = c0 + F.tid; const bool ok = p < hi; int e = 0, lrank = 0;
        if (ok) { e = TOPI[p]; lrank = atomicAdd((int*)(lcnt + e), 1); }
        __syncthreads();
        if (F.tid < 64) { const int c = lcnt[F.tid]; lbase[F.tid] = pb[F.tid] + (c ? (int)atomicAdd(F.ctl + CW_CUR + (DRY ? 1024 : 0) + L * 64 + F.tid, (unsigned)c) : 0); }
        __syncthreads();
        if (ok) { const int dest = lbase[e] + lrank; POS[p] = dest; ROWTOK[dest] = p >> 3; ROWW[dest] = TOPW[p]; }
        __syncthreads();
    }
    if (blockIdx.x < 64) {
        const int e = blockIdx.x, base = pb[e], cnt = pb[65 + e], pad = (cnt + 255) & ~255;
        for (int r = cnt + F.tid; r < pad; r += NTHREADS) { ROWTOK[base + r] = NCTX; ROWW[base + r] = 0.f; }
        for (int tl = F.tid; tl < pad / 256; tl += NTHREADS) TILEE[base / 256 + tl] = e;
    }
    if (blockIdx.x == 64 && F.tid == 0 && !DRY) F.ctl[CW_NT + L] = (unsigned)(pb[64] / 256);
    __syncthreads();
}

struct ListSched {
    const LAS gg::Unit* tab; int n;
    __device__ __forceinline__ bool next(int i, gg::Unit& u) const {
        if (i >= n) return false;
        const LAS unsigned* p = (const LAS unsigned*)(tab + i); unsigned w[10];
#pragma unroll
        for (int k = 0; k < 10; ++k) w[k] = (unsigned)__builtin_amdgcn_readfirstlane((int)p[k]);
        u.a = (const char*)(((unsigned long long)w[1] << 32) | w[0]); u.b = (const char*)(((unsigned long long)w[3] << 32) | w[2]); u.b2 = (const char*)(((unsigned long long)w[5] << 32) | w[4]);
        u.pm = (int)w[6]; u.pn = (int)w[7]; u.gofs = (int)w[8]; u.x = (int)w[9]; return true; }
};
static_assert(sizeof(gg::Unit) == 40, "Unit layout");

struct EpiSwiglu {
    static constexpr bool PERM = true;
    bf16_t* ACT; LAS unsigned char* lds;
    __device__ __forceinline__ void operator()(const gg::Acc& acc, const gg::Unit& u, int wr, int wc, int fr, int fq) const {
        const int row0 = u.pm * 256 + wr * 64 + fr, col0 = u.pn * 128 + wc * 32 + 8 * fq;
        const LAS float* wl = (const LAS float*)(lds + u.gofs + 8192);
#pragma unroll
        for (int ai = 0; ai < 2; ++ai)
#pragma unroll
            for (int m = 0; m < 4; ++m) { const int row = row0 + ai * 128 + m * 16; const float w = wl[wr * 64 + fr + ai * 128 + m * 16];
                const f32x4 g0 = acc[ai][0][m][0], g1 = acc[ai][0][m][1], u0 = acc[ai][1][m][0], u1 = acc[ai][1][m][1];
                u32x4 o; o.x = pk2(siluf_(g0[0]) * u0[0] * w, siluf_(g0[1]) * u0[1] * w); o.y = pk2(siluf_(g0[2]) * u0[2] * w, siluf_(g0[3]) * u0[3] * w);
                o.z = pk2(siluf_(g1[0]) * u1[0] * w, siluf_(g1[1]) * u1[1] * w); o.w = pk2(siluf_(g1[2]) * u1[2] * w, siluf_(g1[3]) * u1[3] * w);
                *(u32x4*)(ACT + (size_t)row * 256 + col0) = o; }
    }
};
struct EpiBf16 {
    static constexpr bool PERM = true;
    bf16_t* O; int ldc;
    __device__ __forceinline__ void operator()(const gg::Acc& acc, const gg::Unit& u, int wr, int wc, int fr, int fq) const {
        const int row0 = u.pm * 256 + wr * 64 + fr, col0 = u.pn * 256 + wc * 32 + 8 * fq;
#pragma unroll
        for (int ai = 0; ai < 2; ++ai)
#pragma unroll
            for (int m = 0; m < 4; ++m) { bf16_t* rp = O + (size_t)(row0 + ai * 128 + m * 16) * ldc + col0;
#pragma unroll
                for (int bj = 0; bj < 2; ++bj) { const f32x4 v0 = acc[ai][bj][m][0], v1 = acc[ai][bj][m][1];
                    u32x4 o; o.x = pk2(v0[0], v0[1]); o.y = pk2(v0[2], v0[3]); o.z = pk2(v1[0], v1[1]); o.w = pk2(v1[2], v1[3]);
                    *(u32x4*)(rp + bj * 128) = o; } }
    }
};

__device__ __forceinline__ unsigned pk4_fp8(float a, float b, float c, float d) { int w = __builtin_amdgcn_cvt_pk_fp8_f32(a, b, 0, false); w = __builtin_amdgcn_cvt_pk_fp8_f32(c, d, w, true); return (unsigned)w; }
struct EpiFp8 {
    static constexpr bool PERM = true;
    unsigned char* O; int rmask;
    __device__ __forceinline__ void operator()(const gg::Acc& acc, const gg::Unit& u, int wr, int wc, int fr, int fq) const {
        const int row0 = (u.pm * 256 + wr * 64 + fr) & rmask, col0 = u.pn * 256 + wc * 32 + 8 * fq;
#pragma unroll
        for (int ai = 0; ai < 2; ++ai)
#pragma unroll
            for (int m = 0; m < 4; ++m) { unsigned char* rp = O + (size_t)((row0 + ai * 128 + m * 16) & rmask) * 1024 + col0;
#pragma unroll
                for (int bj = 0; bj < 2; ++bj) { const f32x4 v0 = acc[ai][bj][m][0], v1 = acc[ai][bj][m][1];
                    u32x2 o; o.x = pk4_fp8(v0[0], v0[1], v0[2], v0[3]); o.y = pk4_fp8(v1[0], v1[1], v1[2], v1[3]);
                    *(u32x2*)(rp + bj * 128) = o; } }
    }
};
template <int L>
__device__ __forceinline__ void moe_gateup_phase(Frame& F, const Args& a) {
    const int ntr = (int)F.ctl[CW_NT + L]; constexpr int s0 = (L == 3) ? 1 : 0; const int nsh = 65 - s0, nunits = (ntr + nsh) * 2;
    gg::Unit* tab = (gg::Unit*)(F.lds + LDS_TAB); LAS int* idx = (LAS int*)(F.lds + LDS_TAB + 512);
    const int* ROWTOK = (const int*)(a.ws + WS_ROWTOK); const int* TILEE = (const int*)(a.ws + WS_TILEE); const float* ROWW = (const float*)(a.ws + WS_ROWW);
    const char* Wgu = (const char*)(a.ws + WS_MOE + L * MOE_STRIDE + MOE_GU); const char* Wsh = (const char*)(a.ws + WS_MOE + L * MOE_STRIDE + MOE_SHGU);
    int nmine = 0;
    for (int i = 0; i < 8; ++i) { const int Lq = i * (int)gridDim.x + (int)blockIdx.x; if (Lq >= nunits) break; nmine = i + 1;
        int uidx; { const int q8 = nunits / 8, r8 = nunits % 8, xcd = Lq % 8, off = Lq / 8; uidx = (xcd < r8 ? xcd * (q8 + 1) : r8 * (q8 + 1) + (xcd - r8) * q8) + off; }
        const int tile = uidx >> 1, pn = uidx & 1; const bool routed = tile < ntr;
        const int rowtile = routed ? tile : (SH_BASE / 256 + s0 + (tile - ntr));
        if (F.tid == 0) { gg::Unit u; u.a = (const char*)(a.ws + WS_U); u.b = routed ? Wgu + ((size_t)TILEE[tile] * 512 + pn * 256) * 2048 : Wsh + (size_t)(pn * 256) * 2048; u.b2 = nullptr;
            u.pm = rowtile; u.pn = pn; u.gofs = LDS_TAB + 512 + i * 1024; u.x = 0; tab[i] = u; }
        if (F.tid < 256) { idx[i * 256 + F.tid] = ROWTOK[rowtile * 256 + F.tid]; ((LAS float*)(F.lds + LDS_TAB + 512 + 8192))[i * 256 + F.tid] = ROWW[rowtile * 256 + F.tid]; }
    }
    __syncthreads();
    ListSched S{(const LAS gg::Unit*)(F.lds + LDS_TAB), nmine}; EpiSwiglu E{(bf16_t*)(a.ws + WS_ACT), F.lds};
    gg::gemm_phase<EpiSwiglu, ListSched, true, false>(F.lds + LDS_STAGE, gg::Dims{1024, 1024, 1024, 0, 0}, S, E);
}
struct EpiFp8S {
    static constexpr bool PERM = true;
    unsigned char* O; LAS unsigned char* slab;
    __device__ __forceinline__ void operator()(const gg::Acc& acc, const gg::Unit& u, int wr, int wc, int fr, int fq) const {
        int t = threadIdx.x; asm volatile("" : "+v"(t));
        const int rrow = t >> 4, rchunk = t & 15;
#pragma unroll
        for (int ai = 0; ai < 2; ++ai)
#pragma unroll
            for (int m = 0; m < 4; ++m) { const int sidx = ai * 4 + m; LAS unsigned char* sb = slab + (sidx & 1) * (32 * 264);
#pragma unroll
                for (int bj = 0; bj < 2; ++bj) { const f32x4 v0 = acc[ai][bj][m][0], v1 = acc[ai][bj][m][1];
                    u32x2 o; o.x = pk4_fp8(v0[0], v0[1], v0[2], v0[3]); o.y = pk4_fp8(v1[0], v1[1], v1[2], v1[3]);
                    *(LAS u32x2*)(sb + (wr * 16 + fr) * 264 + wc * 32 + 8 * fq + bj * 128) = o; }
                __builtin_amdgcn_s_waitcnt(0xc07f); __builtin_amdgcn_s_barrier();
                const u32x4 v = { *(const LAS unsigned*)(sb + rrow * 264 + rchunk * 16), *(const LAS unsigned*)(sb + rrow * 264 + rchunk * 16 + 4), *(const LAS unsigned*)(sb + rrow * 264 + rchunk * 16 + 8), *(const LAS unsigned*)(sb + rrow * 264 + rchunk * 16 + 12) };
                const int grow = u.pm * 256 + (rrow >> 4) * 64 + (rrow & 15) + ai * 128 + m * 16;
                *(u32x4*)(O + (size_t)grow * 1024 + u.pn * 256 + rchunk * 16) = v; }
    }
};
template <int L, int MODE = 0>
__device__ __forceinline__ void moe_down_phase(Frame& F, const Args& a) {
    constexpr bool DRY = MODE == 1;
    const int ntr = (int)F.ctl[CW_NT + L]; constexpr int s0 = (L == 3) ? 1 : 0; const int nsh = 65 - s0, nunits = (ntr + nsh) * 4;
    gg::Unit* tab = (gg::Unit*)(F.lds + LDS_TAB);
    const int* TILEE = (const int*)(a.ws + WS_TILEE);
    const char* Wdn = (const char*)(a.ws + WS_MOE + L * MOE_STRIDE + MOE_DN); const char* Wsh = (const char*)(a.ws + WS_MOE + L * MOE_STRIDE + MOE_SHDN);
    int nmine = 0;
    for (int i = 0; i < 12; ++i) { const int Lq = i * (int)gridDim.x + (int)blockIdx.x; if (Lq >= nunits) break; nmine = i + 1;
        int uidx; { const int q8 = nunits / 8, r8 = nunits % 8, xcd = Lq % 8, off = Lq / 8; uidx = (xcd < r8 ? xcd * (q8 + 1) : r8 * (q8 + 1) + (xcd - r8) * q8) + off; }
        const int tile = uidx >> 2, pn = uidx & 3; const bool routed = tile < ntr;
        const int rowtile = routed ? tile : (SH_BASE / 256 + s0 + (tile - ntr));
        if (F.tid == 0) { gg::Unit u; u.a = (const char*)(a.ws + WS_ACT) + (size_t)rowtile * 256 * 512; u.b = routed ? Wdn + ((size_t)TILEE[tile] * 1024 + pn * 256) * 512 : Wsh + (size_t)(pn * 256) * 512; u.b2 = nullptr;
            u.pm = rowtile; u.pn = pn; u.gofs = 0; u.x = 0; tab[i] = u; }
    }
    __syncthreads();
    ListSched S{(const LAS gg::Unit*)(F.lds + LDS_TAB), nmine};
    if (MODE == 3 || MODE == 4) { EpiFp8S E{(unsigned char*)(a.ws + (MODE == 3 ? WS_DUMMY : WS_OUT)), F.lds + LDS_TAB + 2048};
        gg::gemm_phase<EpiFp8S, ListSched, false, false>(F.lds + LDS_STAGE, gg::Dims{256, 256, 256, 0, 0}, S, E); }
    else { EpiFp8 E{(unsigned char*)(a.ws + (MODE == 0 ? WS_OUT : WS_DUMMY)), DRY ? 63 : 0x7fffffff};
        gg::gemm_phase<EpiFp8, ListSched, false, false>(F.lds + LDS_STAGE, gg::Dims{256, 256, 256, 0, 0}, S, E); }
}

__device__ __forceinline__ int xcd_remap(int L, int n) { const int q8 = n / 8, r8 = n % 8, xcd = L % 8, off = L / 8; return (xcd < r8 ? xcd * (q8 + 1) : r8 * (q8 + 1) + (xcd - r8) * q8) + off; }
__device__ __forceinline__ float gelu_tanh(float x) { const float z = 0.7978845608028654f * (x + 0.044715f * x * x * x); return x * (1.0f - __builtin_amdgcn_rcpf(1.0f + __expf(2.0f * z))); }
struct EpiLruIn {
    static constexpr bool PERM = true;
    bf16_t* GB; bf16_t* RNN;
    __device__ __forceinline__ void operator()(const gg::Acc& acc, const gg::Unit& u, int wr, int wc, int fr, int fq) const {
        const bool isg = u.pn < 4; bf16_t* O = isg ? GB : RNN;
        const int row0 = u.pm * 256 + wr * 64 + fr, col0 = (u.pn & 3) * 256 + wc * 32 + 8 * fq;
#pragma unroll
        for (int ai = 0; ai < 2; ++ai)
#pragma unroll
            for (int m = 0; m < 4; ++m) { bf16_t* rp = O + (size_t)(row0 + ai * 128 + m * 16) * 1024 + col0;
#pragma unroll
                for (int bj = 0; bj < 2; ++bj) { f32x4 v0 = acc[ai][bj][m][0], v1 = acc[ai][bj][m][1];
                    if (isg) {
#pragma unroll
                        for (int e = 0; e < 4; ++e) { v0[e] = gelu_tanh(v0[e]); v1[e] = gelu_tanh(v1[e]); } }
                    u32x4 o; o.x = pk2(v0[0], v0[1]); o.y = pk2(v0[2], v0[3]); o.z = pk2(v1[0], v1[1]); o.w = pk2(v1[2], v1[3]);
                    *(u32x4*)(rp + bj * 128) = o; } }
    }
};
template <bool REV>
__device__ __forceinline__ void lru_scan16(const float (&a)[4], const float (&b)[4], float (&h)[4], float& hc, float& at, int lane) {
    const int q = lane >> 4;
    float Ar[4], Br[4]; float A = 1.0f, B = 0.0f;
#pragma unroll
    for (int ri = 0; ri < 4; ++ri) { const int r = REV ? 3 - ri : ri; B = a[r] * B + b[r]; A = a[r] * A; Ar[r] = A; Br[r] = B; }
    float As = A, Bs = B;
    { const float pA = REV ? __shfl_down(As, 16) : __shfl_up(As, 16), pB = REV ? __shfl_down(Bs, 16) : __shfl_up(Bs, 16); const bool on = REV ? (q <= 2) : (q >= 1); if (on) { Bs = As * pB + Bs; As = As * pA; } }
    { const float pA = REV ? __shfl_down(As, 32) : __shfl_up(As, 32), pB = REV ? __shfl_down(Bs, 32) : __shfl_up(Bs, 32); const bool on = REV ? (q <= 1) : (q >= 2); if (on) { Bs = As * pB + Bs; As = As * pA; } }
    float eA = REV ? __shfl_down(As, 16) : __shfl_up(As, 16), eB = REV ? __shfl_down(Bs, 16) : __shfl_up(Bs, 16);
    const bool first = REV ? (q == 3) : (q == 0); if (first) { eA = 1.0f; eB = 0.0f; }
    const float Hin = eA * hc + eB;
#pragma unroll
    for (int r = 0; r < 4; ++r) h[r] = Ar[r] * Hin + Br[r];
    const int src = (REV ? 0 : 48) + (lane & 15);
    const float tA = __shfl(As, src), tB = __shfl(Bs, src);
    hc = tA * hc + tB; at *= tA;
}
template <bool SUMMARY>
__device__ __forceinline__ void lru_scan_phase(Frame& F, const Args& a) {
    const bf16_t* RNN = (const bf16_t*)(a.ws + WS_MX1); const bf16_t* GB = (const bf16_t*)(a.ws + WS_MX0); bf16_t* A2 = (bf16_t*)(a.ws + WS_MX2);
    float* SUMM = (float*)(a.ws + WS_MX3); const float* CARRY = (const float*)(a.ws + WS_MX4);
    const bf16_t* Wg = (const bf16_t*)(a.ws + WS_W_LRU_GATE);
    const float* cw = a.in[9]; const float* cb = a.in[10]; const float* gbias = a.in[12]; const float* lam = a.in[13];
    LAS unsigned char* xt = F.lds + LDS_STAGE + F.wave * 17408;
    LAS unsigned char* ot = xt + 9216;
    const int lane = F.lane, c16 = lane & 15, q = lane >> 4, cg = lane & 7, rg = lane >> 3;
#pragma unroll 1
    for (int task = F.gw; task < (NTOK / 64) * 16; task += F.ngw) {
        const int k = task >> 4;
        const int t0 = 64 * k, slo = (k < 4) ? 0 : NCTX, shi = (k < 4) ? NCTX : NTOK;
        {
            const int blk = task & 15, ch0 = blk * 64;
            {
                float w[4][8], bsv[8];
#pragma unroll
                for (int e = 0; e < 8; ++e) { bsv[e] = cb[ch0 + 8 * cg + e];
#pragma unroll
                    for (int j = 0; j < 4; ++j) w[j][e] = cw[j * 1024 + ch0 + 8 * cg + e]; }
#pragma unroll 1
                for (int ps = 0; ps < 2; ++ps) {
                    const int rq = rg + 8 * ps;
                    float xin[7][8];
#pragma unroll
                    for (int rr = 0; rr < 7; ++rr) { const int t = t0 + 4 * rq - 1 + rr; u32x4 v = {0u, 0u, 0u, 0u};
                        if (t >= slo && t < shi) v = *(const u32x4*)(RNN + (size_t)t * 1024 + ch0 + 8 * cg);
                        xin[rr][0] = bflo(v.x); xin[rr][1] = bfhi(v.x); xin[rr][2] = bflo(v.y); xin[rr][3] = bfhi(v.y); xin[rr][4] = bflo(v.z); xin[rr][5] = bfhi(v.z); xin[rr][6] = bflo(v.w); xin[rr][7] = bfhi(v.w); }
#pragma unroll
                    for (int r = 0; r < 4; ++r) { float o[8];
#pragma unroll
                        for (int e = 0; e < 8; ++e) o[e] = bsv[e] + w[0][e] * xin[r][e] + w[1][e] * xin[r + 1][e] + w[2][e] * xin[r + 2][e] + w[3][e] * xin[r + 3][e];
                        u32x4 pk; pk.x = pk2(o[0], o[1]); pk.y = pk2(o[2], o[3]); pk.z = pk2(o[4], o[5]); pk.w = pk2(o[6], o[7]);
                        *(LAS u32x4*)(xt + (4 * rq + r) * 144 + 16 * cg) = pk; }
                }
            }
            asm volatile("s_waitcnt lgkmcnt(0)" ::: "memory");
            bf16x8 Af[4][2];
#pragma unroll
            for (int T = 0; T < 4; ++T)
#pragma unroll
                for (int ks = 0; ks < 2; ++ks) Af[T][ks] = *(const LAS bf16x8*)(xt + (16 * T + c16) * 144 + (32 * ks + 8 * q) * 2);
#pragma unroll
            for (int g4 = 0; g4 < 4; ++g4) {
                const int ch = ch0 + 16 * g4 + c16;
                float xv[4][4];
#pragma unroll
                for (int T = 0; T < 4; ++T)
#pragma unroll
                    for (int r = 0; r < 4; ++r) xv[T][r] = bf2f(*(const LAS unsigned short*)(xt + (16 * T + 4 * q + r) * 144 + (16 * g4 + c16) * 2));
                float hsum[4][4];
#pragma unroll
                for (int d = 0; d < 2; ++d) {
                    f32x4 acc[2][4];
#pragma unroll
                    for (int gt = 0; gt < 2; ++gt) {
                        const bf16_t* wp = Wg + ((size_t)((d * 2 + gt) * 16 + blk) * 64 + 16 * g4 + c16) * 64 + 8 * q;
                        const bf16x8 b0 = *(const bf16x8*)wp, b1 = *(const bf16x8*)(wp + 32);
#pragma unroll
                        for (int T = 0; T < 4; ++T) { f32x4 z = {0.f, 0.f, 0.f, 0.f};
                            z = __builtin_amdgcn_mfma_f32_16x16x32_bf16(Af[T][0], b0, z, 0, 0, 0);
                            acc[gt][T] = __builtin_amdgcn_mfma_f32_16x16x32_bf16(Af[T][1], b1, z, 0, 0, 0); }
                    }
                    const float gb0 = gbias[(d * 2 + 0) * 1024 + ch], gb1 = gbias[(d * 2 + 1) * 1024 + ch];
                    const float lm = lam[d * 1024 + ch]; const float sp = log1pf(__expf(-lm));
                    float hc = 0.0f, at = 1.0f;
                    if (!SUMMARY) hc = CARRY[((size_t)d * 260 + k) * 1024 + ch];
#pragma unroll
                    for (int Ti = 0; Ti < 4; ++Ti) {
                        const int T = d ? 3 - Ti : Ti;
                        float av[4], bv[4], hv[4];
#pragma unroll
                        for (int r = 0; r < 4; ++r) { const float rgate = sigmoidf_(acc[0][T][r] + gb0), ig = sigmoidf_(acc[1][T][r] + gb1);
                            const float la = -8.0f * rgate * sp; const float aa = __expf(la); av[r] = aa; bv[r] = __builtin_amdgcn_sqrtf(fmaxf(1.0f - aa * aa, 0.f)) * ig * xv[T][r]; }
                        if (d == 0) lru_scan16<false>(av, bv, hv, hc, at, lane); else lru_scan16<true>(av, bv, hv, hc, at, lane);
                        if (!SUMMARY) {
#pragma unroll
                            for (int r = 0; r < 4; ++r) hsum[T][r] = (d == 0) ? hv[r] : hsum[T][r] + hv[r]; }
                    }
                    if (SUMMARY) { if (q == 0) { SUMM[((size_t)d * 260 + k) * 1024 + ch] = at; SUMM[((size_t)(2 + d) * 260 + k) * 1024 + ch] = hc; } }
                }
                if (!SUMMARY) {
#pragma unroll
                    for (int T = 0; T < 4; ++T)
#pragma unroll
                        for (int r = 0; r < 4; ++r) *(LAS unsigned short*)(ot + (16 * T + 4 * q + r) * 128 + (16 * g4 + c16) * 2) = (unsigned short)f2bf(hsum[T][r]);
                }
            }
            if (!SUMMARY) {
                asm volatile("s_waitcnt lgkmcnt(0)" ::: "memory");
#pragma unroll
                for (int r = 0; r < 8; ++r) { const int row = 8 * rg + r; const u32x4 hv = *(const LAS u32x4*)(ot + row * 128 + 16 * cg);
                    const u32x4 gv = *(const u32x4*)(GB + (size_t)(t0 + row) * 1024 + ch0 + 8 * cg);
                    u32x4 o; o.x = pk2(bflo(hv.x) * bflo(gv.x), bfhi(hv.x) * bfhi(gv.x)); o.y = pk2(bflo(hv.y) * bflo(gv.y), bfhi(hv.y) * bfhi(gv.y));
                    o.z = pk2(bflo(hv.z) * bflo(gv.z), bfhi(hv.z) * bfhi(gv.z)); o.w = pk2(bflo(hv.w) * bflo(gv.w), bfhi(hv.w) * bfhi(gv.w));
                    *(u32x4*)(A2 + (size_t)(t0 + row) * 1024 + ch0 + 8 * cg) = o; }
            }
            asm volatile("s_waitcnt lgkmcnt(0)" ::: "memory");
        }
    }
}
__device__ __forceinline__ void lru_carry_phase(Frame& F, const Args& a) {
    const float* SUMM = (const float*)(a.ws + WS_MX3); float* CARRY = (float*)(a.ws + WS_MX4);
    const int gid = blockIdx.x * NTHREADS + F.tid; if (gid >= 2048) return;
    const int d = gid >> 10, c = gid & 1023; float h = 0.0f;
    const float* At = SUMM + (size_t)d * 260 * 1024 + c; const float* He = SUMM + (size_t)(2 + d) * 260 * 1024 + c; float* Cy = CARRY + (size_t)d * 260 * 1024 + c;
#pragma unroll 1
    for (int b = 0; b < 10; ++b) {
        float av[26], hv[26]; int kk[26];
#pragma unroll
        for (int j = 0; j < 26; ++j) { const int st = b * 26 + j; kk[j] = d == 0 ? st : (st < 4 ? 3 - st : 263 - st); av[j] = At[(size_t)kk[j] * 1024]; hv[j] = He[(size_t)kk[j] * 1024]; }
#pragma unroll
        for (int j = 0; j < 26; ++j) { Cy[(size_t)kk[j] * 1024] = h; h = av[j] * h + hv[j]; }
    }
}
__device__ __forceinline__ void lru_in_gemm_phase(Frame& F, const Args& a) {
    gg::DenseSched S; S.init((const bf16_t*)(a.ws + WS_U), (const bf16_t*)(a.ws + WS_W_LRU_IN), NTOK, 2048, 1024, 1024);
    EpiLruIn E{(bf16_t*)(a.ws + WS_MX0), (bf16_t*)(a.ws + WS_MX1)};
    gg::gemm_phase<EpiLruIn, gg::DenseSched, false, false>(F.lds + LDS_STAGE, gg::Dims{1024, 1024, 1024, 0, 0}, S, E);
}
__device__ __forceinline__ void dense_gemm_bf16(Frame& F, const bf16_t* A, const bf16_t* Bt, bf16_t* O, int M, int N, int K) {
    gg::DenseSched S; S.init(A, Bt, M, N, K, K);
    EpiBf16 E{O, N};
    gg::gemm_phase<EpiBf16, gg::DenseSched, false, false>(F.lds + LDS_STAGE, gg::Dims{K, K, K, 0, 0}, S, E);
}

constexpr size_t RT_QR = WS_SCR, RT_KR = WS_SCR + 33 * MiB, RT_V = WS_SCR + 66 * MiB, RT_SG = WS_SCR + 132 * MiB, RT_ACAT = WS_SCR + 198 * MiB, RT_KTD = WS_SCR + 301 * MiB,
                 RT_VT = WS_SCR + 367 * MiB, RT_ST = WS_SCR + 433 * MiB, RT_O = WS_SCR + 564 * MiB, RT_A3 = RT_V, RT_END = WS_SCR + 630 * MiB;
constexpr int NBLK = NTOK / 256;
struct EpiBf16X {
    static constexpr bool PERM = true;
    bf16_t* O; int ldc;
    __device__ __forceinline__ void operator()(const gg::Acc& acc, const gg::Unit& u, int wr, int wc, int fr, int fq) const {
#pragma unroll
        for (int ai = 0; ai < 2; ++ai)
#pragma unroll
            for (int m = 0; m < 4; ++m) { bf16_t* rp = O + (size_t)(unsigned)u.x + (size_t)(ai * 128 + wr * 64 + m * 16 + fr) * ldc + wc * 32 + 8 * fq;
#pragma unroll
                for (int bj = 0; bj < 2; ++bj) { const f32x4 v0 = acc[ai][bj][m][0], v1 = acc[ai][bj][m][1];
                    u32x4 o; o.x = pk2(v0[0], v0[1]); o.y = pk2(v0[2], v0[3]); o.z = pk2(v1[0], v1[1]); o.w = pk2(v1[2], v1[3]);
                    *(u32x4*)(rp + bj * 128) = o; } }
    }
};
__device__ __forceinline__ float log_sigmoid(float x) { return -(fmaxf(-x, 0.f) + log1pf(__expf(-fabsf(x)))); }
struct EpiRetIn {
    static constexpr bool PERM = true;
    bf16_t *QR, *KR, *V, *SG, *ACAT; const float* rope; const float* decay;
    __device__ __forceinline__ void operator()(const gg::Acc& acc, const gg::Unit& u, int wr, int wc, int fr, int fq) const {
        const int pn = u.pn, row0 = u.pm * 256 + wr * 64 + fr, cx = wc * 32 + 8 * fq;
        if (pn < 8) {
            const int h = pn & 3; const bool isq = pn < 4;
            const float lg0 = log_sigmoid(decay[h]), lg1 = log_sigmoid(decay[4 + h]);
#pragma unroll
            for (int ai = 0; ai < 2; ++ai)
#pragma unroll
                for (int m = 0; m < 4; ++m) {
                    const int row = row0 + ai * 128 + m * 16, i = row & 255, b = row >> 8;
                    f32x4 lo[2] = {acc[ai][0][m][0], acc[ai][0][m][1]}, hi[2] = {acc[ai][1][m][0], acc[ai][1][m][1]};
                    if (row >= NCTX) {
                        const int tl = row - NCTX, pp = (wc < 2) ? (tl >> 6) : (tl & 63), i0 = (wc & 1) * 32 + 8 * fq;
                        const float* cp = rope + pp * 64 + i0; const float* sp = cp + 256 * 64;
#pragma unroll
                        for (int n = 0; n < 2; ++n) { const f32x4 c = *(const f32x4*)(cp + 4 * n), sn = *(const f32x4*)(sp + 4 * n);
                            const f32x4 l2 = lo[n] * c - hi[n] * sn, h2 = hi[n] * c + lo[n] * sn; lo[n] = l2; hi[n] = h2; }
                    }
                    if (isq) {
                        u32x4 o; o.x = pk2(lo[0][0], lo[0][1]); o.y = pk2(lo[0][2], lo[0][3]); o.z = pk2(lo[1][0], lo[1][1]); o.w = pk2(lo[1][2], lo[1][3]);
                        *(u32x4*)(QR + (size_t)row * 1024 + h * 256 + cx) = o;
                        o.x = pk2(hi[0][0], hi[0][1]); o.y = pk2(hi[0][2], hi[0][3]); o.z = pk2(hi[1][0], hi[1][1]); o.w = pk2(hi[1][2], hi[1][3]);
                        *(u32x4*)(QR + (size_t)row * 1024 + h * 256 + 128 + cx) = o;
                        bf16_t* ac = ACAT + ((size_t)(b * 4 + h) * 256 + i) * 768 + 256 + cx;
#pragma unroll
                        for (int d = 0; d < 2; ++d) { const float f = d ? __expf((float)(256 - i) * lg1) : __expf((float)(i + 1) * lg0);
                            o.x = pk2(lo[0][0] * f, lo[0][1] * f); o.y = pk2(lo[0][2] * f, lo[0][3] * f); o.z = pk2(lo[1][0] * f, lo[1][1] * f); o.w = pk2(lo[1][2] * f, lo[1][3] * f);
                            *(u32x4*)(ac + d * 256) = o;
                            o.x = pk2(hi[0][0] * f, hi[0][1] * f); o.y = pk2(hi[0][2] * f, hi[0][3] * f); o.z = pk2(hi[1][0] * f, hi[1][1] * f); o.w = pk2(hi[1][2] * f, hi[1][3] * f);
                            *(u32x4*)(ac + d * 256 + 128) = o; }
                    } else {
                        const float f = 0.0625f;
                        u32x4 o; o.x = pk2(lo[0][0] * f, lo[0][1] * f); o.y = pk2(lo[0][2] * f, lo[0][3] * f); o.z = pk2(lo[1][0] * f, lo[1][1] * f); o.w = pk2(lo[1][2] * f, lo[1][3] * f);
                        *(u32x4*)(KR + (size_t)row * 1024 + h * 256 + cx) = o;
                        o.x = pk2(hi[0][0] * f, hi[0][1] * f); o.y = pk2(hi[0][2] * f, hi[0][3] * f); o.z = pk2(hi[1][0] * f, hi[1][1] * f); o.w = pk2(hi[1][2] * f, hi[1][3] * f);
                        *(u32x4*)(KR + (size_t)row * 1024 + h * 256 + 128 + cx) = o;
                    }
                }
        } else {
            const bool isv = pn < 16; bf16_t* O = isv ? V : SG; const int col0 = ((pn - 8) & 7) * 256 + cx;
#pragma unroll
            for (int ai = 0; ai < 2; ++ai)
#pragma unroll
                for (int m = 0; m < 4; ++m) { bf16_t* rp = O + (size_t)(row0 + ai * 128 + m * 16) * 2048 + col0;
#pragma unroll
                    for (int bj = 0; bj < 2; ++bj) { f32x4 v0 = acc[ai][bj][m][0], v1 = acc[ai][bj][m][1];
                        if (!isv) {
#pragma unroll
                            for (int e = 0; e < 4; ++e) { v0[e] = siluf_(v0[e]); v1[e] = siluf_(v1[e]); } }
                        u32x4 o; o.x = pk2(v0[0], v0[1]); o.y = pk2(v0[2], v0[3]); o.z = pk2(v1[0], v1[1]); o.w = pk2(v1[2], v1[3]);
                        *(u32x4*)(rp + bj * 128) = o; } }
        }
    }
};
__device__ __forceinline__ void ret_in_gemm_phase(Frame& F, const Args& a) {
    gg::DenseSched S; S.init((const bf16_t*)(a.ws + WS_U), (const bf16_t*)(a.ws + WS_W_RET_IN), NTOK, 6144, 1024, 1024);
    EpiRetIn E{(bf16_t*)(a.ws + RT_QR), (bf16_t*)(a.ws + RT_KR), (bf16_t*)(a.ws + RT_V), (bf16_t*)(a.ws + RT_SG), (bf16_t*)(a.ws + RT_ACAT), (const float*)(a.ws + WS_ROPE), a.in[32]};
    gg::gemm_phase<EpiRetIn, gg::DenseSched, false, false>(F.lds + LDS_STAGE, gg::Dims{1024, 1024, 1024, 0, 0}, S, E);
}
__device__ __forceinline__ void tr64_bf16(const bf16_t* src, int ld_src, bf16_t* dst, int ld_dst, LAS unsigned char* scr, int lane, float lgam, int mode, int t0) {
    const int cg = lane & 7, rg = lane >> 3;
#pragma unroll
    for (int k = 0; k < 8; ++k) { const int t = rg + 8 * k; const u32x4 v = *(const u32x4*)(src + (size_t)t * ld_src + 8 * cg);
        float f = 1.0f; if (mode) { const int i = (t0 + t) & 255; f = __expf((float)(mode == 1 ? 255 - i : i) * lgam); }
        const unsigned w[4] = {v.x, v.y, v.z, v.w};
#pragma unroll
        for (int e = 0; e < 4; ++e) { *(LAS unsigned short*)(scr + (8 * cg + 2 * e) * 144 + t * 2) = (unsigned short)f2bf(bflo(w[e]) * f); *(LAS unsigned short*)(scr + (8 * cg + 2 * e + 1) * 144 + t * 2) = (unsigned short)f2bf(bfhi(w[e]) * f); } }
    asm volatile("s_waitcnt lgkmcnt(0)" ::: "memory");
#pragma unroll
    for (int k = 0; k < 8; ++k) { const int c = rg + 8 * k; const u32x4 v = *(const LAS u32x4*)(scr + c * 144 + 16 * cg); *(u32x4*)(dst + (size_t)c * ld_dst + 8 * cg) = v; }
    asm volatile("s_waitcnt lgkmcnt(0)" ::: "memory");
}
__device__ __forceinline__ void ret_transpose_phase(Frame& F, const Args& a) {
    const bf16_t* KR = (const bf16_t*)(a.ws + RT_KR); const bf16_t* V = (const bf16_t*)(a.ws + RT_V); bf16_t* KTD = (bf16_t*)(a.ws + RT_KTD); bf16_t* VT = (bf16_t*)(a.ws + RT_VT);
    LAS unsigned char* scr = F.lds + LDS_STAGE + F.wave * 9216;
    const float* decay = a.in[32];
    constexpr int NT = NTOK / 64;
    for (int it = F.gw; it < NT * (32 + 32); it += F.ngw) {
        const int tt = it % NT, cc = it / NT, t0 = tt * 64;
        if (cc < 32) { const int d = cc >> 4, c0 = (cc & 15) * 64, h = c0 >> 8; const float lg = log_sigmoid(decay[d * 4 + h]);
            tr64_bf16(KR + (size_t)t0 * 1024 + c0, 1024, KTD + ((size_t)d * 1024 + c0) * NTOK + t0, NTOK, scr, F.lane, lg, d ? 2 : 1, t0); }
        else { const int c0 = (cc - 32) * 64; tr64_bf16(V + (size_t)t0 * 2048 + c0, 2048, VT + (size_t)c0 * NTOK + t0, NTOK, scr, F.lane, 0.f, 0, t0); }
    }
}
struct RetKvSched {
    const char* VT; const char* KTD; int G, c;
    __device__ __forceinline__ bool next(int i, gg::Unit& u) const {
        const int L0 = i * G + c; if (L0 >= NBLK * 16) return false; const int L = xcd_remap(L0, NBLK * 16);
        const int dvt = L & 1, d = (L >> 1) & 1, h = (L >> 2) & 3, b = L >> 4;
        u.a = VT + ((size_t)(512 * h + 256 * dvt) * NTOK + 256 * b) * 2; u.b = KTD + ((size_t)(d * 1024 + 256 * h) * NTOK + 256 * b) * 2; u.b2 = nullptr;
        u.pm = 0; u.pn = 0; u.gofs = 0; u.x = ((b * 4 + h) * 512 + 256 * dvt) * 512 + 256 * d; return true; }
};
__device__ __forceinline__ void ret_kv_phase(Frame& F, const Args& a) {
    RetKvSched S{(const char*)(a.ws + RT_VT), (const char*)(a.ws + RT_KTD), (int)gridDim.x, (int)blockIdx.x};
    EpiBf16X E{(bf16_t*)(a.ws + RT_ST), 512};
    gg::gemm_phase<EpiBf16X, RetKvSched, false, false>(F.lds + LDS_STAGE, gg::Dims{256, NTOK, NTOK, 0, 0}, S, E);
}
template <bool DRY = false>
__device__ __forceinline__ void ret_prefix_phase(Frame& F, const Args& a) {
    bf16_t* ST = (bf16_t*)(a.ws + (DRY ? WS_DUMMY : RT_ST)); const float* decay = a.in[32];
    for (int gid = blockIdx.x * NTHREADS + F.tid; gid < 4 * 512 * 2 * 32; gid += gridDim.x * NTHREADS) {
        const int dk8 = gid & 31, d = (gid >> 5) & 1, dv = (gid >> 6) & 511, h = gid >> 15;
        const float gb = __expf(256.0f * log_sigmoid(decay[d * 4 + h]));
        float s[8];
#pragma unroll
        for (int e = 0; e < 8; ++e) s[e] = 0.f;
#define RT_BLK(st_) (((d == 0) || (st_) == 0) ? (st_) : (NBLK - (st_)))
#define RT_PTR(st_) ((u32x4*)(ST + ((size_t)(RT_BLK(st_) * 4 + h) * 512 + dv) * 512 + d * 256 + 8 * dk8))
        u32x4 kb[4];
#pragma unroll
        for (int j = 0; j < 4; ++j) kb[j] = *RT_PTR(j);
#pragma unroll 1
        for (int base = 0; base < 68; base += 4) {
#pragma unroll
            for (int j = 0; j < 4; ++j) { const int step = base + j; if (step < NBLK) {
                u32x4* p = RT_PTR(step); const u32x4 kv = kb[j];
                if (step + 4 < NBLK) kb[j] = *RT_PTR(step + 4);
                u32x4 o; o.x = pk2(s[0], s[1]); o.y = pk2(s[2], s[3]); o.z = pk2(s[4], s[5]); o.w = pk2(s[6], s[7]); *p = o;
                s[0] = s[0] * gb + bflo(kv.x); s[1] = s[1] * gb + bfhi(kv.x); s[2] = s[2] * gb + bflo(kv.y); s[3] = s[3] * gb + bfhi(kv.y);
                s[4] = s[4] * gb + bflo(kv.z); s[5] = s[5] * gb + bfhi(kv.z); s[6] = s[6] * gb + bflo(kv.w); s[7] = s[7] * gb + bfhi(kv.w); } }
        }
#undef RT_BLK
#undef RT_PTR
    }
    bf16_t* ACAT = (bf16_t*)(a.ws + (DRY ? WS_DUMMY + 140 * MiB : RT_ACAT));
    for (int gid = blockIdx.x * NTHREADS + F.tid; gid < NBLK * 4 * 256 * 32; gid += gridDim.x * NTHREADS) {
        const int j0 = (gid & 31) * 8, i = (gid >> 5) & 255, bh = gid >> 13, h = bh & 3;
        const float lg0 = log_sigmoid(decay[h]), lg1 = log_sigmoid(decay[4 + h]);
        u32x4* p = (u32x4*)(ACAT + ((size_t)bh * 256 + i) * 768 + j0);
        const u32x4 v = *p; const unsigned w[4] = {v.x, v.y, v.z, v.w}; unsigned o[4];
#pragma unroll
        for (int e = 0; e < 4; ++e) { const int ja = j0 + 2 * e, jb = ja + 1;
            const float wa = ((i >= ja) ? __expf((float)(i - ja) * lg0) : 0.f) + ((ja >= i) ? __expf((float)(ja - i) * lg1) : 0.f);
            const float wb = ((i >= jb) ? __expf((float)(i - jb) * lg0) : 0.f) + ((jb >= i) ? __expf((float)(jb - i) * lg1) : 0.f);
            o[e] = pk2(bflo(w[e]) * wa, bfhi(w[e]) * wb); }
        *p = (u32x4){o[0], o[1], o[2], o[3]};
    }
}
struct RetPSched {
    const char* QR; const char* KR; int G, c;
    __device__ __forceinline__ bool next(int i, gg::Unit& u) const {
        const int L0 = i * G + c; if (L0 >= NBLK * 4) return false; const int L = xcd_remap(L0, NBLK * 4);
        const int h = L & 3, b = L >> 2;
        u.a = QR + ((size_t)256 * b * 1024 + 256 * h) * 2; u.b = KR + ((size_t)256 * b * 1024 + 256 * h) * 2; u.b2 = nullptr;
        u.pm = b; u.pn = h; u.gofs = 0; u.x = (b * 4 + h) * 256 * 768; return true; }
};
__device__ __forceinline__ void ret_p_phase(Frame& F, const Args& a) {
    RetPSched S{(const char*)(a.ws + RT_QR), (const char*)(a.ws + RT_KR), (int)gridDim.x, (int)blockIdx.x};
    EpiBf16X E{(bf16_t*)(a.ws + RT_ACAT), 768};
    gg::gemm_phase<EpiBf16X, RetPSched, false, false>(F.lds + LDS_STAGE, gg::Dims{256, 1024, 1024, 0, 0}, S, E);
}
struct RetOSched {
    const char* ACAT; const char* VT; const char* ST; int G, c;
    __device__ __forceinline__ bool next(int i, gg::Unit& u) const {
        const int L0 = i * G + c; if (L0 >= NBLK * 8) return false; const int L = xcd_remap(L0, NBLK * 8);
        const int dvt = L & 1, h = (L >> 1) & 3, b = L >> 3;
        u.a = ACAT + (size_t)(b * 4 + h) * 256 * 768 * 2; u.b = VT + ((size_t)(512 * h + 256 * dvt) * NTOK + 256 * b) * 2; u.b2 = ST + ((size_t)((b * 4 + h) * 512 + 256 * dvt) * 512) * 2;
        u.pm = 0; u.pn = 0; u.gofs = 0; u.x = 256 * b * 2048 + 512 * h + 256 * dvt; return true; }
};
__device__ __forceinline__ void ret_o_phase(Frame& F, const Args& a) {
    RetOSched S{(const char*)(a.ws + RT_ACAT), (const char*)(a.ws + RT_VT), (const char*)(a.ws + RT_ST), (int)gridDim.x, (int)blockIdx.x};
    EpiBf16X E{(bf16_t*)(a.ws + RT_O), 2048};
    gg::gemm_phase<EpiBf16X, RetOSched, false, true>(F.lds + LDS_STAGE, gg::Dims{768, 768, NTOK, 4, 512}, S, E);
}
__device__ __forceinline__ void ret_readout_phase(Frame& F, const Args& a) {
    const bf16_t* O = (const bf16_t*)(a.ws + RT_O); const bf16_t* SG = (const bf16_t*)(a.ws + RT_SG); bf16_t* A3 = (bf16_t*)(a.ws + RT_A3);
    const float* gg_ = a.in[33]; const float* gb_ = a.in[34];
    const int lane = F.lane;
    for (int t = F.gw; t < NTOK; t += F.ngw) {
        float v[32]; float s = 0.f;
#pragma unroll
        for (int k = 0; k < 4; ++k) { const u32x4 w = *(const u32x4*)(O + (size_t)t * 2048 + 32 * lane + 8 * k);
            v[8 * k] = bflo(w.x); v[8 * k + 1] = bfhi(w.x); v[8 * k + 2] = bflo(w.y); v[8 * k + 3] = bfhi(w.y); v[8 * k + 4] = bflo(w.z); v[8 * k + 5] = bfhi(w.z); v[8 * k + 6] = bflo(w.w); v[8 * k + 7] = bfhi(w.w); }
#pragma unroll
        for (int e = 0; e < 32; ++e) s += v[e];
#pragma unroll
        for (int o = 1; o < 16; o <<= 1) s += __shfl_xor(s, o);
        const float mean = s * (1.0f / 512.0f); float q = 0.f;
#pragma unroll
        for (int e = 0; e < 32; ++e) { v[e] -= mean; q += v[e] * v[e]; }
#pragma unroll
        for (int o = 1; o < 16; o <<= 1) q += __shfl_xor(q, o);
        const float rstd = 1.0f / sqrtf(q * (1.0f / 512.0f) + LN_EPS);
#pragma unroll
        for (int k = 0; k < 4; ++k) { const u32x4 g = *(const u32x4*)(SG + (size_t)t * 2048 + 32 * lane + 8 * k); const unsigned gw[4] = {g.x, g.y, g.z, g.w}; unsigned ow[4];
#pragma unroll
            for (int e = 0; e < 4; ++e) { const int c = 32 * lane + 8 * k + 2 * e;
                const float y0 = (v[8 * k + 2 * e] * rstd * gg_[c] + gb_[c]) * bflo(gw[e]), y1 = (v[8 * k + 2 * e + 1] * rstd * gg_[c + 1] + gb_[c + 1]) * bfhi(gw[e]); ow[e] = pk2(y0, y1); }
            *(u32x4*)(A3 + (size_t)t * 2048 + 32 * lane + 8 * k) = (u32x4){ow[0], ow[1], ow[2], ow[3]}; }
    }
}

constexpr size_t HG_Q = WS_SCR, HG_F = WS_SCR + 33 * MiB, HG_V = WS_SCR + 99 * MiB, HG_G = WS_SCR + 132 * MiB, HG_O = WS_SCR + 165 * MiB, HG_S = WS_SCR + 231 * MiB, HG_D = WS_SCR + 297 * MiB, HG_A4 = HG_Q;
struct EpiHgrnIn {
    static constexpr bool PERM = true;
    bf16_t *Q, *Fp, *V, *G;
    __device__ __forceinline__ void operator()(const gg::Acc& acc, const gg::Unit& u, int wr, int wc, int fr, int fq) const {
        const int grp = u.pn >> 2; const bool act = (grp == 0 || grp == 4);
        bf16_t* O = grp == 0 ? Q : grp == 1 ? Fp : grp == 2 ? Fp + (size_t)NTOK * 1024 : grp == 3 ? V : G;
        const int row0 = u.pm * 256 + wr * 64 + fr, col0 = (u.pn & 3) * 256 + wc * 32 + 8 * fq;
#pragma unroll
        for (int ai = 0; ai < 2; ++ai)
#pragma unroll
            for (int m = 0; m < 4; ++m) { bf16_t* rp = O + (size_t)(row0 + ai * 128 + m * 16) * 1024 + col0;
#pragma unroll
                for (int bj = 0; bj < 2; ++bj) { f32x4 v0 = acc[ai][bj][m][0], v1 = acc[ai][bj][m][1];
                    if (act) {
#pragma unroll
                        for (int e = 0; e < 4; ++e) { v0[e] = siluf_(v0[e]); v1[e] = siluf_(v1[e]); } }
                    u32x4 o; o.x = pk2(v0[0], v0[1]); o.y = pk2(v0[2], v0[3]); o.z = pk2(v1[0], v1[1]); o.w = pk2(v1[2], v1[3]);
                    *(u32x4*)(rp + bj * 128) = o; } }
    }
};
__device__ __forceinline__ void hgrn_in_gemm_phase(Frame& F, const Args& a) {
    gg::DenseSched S; S.init((const bf16_t*)(a.ws + WS_U), (const bf16_t*)(a.ws + WS_W_HGRN_IN), NTOK, 5120, 1024, 1024);
    EpiHgrnIn E{(bf16_t*)(a.ws + HG_Q), (bf16_t*)(a.ws + HG_F), (bf16_t*)(a.ws + HG_V), (bf16_t*)(a.ws + HG_G)};
    gg::gemm_phase<EpiHgrnIn, gg::DenseSched, false, false>(F.lds + LDS_STAGE, gg::Dims{1024, 1024, 1024, 0, 0}, S, E);
}
typedef short v4s16 __attribute__((ext_vector_type(4)));
__device__ __forceinline__ bf16x8 lds_tr_frag(LAS unsigned char* tile, int stride, int r0, int c0, int lane) {
    const int g = lane >> 4, qq = (lane & 15) >> 2, p = lane & 3;
    LAS unsigned char* a0 = tile + (r0 + 8 * g + qq) * stride + (c0 + 4 * p) * 2;
    const v4s16 x = __builtin_amdgcn_ds_read_tr16_b64_v4i16((LAS v4s16*)a0), y = __builtin_amdgcn_ds_read_tr16_b64_v4i16((LAS v4s16*)(a0 + 4 * stride));
    return (bf16x8){x[0], x[1], x[2], x[3], y[0], y[1], y[2], y[3]};
}
__device__ __forceinline__ bf16x8 lds_row_frag(LAS unsigned char* tile, int stride, int row, int k0) { return *(const LAS bf16x8*)(tile + row * stride + k0 * 2); }
constexpr int HS = 272, HPS = 144;
template <int PASS>
__device__ __forceinline__ void hgrn_chunk_phase(Frame& F, const Args& a) {
    const bf16_t* Qb = (const bf16_t*)(a.ws + HG_Q); const bf16_t* Fb = (const bf16_t*)(a.ws + HG_F); const bf16_t* Vb = (const bf16_t*)(a.ws + HG_V);
    bf16_t* Ob = (bf16_t*)(a.ws + HG_O); float* Sb = (float*)(a.ws + HG_S); float* Db = (float*)(a.ws + HG_D);
    const float* LBV = (const float*)(a.ws + WS_LBV); const float* bfp = a.in[37];
    LAS unsigned char* QH = F.lds + LDS_STAGE; LAS unsigned char* KH = QH + 17408; LAS unsigned char* KB = QH + 34816; LAS unsigned char* VV = QH + 52224;
    LAS unsigned char* PP = QH + 69632; LAS unsigned char* SS = QH + 78848; LAS float* DEC = (LAS float*)(QH + 113664); LAS float* TOT = (LAS float*)(QH + 114176);
    const int tid = F.tid, lane = F.lane, w = F.wave, k = tid & 127, tg = tid >> 7, c16 = lane & 15, q4 = lane >> 4;
    const int lrow = tid >> 3, c8 = tid & 7;
    u32x4 rF[2], rV[2], rQ[2];
#define HG_ISSUE(unit_, bi_) do { const int d_ = (unit_) & 1, h_ = ((unit_) >> 1) & 7, seg_ = (unit_) >> 4; const int tr_ = (seg_ * 4 + (d_ ? 3 - (bi_) : (bi_))) * 64; \
        const size_t o_ = (size_t)(tr_ + (d_ ? 63 - lrow : lrow)) * 1024 + h_ * 128 + 8 * c8; const bf16_t* Fd_ = Fb + (size_t)d_ * NTOK * 1024; \
        rF[0] = *(const u32x4*)(Fd_ + o_); rF[1] = *(const u32x4*)(Fd_ + o_ + 64); rV[0] = *(const u32x4*)(Vb + o_); rV[1] = *(const u32x4*)(Vb + o_ + 64); \
        if (PASS) { rQ[0] = *(const u32x4*)(Qb + o_); rQ[1] = *(const u32x4*)(Qb + o_ + 64); } } while (0)
    if ((int)blockIdx.x < 65 * 16) HG_ISSUE((int)blockIdx.x, 0);
#pragma unroll 1
    for (int unit = blockIdx.x; unit < 65 * 16; unit += gridDim.x) {
        const int d = unit & 1, h = (unit >> 1) & 7, seg = unit >> 4, ch = h * 128 + k;
        const float lbv = LBV[ch], bfv = bfp[d * 1024 + ch];
        const bf16_t* Fd = Fb + (size_t)d * NTOK * 1024;
        f32x4 accS[8]; float dseg = 1.0f;
        float* Su = Sb + (size_t)unit * 16384;
#pragma unroll
        for (int kt = 0; kt < 8; ++kt)
#pragma unroll
            for (int r = 0; r < 4; ++r) accS[kt][r] = PASS ? Su[(16 * kt + 4 * q4 + r) * 128 + 16 * w + c16] : 0.f;
        if (PASS) {
#pragma unroll
            for (int kt = 0; kt < 8; ++kt)
#pragma unroll
                for (int r = 0; r < 4; ++r) *(LAS unsigned short*)(SS + (16 * kt + 4 * q4 + r) * HS + (16 * w + c16) * 2) = (unsigned short)f2bf(accS[kt][r]);
        }
#pragma unroll 1
        for (int bi = 0; bi < 4; ++bi) {
            const int trow0 = (seg * 4 + (d ? 3 - bi : bi)) * 64;
            { const int lo_ = lrow * HS + 16 * c8;
              *(LAS u32x4*)(KB + lo_) = rF[0]; *(LAS u32x4*)(KB + lo_ + 128) = rF[1]; *(LAS u32x4*)(VV + lo_) = rV[0]; *(LAS u32x4*)(VV + lo_ + 128) = rV[1];
              if (PASS) { *(LAS u32x4*)(QH + lo_) = rQ[0]; *(LAS u32x4*)(QH + lo_ + 128) = rQ[1]; } }
            { const int nu = bi < 3 ? unit : unit + (int)gridDim.x, nb = bi < 3 ? bi + 1 : 0; if (nu < 65 * 16) HG_ISSUE(nu, nb); }
            __syncthreads();
            float lfc[16]; float run = 0.f;
#pragma unroll
            for (int ii = 0; ii < 16; ++ii) { const int i = tg * 16 + ii;
                const float fp = bf2f(*(const LAS unsigned short*)(KB + i * HS + k * 2)); const float f = lbv + (1.0f - lbv) * sigmoidf_(fp + bfv);
                run += __logf(f); lfc[ii] = run; }
            TOT[tg * 128 + k] = run;
            __syncthreads();
            float off = 0.f, btot = 0.f;
#pragma unroll
            for (int g2 = 0; g2 < 4; ++g2) { const float tv = TOT[g2 * 128 + k]; btot += tv; if (g2 < tg) off += tv; }
#pragma unroll
            for (int ii = 0; ii < 16; ++ii) { const int i = tg * 16 + ii; const float B = off + lfc[ii];
                const float lf = lfc[ii] - (ii ? lfc[ii - 1] : 0.f); const float kkv = 1.0f - __expf(lf);
                *(LAS unsigned short*)(KB + i * HS + k * 2) = (unsigned short)f2bf(kkv * __expf(btot - B));
                if (PASS) { const float qv = bf2f(*(const LAS unsigned short*)(QH + i * HS + k * 2));
                            *(LAS unsigned short*)(QH + i * HS + k * 2) = (unsigned short)f2bf(qv * __expf(B));
                            *(LAS unsigned short*)(KH + i * HS + k * 2) = (unsigned short)f2bf(kkv * __expf(fminf(-B, 80.0f))); }
                if ((ii & 3) == 3) asm volatile("" ::: "memory"); }
            if (tg == 0) { const float e = __expf(btot); DEC[k] = e; dseg *= e; }
            __syncthreads();
            f32x4 ao[4];
            if (PASS) {
#pragma unroll
                for (int s2 = 0; s2 < 2; ++s2) { const int it = w >> 1, jt = 2 * (w & 1) + s2; f32x4 sc = {0.f, 0.f, 0.f, 0.f};
#pragma unroll
                    for (int ks = 0; ks < 4; ++ks) sc = __builtin_amdgcn_mfma_f32_16x16x32_bf16(lds_row_frag(QH, HS, 16 * it + c16, 32 * ks + 8 * q4), lds_row_frag(KH, HS, 16 * jt + c16, 32 * ks + 8 * q4), sc, 0, 0, 0);
#pragma unroll
                    for (int r = 0; r < 4; ++r) { const int i = 16 * it + 4 * q4 + r, j = 16 * jt + c16; *(LAS unsigned short*)(PP + i * HPS + j * 2) = (unsigned short)f2bf(j <= i ? sc[r] : 0.f); } }
                __syncthreads();
#pragma unroll
                for (int it = 0; it < 4; ++it) ao[it] = (f32x4){0.f, 0.f, 0.f, 0.f};
            }
            bf16x8 vf[2];
#pragma unroll
            for (int ks = 0; ks < 2; ++ks) vf[ks] = lds_tr_frag(VV, HS, 32 * ks, 16 * w, lane);
            if (PASS) {
#pragma unroll
                for (int ks = 0; ks < 2; ++ks)
#pragma unroll
                    for (int it = 0; it < 4; ++it) ao[it] = __builtin_amdgcn_mfma_f32_16x16x32_bf16(lds_row_frag(PP, HPS, 16 * it + c16, 32 * ks + 8 * q4), vf[ks], ao[it], 0, 0, 0);
#pragma unroll 1
                for (int ks = 0; ks < 4; ++ks) { const bf16x8 sf = lds_tr_frag(SS, HS, 32 * ks, 16 * w, lane);
#pragma unroll
                    for (int it = 0; it < 4; ++it) ao[it] = __builtin_amdgcn_mfma_f32_16x16x32_bf16(lds_row_frag(QH, HS, 16 * it + c16, 32 * ks + 8 * q4), sf, ao[it], 0, 0, 0); }
            }
#pragma unroll
            for (int kt = 0; kt < 8; ++kt) {
#pragma unroll
                for (int r = 0; r < 4; ++r) accS[kt][r] *= DEC[16 * kt + 4 * q4 + r];
#pragma unroll
                for (int ks = 0; ks < 2; ++ks) accS[kt] = __builtin_amdgcn_mfma_f32_16x16x32_bf16(lds_tr_frag(KB, HS, 32 * ks, 16 * kt, lane), vf[ks], accS[kt], 0, 0, 0);
            }
            __syncthreads();
            if (PASS) {
#pragma unroll
                for (int kt = 0; kt < 8; ++kt)
#pragma unroll
                    for (int r = 0; r < 4; ++r) *(LAS unsigned short*)(SS + (16 * kt + 4 * q4 + r) * HS + (16 * w + c16) * 2) = (unsigned short)f2bf(accS[kt][r]);
#pragma unroll
                for (int it = 0; it < 4; ++it)
#pragma unroll
                    for (int r = 0; r < 4; ++r) *(LAS unsigned short*)(KH + (16 * it + 4 * q4 + r) * HS + (16 * w + c16) * 2) = (unsigned short)f2bf(ao[it][r]);
                __syncthreads();
                bf16_t* Od = Ob + (size_t)d * NTOK * 1024;
#pragma unroll
                for (int cc = 0; cc < 2; ++cc) { const int row = tid >> 3, chunk = (tid & 7) + 8 * cc, t = trow0 + (d ? 63 - row : row);
                    *(u32x4*)(Od + (size_t)t * 1024 + h * 128 + 8 * chunk) = *(const LAS u32x4*)(KH + row * HS + 16 * chunk); }
            }
        }
        if (!PASS) {
#pragma unroll
            for (int kt = 0; kt < 8; ++kt)
#pragma unroll
                for (int r = 0; r < 4; ++r) Su[(16 * kt + 4 * q4 + r) * 128 + 16 * w + c16] = accS[kt][r];
            if (tg == 0) Db[(size_t)unit * 128 + k] = dseg;
        }
        __syncthreads();
    }
}
#undef HG_ISSUE
template <bool DRY = false>
__device__ __forceinline__ void hgrn_prefix_phase(Frame& F, const Args& a) {
    float* Sb = (float*)(a.ws + (DRY ? WS_DUMMY : HG_S)); const float* Db = (const float*)(a.ws + HG_D);
    for (int gid = blockIdx.x * NTHREADS + F.tid; gid < 16 * 4096; gid += gridDim.x * NTHREADS) {
        const int hd = gid >> 12, e4 = gid & 4095, krow = e4 >> 5, d = hd & 1;
        f32x4 s = {0.f, 0.f, 0.f, 0.f};
#define HG_SEG(st_) (((d == 0) || (st_) == 0) ? (st_) : 65 - (st_))
        f32x4 lb[4]; float db[4];
#pragma unroll
        for (int j = 0; j < 4; ++j) { const int u2 = HG_SEG(j) * 16 + hd; lb[j] = *((const f32x4*)(Sb + (size_t)u2 * 16384) + e4); db[j] = Db[(size_t)u2 * 128 + krow]; }
#pragma unroll 1
        for (int base = 0; base < 68; base += 4) {
#pragma unroll
            for (int j = 0; j < 4; ++j) { const int step = base + j; if (step < 65) {
                const int unit = HG_SEG(step) * 16 + hd; f32x4* p = (f32x4*)(Sb + (size_t)unit * 16384) + e4; const f32x4 loc = lb[j]; const float dec = db[j];
                if (step + 4 < 65) { const int u2 = HG_SEG(step + 4) * 16 + hd; lb[j] = *((const f32x4*)(Sb + (size_t)u2 * 16384) + e4); db[j] = Db[(size_t)u2 * 128 + krow]; }
                *p = s; s = s * dec + loc; } }
        }
#undef HG_SEG
    }
}
__device__ __forceinline__ void hgrn_readout_phase(Frame& F, const Args& a) {
    const bf16_t* O0 = (const bf16_t*)(a.ws + HG_O); const bf16_t* O1 = O0 + (size_t)NTOK * 1024; const bf16_t* G = (const bf16_t*)(a.ws + HG_G); bf16_t* A4 = (bf16_t*)(a.ws + HG_A4);
    const float* ng = a.in[39]; const int lane = F.lane;
    float gn[8];
#pragma unroll
    for (int e = 0; e < 8; ++e) gn[e] = ng[(8 * lane + e) & 127];
    for (int t = F.gw; t < NTOK; t += F.ngw) {
        float o[16], g[16]; ldrow_bf16(O0 + (size_t)t * 1024, lane, o); addrow_bf16(O1 + (size_t)t * 1024, lane, o); ldrow_bf16(G + (size_t)t * 1024, lane, g);
#pragma unroll
        for (int j = 0; j < 2; ++j) { float q = 0.f;
#pragma unroll
            for (int e = 0; e < 8; ++e) q += o[8 * j + e] * o[8 * j + e];
#pragma unroll
            for (int m = 1; m < 16; m <<= 1) q += __shfl_xor(q, m);
            const float rs = 1.0f / sqrtf(q * (1.0f / 128.0f) + LN_EPS);
#pragma unroll
            for (int e = 0; e < 8; ++e) o[8 * j + e] = o[8 * j + e] * rs * gn[e] * g[8 * j + e]; }
        strow_bf16(A4 + (size_t)t * 1024, lane, o);
    }
}

constexpr size_t RW_XM = WS_SCR, RW_WW = WS_SCR, RW_AA = WS_SCR + 131 * MiB, RW_R = WS_SCR + 196 * MiB, RW_K = WS_SCR + 229 * MiB, RW_V = WS_SCR + 262 * MiB, RW_L1 = WS_SCR + 295 * MiB,
                 RW_G = WS_SCR + 321 * MiB, RW_REC = WS_SCR + 354 * MiB, RW_PQ = WS_SCR + (RWKV_CHUNKED ? 354 : 0) * MiB, RW_SST = WS_SCR + (RWKV_CHUNKED ? 420 : 64) * MiB, RW_O = WS_SCR + 745 * MiB, RW_A5 = WS_SCR, RW_Y = WS_SCR + 812 * MiB, RW_END = WS_SCR + 880 * MiB;
constexpr int RECB = 768;
typedef _Float16 h2_t __attribute__((ext_vector_type(2)));
typedef _Float16 h8_t __attribute__((ext_vector_type(8)));
__device__ __forceinline__ void rwkv_xm_phase(Frame& F, const Args& a) {
    const bf16_t* U = (const bf16_t*)(a.ws + WS_U); bf16_t* XM = (bf16_t*)(a.ws + RW_XM); const float* mu = a.in[15];
    for (int t = F.gw; t < NTOK; t += F.ngw) {
        float u[16], sh[16]; ldrow_bf16(U + (size_t)t * D, F.lane, u);
        const bool hasp = (t != 0 && t != NCTX), hasn = (t != NCTX - 1 && t != NTOK - 1);
        { u32x4 pv = {0u, 0u, 0u, 0u}, nv = {0u, 0u, 0u, 0u};
          if (hasp) pv = *(const u32x4*)(U + (size_t)(t - 1) * D + 8 * F.lane);
          if (hasn) nv = *(const u32x4*)(U + (size_t)(t + 1) * D + 512 + 8 * F.lane);
          sh[0] = bflo(pv.x); sh[1] = bfhi(pv.x); sh[2] = bflo(pv.y); sh[3] = bfhi(pv.y); sh[4] = bflo(pv.z); sh[5] = bfhi(pv.z); sh[6] = bflo(pv.w); sh[7] = bfhi(pv.w);
          sh[8] = bflo(nv.x); sh[9] = bfhi(nv.x); sh[10] = bflo(nv.y); sh[11] = bfhi(nv.y); sh[12] = bflo(nv.z); sh[13] = bfhi(nv.z); sh[14] = bflo(nv.w); sh[15] = bfhi(nv.w); }
#pragma unroll 1
        for (int c = 0; c < 6; ++c) { float m[16], o[16]; ldrow_f32(mu + c * D, F.lane, m);
#pragma unroll
            for (int e = 0; e < 16; ++e) o[e] = u[e] + (sh[e] - u[e]) * m[e];
            strow_bf16(XM + ((size_t)c * NTOK + t) * D, F.lane, o); }
    }
}
struct RwkvInSched {
    const char* XM; const char* Win; const char* Wl1; int G, c;
    __device__ __forceinline__ bool next(int i, gg::Unit& u) const {
        const int L0 = i * G + c; if (L0 >= 975) return false; const int L = xcd_remap(L0, 975);
        int g, pm, pn;
        if (L < 780) { g = L / 260; const int r = L % 260; pm = r >> 2; pn = r & 3; u.b = Win + ((size_t)g * 1024 + pn * 256) * 2048; }
        else { const int r = L - 780; g = 3 + r / 65; pm = r % 65; pn = 0; u.b = Wl1 + (size_t)(g - 3) * 256 * 2048; }
        u.a = XM + ((size_t)g * NTOK + pm * 256) * 2048; u.b2 = nullptr; u.pm = pm; u.pn = pn; u.gofs = 0; u.x = g; return true; }
};
struct EpiRwkvIn {
    static constexpr bool PERM = true;
    bf16_t* RKV; bf16_t* L1;
    __device__ __forceinline__ void operator()(const gg::Acc& acc, const gg::Unit& u, int wr, int wc, int fr, int fq) const {
        const int g = u.x; const bool lora = g >= 3;
        bf16_t* O = lora ? L1 + (size_t)(g - 3) * NTOK * 256 : RKV + (size_t)g * (33 * MiB / 2); const int ldc = lora ? 256 : 1024;
        const int row0 = u.pm * 256 + wr * 64 + fr, col0 = u.pn * 256 + wc * 32 + 8 * fq;
#pragma unroll
        for (int ai = 0; ai < 2; ++ai)
#pragma unroll
            for (int m = 0; m < 4; ++m) { bf16_t* rp = O + (size_t)(row0 + ai * 128 + m * 16) * ldc + col0;
#pragma unroll
                for (int bj = 0; bj < 2; ++bj) { f32x4 v0 = acc[ai][bj][m][0], v1 = acc[ai][bj][m][1];
                    if (g == 3) {
#pragma unroll
                        for (int e = 0; e < 4; ++e) { v0[e] = 1.0f - 2.0f * __builtin_amdgcn_rcpf(1.0f + __expf(2.0f * v0[e])); v1[e] = 1.0f - 2.0f * __builtin_amdgcn_rcpf(1.0f + __expf(2.0f * v1[e])); } }
                    if (g == 5) {
#pragma unroll
                        for (int e = 0; e < 4; ++e) { v0[e] = sigmoidf_(v0[e]); v1[e] = sigmoidf_(v1[e]); } }
                    u32x4 o; o.x = pk2(v0[0], v0[1]); o.y = pk2(v0[2], v0[3]); o.z = pk2(v1[0], v1[1]); o.w = pk2(v1[2], v1[3]);
                    *(u32x4*)(rp + bj * 128) = o; } }
    }
};
__device__ __forceinline__ void rwkv_in_gemm_phase(Frame& F, const Args& a) {
    RwkvInSched S{(const char*)(a.ws + RW_XM), (const char*)(a.ws + WS_W_RWKV_IN), (const char*)(a.ws + WS_W_RWKV_L1), (int)gridDim.x, (int)blockIdx.x};
    EpiRwkvIn E{(bf16_t*)(a.ws + RW_R), (bf16_t*)(a.ws + RW_L1)};
    gg::gemm_phase<EpiRwkvIn, RwkvInSched, false, false>(F.lds + LDS_STAGE, gg::Dims{1024, 1024, 1024, 0, 0}, S, E);
}
struct RwkvL2Sched {
    const char* L1; const char* W2; int G, c;
    __device__ __forceinline__ bool next(int i, gg::Unit& u) const {
        const int L0 = i * G + c; if (L0 >= 1300) return false; const int L = xcd_remap(L0, 1300);
        const int g = L / 260, r = L % 260, pm = r >> 2, pn = r & 3, src = g >> 1;
        u.a = L1 + ((size_t)src * NTOK + pm * 256) * 512; u.b = W2 + ((size_t)g * 1024 + pn * 256) * 512; u.b2 = nullptr; u.pm = pm; u.pn = pn; u.gofs = 0; u.x = g; return true; }
};
struct EpiRwkvL2 {
    static constexpr bool PERM = true;
    float* WW; bf16_t* AA; bf16_t* GG;
    __device__ __forceinline__ void operator()(const gg::Acc& acc, const gg::Unit& u, int wr, int wc, int fr, int fq) const {
        const int g = u.x, z = g & 1; const int row0 = u.pm * 256 + wr * 64 + fr, col0 = u.pn * 256 + wc * 32 + 8 * fq;
        float* wbase = WW + (size_t)z * NTOK * 1024; bf16_t* obase = g < 4 ? AA + (size_t)z * NTOK * 1024 : GG;
#pragma unroll
        for (int ai = 0; ai < 2; ++ai)
#pragma unroll
            for (int m = 0; m < 4; ++m) { const size_t ro = (size_t)(row0 + ai * 128 + m * 16) * 1024 + col0;
#pragma unroll
                for (int bj = 0; bj < 2; ++bj) { const f32x4 v0 = acc[ai][bj][m][0], v1 = acc[ai][bj][m][1];
                    if (g < 2) { float* wp = wbase + ro + bj * 128; *(f32x4*)wp = v0; *(f32x4*)(wp + 4) = v1; }
                    else { u32x4 o; o.x = pk2(v0[0], v0[1]); o.y = pk2(v0[2], v0[3]); o.z = pk2(v1[0], v1[1]); o.w = pk2(v1[2], v1[3]); *(u32x4*)(obase + ro + bj * 128) = o; } } }
    }
};
__device__ __forceinline__ void rwkv_l2_gemm_phase(Frame& F, const Args& a) {
    RwkvL2Sched S{(const char*)(a.ws + RW_L1), (const char*)(a.ws + WS_W_RWKV_WL2), (int)gridDim.x, (int)blockIdx.x};
    EpiRwkvL2 E{(float*)(a.ws + RW_WW), (bf16_t*)(a.ws + RW_AA), (bf16_t*)(a.ws + RW_G)};
    gg::gemm_phase<EpiRwkvL2, RwkvL2Sched, false, false>(F.lds + LDS_STAGE, gg::Dims{256, 256, 256, 0, 0}, S, E);
}
__device__ __forceinline__ int rwkv_row(int z, int n) { return z == 0 ? n : (n < NCTX ? NCTX - 1 - n : NTOK - 1 + NCTX - n); }
__device__ __forceinline__ void rwkv_rec_phase(Frame& F, const Args& a) {
    const bf16_t* R = (const bf16_t*)(a.ws + RW_R); const bf16_t* K = (const bf16_t*)(a.ws + RW_K); const bf16_t* V = (const bf16_t*)(a.ws + RW_V);
    const float* WW = (const float*)(a.ws + RW_WW); const bf16_t* AA = (const bf16_t*)(a.ws + RW_AA); unsigned char* REC = a.ws + RW_REC;
    const int lane = F.lane;
    float kkw[16], kaw[16]; ldrow_f32(a.in[25], lane, kkw); ldrow_f32(a.in[26], lane, kaw);
#pragma unroll 1
    for (int t = F.gw; t < NTOK; t += F.ngw) {
        float k[16], r[16], v[16], kk[16];
        ldrow_bf16(K + (size_t)t * 1024, lane, k); ldrow_bf16(R + (size_t)t * 1024, lane, r); ldrow_bf16(V + (size_t)t * 1024, lane, v);
#pragma unroll
        for (int j = 0; j < 2; ++j) { float ss = 0.f;
#pragma unroll
            for (int e = 0; e < 8; ++e) { kk[8 * j + e] = k[8 * j + e] * kkw[8 * j + e]; ss += kk[8 * j + e] * kk[8 * j + e]; }
#pragma unroll
            for (int m = 1; m < 8; m <<= 1) ss += __shfl_xor(ss, m);
            const float rn = __builtin_amdgcn_rsqf(ss + 1e-12f);
#pragma unroll
            for (int e = 0; e < 8; ++e) kk[8 * j + e] *= rn; }
#pragma unroll
        for (int z = 0; z < 2; ++z) {
            float ap[16], wp[16], a0v[16], w0v[16];
            ldrow_bf16(AA + ((size_t)z * NTOK + t) * 1024, lane, ap); ldrow_f32(WW + ((size_t)z * NTOK + t) * 1024, lane, wp); ldrow_f32(a.in[20] + z * 1024, lane, a0v); ldrow_f32(a.in[17] + z * 1024, lane, w0v);
            const int n = (z == 0) ? t : (t < NCTX ? NCTX - 1 - t : NTOK - 1 + NCTX - t);
#pragma unroll
            for (int j = 0; j < 2; ++j) {
                const int col = 8 * lane + 512 * j, hh = col >> 6, cin = col & 63;
                h8_t ow, okk, ob, okt, orr, ov;
#pragma unroll
                for (int e = 0; e < 8; ++e) { const int x = 8 * j + e; const float av = sigmoidf_(a0v[x] + ap[x]), wv = __expf(-0.6065306597126334f * sigmoidf_(w0v[x] + wp[x]));
                    ow[e] = (_Float16)wv; okk[e] = (_Float16)kk[x]; ob[e] = (_Float16)(av * kk[x]); okt[e] = (_Float16)(k[x] * (1.0f + (av - 1.0f) * kaw[x])); orr[e] = (_Float16)r[x]; ov[e] = (_Float16)v[x]; }
                unsigned char* rec = REC + ((size_t)(z * 16 + hh) * NTOK + n) * RECB + cin * 2;
                *(h8_t*)(rec) = ow; *(h8_t*)(rec + 128) = okk; *(h8_t*)(rec + 256) = ob; *(h8_t*)(rec + 384) = okt; *(h8_t*)(rec + 512) = orr; *(h8_t*)(rec + 640) = ov;
            }
        }
    }
}
__device__ __forceinline__ float quad_sum(float x) {
    x += __builtin_bit_cast(float, __builtin_amdgcn_mov_dpp(__builtin_bit_cast(int, x), 0xB1, 0xF, 0xF, true));
    x += __builtin_bit_cast(float, __builtin_amdgcn_mov_dpp(__builtin_bit_cast(int, x), 0x4E, 0xF, 0xF, true));
    return x;
}
template <bool VTERM, bool OUT>
__device__ __forceinline__ void rwkv_scan_task(const unsigned char* rec, LAS unsigned char* buf, int lane, h2_t (&S)[4][8], bf16_t* Ozh, int z, int n0, int nck) {
    const int v_lo = lane >> 2, kq = lane & 3;
#define RW_DMA(ck_, bsel_) do { _Pragma("unroll") for (int m = 0; m < 6; ++m) \
        __builtin_amdgcn_global_load_lds((const unsigned*)(rec + (size_t)(ck_) * 8 * RECB + (size_t)(lane + 64 * m) * 16), (LAS unsigned*)(buf + (bsel_) * 6144 + m * 1024), 16, 0, 0); } while (0)
    RW_DMA(0, 0);
#pragma unroll 1
    for (int ck = 0; ck < nck; ++ck) {
        if (ck < nck - 1) { RW_DMA(ck + 1, (ck + 1) & 1); asm volatile("s_waitcnt vmcnt(6)" ::: "memory"); }
        else asm volatile("s_waitcnt vmcnt(0)" ::: "memory");
        const LAS unsigned char* cb = buf + (ck & 1) * 6144;
#pragma unroll 2
        for (int st = 0; st < 8; ++st) {
            const LAS unsigned char* b = cb + st * RECB + kq * 32;
            h2_t kk[8], wv[8], bv[8], kt[8], rv[8];
            { const h8_t x0 = *(const LAS h8_t*)(b + 128), x1 = *(const LAS h8_t*)(b + 128 + 16);
#pragma unroll
              for (int p2 = 0; p2 < 4; ++p2) { kk[p2] = (h2_t){x0[2 * p2], x0[2 * p2 + 1]}; kk[4 + p2] = (h2_t){x1[2 * p2], x1[2 * p2 + 1]}; } }
            float sa[4];
#pragma unroll
            for (int i = 0; i < 4; ++i) { float a0 = 0.f, a1 = 0.f;
#pragma unroll
                for (int p2 = 0; p2 < 8; p2 += 2) { a0 = __builtin_amdgcn_fdot2(S[i][p2], kk[p2], a0, false); a1 = __builtin_amdgcn_fdot2(S[i][p2 + 1], kk[p2 + 1], a1, false); }
                sa[i] = quad_sum(a0 + a1); }
            { const h8_t x0 = *(const LAS h8_t*)(b), x1 = *(const LAS h8_t*)(b + 16), y0 = *(const LAS h8_t*)(b + 256), y1 = *(const LAS h8_t*)(b + 256 + 16);
#pragma unroll
              for (int p2 = 0; p2 < 4; ++p2) { wv[p2] = (h2_t){x0[2 * p2], x0[2 * p2 + 1]}; wv[4 + p2] = (h2_t){x1[2 * p2], x1[2 * p2 + 1]}; bv[p2] = (h2_t){y0[2 * p2], y0[2 * p2 + 1]}; bv[4 + p2] = (h2_t){y1[2 * p2], y1[2 * p2 + 1]}; } }
            if (VTERM) { const h8_t x0 = *(const LAS h8_t*)(b + 384), x1 = *(const LAS h8_t*)(b + 384 + 16);
#pragma unroll
              for (int p2 = 0; p2 < 4; ++p2) { kt[p2] = (h2_t){x0[2 * p2], x0[2 * p2 + 1]}; kt[4 + p2] = (h2_t){x1[2 * p2], x1[2 * p2 + 1]}; } }
            if (OUT) { const h8_t x0 = *(const LAS h8_t*)(b + 512), x1 = *(const LAS h8_t*)(b + 512 + 16);
#pragma unroll
              for (int p2 = 0; p2 < 4; ++p2) { rv[p2] = (h2_t){x0[2 * p2], x0[2 * p2 + 1]}; rv[4 + p2] = (h2_t){x1[2 * p2], x1[2 * p2 + 1]}; } }
            float oi[4];
#pragma unroll
            for (int i = 0; i < 4; ++i) {
                const _Float16 nsa = (_Float16)(-sa[i]); const h2_t nsa2 = {nsa, nsa};
                h2_t vv2 = {(_Float16)0, (_Float16)0};
                if (VTERM) { const _Float16 vh = *(const LAS _Float16*)(cb + st * RECB + 640 + (16 * i + v_lo) * 2); vv2 = (h2_t){vh, vh}; }
                float o0 = 0.f, o1 = 0.f;
#pragma unroll
                for (int p2 = 0; p2 < 8; ++p2) {
                    h2_t t = nsa2 * bv[p2]; if (VTERM) t = __builtin_elementwise_fma(vv2, kt[p2], t);
                    S[i][p2] = __builtin_elementwise_fma(S[i][p2], wv[p2], t);
                    if (OUT) { if (p2 & 1) o1 = __builtin_amdgcn_fdot2(S[i][p2], rv[p2], o1, false); else o0 = __builtin_amdgcn_fdot2(S[i][p2], rv[p2], o0, false); } }
                if (OUT) oi[i] = quad_sum(o0 + o1);
            }
            if (OUT) { const float o = kq == 0 ? oi[0] : kq == 1 ? oi[1] : kq == 2 ? oi[2] : oi[3];
                Ozh[(size_t)rwkv_row(z, n0 + ck * 8 + st) * 1024 + 16 * kq + v_lo] = (unsigned short)f2bf(o); }
        }
    }
#undef RW_DMA
}
#define RW_STORE_STATE(dst_) do { _Pragma("unroll") for (int i = 0; i < 4; ++i) _Pragma("unroll") for (int p4 = 0; p4 < 4; ++p4) \
        *(f32x4*)((dst_) + (16 * i + v_lo) * 64 + 16 * kq + 4 * p4) = (f32x4){(float)S[i][2 * p4][0], (float)S[i][2 * p4][1], (float)S[i][2 * p4 + 1][0], (float)S[i][2 * p4 + 1][1]}; } while (0)
template <int KIND>
__device__ __forceinline__ void rwkv_scan_phase(Frame& F, const Args& a) {
    const unsigned char* REC = a.ws + RW_REC; float* PQ = (float*)(a.ws + RW_PQ); float* SST = (float*)(a.ws + RW_SST); bf16_t* O = (bf16_t*)(a.ws + RW_O); bf16_t* Y = (bf16_t*)(a.ws + RW_Y);
    LAS unsigned char* buf = F.lds + LDS_STAGE + F.wave * 12288;
    const int lane = F.lane, v_lo = lane >> 2, kq = lane & 3;
#pragma unroll 1
    for (int task = F.gw; task < 2048; task += F.ngw) {
        const int zh = task & 31, z = zh >> 4, h = zh & 15, sidx = task >> 5;
        h2_t S[4][8];
#pragma unroll
        for (int i = 0; i < 4; ++i)
#pragma unroll
            for (int p2 = 0; p2 < 8; ++p2) S[i][p2] = (h2_t){(_Float16)0.f, (_Float16)0.f};
        if (sidx == 0) {
            rwkv_scan_task<true, true>(REC + (size_t)zh * NTOK * RECB, buf, lane, S, O + (size_t)z * NTOK * 1024 + h * 64, z, 0, 64);
            float* dst = SST + ((size_t)zh * 65 + 2) * 4096; RW_STORE_STATE(dst);
        } else {
            const int s = sidx + 1; const unsigned char* rec = REC + ((size_t)zh * NTOK + (size_t)s * 256) * RECB;
            rwkv_scan_task<true, true>(rec, buf, lane, S, O + (size_t)z * NTOK * 1024 + h * 64, z, s * 256, 32);
            { float* dst = PQ + ((size_t)zh * 64 + (s - 1)) * 8192 + 4096; RW_STORE_STATE(dst); }
#pragma unroll
            for (int i = 0; i < 4; ++i)
#pragma unroll
                for (int p2 = 0; p2 < 8; ++p2) { const int key = 16 * kq + 2 * p2, vr = 16 * i + v_lo; S[i][p2] = (h2_t){(_Float16)(vr == key ? 1.0f : 0.f), (_Float16)(vr == key + 1 ? 1.0f : 0.f)}; }
            asm volatile("s_waitcnt lgkmcnt(0)" ::: "memory");
            rwkv_scan_task<false, true>(rec, buf, lane, S, Y + (size_t)z * NTOK * 1024 + h * 64, z, s * 256, 32);
            { float* dst = PQ + ((size_t)zh * 64 + (s - 1)) * 8192; RW_STORE_STATE(dst); }
        }
        asm volatile("s_waitcnt lgkmcnt(0)" ::: "memory");
    }
}
constexpr int CK_TS = 144, CK_YS = 272;
constexpr int CK_AH = 0, CK_BH = 9216, CK_KH = 18432, CK_RH = 27648, CK_VV = 36864, CK_BB = 46080, CK_KB = 55296, CK_NM = 64512, CK_MAK = 73728, CK_MRB = 82944, CK_MRK = 92160,
              CK_YY = 101376, CK_SS = 118784, CK_DEC = 137216, CK_TOT = 137472, CK_TD = 139776, CK_TMP = 141824, CK_CT = 150016;
__device__ __forceinline__ void rwkv_chunk_phase(Frame& F, const Args& a) {
    float* PQ = (float*)(a.ws + RW_PQ); float* SST = (float*)(a.ws + RW_SST);
    LAS unsigned char* L = F.lds + LDS_STAGE;
    LAS float* DEC = (LAS float*)(L + CK_DEC); LAS float* TOT = (LAS float*)(L + CK_TOT); LAS float* CT = (LAS float*)(L + CK_CT);
    const int tid = F.tid, lane = F.lane, w = F.wave, c16 = lane & 15, q = lane >> 4;
    const int si = tid >> 3, c8 = tid & 7;
    const bool zset = w >= 4;
#pragma unroll 1
    for (int unit = blockIdx.x; unit < 2048; unit += gridDim.x) {
        const int zh = unit & 31, z = zh >> 4, h = zh & 15, sidx = unit >> 5;
        const int n0 = sidx == 0 ? 0 : (sidx + 1) * 256, nblk = sidx == 0 ? 8 : 4; const bool use_p = sidx != 0;
        if (tid < 64) { CT[tid] = a.in[25][h * 64 + tid]; CT[64 + tid] = a.in[26][h * 64 + tid]; CT[128 + tid] = a.in[20][z * 1024 + h * 64 + tid]; CT[192 + tid] = a.in[17][z * 1024 + h * 64 + tid]; }
        f32x4 accS[4];
#pragma unroll
        for (int kt = 0; kt < 4; ++kt)
#pragma unroll
            for (int r = 0; r < 4; ++r) { const float v0 = (!zset && (16 * w + 4 * q + r) == (16 * kt + c16)) ? 1.0f : 0.f; accS[kt][r] = v0;
                *(LAS unsigned short*)(L + CK_SS + (16 * w + 4 * q + r) * CK_TS + (16 * kt + c16) * 2) = (unsigned short)f2bf(v0); }
        __syncthreads();
        u32x4 pkx, pax, prx, pvx; f32x4 pw0, pw1;
#define CK_PREFETCH(blk_) do { int _t = threadIdx.x; asm volatile("" : "+v"(_t)); const int _trow = rwkv_row(z, n0 + (blk_) * 64 + (_t >> 3)); const unsigned _go = (unsigned)(_trow * 1024 + h * 64 + 8 * (_t & 7)) * 2u; \
            const unsigned char* _w = a.ws; const unsigned _zo = (unsigned)z * (unsigned)(NTOK * 1024 * 2); \
            pkx = *(const u32x4*)(_w + RW_K + _go); pax = *(const u32x4*)(_w + RW_AA + _zo + _go); prx = *(const u32x4*)(_w + RW_R + _go); pvx = *(const u32x4*)(_w + RW_V + _go); \
            pw0 = *(const f32x4*)(_w + RW_WW + 2u * _zo + 2u * _go); pw1 = *(const f32x4*)(_w + RW_WW + 2u * _zo + 2u * _go + 16u); } while (0)
        CK_PREFETCH(0);
#pragma unroll 1
        for (int blk = 0; blk < nblk; ++blk) {
            int tid_o = threadIdx.x; asm volatile("" : "+v"(tid_o));
            const int lane = tid_o & 63, c16 = lane & 15, q = lane >> 4, si = tid_o >> 3, c8 = tid_o & 7;
            float lw[8], kkv[8], bv[8], ktv[8]; u32x4 rx, vx;
            {
                const u32x4 kx = pkx, ax = pax; rx = prx; vx = pvx; const f32x4 wx0 = pw0, wx1 = pw1;
                const float kf[8] = {bflo(kx.x), bfhi(kx.x), bflo(kx.y), bfhi(kx.y), bflo(kx.z), bfhi(kx.z), bflo(kx.w), bfhi(kx.w)};
                const float af[8] = {bflo(ax.x), bfhi(ax.x), bflo(ax.y), bfhi(ax.y), bflo(ax.z), bfhi(ax.z), bflo(ax.w), bfhi(ax.w)};
                const float wf[8] = {wx0[0], wx0[1], wx0[2], wx0[3], wx1[0], wx1[1], wx1[2], wx1[3]};
                const f32x4 c0a = *(const LAS f32x4*)(CT + 8 * c8), c0b = *(const LAS f32x4*)(CT + 8 * c8 + 4);
                float ss = 0.f;
#pragma unroll
                for (int e = 0; e < 8; ++e) { const float kkw = e < 4 ? c0a[e] : c0b[e - 4]; kkv[e] = kf[e] * kkw; ss += kkv[e] * kkv[e]; }
                ss += __shfl_xor(ss, 1); ss += __shfl_xor(ss, 2); ss += __shfl_xor(ss, 4);
                const float rn = __builtin_amdgcn_rsqf(ss + 1e-12f);
                asm volatile("" ::: "memory");
                const f32x4 c1a = *(const LAS f32x4*)(CT + 64 + 8 * c8), c1b = *(const LAS f32x4*)(CT + 64 + 8 * c8 + 4);
                const f32x4 c2a = *(const LAS f32x4*)(CT + 128 + 8 * c8), c2b = *(const LAS f32x4*)(CT + 128 + 8 * c8 + 4), c3a = *(const LAS f32x4*)(CT + 192 + 8 * c8), c3b = *(const LAS f32x4*)(CT + 192 + 8 * c8 + 4);
#pragma unroll
                for (int e = 0; e < 8; ++e) { const float kaw = e < 4 ? c1a[e] : c1b[e - 4], a0e = e < 4 ? c2a[e] : c2b[e - 4], w0e = e < 4 ? c3a[e] : c3b[e - 4];
                    const float av = sigmoidf_(a0e + af[e]); kkv[e] *= rn; bv[e] = av * kkv[e]; ktv[e] = kf[e] * (1.0f + (av - 1.0f) * kaw);
                    lw[e] = -0.6065306597126334f * sigmoidf_(w0e + wf[e]); }
            }
            float G[8];
#pragma unroll
            for (int e = 0; e < 8; ++e) { float x = lw[e]; float y = __shfl_up(x, 8); if (lane >= 8) x += y; y = __shfl_up(x, 16); if (lane >= 16) x += y; y = __shfl_up(x, 32); if (lane >= 32) x += y; G[e] = x; }
            if (lane >= 56) { *(LAS f32x4*)(TOT + w * 64 + 8 * c8) = (f32x4){G[0], G[1], G[2], G[3]}; *(LAS f32x4*)(TOT + w * 64 + 8 * c8 + 4) = (f32x4){G[4], G[5], G[6], G[7]}; }
            __syncthreads();
            {
                float tot[8];
#pragma unroll
                for (int e = 0; e < 8; ++e) tot[e] = 0.f;
#pragma unroll
                for (int ww = 0; ww < 8; ++ww) { const f32x4 t0 = *(const LAS f32x4*)(TOT + ww * 64 + 8 * c8), t1 = *(const LAS f32x4*)(TOT + ww * 64 + 8 * c8 + 4);
#pragma unroll
                    for (int e = 0; e < 8; ++e) { const float tv = e < 4 ? t0[e] : t1[e - 4]; tot[e] += tv; if (ww < w) G[e] += tv; } }
                if (si == 0) { *(LAS f32x4*)(DEC + 8 * c8) = (f32x4){__expf(tot[0]), __expf(tot[1]), __expf(tot[2]), __expf(tot[3])}; *(LAS f32x4*)(DEC + 8 * c8 + 4) = (f32x4){__expf(tot[4]), __expf(tot[5]), __expf(tot[6]), __expf(tot[7])}; }
                const unsigned rw4[4] = {rx.x, rx.y, rx.z, rx.w}; const int to = si * CK_TS + 16 * c8;
                *(LAS u32x4*)(L + CK_VV + to) = vx;
#pragma unroll
                for (int e2 = 0; e2 < 4; ++e2) { float o7[6][2];
#pragma unroll
                    for (int hh = 0; hh < 2; ++hh) { const int e = 2 * e2 + hh; const float Ge = G[e]; const float rve = hh ? bfhi(rw4[e2]) : bflo(rw4[e2]);
                        const float eg = __expf(Ge), egm = __expf(Ge - lw[e]), eng = __expf(fminf(-Ge, 80.0f)), etg = __expf(tot[e] - Ge);
                        o7[0][hh] = -kkv[e] * egm; o7[1][hh] = bv[e] * eng; o7[2][hh] = ktv[e] * eng; o7[3][hh] = rve * eg; o7[4][hh] = bv[e] * etg; o7[5][hh] = ktv[e] * etg; }
                    *(LAS unsigned*)(L + CK_AH + to + 4 * e2) = pk2(o7[0][0], o7[0][1]); *(LAS unsigned*)(L + CK_BH + to + 4 * e2) = pk2(o7[1][0], o7[1][1]); *(LAS unsigned*)(L + CK_KH + to + 4 * e2) = pk2(o7[2][0], o7[2][1]);
                    *(LAS unsigned*)(L + CK_RH + to + 4 * e2) = pk2(o7[3][0], o7[3][1]); *(LAS unsigned*)(L + CK_BB + to + 4 * e2) = pk2(o7[4][0], o7[4][1]); *(LAS unsigned*)(L + CK_KB + to + 4 * e2) = pk2(o7[5][0], o7[5][1]); }
                if (blk + 1 < nblk) CK_PREFETCH(blk + 1);
            }
            __syncthreads();
            { const int it = w >> 1;
              bf16x8 fa[2], fr[2];
#pragma unroll
              for (int ks = 0; ks < 2; ++ks) { fa[ks] = lds_row_frag(L + CK_AH, CK_TS, 16 * it + c16, 32 * ks + 8 * q); fr[ks] = lds_row_frag(L + CK_RH, CK_TS, 16 * it + c16, 32 * ks + 8 * q); }
#pragma unroll 1
              for (int s2 = 0; s2 < 2; ++s2) { const int jt = 2 * (w & 1) + s2; f32x4 n0v = {0.f, 0.f, 0.f, 0.f}, n1v = n0v, n2v = n0v, n3v = n0v;
#pragma unroll
                  for (int ks = 0; ks < 2; ++ks) { const bf16x8 fb = lds_row_frag(L + CK_BH, CK_TS, 16 * jt + c16, 32 * ks + 8 * q), fk = lds_row_frag(L + CK_KH, CK_TS, 16 * jt + c16, 32 * ks + 8 * q);
                      n0v = __builtin_amdgcn_mfma_f32_16x16x32_bf16(fa[ks], fb, n0v, 0, 0, 0); n1v = __builtin_amdgcn_mfma_f32_16x16x32_bf16(fa[ks], fk, n1v, 0, 0, 0);
                      n2v = __builtin_amdgcn_mfma_f32_16x16x32_bf16(fr[ks], fb, n2v, 0, 0, 0); n3v = __builtin_amdgcn_mfma_f32_16x16x32_bf16(fr[ks], fk, n3v, 0, 0, 0); }
#pragma unroll
                  for (int r = 0; r < 4; ++r) { const int i = 16 * it + 4 * q + r, j = 16 * jt + c16, o = i * CK_TS + j * 2;
                      n0v[r] = j < i ? n0v[r] : 0.f;
                      *(LAS unsigned short*)(L + CK_NM + o) = (unsigned short)f2bf(n0v[r]); *(LAS unsigned short*)(L + CK_MAK + o) = (unsigned short)f2bf(j < i ? n1v[r] : 0.f);
                      *(LAS unsigned short*)(L + CK_MRB + o) = (unsigned short)f2bf(j <= i ? n2v[r] : 0.f); *(LAS unsigned short*)(L + CK_MRK + o) = (unsigned short)f2bf(j <= i ? n3v[r] : 0.f); }
                  if (jt == it) {
                      LAS unsigned char* tp = L + CK_TMP + w * 1024; LAS unsigned char* tt = tp + 512;
                      f32x4 P = n0v, T = n0v;
#pragma unroll
                      for (int r = 0; r < 4; ++r) T[r] += (4 * q + r == c16) ? 1.0f : 0.f;
#pragma unroll
                      for (int pw = 0; pw < 3; ++pw) {
#pragma unroll
                          for (int r = 0; r < 4; ++r) { *(LAS unsigned short*)(tp + (4 * q + r) * 32 + c16 * 2) = (unsigned short)f2bf(P[r]); *(LAS unsigned short*)(tt + (4 * q + r) * 32 + c16 * 2) = (unsigned short)f2bf(T[r]); }
                          bf16x4 pb; pb[0] = (short)f2bf(P[0]); pb[1] = (short)f2bf(P[1]); pb[2] = (short)f2bf(P[2]); pb[3] = (short)f2bf(P[3]);
                          const bf16x4 pa = *(const LAS bf16x4*)(tp + c16 * 32 + 8 * q), ta = *(const LAS bf16x4*)(tt + c16 * 32 + 8 * q);
                          f32x4 zero = {0.f, 0.f, 0.f, 0.f};
                          P = __builtin_amdgcn_mfma_f32_16x16x16bf16_1k(pa, pb, zero, 0, 0, 0);
                          bf16x4 pn; pn[0] = (short)f2bf(P[0]); pn[1] = (short)f2bf(P[1]); pn[2] = (short)f2bf(P[2]); pn[3] = (short)f2bf(P[3]);
                          T = __builtin_amdgcn_mfma_f32_16x16x16bf16_1k(ta, pn, T, 0, 0, 0);
                      }
#pragma unroll
                      for (int r = 0; r < 4; ++r) *(LAS unsigned short*)(L + CK_TD + it * 512 + (4 * q + r) * 32 + c16 * 2) = (unsigned short)f2bf(T[r]);
                  } } }
            __syncthreads();
            const bool active = zset || use_p;
            if (active) {
                f32x4 yv[4];
#pragma unroll
                for (int it = 0; it < 4; ++it) yv[it] = (f32x4){0.f, 0.f, 0.f, 0.f};
                bf16x8 sb[2];
#pragma unroll
                for (int ks = 0; ks < 2; ++ks) { sb[ks] = lds_row_frag(L + CK_SS, CK_TS, 16 * w + c16, 32 * ks + 8 * q);
#pragma unroll
                    for (int it = 0; it < 4; ++it) yv[it] = __builtin_amdgcn_mfma_f32_16x16x32_bf16(lds_row_frag(L + CK_AH, CK_TS, 16 * it + c16, 32 * ks + 8 * q), sb[ks], yv[it], 0, 0, 0); }
                bf16x8 vb[2];
                if (zset) {
#pragma unroll
                    for (int ks = 0; ks < 2; ++ks) { vb[ks] = lds_tr_frag(L + CK_VV, CK_TS, 32 * ks, 16 * (w - 4), lane);
#pragma unroll
                        for (int it = 0; it < 4; ++it) yv[it] = __builtin_amdgcn_mfma_f32_16x16x32_bf16(lds_row_frag(L + CK_MAK, CK_TS, 16 * it + c16, 32 * ks + 8 * q), vb[ks], yv[it], 0, 0, 0); } }
                asm volatile("" ::: "memory");
                bf16x4 ub[4];
#pragma unroll
                for (int b = 0; b < 4; ++b) { f32x4 acc = yv[b];
#pragma unroll
                    for (int c = 0; c < 4; ++c) if (c < b) acc = __builtin_amdgcn_mfma_f32_16x16x16bf16_1k(*(const LAS bf16x4*)(L + CK_NM + (16 * b + c16) * CK_TS + (16 * c + 4 * q) * 2), ub[c], acc, 0, 0, 0);
                    bf16x4 ab; ab[0] = (short)f2bf(acc[0]); ab[1] = (short)f2bf(acc[1]); ab[2] = (short)f2bf(acc[2]); ab[3] = (short)f2bf(acc[3]);
                    const f32x4 zero = {0.f, 0.f, 0.f, 0.f};
                    const f32x4 ubf = __builtin_amdgcn_mfma_f32_16x16x16bf16_1k(*(const LAS bf16x4*)(L + CK_TD + b * 512 + c16 * 32 + 8 * q), ab, zero, 0, 0, 0);
                    ub[b][0] = (short)f2bf(ubf[0]); ub[b][1] = (short)f2bf(ubf[1]); ub[b][2] = (short)f2bf(ubf[2]); ub[b][3] = (short)f2bf(ubf[3]); }
                asm volatile("" ::: "memory");
                { int q3 = lane >> 4, c3 = lane & 15; asm volatile("" : "+v"(q3), "+v"(c3));
                  unsigned char* dstb = a.ws + (zset ? RW_O : RW_Y); const unsigned dco = ((unsigned)z * (unsigned)(NTOK * 1024) + (unsigned)(h * 64 + 16 * (w & 3) + c3)) * 2u;
#pragma unroll
                  for (int it = 0; it < 4; ++it) { f32x4 ov = {0.f, 0.f, 0.f, 0.f};
#pragma unroll
                      for (int ks = 0; ks < 2; ++ks) ov = __builtin_amdgcn_mfma_f32_16x16x32_bf16(lds_row_frag(L + CK_RH, CK_TS, 16 * it + c16, 32 * ks + 8 * q), sb[ks], ov, 0, 0, 0);
#pragma unroll
                      for (int c = 0; c < 4; ++c) if (c <= it) ov = __builtin_amdgcn_mfma_f32_16x16x16bf16_1k(*(const LAS bf16x4*)(L + CK_MRB + (16 * it + c16) * CK_TS + (16 * c + 4 * q) * 2), ub[c], ov, 0, 0, 0);
                      if (zset) {
#pragma unroll
                          for (int ks = 0; ks < 2; ++ks) ov = __builtin_amdgcn_mfma_f32_16x16x32_bf16(lds_row_frag(L + CK_MRK, CK_TS, 16 * it + c16, 32 * ks + 8 * q), vb[ks], ov, 0, 0, 0); }
#pragma unroll
                      for (int r = 0; r < 4; ++r) *(unsigned short*)(dstb + dco + (unsigned)rwkv_row(z, n0 + blk * 64 + 16 * it + 4 * q3 + r) * 2048u) = (unsigned short)f2bf(ov[r]);
                      asm volatile("" ::: "memory"); } }
                asm volatile("" ::: "memory");
#pragma unroll
                for (int kt = 0; kt < 4; ++kt) { const float dc = DEC[16 * kt + c16];
#pragma unroll
                    for (int r = 0; r < 4; ++r) accS[kt][r] *= dc;
#pragma unroll
                    for (int c = 0; c < 4; ++c) { const int g = lane >> 4, qq = (lane & 15) >> 2, pp = lane & 3;
                        const v4s16 bt = __builtin_amdgcn_ds_read_tr16_b64_v4i16((LAS v4s16*)(L + CK_BB + (16 * c + 4 * g + qq) * CK_TS + (16 * kt + 4 * pp) * 2));
                        accS[kt] = __builtin_amdgcn_mfma_f32_16x16x16bf16_1k(ub[c], (bf16x4){bt[0], bt[1], bt[2], bt[3]}, accS[kt], 0, 0, 0); } }
                if (zset) {
#pragma unroll
                    for (int ks = 0; ks < 2; ++ks) { const bf16x8 va = vb[ks];
#pragma unroll
                        for (int kt = 0; kt < 4; ++kt) accS[kt] = __builtin_amdgcn_mfma_f32_16x16x32_bf16(va, lds_tr_frag(L + CK_KB, CK_TS, 32 * ks, 16 * kt, lane), accS[kt], 0, 0, 0); } }
            }
            __syncthreads();
            if (active) {
#pragma unroll
                for (int kt = 0; kt < 4; ++kt)
#pragma unroll
                    for (int r = 0; r < 4; ++r) *(LAS unsigned short*)(L + CK_SS + (16 * w + 4 * q + r) * CK_TS + (16 * kt + c16) * 2) = (unsigned short)f2bf(accS[kt][r]);
            }
        }
        { float* dst = sidx == 0 ? (zset ? SST + ((size_t)zh * 65 + 2) * 4096 : nullptr) : PQ + ((size_t)zh * 64 + sidx) * 8192 + (zset ? 4096 : 0);
          if (dst) { int q2 = lane >> 4, c2 = lane & 15; asm volatile("" : "+v"(q2), "+v"(c2));
#pragma unroll
              for (int kt = 0; kt < 4; ++kt)
#pragma unroll
                  for (int r = 0; r < 4; ++r) dst[(16 * (w & 3) + 4 * q2 + r) * 64 + 16 * kt + c2] = accS[kt][r]; } }
        __syncthreads();
    }
}
__device__ __forceinline__ void rwkv_corr_phase(Frame& F, const Args& a) {
    const float* SST = (const float*)(a.ws + RW_SST); bf16_t* O = (bf16_t*)(a.ws + RW_O); const bf16_t* Y = (const bf16_t*)(a.ws + RW_Y);
    const int lane = F.lane, c16 = lane & 15, q = lane >> 4;
#pragma unroll 1
    for (int task = F.gw; task < 2016; task += F.ngw) {
        const int zh = task & 31, z = zh >> 4, h = zh & 15, s = (task >> 5) + 2;
        const float* Ss = SST + ((size_t)zh * 65 + s) * 4096;
        bf16x8 Sf[4][2];
#pragma unroll
        for (int vt = 0; vt < 4; ++vt)
#pragma unroll
            for (int ks = 0; ks < 2; ++ks) { const f32x4 x0 = *(const f32x4*)(Ss + (16 * vt + c16) * 64 + 32 * ks + 8 * q), x1 = *(const f32x4*)(Ss + (16 * vt + c16) * 64 + 32 * ks + 8 * q + 4);
                bf16x8 f; f[0] = (short)f2bf(x0[0]); f[1] = (short)f2bf(x0[1]); f[2] = (short)f2bf(x0[2]); f[3] = (short)f2bf(x0[3]); f[4] = (short)f2bf(x1[0]); f[5] = (short)f2bf(x1[1]); f[6] = (short)f2bf(x1[2]); f[7] = (short)f2bf(x1[3]); Sf[vt][ks] = f; }
        const bf16_t* Yz = Y + (size_t)z * NTOK * 1024 + h * 64; bf16_t* Oz = O + (size_t)z * NTOK * 1024 + h * 64;
#pragma unroll 2
        for (int T = 0; T < 16; ++T) {
            const size_t row = (size_t)rwkv_row(z, s * 256 + 16 * T + c16) * 1024;
            const bf16x8 y0 = *(const bf16x8*)(Yz + row + 8 * q), y1 = *(const bf16x8*)(Yz + row + 32 + 8 * q);
#pragma unroll
            for (int vt = 0; vt < 4; ++vt) { f32x4 d = {0.f, 0.f, 0.f, 0.f};
                d = __builtin_amdgcn_mfma_f32_16x16x32_bf16(Sf[vt][0], y0, d, 0, 0, 0); d = __builtin_amdgcn_mfma_f32_16x16x32_bf16(Sf[vt][1], y1, d, 0, 0, 0);
                u32x2* op = (u32x2*)(Oz + row + 16 * vt + 4 * q); const u32x2 old = *op;
                u32x2 nw; nw.x = pk2(bflo(old.x) + d[0], bfhi(old.x) + d[1]); nw.y = pk2(bflo(old.y) + d[2], bfhi(old.y) + d[3]); *op = nw; }
        }
    }
}
__device__ __forceinline__ void rwkv_prefix_phase(Frame& F, const Args& a) {
    const float* PQ = (const float*)(a.ws + RW_PQ); float* SST = (float*)(a.ws + RW_SST);
    if (blockIdx.x >= 128) return;
    const int zh = blockIdx.x >> 2, r0 = (blockIdx.x & 3) * 16, tid = F.tid, lane = F.lane, w = F.wave, kq = lane >> 4, j = lane & 15;
    constexpr int PS = 68;
    LAS float* Sl = (LAS float*)(F.lds + LDS_STAGE);
    LAS float* Pl = Sl + 2 * 16 * 68;
    { const float* s1 = SST + ((size_t)zh * 65 + 2) * 4096 + r0 * 64;
      for (int i = tid; i < 1024; i += NTHREADS) Sl[(i >> 6) * 68 + (i & 63)] = s1[i]; }
    f32x4 pa[4], pc[4], qb[4];
    const int pr0 = tid >> 4, pc0 = (tid & 15) * 4;
#define RP_PG(step_) (PQ + ((size_t)zh * 64 + ((step_) - 1)) * 8192)
#define RP_LOADP(sl_, step_) do { const float* Pg = RP_PG(step_); pa[sl_] = *(const f32x4*)(Pg + 4 * tid); pc[sl_] = *(const f32x4*)(Pg + 4 * (tid + 512)); } while (0)
#define RP_LOADQ(sl_, step_) do { if (w < 4) { const float* Pg = RP_PG(step_); _Pragma("unroll") for (int r = 0; r < 4; ++r) qb[sl_][r] = Pg[4096 + (r0 + 4 * kq + r) * 64 + 16 * w + j]; } } while (0)
#define RP_PUTP(sl_, buf_) do { LAS float* Pd = Pl + (buf_) * (64 * PS); *(LAS f32x4*)(Pd + pr0 * PS + pc0) = pa[sl_]; *(LAS f32x4*)(Pd + (pr0 + 32) * PS + pc0) = pc[sl_]; } while (0)
    RP_LOADP(2, 2); RP_LOADP(3, 3); RP_LOADP(0, 4); RP_LOADP(1, 5);
    RP_LOADQ(2, 2); RP_LOADQ(3, 3); RP_LOADQ(0, 4); RP_LOADQ(1, 5);
    RP_PUTP(2, 0); RP_LOADP(2, 6);
    __syncthreads();
    int cur = 0;
#pragma unroll 1
    for (int s = 2; s < 64; s += 4) {
#pragma unroll
        for (int u = 0; u < 4; ++u) { const int step = s + u;
            if (step < 64) {
                const int slq = (2 + u) & 3, slp = (3 + u) & 3;
                f32x4 acc = qb[slq];
                if (w < 4) {
                    const LAS float* Sc = Sl + cur * (16 * 68); const LAS float* Pc = Pl + (step & 1) * (64 * PS);
#pragma unroll
                    for (int kk = 0; kk < 16; ++kk) acc = __builtin_amdgcn_mfma_f32_16x16x4f32(Sc[j * 68 + 4 * kk + kq], Pc[(4 * kk + kq) * PS + 16 * w + j], acc, 0, 0, 0);
                }
                if (step + 1 < 64) { RP_PUTP(slp, (step + 1) & 1); if (step + 5 < 64) RP_LOADP(slp, step + 5); }
                if (step + 4 < 64) RP_LOADQ(slq, step + 4);
                if (w < 4) {
                    LAS float* Sn = Sl + (cur ^ 1) * (16 * 68);
                    float* dst = SST + ((size_t)zh * 65 + step + 1) * 4096 + (r0 + 4 * kq) * 64 + 16 * w + j;
#pragma unroll
                    for (int r = 0; r < 4; ++r) { dst[r * 64] = acc[r]; Sn[(4 * kq + r) * 68 + 16 * w + j] = acc[r]; }
                }
                __syncthreads();
                cur ^= 1;
            }
        }
    }
#undef RP_PG
#undef RP_LOADP
#undef RP_LOADQ
#undef RP_PUTP
}
__device__ __forceinline__ void rwkv_readout_phase(Frame& F, const Args& a) {
    const bf16_t* O0 = (const bf16_t*)(a.ws + RW_O); const bf16_t* O1 = O0 + (size_t)NTOK * 1024; const bf16_t* R = (const bf16_t*)(a.ws + RW_R); const bf16_t* K = (const bf16_t*)(a.ws + RW_K);
    const bf16_t* V = (const bf16_t*)(a.ws + RW_V); const bf16_t* A0 = (const bf16_t*)(a.ws + RW_AA); const bf16_t* A1 = A0 + (size_t)NTOK * 1024; const bf16_t* G = (const bf16_t*)(a.ws + RW_G);
    bf16_t* A5 = (bf16_t*)(a.ws + RW_A5); const int lane = F.lane;
    float ka[16], rk[16], lg[16], lb[16], ab0[16], ab1[16]; ldrow_f32(a.in[20], lane, ab0); ldrow_f32(a.in[20] + 1024, lane, ab1); ldrow_f32(a.in[26], lane, ka); ldrow_f32(a.in[27], lane, rk); ldrow_f32(a.in[28], lane, lg); ldrow_f32(a.in[29], lane, lb);
    for (int t = F.gw; t < NTOK; t += F.ngw) {
        float o[16], r[16], k[16], v[16], a0[16], a1[16], g[16];
        ldrow_bf16(O0 + (size_t)t * 1024, lane, o); addrow_bf16(O1 + (size_t)t * 1024, lane, o); ldrow_bf16(R + (size_t)t * 1024, lane, r); ldrow_bf16(K + (size_t)t * 1024, lane, k);
        ldrow_bf16(V + (size_t)t * 1024, lane, v); ldrow_bf16(A0 + (size_t)t * 1024, lane, a0); ldrow_bf16(A1 + (size_t)t * 1024, lane, a1); ldrow_bf16(G + (size_t)t * 1024, lane, g);
#pragma unroll
        for (int j = 0; j < 2; ++j) { float s = 0.f, bn = 0.f;
#pragma unroll
            for (int e = 0; e < 8; ++e) { const int x = 8 * j + e; s += o[x]; bn += r[x] * k[x] * rk[x] * (2.0f + (sigmoidf_(a0[x] + ab0[x]) + sigmoidf_(a1[x] + ab1[x]) - 2.0f) * ka[x]); }
#pragma unroll
            for (int m = 1; m < 8; m <<= 1) { s += __shfl_xor(s, m); bn += __shfl_xor(bn, m); }
            const float mean = s * (1.0f / 64.0f); float q = 0.f;
#pragma unroll
            for (int e = 0; e < 8; ++e) { o[8 * j + e] -= mean; q += o[8 * j + e] * o[8 * j + e]; }
#pragma unroll
            for (int m = 1; m < 8; m <<= 1) q += __shfl_xor(q, m);
            const float rs = 1.0f / sqrtf(q * (1.0f / 64.0f) + 64e-5f);
#pragma unroll
            for (int e = 0; e < 8; ++e) { const int x = 8 * j + e; o[x] = (o[x] * rs * lg[x] + lb[x] + bn * v[x]) * g[x]; } }
        strow_bf16(A5 + (size_t)t * 1024, lane, o);
    }
}

__device__ __forceinline__ void zero_y_phase(Frame& F, const Args& a) {
    u32x4* y = (u32x4*)(a.ws + WS_MX5); const u32x4 z = {0u, 0u, 0u, 0u};
    for (size_t i = (size_t)blockIdx.x * NTHREADS + F.tid; i < (size_t)NTOK * D / 8; i += (size_t)gridDim.x * NTHREADS) y[i] = z;
}

__device__ __forceinline__ Frame mk_frame(const Args& a, unsigned char* lds_raw) {
    Frame F; int tid = threadIdx.x; asm volatile("" : "+v"(tid));
    F.lds = (LAS unsigned char*)lds_raw; F.misc = (volatile LAS unsigned*)(F.lds + LDS_MISC);
    F.tid = tid; F.lane = tid & 63; F.wave = __builtin_amdgcn_readfirstlane(tid >> 6);
    F.ws = a.ws; F.ctl = (unsigned*)(a.ws + WS_CTL);
    F.gw = blockIdx.x * NWAVES + F.wave; F.ngw = gridDim.x * NWAVES; F.tacc = 0;
    return F;
}
__global__ void __launch_bounds__(NTHREADS, 2) fwd_kernel(Args a) {
    extern __shared__ __attribute__((aligned(16))) unsigned char lds_raw[];
    if (threadIdx.x < 64) ((volatile LAS unsigned*)((LAS unsigned char*)lds_raw + LDS_MISC))[threadIdx.x] = 0u;
    __syncthreads();
    (void)xcd_barrier_post((unsigned*)(a.ws + WS_CTL) + CW_BAR, (volatile LAS unsigned*)((LAS unsigned char*)lds_raw + LDS_MISC) + 8);
    int phase = 0;
    unsigned long long pacc = 0; bool pmark = false, pmarkd = false; unsigned long long tstart_ = 0; if (TPROBE) tstart_ = __builtin_amdgcn_s_memrealtime();
#define PMARK(g) do { if (TPROBE) pmark = ((TPROBE >> (g)) & 1) != 0; } while (0)
#define PDUR(g) do { if (TPROBE) pmarkd = ((TPROBE >> (g)) & 1) != 0; } while (0)
#define PHASE(body) do { if (phase >= a.ph_lo && phase < a.ph_hi) { unsigned long long tp0_ = 0; if (TPROBE) tp0_ = __builtin_amdgcn_s_memrealtime(); { Frame F = mk_frame(a, lds_raw); body; if (TPROBE & (1 << 29)) pacc += F.tacc; } \
        unsigned long long t0_ = 0; if (TPROBE) t0_ = __builtin_amdgcn_s_memrealtime(); \
        if (phase + 1 < a.ph_hi) { XcdBarrier bar; bar.bar = (unsigned*)(a.ws + WS_CTL) + CW_BAR; bar.x = xb_xcc_id(); bar.st = (volatile LAS unsigned*)((LAS unsigned char*)lds_raw + LDS_MISC) + 8; xcd_barrier(bar); } \
        if (TPROBE) { if (pmark) pacc += __builtin_amdgcn_s_memrealtime() - t0_; pmark = false; if (pmarkd) pacc += __builtin_amdgcn_s_memrealtime() - tp0_; pmarkd = false; if ((TPROBE & (1 << 28)) && phase == 2) pacc += __builtin_amdgcn_s_memrealtime() - tstart_; } } ++phase; } while (0)

#define PHASED(bit, body) do { PHASE(body); if (DUP & (bit)) PHASE(body); } while (0)
    PHASED(1, p0_phase(F, a));
    PHASE(p1a_phase(F, a));
    PHASE(p1b_phase(F, a));

#define MOE_LAYER(L) do { \
    if (EN_MOE) { PHASE({ PMARK(7); PDUR(8); moe_route_phase<L>(F, a); if (L < 3) bg_slot<(L == 0 ? EV_ROUTE0 : L == 1 ? EV_ROUTE1 : EV_ROUTE2)>(F, a); }); if (DUP & (1 << 20)) PHASE((moe_route_phase<L, true>(F, a))); PHASE({ PDUR(9); moe_dispatch_phase<L>(F, a); }); if (DUP & (1 << 26)) PHASE((moe_dispatch_phase<L, true>(F, a))); PHASED(2, { PDUR(10); moe_gateup_phase<L>(F, a); }); PHASE((moe_down_phase<L, 4>(F, a))); if (DUP & 4) PHASE({ PDUR(11); (moe_down_phase<L, DOWN_PROBE_MODE>(F, a)); }); } \
    PHASE({ PDUR(12); (ln_phase<L, 1>(F, a)); }); if (DUP & (1 << 21)) PHASE((ln_phase<L, 1, true>(F, a))); } while (0)

    if (EN_LRU) {
        PHASED(65536, { PMARK(0); lru_in_gemm_phase(F, a); bg_slot<EV_LRU_IN>(F, a); });
        PHASED(131072, { PMARK(2); lru_scan_phase<true>(F, a); bg_slot<EV_S1>(F, a); });
        PHASED(1 << 24, { PDUR(14); lru_carry_phase(F, a); bg_slot<EV_CARRY>(F, a); });
        PHASED(131072, { PMARK(2); lru_scan_phase<false>(F, a); bg_slot<EV_S3>(F, a); });
        PHASED(1 << 25, { PMARK(0); dense_gemm_bf16(F, (const bf16_t*)(a.ws + WS_MX2), (const bf16_t*)(a.ws + WS_W_LRU_OUT), (bf16_t*)(a.ws + WS_MX5), NTOK, 1024, 1024); bg_slot<EV_LRU_OUT>(F, a); });
    } else PHASE(zero_y_phase(F, a));
    PHASE({ bg_catch<EV_C0>(F, a); (ln_phase<0, 0>(F, a)); }); if (DUP & (1 << 22)) PHASE((ln_phase<0, 0, true>(F, a)));
    MOE_LAYER(0);
    if (EN_RWKV) {
        PHASED(64, rwkv_xm_phase(F, a));
        PHASED(128, { rwkv_in_gemm_phase(F, a); bg_slot<EV_RW_IN>(F, a); });
        PHASED(256, { rwkv_l2_gemm_phase(F, a); bg_slot<EV_RW_L2>(F, a); });
#if !RWKV_CHUNKED
        PHASED(8, rwkv_rec_phase(F, a));
#endif
#if RWKV_CHUNKED
        PHASED(16, { PMARK(3); rwkv_chunk_phase(F, a); bg_slot<EV_RW_CHUNK>(F, a); });
#else
        PHASED(16, rwkv_scan_phase<0>(F, a));
#endif
        PHASED(1 << 24, { PDUR(13); rwkv_prefix_phase(F, a); bg_slot<EV_RW_PREFIX>(F, a); });
        PHASE({ PDUR(17); rwkv_corr_phase(F, a); });
        PHASED(1 << 23, rwkv_readout_phase(F, a));
        PHASED(1 << 25, { PMARK(0); dense_gemm_bf16(F, (const bf16_t*)(a.ws + RW_A5), (const bf16_t*)(a.ws + WS_W_RWKV_OUT), (bf16_t*)(a.ws + WS_MX5), NTOK, 1024, 1024); bg_slot<EV_RW_OUT>(F, a); });
    } else PHASE(zero_y_phase(F, a));
    PHASE({ bg_catch<EV_C1>(F, a); (ln_phase<1, 0>(F, a)); }); if (DUP & (1 << 22)) PHASE((ln_phase<1, 0, true>(F, a)));
    MOE_LAYER(1);
    if (EN_RET) {
        PHASED(4096, { PMARK(0); ret_in_gemm_phase(F, a); bg_slot<EV_RET_IN>(F, a); });
        PHASED(8192, { ret_p_phase(F, a); ret_transpose_phase(F, a); bg_slot<EV_RET_P>(F, a); });
        PHASED(16384, { ret_kv_phase(F, a); bg_slot<EV_RET_KV>(F, a); });
        PHASE({ PDUR(16); ret_prefix_phase<false>(F, a); }); if (DUP & (1 << 27)) PHASE(ret_prefix_phase<true>(F, a));
        PHASED(32768, { PMARK(6); ret_o_phase(F, a); bg_slot<EV_RET_O>(F, a); });
        PHASED(1 << 23, ret_readout_phase(F, a));
        PHASED(1 << 25, { PMARK(1); dense_gemm_bf16(F, (const bf16_t*)(a.ws + RT_A3), (const bf16_t*)(a.ws + WS_W_RET_OUT), (bf16_t*)(a.ws + WS_MX5), NTOK, 1024, 2048); bg_slot<EV_RET_OUT>(F, a); });
    } else PHASE(zero_y_phase(F, a));
    PHASE({ bg_catch<EV_C2>(F, a); (ln_phase<2, 0>(F, a)); }); if (DUP & (1 << 22)) PHASE((ln_phase<2, 0, true>(F, a)));
    MOE_LAYER(2);
    if (EN_HGRN) {
        PHASED(2048, { PMARK(0); hgrn_in_gemm_phase(F, a); bg_slot<EV_HG_IN>(F, a); });
        PHASED(512, { PMARK(4); hgrn_chunk_phase<0>(F, a); bg_slot<EV_HG_C0>(F, a); });
        PHASE({ PDUR(15); hgrn_prefix_phase<false>(F, a); bg_slot<EV_HG_PREFIX>(F, a); }); if (DUP & (1 << 27)) PHASE(hgrn_prefix_phase<true>(F, a));
        PHASED(1024, { PMARK(5); hgrn_chunk_phase<1>(F, a); bg_slot<EV_HG_C1>(F, a); });
        PHASED(1 << 23, hgrn_readout_phase(F, a));
        PHASED(1 << 25, dense_gemm_bf16(F, (const bf16_t*)(a.ws + HG_A4) + (size_t)NCTX * 1024, (const bf16_t*)(a.ws + WS_W_HGRN_OUT), (bf16_t*)(a.ws + WS_MX5) + (size_t)NCTX * 1024, SEQ, 1024, 1024));
    } else PHASE(zero_y_phase(F, a));
    PHASE({ bg_catch<EV_C3>(F, a); (ln_phase<3, 0>(F, a)); }); if (DUP & (1 << 22)) PHASE((ln_phase<3, 0, true>(F, a)));
    MOE_LAYER(3);
    if (TPROBE) { if (blockIdx.x == 200 && threadIdx.x == 0) { const unsigned long long ts = __builtin_amdgcn_s_memrealtime(); while (__builtin_amdgcn_s_memrealtime() - ts < pacc * 20ull) __builtin_amdgcn_s_sleep(8); } }
}

extern "C" void kernel_launch(void* const* d_in, const int* in_sizes, int n_in, void* d_out, int out_size, void* d_ws, size_t ws_size, hipStream_t stream) {
    static int grid = 0;
    if (grid == 0) {
        if (n_in != 47 || out_size != SEQ * D || ws_size < WS_END) { fprintf(stderr, "kernel_launch: unexpected shapes (n_in %d out %d ws %zu need %zu)\n", n_in, out_size, ws_size, (size_t)WS_END); grid = -1; return; }
        int dev = 0, cus = 0, per_cu = 0;
        (void)hipGetDevice(&dev); (void)hipDeviceGetAttribute(&cus, hipDeviceAttributeMultiprocessorCount, dev);
        if (hipFuncSetAttribute((const void*)fwd_kernel, hipFuncAttributeMaxDynamicSharedMemorySize, LDS_BYTES) != hipSuccess) { fprintf(stderr, "kernel_launch: hipFuncSetAttribute failed\n"); grid = -1; return; }
        (void)hipOccupancyMaxActiveBlocksPerMultiprocessor(&per_cu, (const void*)fwd_kernel, NTHREADS, LDS_BYTES);
        (void)hipGetLastError();
        if (per_cu < 1) fprintf(stderr, "kernel_launch: occupancy query says %d blocks per CU\n", per_cu);
        grid = cus;
    }
    if (grid < 0) return;
    (void)hipMemsetAsync((char*)d_ws + WS_CTL, 0, CTL_BYTES, stream);
    Args a; memset(&a, 0, sizeof(a));
    for (int i = 0; i < 47; ++i) a.in[i] = (const float*)d_in[i];
    a.out = (float*)d_out; a.ws = (unsigned char*)d_ws; a.ph_lo = 0; a.ph_hi = 1000;
    hipLaunchKernelGGL(fwd_kernel, dim3(grid), dim3(NTHREADS), LDS_BYTES, stream, a);
}
```

```cpp
#include <hip/hip_runtime.h>
#include <stdint.h>
#include <stdio.h>
#include <string.h>

#define LAS __attribute__((address_space(3)))
#define GAS __attribute__((address_space(1)))
typedef unsigned short bf16_t;
typedef short bf16x8 __attribute__((ext_vector_type(8)));
typedef short bf16x4 __attribute__((ext_vector_type(4)));
typedef float f32x4 __attribute__((ext_vector_type(4)));
typedef float f32x2 __attribute__((ext_vector_type(2)));
typedef unsigned u32x4 __attribute__((ext_vector_type(4)));
typedef unsigned u32x2 __attribute__((ext_vector_type(2)));

constexpr int D = 1024, SEQ = 16384, NCTX = 256, NTOK = SEQ + NCTX;
constexpr int NE = 64, TOPK = 8, EDIM = 256;
constexpr float ALPHA = 1.681792830507429f;
constexpr float LN_EPS = 1e-5f;
constexpr int NTHREADS = 512, NWAVES = 8;

#ifndef TPROBE
#define TPROBE 0
#endif
#define BQ(q) ((TPROBE & 0xFF) ? 0 : (q))
#ifndef DUP
#define DUP 0
#define DOWN_PROBE_MODE 3
#endif
#ifndef RWKV_CHUNKED
#define RWKV_CHUNKED 1
#endif
#ifndef EN_LRU
#define EN_LRU 1
#endif
#ifndef EN_RWKV
#define EN_RWKV 1
#endif
#ifndef EN_RET
#define EN_RET 1
#endif
#ifndef EN_HGRN
#define EN_HGRN 1
#endif
#ifndef EN_MOE
#define EN_MOE 1
#endif

__device__ __forceinline__ unsigned f2bf(float f) { unsigned u = __builtin_bit_cast(unsigned, f); return (u + 0x7fffu + ((u >> 16) & 1u)) >> 16; }
__device__ __forceinline__ float bf2f(unsigned b) { return __builtin_bit_cast(float, b << 16); }
__device__ __forceinline__ unsigned pk2(float lo, float hi) { unsigned r; asm volatile("v_cvt_pk_bf16_f32 %0, %1, %2" : "=v"(r) : "v"(lo), "v"(hi)); return r; }
__device__ __forceinline__ float bflo(unsigned w) { return __builtin_bit_cast(float, w << 16); }
__device__ __forceinline__ float bfhi(unsigned w) { return __builtin_bit_cast(float, w & 0xffff0000u); }
__device__ __forceinline__ float sigmoidf_(float x) { return __builtin_amdgcn_rcpf(1.0f + __expf(-x)); }
__device__ __forceinline__ float siluf_(float x) { return x * __builtin_amdgcn_rcpf(1.0f + __expf(-x)); }
__device__ __forceinline__ float wave_sum(float v) {
#pragma unroll
    for (int o = 1; o < 64; o <<= 1) v += __shfl_xor(v, o);
    return v;
}

#define XB_TMO      128
#define XB_XCNT(j)  (256  + 64 * (j))
#define XB_XSUB(j)  (1280 + 64 * (j))
#define XB_XGEN(j)  (2304 + 64 * (j))
#define XB_TOP      3328
#define XB_TOPGEN   3392
#define XCD_BAR_WORDS 3456
#define XB_SPIN_CAP (1u << 22)
__device__ __forceinline__ unsigned xb_ld(unsigned* p)              { return __hip_atomic_load(p, __ATOMIC_RELAXED, __HIP_MEMORY_SCOPE_AGENT); }
__device__ __forceinline__ unsigned xb_add(unsigned* p, unsigned v) { return __hip_atomic_fetch_add(p, v, __ATOMIC_RELAXED, __HIP_MEMORY_SCOPE_AGENT); }
__device__ __forceinline__ unsigned xb_xcc_id() { return (unsigned)__builtin_amdgcn_s_getreg((3 << 11) | 20) & 0xFu; }
#define XB_SPIN(cond, bar) do { unsigned _sp = 0; while (cond) { __builtin_amdgcn_s_sleep(1); \
    if ((++_sp & 255u) == 0u) { if (xb_ld(&(bar)[XB_TMO])) break; if (_sp > XB_SPIN_CAP) { atomicAdd(&(bar)[XB_TMO], 1u); break; } } } } while (0)
struct XcdBarrier { unsigned* bar; unsigned x; volatile LAS unsigned* st; };
__device__ __forceinline__ XcdBarrier xcd_barrier_post(unsigned* bar, volatile LAS unsigned* st) {
    XcdBarrier b; b.bar = bar; b.x = xb_xcc_id(); b.st = st;
    if (threadIdx.x == 0) (void)xb_add(&bar[XB_XCNT(b.x)], 1u);
    return b;
}
__device__ __forceinline__ void xcd_barrier_complete(unsigned* bar, unsigned x, unsigned& nloc, unsigned& nx) {
    const unsigned G = gridDim.x * gridDim.y * gridDim.z;
    unsigned sum, cnt, mine, sp = 0u;
    for (;;) {
        sum = 0u; cnt = 0u; mine = 0u;
#pragma unroll
        for (unsigned j = 0; j < 16; ++j) { const unsigned c = xb_ld(&bar[XB_XCNT(j)]); sum += c; cnt += (c > 0u) ? 1u : 0u; mine = (j == x) ? c : mine; }
        if (sum == G) break;
        __builtin_amdgcn_s_sleep(1);
        if ((++sp & 255u) == 0u) { if (xb_ld(&bar[XB_TMO])) break; if (sp > XB_SPIN_CAP) { atomicAdd(&bar[XB_TMO], 1u); break; } }
    }
    nloc = mine > 0u ? mine : 1u; nx = cnt > 0u ? cnt : 1u;
}
__device__ __forceinline__ void xcd_barrier(const XcdBarrier& b) {
    asm volatile("s_waitcnt vmcnt(0)" ::: "memory");
    __syncthreads();
    if (threadIdx.x == 0) {
        unsigned* bar = b.bar;
        __builtin_amdgcn_s_waitcnt(0);
        unsigned nloc = b.st[0], nx = b.st[1];
        if (nloc == 0u) { xcd_barrier_complete(bar, b.x, nloc, nx); b.st[0] = nloc; b.st[1] = nx; }
        const unsigned old = xb_add(&bar[XB_XSUB(b.x)], 1u);
        const unsigned gen = old / nloc;
        if (old + 1u == (gen + 1u) * nloc) {
            __builtin_amdgcn_fence(__ATOMIC_RELEASE, "agent");
            asm volatile("s_waitcnt vmcnt(0)" ::: "memory");
            const unsigned og = xb_add(&bar[XB_TOP], 1u);
            const unsigned tg = og / nx;
            if (og + 1u == (tg + 1u) * nx) xb_add(&bar[XB_TOPGEN], 1u);
            else XB_SPIN(xb_ld(&bar[XB_TOPGEN]) == tg, bar);
            __builtin_amdgcn_fence(__ATOMIC_ACQUIRE, "agent");
            xb_add(&bar[XB_XGEN(b.x)], 1u);
            asm volatile("s_waitcnt vmcnt(0)" ::: "memory");
        } else {
            XB_SPIN(xb_ld(&bar[XB_XGEN(b.x)]) == gen, bar);
            __builtin_amdgcn_fence(__ATOMIC_ACQUIRE, "agent");
            asm volatile("s_waitcnt vmcnt(0)" ::: "memory");
        }
    }
    __syncthreads();
}

namespace gg {
constexpr int BM = 256, BK = 64, HALF = 128, HTB = HALF * BK * 2, STAGE_BYTES = 8 * HTB;
__device__ __forceinline__ int lds_byte(int r, int c) { const int st = (r >> 4) * 2 + (c >> 5), rr = r & 15, cc = c & 31, ob = rr * 64 + cc * 2; return st * 1024 + (ob ^ (((ob >> 9) & 1) << 5)); }
__device__ __forceinline__ void stage_rc(int b, int& R, int& C) { const int st = b / 1024, sb = b % 1024, swz = sb ^ (((sb >> 9) & 1) << 5); R = (st >> 1) * 16 + swz / 64; C = (st & 1) * 32 + (swz % 64) / 2; }
__device__ __forceinline__ int perm32(int rho) { const int n = rho >> 4, i = rho & 15; return 8 * (i >> 2) + 4 * n + (i & 3); }

struct Unit { const char* a; const char* b; const char* b2; int pm, pn, gofs, x; };
struct Dims { int K, lda, ldb, kseg, ldb2; };

typedef f32x4 Acc[2][2][4][2];

template <class Epi, class Sched, bool GATHER, bool SEGB>
__device__ __forceinline__ void gemm_phase(LAS unsigned char* lds, const Dims dm, const Sched& S, const Epi& E) {
    const int tid = threadIdx.x, wid = __builtin_amdgcn_readfirstlane(tid >> 6), lane = tid & 63, wr = wid >> 2, wc = wid & 3, fr = lane & 15, fq = lane >> 4;
    const int K = dm.K, nt = K / BK;
    unsigned voffB[2], voffB2[2], cAo[2][2], nAo[2][2]; int gR[2], gC[2];
    const unsigned hstepA = (unsigned)HALF * dm.lda * 2u, hstepB = (unsigned)HALF * dm.ldb * 2u, hstepB2 = (unsigned)HALF * dm.ldb2 * 2u;
#pragma unroll
    for (int i = 0; i < 2; ++i) { int R, C; stage_rc(tid * 16 + i * 8192, R, C); const int Rb = Epi::PERM ? ((R & ~31) + perm32(R & 31)) : R;
        gR[i] = R; gC[i] = C * 2; voffB[i] = (unsigned)(Rb * dm.ldb + C) * 2u; voffB2[i] = SEGB ? (unsigned)(Rb * dm.ldb2 + C) * 2u : 0u;
        cAo[0][i] = (unsigned)(R * dm.lda + C) * 2u; cAo[1][i] = cAo[0][i] + hstepA; }
    const unsigned ldsw = (unsigned)wid * 1024u;
    const int aoff = lds_byte(wr * 64 + fr, fq * 8), boff = lds_byte(wc * 32 + fr, fq * 8);
#define GG_SA(b, h) (((b) * 2 + (h)) * HTB)
#define GG_SB(b, h) ((4 + (b) * 2 + (h)) * HTB)
#define GG_STAGE(bufoff, gbase, voff) do { _Pragma("unroll") for (int _i = 0; _i < 2; ++_i) \
        __builtin_amdgcn_global_load_lds((const unsigned*)((const char*)(gbase) + (voff)[_i]), (LAS unsigned*)(lds + (bufoff) + ldsw + _i * 8192), 16, 0, 0); } while (0)
#define GG_LDA(dst, b, h) do { _Pragma("unroll") for (int m = 0; m < 4; ++m) _Pragma("unroll") for (int k = 0; k < 2; ++k) dst[m][k] = *(const LAS bf16x8*)(lds + GG_SA(b, h) + aoff + m * 2048 + k * 1024); } while (0)
#define GG_LDB(dst, b, h) do { _Pragma("unroll") for (int n = 0; n < 2; ++n) _Pragma("unroll") for (int k = 0; k < 2; ++k) dst[n][k] = *(const LAS bf16x8*)(lds + GG_SB(b, h) + boff + n * 2048 + k * 1024); } while (0)
#define GG_MMA(ai, bj, At, Bt) do { __builtin_amdgcn_s_setprio(1); _Pragma("unroll") for (int m = 0; m < 4; ++m) _Pragma("unroll") for (int n = 0; n < 2; ++n) _Pragma("unroll") for (int k = 0; k < 2; ++k) \
        acc[ai][bj][m][n] = __builtin_amdgcn_mfma_f32_16x16x32_bf16(Bt[n][k], At[m][k], acc[ai][bj][m][n], 0, 0, 0); __builtin_amdgcn_s_setprio(0); } while (0)
#define GG_WAIT_V(n) asm volatile("s_waitcnt vmcnt(" #n ")" ::: "memory")
#define GG_WAIT_L(n) asm volatile("s_waitcnt lgkmcnt(" #n ")" ::: "memory")
#define GG_BAR __builtin_amdgcn_s_barrier()
#define GG_SCHED __builtin_amdgcn_sched_barrier(0)
#define GG_BSRC(u, kt) ((SEGB && (kt) >= dm.kseg) ? (u).b2 + (size_t)((kt) - dm.kseg) * 128 : (u).b + (size_t)(kt) * 128)
#define GG_STAGE_B(bufoff, u, kt, h) do { const bool _s2 = SEGB && (kt) >= dm.kseg; \
        const char* _bp = _s2 ? (u).b2 + (size_t)((kt) - dm.kseg) * 128 + (h) * hstepB2 : (u).b + (size_t)(kt) * 128 + (h) * hstepB; \
        unsigned _vo[2]; _vo[0] = _s2 ? voffB2[0] : voffB[0]; _vo[1] = _s2 ? voffB2[1] : voffB[1]; GG_STAGE(bufoff, _bp, _vo); } while (0)
#define GG_GOFF(u, dst) do { if (GATHER) { const LAS int* _ix = (const LAS int*)(lds + (u).gofs); _Pragma("unroll") for (int _h = 0; _h < 2; ++_h) _Pragma("unroll") for (int _i = 0; _i < 2; ++_i) \
        dst[_h][_i] = (unsigned)_ix[_h * 128 + gR[_i]] * (unsigned)(dm.lda * 2) + (unsigned)gC[_i]; } } while (0)
    Unit cur, nxt; int ui = 0;
    if (!S.next(0, cur)) return;
    Acc acc;
#pragma unroll
    for (int a = 0; a < 2; ++a)
#pragma unroll
        for (int b = 0; b < 2; ++b)
#pragma unroll
            for (int m = 0; m < 4; ++m)
#pragma unroll
                for (int n = 0; n < 2; ++n) acc[a][b][m][n] = (f32x4){0.f, 0.f, 0.f, 0.f};
    bf16x8 At[4][2], B0[2][2], B1[2][2];
    GG_GOFF(cur, cAo);
    GG_STAGE_B(GG_SB(0, 0), cur, 0, 0); GG_STAGE(GG_SA(0, 0), cur.a, cAo[0]); GG_STAGE_B(GG_SB(0, 1), cur, 0, 1); GG_STAGE(GG_SA(0, 1), cur.a, cAo[1]);
    if (wr == 1) GG_BAR;
    GG_WAIT_V(4); GG_BAR;
    GG_STAGE_B(GG_SB(1, 0), cur, 1, 0); GG_STAGE(GG_SA(1, 0), cur.a + 128, cAo[0]); GG_STAGE_B(GG_SB(1, 1), cur, 1, 1);
    GG_WAIT_V(6); GG_BAR;
    for (;;) {
        const bool has_next = S.next(ui + 1, nxt);
        if (!has_next) nxt = cur;
        if (GATHER) { if (has_next) { GG_GOFF(nxt, nAo); } else {
#pragma unroll
            for (int h = 0; h < 2; ++h)
#pragma unroll
                for (int i = 0; i < 2; ++i) nAo[h][i] = cAo[h][i]; } }
        for (int t = 0; t < nt; t += 2) {
            const bool last = (t == nt - 2);
            const char* a1 = cur.a + (size_t)(t + 1) * 128;
            const char* a2 = last ? nxt.a : cur.a + (size_t)(t + 2) * 128;
            const char* a3 = a2 + 128;
            unsigned o2[2][2];
#pragma unroll
            for (int h = 0; h < 2; ++h)
#pragma unroll
                for (int i = 0; i < 2; ++i) o2[h][i] = (GATHER && last) ? nAo[h][i] : cAo[h][i];
            const int k2 = last ? 0 : t + 2, k3 = k2 + 1;
            struct { const char* b; const char* b2; } bu; bu.b = last ? nxt.b : cur.b; bu.b2 = last ? nxt.b2 : cur.b2;
            GG_LDB(B0, 0, 0); GG_SCHED; GG_LDA(At, 0, 0); GG_STAGE(GG_SA(1, 1), a1, cAo[1]);
            GG_WAIT_L(8); GG_BAR; GG_WAIT_L(0); GG_MMA(0, 0, At, B0); GG_BAR; GG_SCHED;
            GG_LDB(B1, 0, 1); GG_STAGE_B(GG_SB(0, 0), bu, k2, 0);
            GG_BAR; GG_WAIT_L(0); GG_MMA(0, 1, At, B1); GG_BAR;
            GG_LDA(At, 0, 1); GG_STAGE(GG_SA(0, 0), a2, o2[0]);
            GG_BAR; GG_WAIT_L(0); GG_MMA(1, 0, At, B0); GG_BAR; GG_SCHED;
            GG_STAGE_B(GG_SB(0, 1), bu, k2, 1);
            GG_WAIT_V(6); GG_BAR; GG_MMA(1, 1, At, B1); GG_BAR;
            GG_LDB(B0, 1, 0); GG_SCHED; GG_LDA(At, 1, 0); GG_STAGE(GG_SA(0, 1), a2, o2[1]);
            GG_WAIT_L(8); GG_BAR; GG_WAIT_L(0); GG_MMA(0, 0, At, B0); GG_BAR; GG_SCHED;
            GG_LDB(B1, 1, 1); GG_STAGE_B(GG_SB(1, 0), bu, k3, 0);
            GG_BAR; GG_WAIT_L(0); GG_MMA(0, 1, At, B1); GG_BAR;
            GG_LDA(At, 1, 1); GG_STAGE(GG_SA(1, 0), a3, o2[0]);
            GG_BAR; GG_WAIT_L(0); GG_MMA(1, 0, At, B0); GG_BAR; GG_SCHED;
            GG_STAGE_B(GG_SB(1, 1), bu, k3, 1);
            GG_WAIT_V(6); GG_BAR; GG_MMA(1, 1, At, B1); GG_BAR;
        }
        E(acc, cur, wr, wc, fr, fq);
        if (!has_next) break;
#pragma unroll
        for (int a = 0; a < 2; ++a)
#pragma unroll
            for (int b = 0; b < 2; ++b)
#pragma unroll
                for (int m = 0; m < 4; ++m)
#pragma unroll
                    for (int n = 0; n < 2; ++n) acc[a][b][m][n] = (f32x4){0.f, 0.f, 0.f, 0.f};
        cur = nxt; ++ui;
        if (GATHER) {
#pragma unroll
            for (int h = 0; h < 2; ++h)
#pragma unroll
                for (int i = 0; i < 2; ++i) cAo[h][i] = nAo[h][i]; }
    }
    GG_WAIT_V(0);
    if (wr == 0) GG_BAR;
    GG_BAR;
#undef GG_SA
#undef GG_SB
#undef GG_STAGE
#undef GG_LDA
#undef GG_LDB
#undef GG_MMA
#undef GG_WAIT_V
#undef GG_WAIT_L
#undef GG_BAR
#undef GG_SCHED
#undef GG_BSRC
#undef GG_STAGE_B
#undef GG_GOFF
}

struct DenseSched {
    const char* A; const char* Bt; int nM, nN, G, c; unsigned astep, bstep;
    __device__ __forceinline__ void init(const bf16_t* A_, const bf16_t* Bt_, int M, int N, int lda, int ldb) {
        A = (const char*)A_; Bt = (const char*)Bt_; nM = M / 256; nN = N / 256; G = gridDim.x; c = blockIdx.x; astep = 256u * lda * 2u; bstep = 256u * ldb * 2u; }
    __device__ __forceinline__ bool next(int i, Unit& u) const {
        const int L = i * G + c, nwg = nM * nN; if (L >= nwg) return false;
        int wgid; { const int q = nwg / 8, r = nwg % 8, xcd = L % 8, off = L / 8; wgid = (xcd < r ? xcd * (q + 1) : r * (q + 1) + (xcd - r) * q) + off; }
        const int nig = 8 * nN, gid = wgid / nig, fm = gid * 8, gsz = (nM - fm) < 8 ? (nM - fm) : 8;
        u.pm = fm + ((wgid % nig) % gsz); u.pn = (wgid % nig) / gsz;
        u.a = A + (size_t)u.pm * astep; u.b = Bt + (size_t)u.pn * bstep; u.b2 = nullptr; u.gofs = 0; u.x = 0; return true; }
};
}

constexpr size_t MiB = 1u << 20;
constexpr size_t WS_CTL = 0, CTL_BYTES = 1 * MiB;
constexpr int CW_BAR = 4096, CW_CNT = 8192, CW_CUR = 8192 + 256, CW_NT = 8192 + 512;
constexpr size_t WS_MODP = 1 * MiB, WS_MOD = 3 * MiB, WS_ROPE = 3 * MiB + 256 * 1024, WS_LBV = 3 * MiB + 512 * 1024;
constexpr size_t WS_W_LRU_IN = 4 * MiB, WS_W_LRU_OUT = 8 * MiB, WS_W_LRU_GATE = 10 * MiB;
constexpr size_t WS_W_RWKV_IN = 11 * MiB, WS_W_RWKV_L1 = 17 * MiB, WS_W_RWKV_OUT = 20 * MiB, WS_W_RWKV_WL2 = 556 * MiB;
constexpr size_t WS_W_RET_IN = 22 * MiB, WS_W_RET_OUT = 34 * MiB, WS_W_HGRN_IN = 38 * MiB, WS_W_HGRN_OUT = 48 * MiB;
constexpr size_t WS_MOE = 50 * MiB, MOE_STRIDE = 100 * MiB, MOE_GU = 0, MOE_DN = 64 * MiB, MOE_SHGU = 96 * MiB, MOE_SHDN = 97 * MiB, MOE_RT = 97 * MiB + 512 * 1024;
constexpr size_t WS_H = 450 * MiB, WS_U = 515 * MiB;
constexpr size_t WS_TOPI = 548 * MiB, WS_TOPW = 549 * MiB, WS_POS = 550 * MiB, WS_ROWTOK = 551 * MiB, WS_ROWW = 552 * MiB, WS_TILEE = 553 * MiB;
constexpr size_t WS_SCR = 560 * MiB;
constexpr size_t WS_ULO = WS_SCR + 760 * MiB;
constexpr size_t WS_DUMMY = 1500 * MiB;
constexpr int SH_BASE = 149504;
constexpr int NROWS_SORT = SH_BASE + NTOK;
constexpr size_t WS_ACT = WS_SCR, WS_OUT = WS_SCR + 82 * MiB;
constexpr size_t WS_END = WS_SCR + 880 * MiB;
constexpr size_t WS_MX0 = WS_SCR, WS_MX1 = WS_SCR + 33 * MiB, WS_MX2 = WS_SCR + 66 * MiB, WS_MX3 = WS_SCR + 99 * MiB, WS_MX4 = WS_SCR + 132 * MiB, WS_MX5 = WS_SCR + 165 * MiB;

constexpr int LDS_STAGE = 0, LDS_TAB = 131072, LDS_TAB_BYTES = 20480, LDS_MISC = LDS_TAB + LDS_TAB_BYTES, LDS_BYTES = 155648;

struct Args { const float* in[47]; float* out; unsigned char* ws; int ph_lo, ph_hi; };

struct Frame {
    LAS unsigned char* lds; volatile LAS unsigned* misc; unsigned* ctl; unsigned char* ws;
    int tid, lane, wave, gw, ngw;
    unsigned long long tacc;
};

struct TrJob { const float* src; bf16_t* dst; int ld_src, K, N, ld_dst, nb, sbs, dbs, mode, start; };
constexpr int MAXJOBS = 64;
__device__ __forceinline__ void tr_item(const TrJob& J, int item, LAS unsigned char* scr, int lane) {
    const int nblk = (J.N + 63) >> 6, kblk = J.K >> 6, per = nblk * kblk, bi = item / per, r = item - bi * per, kb = r / nblk, nb = r - kb * nblk, k0 = 64 * kb, n0 = 64 * nb;
    int c0 = n0;
    if (J.mode == 1) { const int pn = n0 >> 8, j = n0 & 255; c0 = (j < 128) ? (128 * pn + j) : (256 + 128 * pn + (j - 128)); }
    const float* W = J.src + (size_t)bi * J.sbs + (size_t)k0 * J.ld_src + c0; bf16_t* WT = J.dst + (size_t)bi * J.dbs + (size_t)n0 * J.ld_dst + k0;
    const int cq = lane & 15, rq = lane >> 4;
    const bool nok = (n0 + 4 * cq) < J.N;
    f32x4 v[16];
#pragma unroll
    for (int i = 0; i < 16; ++i) { v[i] = (f32x4){0.f, 0.f, 0.f, 0.f}; if (nok) v[i] = *(const f32x4*)(W + (size_t)(4 * i + rq) * J.ld_src + 4 * cq); }
#pragma unroll
    for (int i = 0; i < 16; ++i) { const int kk = 4 * i + rq;
#pragma unroll
        for (int e = 0; e < 4; ++e) { float x = v[i][e]; if (J.mode == 3) x = x - bf2f(f2bf(x)); *(LAS unsigned short*)(scr + (4 * cq + e) * 144 + kk * 2) = (unsigned short)f2bf(x); } }
    asm volatile("s_waitcnt lgkmcnt(0)" ::: "memory");
    const int ch = lane & 7, nr = lane >> 3;
#pragma unroll
    for (int j = 0; j < 8; ++j) { const int n = nr + 8 * j; if (n0 + n < J.N) *(u32x4*)(WT + (size_t)n * J.ld_dst + 8 * ch) = *(const LAS u32x4*)(scr + n * 144 + 16 * ch); }
    asm volatile("s_waitcnt lgkmcnt(0)" ::: "memory");
}
__device__ __forceinline__ void ldrow_f32(const float* row, int lane, float (&v)[16]) {
#pragma unroll
    for (int j = 0; j < 2; ++j) { const f32x4 a = *(const f32x4*)(row + 8 * lane + 512 * j), b = *(const f32x4*)(row + 8 * lane + 512 * j + 4);
        v[8 * j + 0] = a.x; v[8 * j + 1] = a.y; v[8 * j + 2] = a.z; v[8 * j + 3] = a.w; v[8 * j + 4] = b.x; v[8 * j + 5] = b.y; v[8 * j + 6] = b.z; v[8 * j + 7] = b.w; }
}
__device__ __forceinline__ void strow_f32(float* row, int lane, const float (&v)[16]) {
#pragma unroll
    for (int j = 0; j < 2; ++j) { *(f32x4*)(row + 8 * lane + 512 * j) = (f32x4){v[8 * j], v[8 * j + 1], v[8 * j + 2], v[8 * j + 3]}; *(f32x4*)(row + 8 * lane + 512 * j + 4) = (f32x4){v[8 * j + 4], v[8 * j + 5], v[8 * j + 6], v[8 * j + 7]}; }
}
__device__ __forceinline__ void ldrow_bf16(const bf16_t* row, int lane, float (&v)[16]) {
#pragma unroll
    for (int j = 0; j < 2; ++j) { const u32x4 a = *(const u32x4*)(row + 8 * lane + 512 * j);
        v[8 * j + 0] = bflo(a.x); v[8 * j + 1] = bfhi(a.x); v[8 * j + 2] = bflo(a.y); v[8 * j + 3] = bfhi(a.y); v[8 * j + 4] = bflo(a.z); v[8 * j + 5] = bfhi(a.z); v[8 * j + 6] = bflo(a.w); v[8 * j + 7] = bfhi(a.w); }
}
__device__ __forceinline__ void addrow_bf16(const bf16_t* row, int lane, float (&v)[16]) {
#pragma unroll
    for (int j = 0; j < 2; ++j) { const u32x4 a = *(const u32x4*)(row + 8 * lane + 512 * j);
        v[8 * j + 0] += bflo(a.x); v[8 * j + 1] += bfhi(a.x); v[8 * j + 2] += bflo(a.y); v[8 * j + 3] += bfhi(a.y); v[8 * j + 4] += bflo(a.z); v[8 * j + 5] += bfhi(a.z); v[8 * j + 6] += bflo(a.w); v[8 * j + 7] += bfhi(a.w); }
}
__device__ __forceinline__ void addrow_fp8(const unsigned char* row, int lane, float (&v)[16]) {
    typedef float f2v __attribute__((ext_vector_type(2)));
#pragma unroll
    for (int j = 0; j < 2; ++j) { const u32x2 a = *(const u32x2*)(row + 8 * lane + 512 * j);
        const f2v p0 = __builtin_amdgcn_cvt_pk_f32_fp8((int)a.x, false), p1 = __builtin_amdgcn_cvt_pk_f32_fp8((int)a.x, true), p2 = __builtin_amdgcn_cvt_pk_f32_fp8((int)a.y, false), p3 = __builtin_amdgcn_cvt_pk_f32_fp8((int)a.y, true);
        v[8 * j + 0] += p0[0]; v[8 * j + 1] += p0[1]; v[8 * j + 2] += p1[0]; v[8 * j + 3] += p1[1]; v[8 * j + 4] += p2[0]; v[8 * j + 5] += p2[1]; v[8 * j + 6] += p3[0]; v[8 * j + 7] += p3[1]; }
}
__device__ __forceinline__ void strow_bf16(bf16_t* row, int lane, const float (&v)[16]) {
#pragma unroll
    for (int j = 0; j < 2; ++j) { u32x4 o; o.x = pk2(v[8 * j], v[8 * j + 1]); o.y = pk2(v[8 * j + 2], v[8 * j + 3]); o.z = pk2(v[8 * j + 4], v[8 * j + 5]); o.w = pk2(v[8 * j + 6], v[8 * j + 7]);
        *(u32x4*)(row + 8 * lane + 512 * j) = o; }
}

#define add(src_, wsoff_, ld_src_, K_, N_, ld_dst_, nb_, sbs_, dbs_, mode_) do { TrJob J; J.src = (src_); J.dst = (bf16_t*)(a.ws + (wsoff_)); J.ld_src = (ld_src_); J.K = (K_); J.N = (N_); J.ld_dst = (ld_dst_); \
            J.nb = (nb_); J.sbs = (sbs_); J.dbs = (dbs_); J.mode = (mode_); J.start = start; jobs[n] = J; start += (nb_) * ((K_) / 64) * (((N_) + 63) / 64); ++n; } while (0)
__device__ __forceinline__ void add_moe_jobs(TrJob* jobs, int& n, int& start, const Args& a, int l) {
    const size_t mb = WS_MOE + l * MOE_STRIDE;
    add(a.in[43] + (size_t)l * 64 * 1024 * 512, mb + MOE_GU, 512, 1024, 512, 1024, 64, 1024 * 512, 512 * 1024, 1);
    add(a.in[44] + (size_t)l * 64 * 256 * 1024, mb + MOE_DN, 1024, 256, 1024, 256, 64, 256 * 1024, 1024 * 256, 0);
    add(a.in[45] + (size_t)l * 1024 * 512, mb + MOE_SHGU, 512, 1024, 512, 1024, 1, 0, 0, 1);
    add(a.in[46] + (size_t)l * 256 * 1024, mb + MOE_SHDN, 1024, 256, 1024, 256, 1, 0, 0, 0);
    add(a.in[41] + (size_t)l * 1024 * 64, mb + MOE_RT, 64, 1024, 64, 1024, 1, 0, 0, 2);
    add(a.in[41] + (size_t)l * 1024 * 64, mb + MOE_RT + 64 * 1024 * 2, 64, 1024, 64, 1024, 1, 0, 0, 3);
}
constexpr int BG_PER_LAYER = 12512, BG_NJOBS = 28, BG_E0 = 12512, BG_E1 = 27072, BG_E2 = 41120, BG_TOTAL = 53632;
constexpr int BG_NW = 8;
__device__ __forceinline__ void bg_convert(Frame& F, const Args& a, int lo, int hi, int first, int stride, bool active = true) {
    if (lo >= hi) return;
    __syncthreads();
    TrJob* jobs = (TrJob*)(F.lds + LDS_TAB);
    if (F.tid == 0) { int n = 0, start = 0;
        add_moe_jobs(jobs, n, start, a, 0);
        add_moe_jobs(jobs, n, start, a, 1);
        add(a.in[31], WS_W_RET_IN, 6144, 1024, 6144, 1024, 1, 0, 0, 0);
        add(a.in[35], WS_W_RET_OUT, 1024, 2048, 1024, 2048, 1, 0, 0, 0);
        add_moe_jobs(jobs, n, start, a, 2);
        add(a.in[36], WS_W_HGRN_IN, 5120, 1024, 5120, 1024, 1, 0, 0, 0);
        add(a.in[40], WS_W_HGRN_OUT, 1024, 1024, 1024, 1024, 1, 0, 0, 0);
        add_moe_jobs(jobs, n, start, a, 3);
        { TrJob J = jobs[n - 1]; J.start = start; J.nb = 0; jobs[n] = J; } }
    __syncthreads();
    LAS unsigned char* scr = F.lds + LDS_STAGE + F.wave * 16384;
    if (active) for (int it = lo + first; it < hi; it += stride) {
        int j = 0; while (j + 1 < BG_NJOBS && jobs[j + 1].start <= it) ++j;
        const TrJob J = jobs[j];
        tr_item(J, it - J.start, scr, F.lane);
    }
    __syncthreads();
}
enum BgEv { EV_LRU_IN, EV_S1, EV_CARRY, EV_S3, EV_LRU_OUT, EV_C0, EV_ROUTE0, EV_RW_IN, EV_RW_L2, EV_RW_CHUNK, EV_RW_PREFIX, EV_RW_OUT, EV_C1, EV_ROUTE1,
            EV_RET_IN, EV_RET_P, EV_RET_KV, EV_RET_O, EV_RET_OUT, EV_C2, EV_ROUTE2, EV_HG_IN, EV_HG_C0, EV_HG_PREFIX, EV_HG_C1, EV_C3 };
template <int EV>
__device__ __forceinline__ void bg_range(int G, int& lo, int& hi, int& nidle, int& rem) {
    int ptr = 0; lo = hi = 0; nidle = 0; rem = 0;
#define BG_SLOT(e, rem_, q) if (EV >= (e)) { const int r_ = (rem_), ni_ = G > r_ ? G - r_ : 0; lo = ptr; hi = min(ptr + ((q) * ni_ * 8) / 2, BG_TOTAL); ptr = hi; nidle = ni_; rem = r_; }
#define BG_CATCH(e, end_) if (EV >= (e)) { lo = ptr; hi = max(ptr, (end_)); ptr = hi; nidle = 0; rem = 0; }
    BG_SLOT(EV_LRU_IN, 520 % G, BQ(3)) BG_SLOT(EV_S1, 8, BQ(7)) BG_SLOT(EV_CARRY, 4, 0) BG_SLOT(EV_S3, 8, BQ(7)) BG_SLOT(EV_LRU_OUT, 260 % G, BQ(3)) BG_CATCH(EV_C0, BG_E0)
    BG_SLOT(EV_ROUTE0, 1040 % G, 0) BG_SLOT(EV_RW_IN, 975 % G, 0) BG_SLOT(EV_RW_L2, 1300 % G, 0) BG_SLOT(EV_RW_CHUNK, 32, BQ(7)) BG_SLOT(EV_RW_PREFIX, 128, 0) BG_SLOT(EV_RW_OUT, 260 % G, BQ(3)) BG_CATCH(EV_C1, BG_E1)
    BG_SLOT(EV_ROUTE1, 1040 % G, 0) BG_SLOT(EV_RET_IN, 1560 % G, BQ(3)) BG_SLOT(EV_RET_P, 260 % G, 0) BG_SLOT(EV_RET_KV, 1040 % G, 0) BG_SLOT(EV_RET_O, 520 % G, BQ(3)) BG_SLOT(EV_RET_OUT, 260 % G, BQ(7)) BG_CATCH(EV_C2, BG_E2)
    BG_SLOT(EV_ROUTE2, 1040 % G, 0) BG_SLOT(EV_HG_IN, 1300 % G, BQ(3)) BG_SLOT(EV_HG_C0, 1040 % G, BQ(3)) BG_SLOT(EV_HG_PREFIX, 128, 0) BG_SLOT(EV_HG_C1, 1040 % G, BQ(7)) BG_CATCH(EV_C3, BG_TOTAL)
#undef BG_SLOT
#undef BG_CATCH
}
template <int EV>
__device__ __forceinline__ void bg_slot(Frame& F, const Args& a) {
    int lo, hi, nidle, rem; bg_range<EV>((int)gridDim.x, lo, hi, nidle, rem);
    const int c = (int)blockIdx.x;
    if (nidle > 0 && c >= rem) { unsigned long long t0 = 0; if (TPROBE) t0 = __builtin_amdgcn_s_memrealtime(); bg_convert(F, a, lo, hi, (c - rem) * BG_NW + F.wave, nidle * BG_NW, F.wave < BG_NW); if (TPROBE) F.tacc += __builtin_amdgcn_s_memrealtime() - t0; }
}
template <int EV>
__device__ __forceinline__ void bg_catch(Frame& F, const Args& a) {
    int lo, hi, nidle, rem; bg_range<EV>((int)gridDim.x, lo, hi, nidle, rem);
    bg_convert(F, a, lo, hi, F.gw, F.ngw);
}

__device__ __forceinline__ void p0_phase(Frame& F, const Args& a) {
    TrJob* jobs = (TrJob*)(F.lds + LDS_TAB);
    int* njobs = (int*)(F.lds + LDS_TAB + MAXJOBS * sizeof(TrJob));
    if (F.tid == 0) {
        int n = 0, start = 0;
        add(a.in[8], WS_W_LRU_IN, 2048, 1024, 2048, 1024, 1, 0, 0, 0);
        add(a.in[14], WS_W_LRU_OUT, 1024, 1024, 1024, 1024, 1, 0, 0, 0);
        add(a.in[11], WS_W_LRU_GATE, 64, 64, 64, 64, 64, 4096, 4096, 0);
        add(a.in[16], WS_W_RWKV_IN, 1024, 1024, 1024, 1024, 3, 1024 * 1024, 1024 * 1024, 0);
        add(a.in[18], WS_W_RWKV_L1, 64, 1024, 64, 1024, 2, 1024 * 64, 64 * 1024, 0);
        add(a.in[21], WS_W_RWKV_L1 + 256 * 1024 * 2, 64, 1024, 64, 1024, 2, 1024 * 64, 64 * 1024, 0);
        add(a.in[23], WS_W_RWKV_L1 + 512 * 1024 * 2, 128, 1024, 128, 1024, 1, 0, 0, 0);
        add(a.in[19], WS_W_RWKV_WL2, 1024, 64, 1024, 256, 1, 0, 0, 0);
        add(a.in[19] + 64 * 1024, WS_W_RWKV_WL2 + (size_t)(1 * 1024 * 256 + 64) * 2, 1024, 64, 1024, 256, 1, 0, 0, 0);
        add(a.in[22], WS_W_RWKV_WL2 + (size_t)(2 * 1024 * 256) * 2, 1024, 64, 1024, 256, 1, 0, 0, 0);
        add(a.in[22] + 64 * 1024, WS_W_RWKV_WL2 + (size_t)(3 * 1024 * 256 + 64) * 2, 1024, 64, 1024, 256, 1, 0, 0, 0);
        add(a.in[24], WS_W_RWKV_WL2 + (size_t)(4 * 1024 * 256) * 2, 1024, 128, 1024, 256, 1, 0, 0, 0);
        add(a.in[30], WS_W_RWKV_OUT, 1024, 1024, 1024, 1024, 1, 0, 0, 0);
        { TrJob J = jobs[n - 1]; J.start = start; J.nb = 0; jobs[n] = J; }
        *njobs = n;
#undef add
    }
    __syncthreads();
    const int nj = *njobs, total = jobs[nj].start;
    LAS unsigned char* scr = F.lds + LDS_STAGE + F.wave * 16384;
    for (int it = F.gw; it < total; it += F.ngw) {
        int j = 0; while (j + 1 < nj && jobs[j + 1].start <= it) ++j;
        const TrJob J = jobs[j];
        tr_item(J, it - J.start, scr, F.lane);
    }
    { u32x4* z = (u32x4*)(a.ws + WS_W_RWKV_L1); const u32x4 zero = {0u, 0u, 0u, 0u};
      for (int i = blockIdx.x * NTHREADS + F.tid; i < 3 * 128 * 128; i += gridDim.x * NTHREADS) { const int blk = i / (128 * 128), r = i % (128 * 128); z[(size_t)(blk * 256 + 128) * 128 + r] = zero; } }
    { u32x4* z = (u32x4*)(a.ws + WS_W_RWKV_WL2); const u32x4 zero = {0u, 0u, 0u, 0u};
      for (int i = blockIdx.x * NTHREADS + F.tid; i < 5 * 1024 * 32; i += gridDim.x * NTHREADS) { const int g = i / (1024 * 32), c8 = (i & 31) * 8;
          const int lo = (g == 1 || g == 3) ? 64 : 0, hi = (g == 4) ? 128 : lo + 64; if (c8 < lo || c8 >= hi) z[i] = zero; } }
    const float* cvec = a.in[1]; const float* ccvec = a.in[3]; const float* adaw = a.in[4];
    float* modp = (float*)(a.ws + WS_MODP);
    for (int it = F.wave * (int)gridDim.x + (int)blockIdx.x; it < 4 * 24 * 8; it += F.ngw) {
        const int s = it & 7, cb = (it >> 3) % 24, l = it / 192, j = cb * 256 + 4 * F.lane;
        const float* W = adaw + ((size_t)l * 1024 + s * 128) * 6144 + j;
        f32x4 al = {0.f, 0.f, 0.f, 0.f}, ac = {0.f, 0.f, 0.f, 0.f};
#pragma unroll 16
        for (int k = 0; k < 128; ++k) { const f32x4 w = *(const f32x4*)(W + (size_t)k * 6144); const float sl = siluf_(cvec[s * 128 + k]), sc = siluf_(ccvec[s * 128 + k]); al += sl * w; ac += sc * w; }
        *(f32x4*)(modp + ((size_t)(s * 4 + l) * 2 + 0) * 6144 + j) = al; *(f32x4*)(modp + ((size_t)(s * 4 + l) * 2 + 1) * 6144 + j) = ac;
    }
    { const int gt = blockIdx.x * NTHREADS + F.tid, ngt = gridDim.x * NTHREADS;
      float* rope = (float*)(a.ws + WS_ROPE);
      for (int i = gt; i < 256 * 64; i += ngt) { const int p = i >> 6, f = i & 63; const double ang = (double)p * pow(10000.0, -(double)f / 64.0); rope[i] = (float)cos(ang); rope[256 * 64 + i] = (float)sin(ang); }
      float* lbv = (float*)(a.ws + WS_LBV); const float* hl = a.in[38];
      for (int i = gt; i < 1024; i += ngt) { const float x0 = hl[i], x1 = hl[1024 + i], x2 = hl[2048 + i], x3 = hl[3072 + i]; const float m = fmaxf(fmaxf(x0, x1), fmaxf(x2, x3));
          const float e0 = expf(x0 - m), e1 = expf(x1 - m), e2 = expf(x2 - m), e3 = expf(x3 - m); lbv[i] = (e1 + e2 + e3) / (e0 + e1 + e2 + e3); } }
}
__device__ __forceinline__ void p1a_phase(Frame& F, const Args& a) {
    const float* modp = (const float*)(a.ws + WS_MODP); float* mod = (float*)(a.ws + WS_MOD); const float* adab = a.in[5];
    const int gt = blockIdx.x * NTHREADS + F.tid, ngt = gridDim.x * NTHREADS;
    for (int i = gt; i < 4 * 2 * 6144; i += ngt) { const int j = i % 6144, l = i / (2 * 6144);
        float s = adab[l * 6144 + j];
#pragma unroll
        for (int sl = 0; sl < 8; ++sl) s += modp[(size_t)sl * 4 * 2 * 6144 + i];
        mod[i] = s; }
}
__device__ __forceinline__ const float* modptr(const unsigned char* ws, int l, int kind, int which) { return (const float*)(ws + WS_MOD) + ((size_t)(l * 2 + kind) * 6 + which) * 1024; }
__device__ __forceinline__ void p1b_phase(Frame& F, const Args& a) {
    bf16_t* H = (bf16_t*)(a.ws + WS_H); bf16_t* U = (bf16_t*)(a.ws + WS_U);
    { int* ROWTOK = (int*)(a.ws + WS_ROWTOK); float* ROWW = (float*)(a.ws + WS_ROWW);
      for (int t = blockIdx.x * NTHREADS + F.tid; t < NTOK; t += gridDim.x * NTHREADS) { ROWTOK[SH_BASE + t] = t; ROWW[SH_BASE + t] = 1.0f; } }
    for (int t = F.gw; t < NTOK; t += F.ngw) {
        const int kind = t < NCTX ? 1 : 0; const float* src = kind ? a.in[2] + (size_t)t * D : a.in[0] + (size_t)(t - NCTX) * D;
        float v[16], m0[16], m1[16]; ldrow_f32(src, F.lane, v); ldrow_f32(modptr(a.ws, 0, kind, 0), F.lane, m0); ldrow_f32(modptr(a.ws, 0, kind, 1), F.lane, m1);
        strow_bf16(H + (size_t)t * D, F.lane, v);
#pragma unroll
        for (int e = 0; e < 16; ++e) v[e] = v[e] * (1.0f + m1[e]) + m0[e];
        strow_bf16(U + (size_t)t * D, F.lane, v);
    }
}

template <int L, int MODE, bool DRY = false>
__device__ __forceinline__ void ln_phase(Frame& F, const Args& a) {
    bf16_t* H = (bf16_t*)(a.ws + WS_H); bf16_t* U = (bf16_t*)(a.ws + WS_U);
    bf16_t* Hw = DRY ? (bf16_t*)(a.ws + WS_DUMMY) : H; bf16_t* Uw = DRY ? (bf16_t*)(a.ws + WS_DUMMY + 70 * MiB) : U; float* outw = DRY ? (float*)(a.ws + WS_DUMMY) : a.out;
    const bf16_t* Y = (const bf16_t*)(a.ws + WS_MX5); const unsigned char* OUT = (const unsigned char*)(a.ws + WS_OUT); const int* POS = (const int*)(a.ws + WS_POS);
    const float* lg = a.in[6] + (size_t)(L * 2 + MODE) * D; const float* lb = a.in[7] + (size_t)(L * 2 + MODE) * D;
    constexpr bool LASTL = (L == 3);
#pragma unroll 1
    for (int kind = 0; kind < 2; ++kind) {
        if (LASTL && kind == 1) break;
        float mg[16], g[16], b[16], msh[16], msc[16];
        ldrow_f32(modptr(a.ws, L, kind, MODE == 0 ? 2 : 5), F.lane, mg); ldrow_f32(lg, F.lane, g); ldrow_f32(lb, F.lane, b);
        if (MODE == 0) { ldrow_f32(modptr(a.ws, L, kind, 3), F.lane, msh); ldrow_f32(modptr(a.ws, L, kind, 4), F.lane, msc); }
        else if (!LASTL) { ldrow_f32(modptr(a.ws, (L + 1) & 3, kind, 0), F.lane, msh); ldrow_f32(modptr(a.ws, (L + 1) & 3, kind, 1), F.lane, msc); }
        const int t0 = kind ? 0 : NCTX, t1 = kind ? NCTX : NTOK;
#pragma unroll 1
        for (int t = t0 + F.gw; t < t1; t += F.ngw) {
            float h[16], y[16];
            ldrow_bf16(H + (size_t)t * D, F.lane, h);
            if (MODE == 0) ldrow_bf16(Y + (size_t)t * D, F.lane, y);
            else if (!EN_MOE) {
#pragma unroll
                for (int e = 0; e < 16; ++e) y[e] = 0.f;
            } else {
                int p = 0; if (F.lane < 8) p = POS[t * 8 + F.lane];
#pragma unroll
                for (int e = 0; e < 16; ++e) y[e] = 0.f;
                addrow_fp8(OUT + (size_t)(SH_BASE + t) * D, F.lane, y);
#pragma unroll
                for (int s = 0; s < 8; ++s) { const int r = __builtin_amdgcn_readlane(p, s); addrow_fp8(OUT + (size_t)r * D, F.lane, y); }
            }
            float s = 0.f;
#pragma unroll
            for (int e = 0; e < 16; ++e) { h[e] = ALPHA * h[e] + mg[e] * y[e]; s += h[e]; }
            const float mean = wave_sum(s) * (1.0f / D); float q = 0.f;
#pragma unroll
            for (int e = 0; e < 16; ++e) { h[e] -= mean; q += h[e] * h[e]; }
            const float rstd = 1.0f / sqrtf(wave_sum(q) * (1.0f / D) + LN_EPS);
#pragma unroll
            for (int e = 0; e < 16; ++e) h[e] = h[e] * rstd * g[e] + b[e];
            if (MODE == 1 && LASTL) { strow_f32(outw + (size_t)(t - NCTX) * D, F.lane, h); }
            else {
                strow_bf16(Hw + (size_t)t * D, F.lane, h);
#pragma unroll
                for (int e = 0; e < 16; ++e) h[e] = h[e] * (1.0f + msc[e]) + msh[e];
                strow_bf16(Uw + (size_t)t * D, F.lane, h);

            }
        }
    }
}

template <int L, bool DRY = false>
__device__ __forceinline__ void moe_route_phase(Frame& F, const Args& a) {
    const bf16_t* U = (const bf16_t*)(a.ws + WS_U); const bf16_t* ULO = (const bf16_t*)(a.ws + WS_ULO);
    const bf16_t* Rhi = (const bf16_t*)(a.ws + WS_MOE + L * MOE_STRIDE + MOE_RT); const bf16_t* Rlo = Rhi + 64 * 1024;
    const float* bias = a.in[42] + L * 64;
    int* TOPI = (int*)(a.ws + (DRY ? WS_DUMMY : WS_TOPI)); float* TOPW = (float*)(a.ws + (DRY ? WS_DUMMY + 4 * MiB : WS_TOPW));
    LAS float* part = (LAS float*)(F.lds + LDS_STAGE);
    const int lane = F.lane, r16 = lane & 15, q = lane >> 4, w = F.wave;
    bf16x8 Bh[4][4], Bl[4][4];
#pragma unroll
    for (int n = 0; n < 4; ++n)
#pragma unroll
        for (int ks = 0; ks < 4; ++ks) { const size_t o = (size_t)(16 * n + r16) * 1024 + 128 * w + 32 * ks + 8 * q; Bh[n][ks] = *(const bf16x8*)(Rhi + o); Bl[n][ks] = *(const bf16x8*)(Rlo + o); }
    const int g0 = (L == 3) ? NCTX / 16 : 0;
    int cnt_e = 0;
    const float mybias = bias[lane];
    bf16x8 Ahn[4];
    if (g0 + (int)blockIdx.x < NTOK / 16) { const size_t ao = (size_t)((g0 + (int)blockIdx.x) * 16 + r16) * D + 128 * w + 8 * q;
#pragma unroll
        for (int ks = 0; ks < 4; ++ks) Ahn[ks] = *(const bf16x8*)(U + ao + 32 * ks); }
#pragma unroll 1
    for (int grp = g0 + blockIdx.x; grp < NTOK / 16; grp += gridDim.x) {
        bf16x8 Ah[4];
#pragma unroll
        for (int ks = 0; ks < 4; ++ks) Ah[ks] = Ahn[ks];
        if (grp + (int)gridDim.x < NTOK / 16) { const size_t ao = (size_t)((grp + (int)gridDim.x) * 16 + r16) * D + 128 * w + 8 * q;
#pragma unroll
            for (int ks = 0; ks < 4; ++ks) Ahn[ks] = *(const bf16x8*)(U + ao + 32 * ks); }
        f32x4 acc[4];
#pragma unroll
        for (int n = 0; n < 4; ++n) { acc[n] = (f32x4){0.f, 0.f, 0.f, 0.f};
#pragma unroll
            for (int ks = 0; ks < 4; ++ks) {
                acc[n] = __builtin_amdgcn_mfma_f32_16x16x32_bf16(Ah[ks], Bh[n][ks], acc[n], 0, 0, 0);
                acc[n] = __builtin_amdgcn_mfma_f32_16x16x32_bf16(Ah[ks], Bl[n][ks], acc[n], 0, 0, 0); } }
        __syncthreads();
#pragma unroll
        for (int n = 0; n < 4; ++n)
#pragma unroll
            for (int r = 0; r < 4; ++r) part[(w * 16 + 4 * q + r) * 64 + 16 * n + r16] = acc[n][r];
        __syncthreads();
#pragma unroll 1
        for (int rr = 0; rr < 2; ++rr) {
            const int row = 2 * w + rr, t = grp * 16 + row;
            float lgt = 0.f;
#pragma unroll
            for (int ww = 0; ww < 8; ++ww) lgt += part[(ww * 16 + row) * 64 + lane];
            const float sc = sigmoidf_(lgt);
            const float ch = sc + mybias;
            float m1 = -INFINITY, m2 = -INFINITY;
#pragma unroll
            for (int j = 0; j < 8; ++j) { const float v = __shfl(ch, (lane & ~7) + j); if (v > m1) { m2 = m1; m1 = v; } else if (v > m2) m2 = v; }
            const float gs = m1 + m2; const int g = lane >> 3;
            int grank = 0;
#pragma unroll
            for (int gg2 = 0; gg2 < 8; ++gg2) { const float v = __shfl(gs, 8 * gg2); grank += (v > gs || (v == gs && gg2 < g)) ? 1 : 0; }
            const bool sel = grank < 4;
            const float chm = sel ? ch : -INFINITY;
            int rank = 0;
#pragma unroll
            for (int e2 = 0; e2 < 64; ++e2) { const float v = __builtin_bit_cast(float, __builtin_amdgcn_readlane(__builtin_bit_cast(int, chm), e2)); rank += (v > chm || (v == chm && e2 < lane)) ? 1 : 0; }
            const bool chosen = sel && rank < 8;
            const float wsum = wave_sum(chosen ? sc : 0.f);
            const unsigned long long bal = __ballot(chosen);
            const int slot = __popcll(bal & ((1ull << lane) - 1ull));
            if (chosen) { TOPI[t * 8 + slot] = lane; TOPW[t * 8 + slot] = 2.5f * sc / wsum; cnt_e++; }
        }
    }
    if (cnt_e && !DRY) atomicAdd(F.ctl + CW_CNT + L * 64 + lane, (unsigned)cnt_e);
}

template <int L, bool DRY = false>
__device__ __forceinline__ void moe_dispatch_phase(Frame& F, const Args& a) {
    LAS int* pb = (LAS int*)(F.lds + LDS_TAB);
    if (F.wave == 0) {
        const int cnt = (int)F.ctl[CW_CNT + L * 64 + F.lane]; const int pad = (cnt + 255) & ~255;
        int inc = pad;
#pragma unroll
        for (int o = 1; o < 64; o <<= 1) { const int v = __shfl_up(inc, o); if (F.lane >= o) inc += v; }
        pb[F.lane] = inc - pad; pb[65 + F.lane] = cnt; if (F.lane == 63) pb[64] = inc;
    }
    __syncthreads();
    const int* TOPI = (const int*)(a.ws + WS_TOPI); const float* TOPW = (const float*)(a.ws + WS_TOPW);
    int* POS = (int*)(a.ws + (DRY ? WS_DUMMY : WS_POS)); int* ROWTOK = (int*)(a.ws + (DRY ? WS_DUMMY + 2 * MiB : WS_ROWTOK)); float* ROWW = (float*)(a.ws + (DRY ? WS_DUMMY + 4 * MiB : WS_ROWW)); int* TILEE = (int*)(a.ws + (DRY ? WS_DUMMY + 6 * MiB : WS_TILEE));
    const int p0 = (L == 3) ? NCTX * 8 : 0;
    LAS int* lcnt = pb + 160; LAS int* lbase = pb + 224;
    const int npairs = NTOK * 8 - p0, per = (npairs + (int)gridDim.x - 1) / (int)gridDim.x, lo = p0 + (int)blockIdx.x * per, hi = min(lo + per, NTOK * 8);
#pragma unroll 1
    for (int c0 = lo; c0 < hi; c0 += NTHREADS) {
        if (F.tid < 64) lcnt[F.tid] = 0;
        __syncthreads();
        const int p = c0 + F.tid; const bool ok = p < hi; int e = 0, lrank = 0;
        if (ok) { e = TOPI[p]; lrank = atomicAdd((int*)(lcnt + e), 1); }
        __syncthreads();
        if (F.tid < 64) { const int c = lcnt[F.tid]; lbase[F.tid] = pb[F.tid] + (c ? (int)atomicAdd(F.ctl + CW_CUR + (DRY ? 1024 : 0) + L * 64 + F.tid, (unsigned)c) : 0); }
        __syncthreads();
        if (ok) { const int dest = lbase[e] + lrank; POS[p] = dest; ROWTOK[dest] = p >> 3; ROWW[dest] = TOPW[p]; }
        __syncthreads();
    }
    if (blockIdx.x < 64) {
        const int e = blockIdx.x, base = pb[e], cnt = pb[65 + e], pad = (cnt + 255) & ~255;
        for (int r = cnt + F.tid; r < pad; r += NTHREADS) { ROWTOK[base + r] = NCTX; ROWW[base + r] = 0.f; }
        for (int tl = F.tid; tl < pad / 256; tl += NTHREADS) TILEE[base / 256 + tl] = e;
    }
    if (blockIdx.x == 64 && F.tid == 0 && !DRY) F.ctl[CW_NT + L] = (unsigned)(pb[64] / 256);
    __syncthreads();
}

struct ListSched {
    const LAS gg::Unit* tab; int n;
    __device__ __forceinline__ bool next(int i, gg::Unit& u) const {
        if (i >= n) return false;
        const LAS unsigned* p = (const LAS unsigned*)(tab + i); unsigned w[10];
#pragma unroll
        for (int k = 0; k < 10; ++k) w[k] = (unsigned)__builtin_amdgcn_readfirstlane((int)p[k]);
        u.a = (const char*)(((unsigned long long)w[1] << 32) | w[0]); u.b = (const char*)(((unsigned long long)w[3] << 32) | w[2]); u.b2 = (const char*)(((unsigned long long)w[5] << 32) | w[4]);
        u.pm = (int)w[6]; u.pn = (int)w[7]; u.gofs = (int)w[8]; u.x = (int)w[9]; return true; }
};
static_assert(sizeof(gg::Unit) == 40, "Unit layout");

struct EpiSwiglu {
    static constexpr bool PERM = true;
    bf16_t* ACT; LAS unsigned char* lds;
    __device__ __forceinline__ void operator()(const gg::Acc& acc, const gg::Unit& u, int wr, int wc, int fr, int fq) const {
        const int row0 = u.pm * 256 + wr * 64 + fr, col0 = u.pn * 128 + wc * 32 + 8 * fq;
        const LAS float* wl = (const LAS float*)(lds + u.gofs + 8192);
#pragma unroll
        for (int ai = 0; ai < 2; ++ai)
#pragma unroll
            for (int m = 0; m < 4; ++m) { const int row = row0 + ai * 128 + m * 16; const float w = wl[wr * 64 + fr + ai * 128 + m * 16];
                const f32x4 g0 = acc[ai][0][m][0], g1 = acc[ai][0][m][1], u0 = acc[ai][1][m][0], u1 = acc[ai][1][m][1];
                u32x4 o; o.x = pk2(siluf_(g0[0]) * u0[0] * w, siluf_(g0[1]) * u0[1] * w); o.y = pk2(siluf_(g0[2]) * u0[2] * w, siluf_(g0[3]) * u0[3] * w);
                o.z = pk2(siluf_(g1[0]) * u1[0] * w, siluf_(g1[1]) * u1[1] * w); o.w = pk2(siluf_(g1[2]) * u1[2] * w, siluf_(g1[3]) * u1[3] * w);
                *(u32x4*)(ACT + (size_t)row * 256 + col0) = o; }
    }
};
struct EpiBf16 {
    static constexpr bool PERM = true;
    bf16_t* O; int ldc;
    __device__ __forceinline__ void operator()(const gg::Acc& acc, const gg::Unit& u, int wr, int wc, int fr, int fq) const {
        const int row0 = u.pm * 256 + wr * 64 + fr, col0 = u.pn * 256 + wc * 32 + 8 * fq;
#pragma unroll
        for (int ai = 0; ai < 2; ++ai)
#pragma unroll
            for (int m = 0; m < 4; ++m) { bf16_t* rp = O + (size_t)(row0 + ai * 128 + m * 16) * ldc + col0;
#pragma unroll
                for (int bj = 0; bj < 2; ++bj) { const f32x4 v0 = acc[ai][bj][m][0], v1 = acc[ai][bj][m][1];
                    u32x4 o; o.x = pk2(v0[0], v0[1]); o.y = pk2(v0[2], v0[3]); o.z = pk2(v1[0], v1[1]); o.w = pk2(v1[2], v1[3]);
                    *(u32x4*)(rp + bj * 128) = o; } }
    }
};

__device__ __forceinline__ unsigned pk4_fp8(float a, float b, float c, float d) { int w = __builtin_amdgcn_cvt_pk_fp8_f32(a, b, 0, false); w = __builtin_amdgcn_cvt_pk_fp8_f32(c, d, w, true); return (unsigned)w; }
struct EpiFp8 {
    static constexpr bool PERM = true;
    unsigned char* O; int rmask;
    __device__ __forceinline__ void operator()(const gg::Acc& acc, const gg::Unit& u, int wr, int wc, int fr, int fq) const {
        const int row0 = (u.pm * 256 + wr * 64 + fr) & rmask, col0 = u.pn * 256 + wc * 32 + 8 * fq;
#pragma unroll
        for (int ai = 0; ai < 2; ++ai)
#pragma unroll
            for (int m = 0; m < 4; ++m) { unsigned char* rp = O + (size_t)((row0 + ai * 128 + m * 16) & rmask) * 1024 + col0;
#pragma unroll
                for (int bj = 0; bj < 2; ++bj) { const f32x4 v0 = acc[ai][bj][m][0], v1 = acc[ai][bj][m][1];
                    u32x2 o; o.x = pk4_fp8(v0[0], v0[1], v0[2], v0[3]); o.y = pk4_fp8(v1[0], v1[1], v1[2], v1[3]);
                    *(u32x2*)(rp + bj * 128) = o; } }
    }
};
template <int L>
__device__ __forceinline__ void moe_gateup_phase(Frame& F, const Args& a) {
    const int ntr = (int)F.ctl[CW_NT + L]; constexpr int s0 = (L == 3) ? 1 : 0; const int nsh = 65 - s0, nunits = (ntr + nsh) * 2;
    gg::Unit* tab = (gg::Unit*)(F.lds + LDS_TAB); LAS int* idx = (LAS int*)(F.lds + LDS_TAB + 512);
    const int* ROWTOK = (const int*)(a.ws + WS_ROWTOK); const int* TILEE = (const int*)(a.ws + WS_TILEE); const float* ROWW = (const float*)(a.ws + WS_ROWW);
    const char* Wgu = (const char*)(a.ws + WS_MOE + L * MOE_STRIDE + MOE_GU); const char* Wsh = (const char*)(a.ws + WS_MOE + L * MOE_STRIDE + MOE_SHGU);
    int nmine = 0;
    for (int i = 0; i < 8; ++i) { const int Lq = i * (int)gridDim.x + (int)blockIdx.x; if (Lq >= nunits) break; nmine = i + 1;
        int uidx; { const int q8 = nunits / 8, r8 = nunits % 8, xcd = Lq % 8, off = Lq / 8; uidx = (xcd < r8 ? xcd * (q8 + 1) : r8 * (q8 + 1) + (xcd - r8) * q8) + off; }
        const int tile = uidx >> 1, pn = uidx & 1; const bool routed = tile < ntr;
        const int rowtile = routed ? tile : (SH_BASE / 256 + s0 + (tile - ntr));
        if (F.tid == 0) { gg::Unit u; u.a = (const char*)(a.ws + WS_U); u.b = routed ? Wgu + ((size_t)TILEE[tile] * 512 + pn * 256) * 2048 : Wsh + (size_t)(pn * 256) * 2048; u.b2 = nullptr;
            u.pm = rowtile; u.pn = pn; u.gofs = LDS_TAB + 512 + i * 1024; u.x = 0; tab[i] = u; }
        if (F.tid < 256) { idx[i * 256 + F.tid] = ROWTOK[rowtile * 256 + F.tid]; ((LAS float*)(F.lds + LDS_TAB + 512 + 8192))[i * 256 + F.tid] = ROWW[rowtile * 256 + F.tid]; }
    }
    __syncthreads();
    ListSched S{(const LAS gg::Unit*)(F.lds + LDS_TAB), nmine}; EpiSwiglu E{(bf16_t*)(a.ws + WS_ACT), F.lds};
    gg::gemm_phase<EpiSwiglu, ListSched, true, false>(F.lds + LDS_STAGE, gg::Dims{1024, 1024, 1024, 0, 0}, S, E);
}
struct EpiFp8S {
    static constexpr bool PERM = true;
    unsigned char* O; LAS unsigned char* slab;
    __device__ __forceinline__ void operator()(const gg::Acc& acc, const gg::Unit& u, int wr, int wc, int fr, int fq) const {
        int t = threadIdx.x; asm volatile("" : "+v"(t));
        const int rrow = t >> 4, rchunk = t & 15;
#pragma unroll
        for (int ai = 0; ai < 2; ++ai)
#pragma unroll
            for (int m = 0; m < 4; ++m) { const int sidx = ai * 4 + m; LAS unsigned char* sb = slab + (sidx & 1) * (32 * 264);
#pragma unroll
                for (int bj = 0; bj < 2; ++bj) { const f32x4 v0 = acc[ai][bj][m][0], v1 = acc[ai][bj][m][1];
                    u32x2 o; o.x = pk4_fp8(v0[0], v0[1], v0[2], v0[3]); o.y = pk4_fp8(v1[0], v1[1], v1[2], v1[3]);
                    *(LAS u32x2*)(sb + (wr * 16 + fr) * 264 + wc * 32 + 8 * fq + bj * 128) = o; }
                __builtin_amdgcn_s_waitcnt(0xc07f); __builtin_amdgcn_s_barrier();
                const u32x4 v = { *(const LAS unsigned*)(sb + rrow * 264 + rchunk * 16), *(const LAS unsigned*)(sb + rrow * 264 + rchunk * 16 + 4), *(const LAS unsigned*)(sb + rrow * 264 + rchunk * 16 + 8), *(const LAS unsigned*)(sb + rrow * 264 + rchunk * 16 + 12) };
                const int grow = u.pm * 256 + (rrow >> 4) * 64 + (rrow & 15) + ai * 128 + m * 16;
                *(u32x4*)(O + (size_t)grow * 1024 + u.pn * 256 + rchunk * 16) = v; }
    }
};
template <int L, int MODE = 0>
__device__ __forceinline__ void moe_down_phase(Frame& F, const Args& a) {
    constexpr bool DRY = MODE == 1;
    const int ntr = (int)F.ctl[CW_NT + L]; constexpr int s0 = (L == 3) ? 1 : 0; const int nsh = 65 - s0, nunits = (ntr + nsh) * 4;
    gg::Unit* tab = (gg::Unit*)(F.lds + LDS_TAB);
    const int* TILEE = (const int*)(a.ws + WS_TILEE);
    const char* Wdn = (const char*)(a.ws + WS_MOE + L * MOE_STRIDE + MOE_DN); const char* Wsh = (const char*)(a.ws + WS_MOE + L * MOE_STRIDE + MOE_SHDN);
    int nmine = 0;
    for (int i = 0; i < 12; ++i) { const int Lq = i * (int)gridDim.x + (int)blockIdx.x; if (Lq >= nunits) break; nmine = i + 1;
        int uidx; { const int q8 = nunits / 8, r8 = nunits % 8, xcd = Lq % 8, off = Lq / 8; uidx = (xcd < r8 ? xcd * (q8 + 1) : r8 * (q8 + 1) + (xcd - r8) * q8) + off; }
        const int tile = uidx >> 2, pn = uidx & 3; const bool routed = tile < ntr;
        const int rowtile = routed ? tile : (SH_BASE / 256 + s0 + (tile - ntr));
        if (F.tid == 0) { gg::Unit u; u.a = (const char*)(a.ws + WS_ACT) + (size_t)rowtile * 256 * 512; u.b = routed ? Wdn + ((size_t)TILEE[tile] * 1024 + pn * 256) * 512 : Wsh + (size_t)(pn * 256) * 512; u.b2 = nullptr;
            u.pm = rowtile; u.pn = pn; u.gofs = 0; u.x = 0; tab[i] = u; }
    }
    __syncthreads();
    ListSched S{(const LAS gg::Unit*)(F.lds + LDS_TAB), nmine};
    if (MODE == 3 || MODE == 4) { EpiFp8S E{(unsigned char*)(a.ws + (MODE == 3 ? WS_DUMMY : WS_OUT)), F.lds + LDS_TAB + 2048};
        gg::gemm_phase<EpiFp8S, ListSched, false, false>(F.lds + LDS_STAGE, gg::Dims{256, 256, 256, 0, 0}, S, E); }
    else { EpiFp8 E{(unsigned char*)(a.ws + (MODE == 0 ? WS_OUT : WS_DUMMY)), DRY ? 63 : 0x7fffffff};
        gg::gemm_phase<EpiFp8, ListSched, false, false>(F.lds + LDS_STAGE, gg::Dims{256, 256, 256, 0, 0}, S, E); }
}

__device__ __forceinline__ int xcd_remap(int L, int n) { const int q8 = n / 8, r8 = n % 8, xcd = L % 8, off = L / 8; return (xcd < r8 ? xcd * (q8 + 1) : r8 * (q8 + 1) + (xcd - r8) * q8) + off; }
__device__ __forceinline__ float gelu_tanh(float x) { const float z = 0.7978845608028654f * (x + 0.044715f * x * x * x); return x * (1.0f - __builtin_amdgcn_rcpf(1.0f + __expf(2.0f * z))); }
struct EpiLruIn {
    static constexpr bool PERM = true;
    bf16_t* GB; bf16_t* RNN;
    __device__ __forceinline__ void operator()(const gg::Acc& acc, const gg::Unit& u, int wr, int wc, int fr, int fq) const {
        const bool isg = u.pn < 4; bf16_t* O = isg ? GB : RNN;
        const int row0 = u.pm * 256 + wr * 64 + fr, col0 = (u.pn & 3) * 256 + wc * 32 + 8 * fq;
#pragma unroll
        for (int ai = 0; ai < 2; ++ai)
#pragma unroll
            for (int m = 0; m < 4; ++m) { bf16_t* rp = O + (size_t)(row0 + ai * 128 + m * 16) * 1024 + col0;
#pragma unroll
                for (int bj = 0; bj < 2; ++bj) { f32x4 v0 = acc[ai][bj][m][0], v1 = acc[ai][bj][m][1];
                    if (isg) {
#pragma unroll
                        for (int e = 0; e < 4; ++e) { v0[e] = gelu_tanh(v0[e]); v1[e] = gelu_tanh(v1[e]); } }
                    u32x4 o; o.x = pk2(v0[0], v0[1]); o.y = pk2(v0[2], v0[3]); o.z = pk2(v1[0], v1[1]); o.w = pk2(v1[2], v1[3]);
                    *(u32x4*)(rp + bj * 128) = o; } }
    }
};
template <bool REV>
__device__ __forceinline__ void lru_scan16(const float (&a)[4], const float (&b)[4], float (&h)[4], float& hc, float& at, int lane) {
    const int q = lane >> 4;
    float Ar[4], Br[4]; float A = 1.0f, B = 0.0f;
#pragma unroll
    for (int ri = 0; ri < 4; ++ri) { const int r = REV ? 3 - ri : ri; B = a[r] * B + b[r]; A = a[r] * A; Ar[r] = A; Br[r] = B; }
    float As = A, Bs = B;
    { const float pA = REV ? __shfl_down(As, 16) : __shfl_up(As, 16), pB = REV ? __shfl_down(Bs, 16) : __shfl_up(Bs, 16); const bool on = REV ? (q <= 2) : (q >= 1); if (on) { Bs = As * pB + Bs; As = As * pA; } }
    { const float pA = REV ? __shfl_down(As, 32) : __shfl_up(As, 32), pB = REV ? __shfl_down(Bs, 32) : __shfl_up(Bs, 32); const bool on = REV ? (q <= 1) : (q >= 2); if (on) { Bs = As * pB + Bs; As = As * pA; } }
    float eA = REV ? __shfl_down(As, 16) : __shfl_up(As, 16), eB = REV ? __shfl_down(Bs, 16) : __shfl_up(Bs, 16);
    const bool first = REV ? (q == 3) : (q == 0); if (first) { eA = 1.0f; eB = 0.0f; }
    const float Hin = eA * hc + eB;
#pragma unroll
    for (int r = 0; r < 4; ++r) h[r] = Ar[r] * Hin + Br[r];
    const int src = (REV ? 0 : 48) + (lane & 15);
    const float tA = __shfl(As, src), tB = __shfl(Bs, src);
    hc = tA * hc + tB; at *= tA;
}
template <bool SUMMARY>
__device__ __forceinline__ void lru_scan_phase(Frame& F, const Args& a) {
    const bf16_t* RNN = (const bf16_t*)(a.ws + WS_MX1); const bf16_t* GB = (const bf16_t*)(a.ws + WS_MX0); bf16_t* A2 = (bf16_t*)(a.ws + WS_MX2);
    float* SUMM = (float*)(a.ws + WS_MX3); const float* CARRY = (const float*)(a.ws + WS_MX4);
    const bf16_t* Wg = (const bf16_t*)(a.ws + WS_W_LRU_GATE);
    const float* cw = a.in[9]; const float* cb = a.in[10]; const float* gbias = a.in[12]; const float* lam = a.in[13];
    LAS unsigned char* xt = F.lds + LDS_STAGE + F.wave * 17408;
    LAS unsigned char* ot = xt + 9216;
    const int lane = F.lane, c16 = lane & 15, q = lane >> 4, cg = lane & 7, rg = lane >> 3;
#pragma unroll 1
    for (int task = F.gw; task < (NTOK / 64) * 16; task += F.ngw) {
        const int k = task >> 4;
        const int t0 = 64 * k, slo = (k < 4) ? 0 : NCTX, shi = (k < 4) ? NCTX : NTOK;
        {
            const int blk = task & 15, ch0 = blk * 64;
            {
                float w[4][8], bsv[8];
#pragma unroll
                for (int e = 0; e < 8; ++e) { bsv[e] = cb[ch0 + 8 * cg + e];
#pragma unroll
                    for (int j = 0; j < 4; ++j) w[j][e] = cw[j * 1024 + ch0 + 8 * cg + e]; }
#pragma unroll 1
                for (int ps = 0; ps < 2; ++ps) {
                    const int rq = rg + 8 * ps;
                    float xin[7][8];
#pragma unroll
                    for (int rr = 0; rr < 7; ++rr) { const int t = t0 + 4 * rq - 1 + rr; u32x4 v = {0u, 0u, 0u, 0u};
                        if (t >= slo && t < shi) v = *(const u32x4*)(RNN + (size_t)t * 1024 + ch0 + 8 * cg);
                        xin[rr][0] = bflo(v.x); xin[rr][1] = bfhi(v.x); xin[rr][2] = bflo(v.y); xin[rr][3] = bfhi(v.y); xin[rr][4] = bflo(v.z); xin[rr][5] = bfhi(v.z); xin[rr][6] = bflo(v.w); xin[rr][7] = bfhi(v.w); }
#pragma unroll
                    for (int r = 0; r < 4; ++r) { float o[8];
#pragma unroll
                        for (int e = 0; e < 8; ++e) o[e] = bsv[e] + w[0][e] * xin[r][e] + w[1][e] * xin[r + 1][e] + w[2][e] * xin[r + 2][e] + w[3][e] * xin[r + 3][e];
                        u32x4 pk; pk.x = pk2(o[0], o[1]); pk.y = pk2(o[2], o[3]); pk.z = pk2(o[4], o[5]); pk.w = pk2(o[6], o[7]);
                        *(LAS u32x4*)(xt + (4 * rq + r) * 144 + 16 * cg) = pk; }
                }
            }
            asm volatile("s_waitcnt lgkmcnt(0)" ::: "memory");
            bf16x8 Af[4][2];
#pragma unroll
            for (int T = 0; T < 4; ++T)
#pragma unroll
                for (int ks = 0; ks < 2; ++ks) Af[T][ks] = *(const LAS bf16x8*)(xt + (16 * T + c16) * 144 + (32 * ks + 8 * q) * 2);
#pragma unroll
            for (int g4 = 0; g4 < 4; ++g4) {
                const int ch = ch0 + 16 * g4 + c16;
                float xv[4][4];
#pragma unroll
                for (int T = 0; T < 4; ++T)
#pragma unroll
                    for (int r = 0; r < 4; ++r) xv[T][r] = bf2f(*(const LAS unsigned short*)(xt + (16 * T + 4 * q + r) * 144 + (16 * g4 + c16) * 2));
                float hsum[4][4];
#pragma unroll
                for (int d = 0; d < 2; ++d) {
                    f32x4 acc[2][4];
#pragma unroll
                    for (int gt = 0; gt < 2; ++gt) {
                        const bf16_t* wp = Wg + ((size_t)((d * 2 + gt) * 16 + blk) * 64 + 16 * g4 + c16) * 64 + 8 * q;
                        const bf16x8 b0 = *(const bf16x8*)wp, b1 = *(const bf16x8*)(wp + 32);
#pragma unroll
                        for (int T = 0; T < 4; ++T) { f32x4 z = {0.f, 0.f, 0.f, 0.f};
                            z = __builtin_amdgcn_mfma_f32_16x16x32_bf16(Af[T][0], b0, z, 0, 0, 0);
                            acc[gt][T] = __builtin_amdgcn_mfma_f32_16x16x32_bf16(Af[T][1], b1, z, 0, 0, 0); }
                    }
                    const float gb0 = gbias[(d * 2 + 0) * 1024 + ch], gb1 = gbias[(d * 2 + 1) * 1024 + ch];
                    const float lm = lam[d * 1024 + ch]; const float sp = log1pf(__expf(-lm));
                    float hc = 0.0f, at = 1.0f;
                    if (!SUMMARY) hc = CARRY[((size_t)d * 260 + k) * 1024 + ch];
#pragma unroll
                    for (int Ti = 0; Ti < 4; ++Ti) {
                        const int T = d ? 3 - Ti : Ti;
                        float av[4], bv[4], hv[4];
#pragma unroll
                        for (int r = 0; r < 4; ++r) { const float rgate = sigmoidf_(acc[0][T][r] + gb0), ig = sigmoidf_(acc[1][T][r] + gb1);
                            const float la = -8.0f * rgate * sp; const float aa = __expf(la); av[r] = aa; bv[r] = __builtin_amdgcn_sqrtf(fmaxf(1.0f - aa * aa, 0.f)) * ig * xv[T][r]; }
                        if (d == 0) lru_scan16<false>(av, bv, hv, hc, at, lane); else lru_scan16<true>(av, bv, hv, hc, at, lane);
                        if (!SUMMARY) {
#pragma unroll
                            for (int r = 0; r < 4; ++r) hsum[T][r] = (d == 0) ? hv[r] : hsum[T][r] + hv[r]; }
                    }
                    if (SUMMARY) { if (q == 0) { SUMM[((size_t)d * 260 + k) * 1024 + ch] = at; SUMM[((size_t)(2 + d) * 260 + k) * 1024 + ch] = hc; } }
                }
                if (!SUMMARY) {
#pragma unroll
                    for (int T = 0; T < 4; ++T)
#pragma unroll
                        for (int r = 0; r < 4; ++r) *(LAS unsigned short*)(ot + (16 * T + 4 * q + r) * 128 + (16 * g4 + c16) * 2) = (unsigned short)f2bf(hsum[T][r]);
                }
            }
            if (!SUMMARY) {
                asm volatile("s_waitcnt lgkmcnt(0)" ::: "memory");
#pragma unroll
                for (int r = 0; r < 8; ++r) { const int row = 8 * rg + r; const u32x4 hv = *(const LAS u32x4*)(ot + row * 128 + 16 * cg);
                    const u32x4 gv = *(const u32x4*)(GB + (size_t)(t0 + row) * 1024 + ch0 + 8 * cg);
                    u32x4 o; o.x = pk2(bflo(hv.x) * bflo(gv.x), bfhi(hv.x) * bfhi(gv.x)); o.y = pk2(bflo(hv.y) * bflo(gv.y), bfhi(hv.y) * bfhi(gv.y));
                    o.z = pk2(bflo(hv.z) * bflo(gv.z), bfhi(hv.z) * bfhi(gv.z)); o.w = pk2(bflo(hv.w) * bflo(gv.w), bfhi(hv.w) * bfhi(gv.w));
                    *(u32x4*)(A2 + (size_t)(t0 + row) * 1024 + ch0 + 8 * cg) = o; }
            }
            asm volatile("s_waitcnt lgkmcnt(0)" ::: "memory");
        }
    }
}
__device__ __forceinline__ void lru_carry_phase(Frame& F, const Args& a) {
    const float* SUMM = (const float*)(a.ws + WS_MX3); float* CARRY = (float*)(a.ws + WS_MX4);
    const int gid = blockIdx.x * NTHREADS + F.tid; if (gid >= 2048) return;
    const int d = gid >> 10, c = gid & 1023; float h = 0.0f;
    const float* At = SUMM + (size_t)d * 260 * 1024 + c; const float* He = SUMM + (size_t)(2 + d) * 260 * 1024 + c; float* Cy = CARRY + (size_t)d * 260 * 1024 + c;
#pragma unroll 1
    for (int b = 0; b < 10; ++b) {
        float av[26], hv[26]; int kk[26];
#pragma unroll
        for (int j = 0; j < 26; ++j) { const int st = b * 26 + j; kk[j] = d == 0 ? st : (st < 4 ? 3 - st : 263 - st); av[j] = At[(size_t)kk[j] * 1024]; hv[j] = He[(size_t)kk[j] * 1024]; }
#pragma unroll
        for (int j = 0; j < 26; ++j) { Cy[(size_t)kk[j] * 1024] = h; h = av[j] * h + hv[j]; }
    }
}
__device__ __forceinline__ void lru_in_gemm_phase(Frame& F, const Args& a) {
    gg::DenseSched S; S.init((const bf16_t*)(a.ws + WS_U), (const bf16_t*)(a.ws + WS_W_LRU_IN), NTOK, 2048, 1024, 1024);
    EpiLruIn E{(bf16_t*)(a.ws + WS_MX0), (bf16_t*)(a.ws + WS_MX1)};
    gg::gemm_phase<EpiLruIn, gg::DenseSched, false, false>(F.lds + LDS_STAGE, gg::Dims{1024, 1024, 1024, 0, 0}, S, E);
}
__device__ __forceinline__ void dense_gemm_bf16(Frame& F, const bf16_t* A, const bf16_t* Bt, bf16_t* O, int M, int N, int K) {
    gg::DenseSched S; S.init(A, Bt, M, N, K, K);
    EpiBf16 E{O, N};
    gg::gemm_phase<EpiBf16, gg::DenseSched, false, false>(F.lds + LDS_STAGE, gg::Dims{K, K, K, 0, 0}, S, E);
}

constexpr size_t RT_QR = WS_SCR, RT_KR = WS_SCR + 33 * MiB, RT_V = WS_SCR + 66 * MiB, RT_SG = WS_SCR + 132 * MiB, RT_ACAT = WS_SCR + 198 * MiB, RT_KTD = WS_SCR + 301 * MiB,
                 RT_VT = WS_SCR + 367 * MiB, RT_ST = WS_SCR + 433 * MiB, RT_O = WS_SCR + 564 * MiB, RT_A3 = RT_V, RT_END = WS_SCR + 630 * MiB;
constexpr int NBLK = NTOK / 256;
struct EpiBf16X {
    static constexpr bool PERM = true;
    bf16_t* O; int ldc;
    __device__ __forceinline__ void operator()(const gg::Acc& acc, const gg::Unit& u, int wr, int wc, int fr, int fq) const {
#pragma unroll
        for (int ai = 0; ai < 2; ++ai)
#pragma unroll
            for (int m = 0; m < 4; ++m) { bf16_t* rp = O + (size_t)(unsigned)u.x + (size_t)(ai * 128 + wr * 64 + m * 16 + fr) * ldc + wc * 32 + 8 * fq;
#pragma unroll
                for (int bj = 0; bj < 2; ++bj) { const f32x4 v0 = acc[ai][bj][m][0], v1 = acc[ai][bj][m][1];
                    u32x4 o; o.x = pk2(v0[0], v0[1]); o.y = pk2(v0[2], v0[3]); o.z = pk2(v1[0], v1[1]); o.w = pk2(v1[2], v1[3]);
                    *(u32x4*)(rp + bj * 128) = o; } }
    }
};
__device__ __forceinline__ float log_sigmoid(float x) { return -(fmaxf(-x, 0.f) + log1pf(__expf(-fabsf(x)))); }
struct EpiRetIn {
    static constexpr bool PERM = true;
    bf16_t *QR, *KR, *V, *SG, *ACAT; const float* rope; const float* decay;
    __device__ __forceinline__ void operator()(const gg::Acc& acc, const gg::Unit& u, int wr, int wc, int fr, int fq) const {
        const int pn = u.pn, row0 = u.pm * 256 + wr * 64 + fr, cx = wc * 32 + 8 * fq;
        if (pn < 8) {
            const int h = pn & 3; const bool isq = pn < 4;
            const float lg0 = log_sigmoid(decay[h]), lg1 = log_sigmoid(decay[4 + h]);
#pragma unroll
            for (int ai = 0; ai < 2; ++ai)
#pragma unroll
                for (int m = 0; m < 4; ++m) {
                    const int row = row0 + ai * 128 + m * 16, i = row & 255, b = row >> 8;
                    f32x4 lo[2] = {acc[ai][0][m][0], acc[ai][0][m][1]}, hi[2] = {acc[ai][1][m][0], acc[ai][1][m][1]};
                    if (row >= NCTX) {
                        const int tl = row - NCTX, pp = (wc < 2) ? (tl >> 6) : (tl & 63), i0 = (wc & 1) * 32 + 8 * fq;
                        const float* cp = rope + pp * 64 + i0; const float* sp = cp + 256 * 64;
#pragma unroll
                        for (int n = 0; n < 2; ++n) { const f32x4 c = *(const f32x4*)(cp + 4 * n), sn = *(const f32x4*)(sp + 4 * n);
                            const f32x4 l2 = lo[n] * c - hi[n] * sn, h2 = hi[n] * c + lo[n] * sn; lo[n] = l2; hi[n] = h2; }
                    }
                    if (isq) {
                        u32x4 o; o.x = pk2(lo[0][0], lo[0][1]); o.y = pk2(lo[0][2], lo[0][3]); o.z = pk2(lo[1][0], lo[1][1]); o.w = pk2(lo[1][2], lo[1][3]);
                        *(u32x4*)(QR + (size_t)row * 1024 + h * 256 + cx) = o;
                        o.x = pk2(hi[0][0], hi[0][1]); o.y = pk2(hi[0][2], hi[0][3]); o.z = pk2(hi[1][0], hi[1][1]); o.w = pk2(hi[1][2], hi[1][3]);
                        *(u32x4*)(QR + (size_t)row * 1024 + h * 256 + 128 + cx) = o;
                        bf16_t* ac = ACAT + ((size_t)(b * 4 + h) * 256 + i) * 768 + 256 + cx;
#pragma unroll
                        for (int d = 0; d < 2; ++d) { const float f = d ? __expf((float)(256 - i) * lg1) : __expf((float)(i + 1) * lg0);
                            o.x = pk2(lo[0][0] * f, lo[0][1] * f); o.y = pk2(lo[0][2] * f, lo[0][3] * f); o.z = pk2(lo[1][0] * f, lo[1][1] * f); o.w = pk2(lo[1][2] * f, lo[1][3] * f);
                            *(u32x4*)(ac + d * 256) = o;
                            o.x = pk2(hi[0][0] * f, hi[0][1] * f); o.y = pk2(hi[0][2] * f, hi[0][3] * f); o.z = pk2(hi[1][0] * f, hi[1][1] * f); o.w = pk2(hi[1][2] * f, hi[1][3] * f);
                            *(u32x4*)(ac + d * 256 + 128) = o; }
                    } else {
                        const float f = 0.0625f;
                        u32x4 o; o.x = pk2(lo[0][0] * f, lo[0][1] * f); o.y = pk2(lo[0][2] * f, lo[0][3] * f); o.z = pk2(lo[1][0] * f, lo[1][1] * f); o.w = pk2(lo[1][2] * f, lo[1][3] * f);
                        *(u32x4*)(KR + (size_t)row * 1024 + h * 256 + cx) = o;
                        o.x = pk2(hi[0][0] * f, hi[0][1] * f); o.y = pk2(hi[0][2] * f, hi[0][3] * f); o.z = pk2(hi[1][0] * f, hi[1][1] * f); o.w = pk2(hi[1][2] * f, hi[1][3] * f);
                        *(u32x4*)(KR + (size_t)row * 1024 + h * 256 + 128 + cx) = o;
                    }
                }
        } else {
            const bool isv = pn < 16; bf16_t* O = isv ? V : SG; const int col0 = ((pn - 8) & 7) * 256 + cx;
#pragma unroll
            for (int ai = 0; ai < 2; ++ai)
#pragma unroll
                for (int m = 0; m < 4; ++m) { bf16_t* rp = O + (size_t)(row0 + ai * 128 + m * 16) * 2048 + col0;
#pragma unroll
                    for (int bj = 0; bj < 2; ++bj) { f32x4 v0 = acc[ai][bj][m][0], v1 = acc[ai][bj][m][1];
                        if (!isv) {
#pragma unroll
                            for (int e = 0; e < 4; ++e) { v0[e] = siluf_(v0[e]); v1[e] = siluf_(v1[e]); } }
                        u32x4 o; o.x = pk2(v0[0], v0[1]); o.y = pk2(v0[2], v0[3]); o.z = pk2(v1[0], v1[1]); o.w = pk2(v1[2], v1[3]);
                        *(u32x4*)(rp + bj * 128) = o; } }
        }
    }
};
__device__ __forceinline__ void ret_in_gemm_phase(Frame& F, const Args& a) {
    gg::DenseSched S; S.init((const bf16_t*)(a.ws + WS_U), (const bf16_t*)(a.ws + WS_W_RET_IN), NTOK, 6144, 1024, 1024);
    EpiRetIn E{(bf16_t*)(a.ws + RT_QR), (bf16_t*)(a.ws + RT_KR), (bf16_t*)(a.ws + RT_V), (bf16_t*)(a.ws + RT_SG), (bf16_t*)(a.ws + RT_ACAT), (const float*)(a.ws + WS_ROPE), a.in[32]};
    gg::gemm_phase<EpiRetIn, gg::DenseSched, false, false>(F.lds + LDS_STAGE, gg::Dims{1024, 1024, 1024, 0, 0}, S, E);
}
__device__ __forceinline__ void tr64_bf16(const bf16_t* src, int ld_src, bf16_t* dst, int ld_dst, LAS unsigned char* scr, int lane, float lgam, int mode, int t0) {
    const int cg = lane & 7, rg = lane >> 3;
#pragma unroll
    for (int k = 0; k < 8; ++k) { const int t = rg + 8 * k; const u32x4 v = *(const u32x4*)(src + (size_t)t * ld_src + 8 * cg);
        float f = 1.0f; if (mode) { const int i = (t0 + t) & 255; f = __expf((float)(mode == 1 ? 255 - i : i) * lgam); }
        const unsigned w[4] = {v.x, v.y, v.z, v.w};
#pragma unroll
        for (int e = 0; e < 4; ++e) { *(LAS unsigned short*)(scr + (8 * cg + 2 * e) * 144 + t * 2) = (unsigned short)f2bf(bflo(w[e]) * f); *(LAS unsigned short*)(scr + (8 * cg + 2 * e + 1) * 144 + t * 2) = (unsigned short)f2bf(bfhi(w[e]) * f); } }
    asm volatile("s_waitcnt lgkmcnt(0)" ::: "memory");
#pragma unroll
    for (int k = 0; k < 8; ++k) { const int c = rg + 8 * k; const u32x4 v = *(const LAS u32x4*)(scr + c * 144 + 16 * cg); *(u32x4*)(dst + (size_t)c * ld_dst + 8 * cg) = v; }
    asm volatile("s_waitcnt lgkmcnt(0)" ::: "memory");
}
__device__ __forceinline__ void ret_transpose_phase(Frame& F, const Args& a) {
    const bf16_t* KR = (const bf16_t*)(a.ws + RT_KR); const bf16_t* V = (const bf16_t*)(a.ws + RT_V); bf16_t* KTD = (bf16_t*)(a.ws + RT_KTD); bf16_t* VT = (bf16_t*)(a.ws + RT_VT);
    LAS unsigned char* scr = F.lds + LDS_STAGE + F.wave * 9216;
    const float* decay = a.in[32];
    constexpr int NT = NTOK / 64;
    for (int it = F.gw; it < NT * (32 + 32); it += F.ngw) {
        const int tt = it % NT, cc = it / NT, t0 = tt * 64;
        if (cc < 32) { const int d = cc >> 4, c0 = (cc & 15) * 64, h = c0 >> 8; const float lg = log_sigmoid(decay[d * 4 + h]);
            tr64_bf16(KR + (size_t)t0 * 1024 + c0, 1024, KTD + ((size_t)d * 1024 + c0) * NTOK + t0, NTOK, scr, F.lane, lg, d ? 2 : 1, t0); }
        else { const int c0 = (cc - 32) * 64; tr64_bf16(V + (size_t)t0 * 2048 + c0, 2048, VT + (size_t)c0 * NTOK + t0, NTOK, scr, F.lane, 0.f, 0, t0); }
    }
}
struct RetKvSched {
    const char* VT; const char* KTD; int G, c;
    __device__ __forceinline__ bool next(int i, gg::Unit& u) const {
        const int L0 = i * G + c; if (L0 >= NBLK * 16) return false; const int L = xcd_remap(L0, NBLK * 16);
        const int dvt = L & 1, d = (L >> 1) & 1, h = (L >> 2) & 3, b = L >> 4;
        u.a = VT + ((size_t)(512 * h + 256 * dvt) * NTOK + 256 * b) * 2; u.b = KTD + ((size_t)(d * 1024 + 256 * h) * NTOK + 256 * b) * 2; u.b2 = nullptr;
        u.pm = 0; u.pn = 0; u.gofs = 0; u.x = ((b * 4 + h) * 512 + 256 * dvt) * 512 + 256 * d; return true; }
};
__device__ __forceinline__ void ret_kv_phase(Frame& F, const Args& a) {
    RetKvSched S{(const char*)(a.ws + RT_VT), (const char*)(a.ws + RT_KTD), (int)gridDim.x, (int)blockIdx.x};
    EpiBf16X E{(bf16_t*)(a.ws + RT_ST), 512};
    gg::gemm_phase<EpiBf16X, RetKvSched, false, false>(F.lds + LDS_STAGE, gg::Dims{256, NTOK, NTOK, 0, 0}, S, E);
}
template <bool DRY = false>
__device__ __forceinline__ void ret_prefix_phase(Frame& F, const Args& a) {
    bf16_t* ST = (bf16_t*)(a.ws + (DRY ? WS_DUMMY : RT_ST)); const float* decay = a.in[32];
    for (int gid = blockIdx.x * NTHREADS + F.tid; gid < 4 * 512 * 2 * 32; gid += gridDim.x * NTHREADS) {
        const int dk8 = gid & 31, d = (gid >> 5) & 1, dv = (gid >> 6) & 511, h = gid >> 15;
        const float gb = __expf(256.0f * log_sigmoid(decay[d * 4 + h]));
        float s[8];
#pragma unroll
        for (int e = 0; e < 8; ++e) s[e] = 0.f;
#define RT_BLK(st_) (((d == 0) || (st_) == 0) ? (st_) : (NBLK - (st_)))
#define RT_PTR(st_) ((u32x4*)(ST + ((size_t)(RT_BLK(st_) * 4 + h) * 512 + dv) * 512 + d * 256 + 8 * dk8))
        u32x4 kb[4];
#pragma unroll
        for (int j = 0; j < 4; ++j) kb[j] = *RT_PTR(j);
#pragma unroll 1
        for (int base = 0; base < 68; base += 4) {
#pragma unroll
            for (int j = 0; j < 4; ++j) { const int step = base + j; if (step < NBLK) {
                u32x4* p = RT_PTR(step); const u32x4 kv = kb[j];
                if (step + 4 < NBLK) kb[j] = *RT_PTR(step + 4);
                u32x4 o; o.x = pk2(s[0], s[1]); o.y = pk2(s[2], s[3]); o.z = pk2(s[4], s[5]); o.w = pk2(s[6], s[7]); *p = o;
                s[0] = s[0] * gb + bflo(kv.x); s[1] = s[1] * gb + bfhi(kv.x); s[2] = s[2] * gb + bflo(kv.y); s[3] = s[3] * gb + bfhi(kv.y);
                s[4] = s[4] * gb + bflo(kv.z); s[5] = s[5] * gb + bfhi(kv.z); s[6] = s[6] * gb + bflo(kv.w); s[7] = s[7] * gb + bfhi(kv.w); } }
        }
#undef RT_BLK
#undef RT_PTR
    }
    bf16_t* ACAT = (bf16_t*)(a.ws + (DRY ? WS_DUMMY + 140 * MiB : RT_ACAT));
    for (int gid = blockIdx.x * NTHREADS + F.tid; gid < NBLK * 4 * 256 * 32; gid += gridDim.x * NTHREADS) {
        const int j0 = (gid & 31) * 8, i = (gid >> 5) & 255, bh = gid >> 13, h = bh & 3;
        const float lg0 = log_sigmoid(decay[h]), lg1 = log_sigmoid(decay[4 + h]);
        u32x4* p = (u32x4*)(ACAT + ((size_t)bh * 256 + i) * 768 + j0);
        const u32x4 v = *p; const unsigned w[4] = {v.x, v.y, v.z, v.w}; unsigned o[4];
#pragma unroll
        for (int e = 0; e < 4; ++e) { const int ja = j0 + 2 * e, jb = ja + 1;
            const float wa = ((i >= ja) ? __expf((float)(i - ja) * lg0) : 0.f) + ((ja >= i) ? __expf((float)(ja - i) * lg1) : 0.f);
            const float wb = ((i >= jb) ? __expf((float)(i - jb) * lg0) : 0.f) + ((jb >= i) ? __expf((float)(jb - i) * lg1) : 0.f);
            o[e] = pk2(bflo(w[e]) * wa, bfhi(w[e]) * wb); }
        *p = (u32x4){o[0], o[1], o[2], o[3]};
    }
}
struct RetPSched {
    const char* QR; const char* KR; int G, c;
    __device__ __forceinline__ bool next(int i, gg::Unit& u) const {
        const int L0 = i * G + c; if (L0 >= NBLK * 4) return false; const int L = xcd_remap(L0, NBLK * 4);
        const int h = L & 3, b = L >> 2;
        u.a = QR + ((size_t)256 * b * 1024 + 256 * h) * 2; u.b = KR + ((size_t)256 * b * 1024 + 256 * h) * 2; u.b2 = nullptr;
        u.pm = b; u.pn = h; u.gofs = 0; u.x = (b * 4 + h) * 256 * 768; return true; }
};
__device__ __forceinline__ void ret_p_phase(Frame& F, const Args& a) {
    RetPSched S{(const char*)(a.ws + RT_QR), (const char*)(a.ws + RT_KR), (int)gridDim.x, (int)blockIdx.x};
    EpiBf16X E{(bf16_t*)(a.ws + RT_ACAT), 768};
    gg::gemm_phase<EpiBf16X, RetPSched, false, false>(F.lds + LDS_STAGE, gg::Dims{256, 1024, 1024, 0, 0}, S, E);
}
struct RetOSched {
    const char* ACAT; const char* VT; const char* ST; int G, c;
    __device__ __forceinline__ bool next(int i, gg::Unit& u) const {
        const int L0 = i * G + c; if (L0 >= NBLK * 8) return false; const int L = xcd_remap(L0, NBLK * 8);
        const int dvt = L & 1, h = (L >> 1) & 3, b = L >> 3;
        u.a = ACAT + (size_t)(b * 4 + h) * 256 * 768 * 2; u.b = VT + ((size_t)(512 * h + 256 * dvt) * NTOK + 256 * b) * 2; u.b2 = ST + ((size_t)((b * 4 + h) * 512 + 256 * dvt) * 512) * 2;
        u.pm = 0; u.pn = 0; u.gofs = 0; u.x = 256 * b * 2048 + 512 * h + 256 * dvt; return true; }
};
__device__ __forceinline__ void ret_o_phase(Frame& F, const Args& a) {
    RetOSched S{(const char*)(a.ws + RT_ACAT), (const char*)(a.ws + RT_VT), (const char*)(a.ws + RT_ST), (int)gridDim.x, (int)blockIdx.x};
    EpiBf16X E{(bf16_t*)(a.ws + RT_O), 2048};
    gg::gemm_phase<EpiBf16X, RetOSched, false, true>(F.lds + LDS_STAGE, gg::Dims{768, 768, NTOK, 4, 512}, S, E);
}
__device__ __forceinline__ void ret_readout_phase(Frame& F, const Args& a) {
    const bf16_t* O = (const bf16_t*)(a.ws + RT_O); const bf16_t* SG = (const bf16_t*)(a.ws + RT_SG); bf16_t* A3 = (bf16_t*)(a.ws + RT_A3);
    const float* gg_ = a.in[33]; const float* gb_ = a.in[34];
    const int lane = F.lane;
    for (int t = F.gw; t < NTOK; t += F.ngw) {
        float v[32]; float s = 0.f;
#pragma unroll
        for (int k = 0; k < 4; ++k) { const u32x4 w = *(const u32x4*)(O + (size_t)t * 2048 + 32 * lane + 8 * k);
            v[8 * k] = bflo(w.x); v[8 * k + 1] = bfhi(w.x); v[8 * k + 2] = bflo(w.y); v[8 * k + 3] = bfhi(w.y); v[8 * k + 4] = bflo(w.z); v[8 * k + 5] = bfhi(w.z); v[8 * k + 6] = bflo(w.w); v[8 * k + 7] = bfhi(w.w); }
#pragma unroll
        for (int e = 0; e < 32; ++e) s += v[e];
#pragma unroll
        for (int o = 1; o < 16; o <<= 1) s += __shfl_xor(s, o);
        const float mean = s * (1.0f / 512.0f); float q = 0.f;
#pragma unroll
        for (int e = 0; e < 32; ++e) { v[e] -= mean; q += v[e] * v[e]; }
#pragma unroll
        for (int o = 1; o < 16; o <<= 1) q += __shfl_xor(q, o);
        const float rstd = 1.0f / sqrtf(q * (1.0f / 512.0f) + LN_EPS);
#pragma unroll
        for (int k = 0; k < 4; ++k) { const u32x4 g = *(const u32x4*)(SG + (size_t)t * 2048 + 32 * lane + 8 * k); const unsigned gw[4] = {g.x, g.y, g.z, g.w}; unsigned ow[4];
#pragma unroll
            for (int e = 0; e < 4; ++e) { const int c = 32 * lane + 8 * k + 2 * e;
                const float y0 = (v[8 * k + 2 * e] * rstd * gg_[c] + gb_[c]) * bflo(gw[e]), y1 = (v[8 * k + 2 * e + 1] * rstd * gg_[c + 1] + gb_[c + 1]) * bfhi(gw[e]); ow[e] = pk2(y0, y1); }
            *(u32x4*)(A3 + (size_t)t * 2048 + 32 * lane + 8 * k) = (u32x4){ow[0], ow[1], ow[2], ow[3]}; }
    }
}

constexpr size_t HG_Q = WS_SCR, HG_F = WS_SCR + 33 * MiB, HG_V = WS_SCR + 99 * MiB, HG_G = WS_SCR + 132 * MiB, HG_O = WS_SCR + 165 * MiB, HG_S = WS_SCR + 231 * MiB, HG_D = WS_SCR + 297 * MiB, HG_A4 = HG_Q;
struct EpiHgrnIn {
    static constexpr bool PERM = true;
    bf16_t *Q, *Fp, *V, *G;
    __device__ __forceinline__ void operator()(const gg::Acc& acc, const gg::Unit& u, int wr, int wc, int fr, int fq) const {
        const int grp = u.pn >> 2; const bool act = (grp == 0 || grp == 4);
        bf16_t* O = grp == 0 ? Q : grp == 1 ? Fp : grp == 2 ? Fp + (size_t)NTOK * 1024 : grp == 3 ? V : G;
        const int row0 = u.pm * 256 + wr * 64 + fr, col0 = (u.pn & 3) * 256 + wc * 32 + 8 * fq;
#pragma unroll
        for (int ai = 0; ai < 2; ++ai)
#pragma unroll
            for (int m = 0; m < 4; ++m) { bf16_t* rp = O + (size_t)(row0 + ai * 128 + m * 16) * 1024 + col0;
#pragma unroll
                for (int bj = 0; bj < 2; ++bj) { f32x4 v0 = acc[ai][bj][m][0], v1 = acc[ai][bj][m][1];
                    if (act) {
#pragma unroll
                        for (int e = 0; e < 4; ++e) { v0[e] = siluf_(v0[e]); v1[e] = siluf_(v1[e]); } }
                    u32x4 o; o.x = pk2(v0[0], v0[1]); o.y = pk2(v0[2], v0[3]); o.z = pk2(v1[0], v1[1]); o.w = pk2(v1[2], v1[3]);
                    *(u32x4*)(rp + bj * 128) = o; } }
    }
};
__device__ __forceinline__ void hgrn_in_gemm_phase(Frame& F, const Args& a) {
    gg::DenseSched S; S.init((const bf16_t*)(a.ws + WS_U), (const bf16_t*)(a.ws + WS_W_HGRN_IN), NTOK, 5120, 1024, 1024);
    EpiHgrnIn E{(bf16_t*)(a.ws + HG_Q), (bf16_t*)(a.ws + HG_F), (bf16_t*)(a.ws + HG_V), (bf16_t*)(a.ws + HG_G)};
    gg::gemm_phase<EpiHgrnIn, gg::DenseSched, false, false>(F.lds + LDS_STAGE, gg::Dims{1024, 1024, 1024, 0, 0}, S, E);
}
typedef short v4s16 __attribute__((ext_vector_type(4)));
__device__ __forceinline__ bf16x8 lds_tr_frag(LAS unsigned char* tile, int stride, int r0, int c0, int lane) {
    const int g = lane >> 4, qq = (lane & 15) >> 2, p = lane & 3;
    LAS unsigned char* a0 = tile + (r0 + 8 * g + qq) * stride + (c0 + 4 * p) * 2;
    const v4s16 x = __builtin_amdgcn_ds_read_tr16_b64_v4i16((LAS v4s16*)a0), y = __builtin_amdgcn_ds_read_tr16_b64_v4i16((LAS v4s16*)(a0 + 4 * stride));
    return (bf16x8){x[0], x[1], x[2], x[3], y[0], y[1], y[2], y[3]};
}
__device__ __forceinline__ bf16x8 lds_row_frag(LAS unsigned char* tile, int stride, int row, int k0) { return *(const LAS bf16x8*)(tile + row * stride + k0 * 2); }
constexpr int HS = 272, HPS = 144;
template <int PASS>
__device__ __forceinline__ void hgrn_chunk_phase(Frame& F, const Args& a) {
    const bf16_t* Qb = (const bf16_t*)(a.ws + HG_Q); const bf16_t* Fb = (const bf16_t*)(a.ws + HG_F); const bf16_t* Vb = (const bf16_t*)(a.ws + HG_V);
    bf16_t* Ob = (bf16_t*)(a.ws + HG_O); float* Sb = (float*)(a.ws + HG_S); float* Db = (float*)(a.ws + HG_D);
    const float* LBV = (const float*)(a.ws + WS_LBV); const float* bfp = a.in[37];
    LAS unsigned char* QH = F.lds + LDS_STAGE; LAS unsigned char* KH = QH + 17408; LAS unsigned char* KB = QH + 34816; LAS unsigned char* VV = QH + 52224;
    LAS unsigned char* PP = QH + 69632; LAS unsigned char* SS = QH + 78848; LAS float* DEC = (LAS float*)(QH + 113664); LAS float* TOT = (LAS float*)(QH + 114176);
    const int tid = F.tid, lane = F.lane, w = F.wave, k = tid & 127, tg = tid >> 7, c16 = lane & 15, q4 = lane >> 4;
    const int lrow = tid >> 3, c8 = tid & 7;
    u32x4 rF[2], rV[2], rQ[2];
#define HG_ISSUE(unit_, bi_) do { const int d_ = (unit_) & 1, h_ = ((unit_) >> 1) & 7, seg_ = (unit_) >> 4; const int tr_ = (seg_ * 4 + (d_ ? 3 - (bi_) : (bi_))) * 64; \
        const size_t o_ = (size_t)(tr_ + (d_ ? 63 - lrow : lrow)) * 1024 + h_ * 128 + 8 * c8; const bf16_t* Fd_ = Fb + (size_t)d_ * NTOK * 1024; \
        rF[0] = *(const u32x4*)(Fd_ + o_); rF[1] = *(const u32x4*)(Fd_ + o_ + 64); rV[0] = *(const u32x4*)(Vb + o_); rV[1] = *(const u32x4*)(Vb + o_ + 64); \
        if (PASS) { rQ[0] = *(const u32x4*)(Qb + o_); rQ[1] = *(const u32x4*)(Qb + o_ + 64); } } while (0)
    if ((int)blockIdx.x < 65 * 16) HG_ISSUE((int)blockIdx.x, 0);
#pragma unroll 1
    for (int unit = blockIdx.x; unit < 65 * 16; unit += gridDim.x) {
        const int d = unit & 1, h = (unit >> 1) & 7, seg = unit >> 4, ch = h * 128 + k;
        const float lbv = LBV[ch], bfv = bfp[d * 1024 + ch];
        const bf16_t* Fd = Fb + (size_t)d * NTOK * 1024;
        f32x4 accS[8]; float dseg = 1.0f;
        float* Su = Sb + (size_t)unit * 16384;
#pragma unroll
        for (int kt = 0; kt < 8; ++kt)
#pragma unroll
            for (int r = 0; r < 4; ++r) accS[kt][r] = PASS ? Su[(16 * kt + 4 * q4 + r) * 128 + 16 * w + c16] : 0.f;
        if (PASS) {
#pragma unroll
            for (int kt = 0; kt < 8; ++kt)
#pragma unroll
                for (int r = 0; r < 4; ++r) *(LAS unsigned short*)(SS + (16 * kt + 4 * q4 + r) * HS + (16 * w + c16) * 2) = (unsigned short)f2bf(accS[kt][r]);
        }
#pragma unroll 1
        for (int bi = 0; bi < 4; ++bi) {
            const int trow0 = (seg * 4 + (d ? 3 - bi : bi)) * 64;
            { const int lo_ = lrow * HS + 16 * c8;
              *(LAS u32x4*)(KB + lo_) = rF[0]; *(LAS u32x4*)(KB + lo_ + 128) = rF[1]; *(LAS u32x4*)(VV + lo_) = rV[0]; *(LAS u32x4*)(VV + lo_ + 128) = rV[1];
              if (PASS) { *(LAS u32x4*)(QH + lo_) = rQ[0]; *(LAS u32x4*)(QH + lo_ + 128) = rQ[1]; } }
            { const int nu = bi < 3 ? unit : unit + (int)gridDim.x, nb = bi < 3 ? bi + 1 : 0; if (nu < 65 * 16) HG_ISSUE(nu, nb); }
            __syncthreads();
            float lfc[16]; float run = 0.f;
#pragma unroll
            for (int ii = 0; ii < 16; ++ii) { const int i = tg * 16 + ii;
                const float fp = bf2f(*(const LAS unsigned short*)(KB + i * HS + k * 2)); const float f = lbv + (1.0f - lbv) * sigmoidf_(fp + bfv);
                run += __logf(f); lfc[ii] = run; }
            TOT[tg * 128 + k] = run;
            __syncthreads();
            float off = 0.f, btot = 0.f;
#pragma unroll
            for (int g2 = 0; g2 < 4; ++g2) { const float tv = TOT[g2 * 128 + k]; btot += tv; if (g2 < tg) off += tv; }
#pragma unroll
            for (int ii = 0; ii < 16; ++ii) { const int i = tg * 16 + ii; const float B = off + lfc[ii];
                const float lf = lfc[ii] - (ii ? lfc[ii - 1] : 0.f); const float kkv = 1.0f - __expf(lf);
                *(LAS unsigned short*)(KB + i * HS + k * 2) = (unsigned short)f2bf(kkv * __expf(btot - B));
                if (PASS) { const float qv = bf2f(*(const LAS unsigned short*)(QH + i * HS + k * 2));
                            *(LAS unsigned short*)(QH + i * HS + k * 2) = (unsigned short)f2bf(qv * __expf(B));
                            *(LAS unsigned short*)(KH + i * HS + k * 2) = (unsigned short)f2bf(kkv * __expf(fminf(-B, 80.0f))); }
                if ((ii & 3) == 3) asm volatile("" ::: "memory"); }
            if (tg == 0) { const float e = __expf(btot); DEC[k] = e; dseg *= e; }
            __syncthreads();
            f32x4 ao[4];
            if (PASS) {
#pragma unroll
                for (int s2 = 0; s2 < 2; ++s2) { const int it = w >> 1, jt = 2 * (w & 1) + s2; f32x4 sc = {0.f, 0.f, 0.f, 0.f};
#pragma unroll
                    for (int ks = 0; ks < 4; ++ks) sc = __builtin_amdgcn_mfma_f32_16x16x32_bf16(lds_row_frag(QH, HS, 16 * it + c16, 32 * ks + 8 * q4), lds_row_frag(KH, HS, 16 * jt + c16, 32 * ks + 8 * q4), sc, 0, 0, 0);
#pragma unroll
                    for (int r = 0; r < 4; ++r) { const int i = 16 * it + 4 * q4 + r, j = 16 * jt + c16; *(LAS unsigned short*)(PP + i * HPS + j * 2) = (unsigned short)f2bf(j <= i ? sc[r] : 0.f); } }
                __syncthreads();
#pragma unroll
                for (int it = 0; it < 4; ++it) ao[it] = (f32x4){0.f, 0.f, 0.f, 0.f};
            }
            bf16x8 vf[2];
#pragma unroll
            for (int ks = 0; ks < 2; ++ks) vf[ks] = lds_tr_frag(VV, HS, 32 * ks, 16 * w, lane);
            if (PASS) {
#pragma unroll
                for (int ks = 0; ks < 2; ++ks)
#pragma unroll
                    for (int it = 0; it < 4; ++it) ao[it] = __builtin_amdgcn_mfma_f32_16x16x32_bf16(lds_row_frag(PP, HPS, 16 * it + c16, 32 * ks + 8 * q4), vf[ks], ao[it], 0, 0, 0);
#pragma unroll 1
                for (int ks = 0; ks < 4; ++ks) { const bf16x8 sf = lds_tr_frag(SS, HS, 32 * ks, 16 * w, lane);
#pragma unroll
                    for (int it = 0; it < 4; ++it) ao[it] = __builtin_amdgcn_mfma_f32_16x16x32_bf16(lds_row_frag(QH, HS, 16 * it + c16, 32 * ks + 8 * q4), sf, ao[it], 0, 0, 0); }
            }
#pragma unroll
            for (int kt = 0; kt < 8; ++kt) {
#pragma unroll
                for (int r = 0; r < 4; ++r) accS[kt][r] *= DEC[16 * kt + 4 * q4 + r];
#pragma unroll
                for (int ks = 0; ks < 2; ++ks) accS[kt] = __builtin_amdgcn_mfma_f32_16x16x32_bf16(lds_tr_frag(KB, HS, 32 * ks, 16 * kt, lane), vf[ks], accS[kt], 0, 0, 0);
            }
            __syncthreads();
            if (PASS) {
#pragma unroll
                for (int kt = 0; kt < 8; ++kt)
#pragma unroll
                    for (int r = 0; r < 4; ++r) *(LAS unsigned short*)(SS + (16 * kt + 4 * q4 + r) * HS + (16 * w + c16) * 2) = (unsigned short)f2bf(accS[kt][r]);
#pragma unroll
                for (int it = 0; it < 4; ++it)
#pragma unroll
                    for (int r = 0; r < 4; ++r) *(LAS unsigned short*)(KH + (16 * it + 4 * q4 + r) * HS + (16 * w + c16) * 2) = (unsigned short)f2bf(ao[it][r]);
                __syncthreads();
                bf16_t* Od = Ob + (size_t)d * NTOK * 1024;
#pragma unroll
                for (int cc = 0; cc < 2; ++cc) { const int row = tid >> 3, chunk = (tid & 7) + 8 * cc, t = trow0 + (d ? 63 - row : row);
                    *(u32x4*)(Od + (size_t)t * 1024 + h * 128 + 8 * chunk) = *(const LAS u32x4*)(KH + row * HS + 16 * chunk); }
            }
        }
        if (!PASS) {
#pragma unroll
            for (int kt = 0; kt < 8; ++kt)
#pragma unroll
                for (int r = 0; r < 4; ++r) Su[(16 * kt + 4 * q4 + r) * 128 + 16 * w + c16] = accS[kt][r];
            if (tg == 0) Db[(size_t)unit * 128 + k] = dseg;
        }
        __syncthreads();
    }
}
#undef HG_ISSUE
template <bool DRY = false>
__device__ __forceinline__ void hgrn_prefix_phase(Frame& F, const Args& a) {
    float* Sb = (float*)(a.ws + (DRY ? WS_DUMMY : HG_S)); const float* Db = (const float*)(a.ws + HG_D);
    for (int gid = blockIdx.x * NTHREADS + F.tid; gid < 16 * 4096; gid += gridDim.x * NTHREADS) {
        const int hd = gid >> 12, e4 = gid & 4095, krow = e4 >> 5, d = hd & 1;
        f32x4 s = {0.f, 0.f, 0.f, 0.f};
#define HG_SEG(st_) (((d == 0) || (st_) == 0) ? (st_) : 65 - (st_))
        f32x4 lb[4]; float db[4];
#pragma unroll
        for (int j = 0; j < 4; ++j) { const int u2 = HG_SEG(j) * 16 + hd; lb[j] = *((const f32x4*)(Sb + (size_t)u2 * 16384) + e4); db[j] = Db[(size_t)u2 * 128 + krow]; }
#pragma unroll 1
        for (int base = 0; base < 68; base += 4) {
#pragma unroll
            for (int j = 0; j < 4; ++j) { const int step = base + j; if (step < 65) {
                const int unit = HG_SEG(step) * 16 + hd; f32x4* p = (f32x4*)(Sb + (size_t)unit * 16384) + e4; const f32x4 loc = lb[j]; const float dec = db[j];
                if (step + 4 < 65) { const int u2 = HG_SEG(step + 4) * 16 + hd; lb[j] = *((const f32x4*)(Sb + (size_t)u2 * 16384) + e4); db[j] = Db[(size_t)u2 * 128 + krow]; }
                *p = s; s = s * dec + loc; } }
        }
#undef HG_SEG
    }
}
__device__ __forceinline__ void hgrn_readout_phase(Frame& F, const Args& a) {
    const bf16_t* O0 = (const bf16_t*)(a.ws + HG_O); const bf16_t* O1 = O0 + (size_t)NTOK * 1024; const bf16_t* G = (const bf16_t*)(a.ws + HG_G); bf16_t* A4 = (bf16_t*)(a.ws + HG_A4);
    const float* ng = a.in[39]; const int lane = F.lane;
    float gn[8];
#pragma unroll
    for (int e = 0; e < 8; ++e) gn[e] = ng[(8 * lane + e) & 127];
    for (int t = F.gw; t < NTOK; t += F.ngw) {
        float o[16], g[16]; ldrow_bf16(O0 + (size_t)t * 1024, lane, o); addrow_bf16(O1 + (size_t)t * 1024, lane, o); ldrow_bf16(G + (size_t)t * 1024, lane, g);
#pragma unroll
        for (int j = 0; j < 2; ++j) { float q = 0.f;
#pragma unroll
            for (int e = 0; e < 8; ++e) q += o[8 * j + e] * o[8 * j + e];
#pragma unroll
            for (int m = 1; m < 16; m <<= 1) q += __shfl_xor(q, m);
            const float rs = 1.0f / sqrtf(q * (1.0f / 128.0f) + LN_EPS);
#pragma unroll
            for (int e = 0; e < 8; ++e) o[8 * j + e] = o[8 * j + e] * rs * gn[e] * g[8 * j + e]; }
        strow_bf16(A4 + (size_t)t * 1024, lane, o);
    }
}

constexpr size_t RW_XM = WS_SCR, RW_WW = WS_SCR, RW_AA = WS_SCR + 131 * MiB, RW_R = WS_SCR + 196 * MiB, RW_K = WS_SCR + 229 * MiB, RW_V = WS_SCR + 262 * MiB, RW_L1 = WS_SCR + 295 * MiB,
                 RW_G = WS_SCR + 321 * MiB, RW_REC = WS_SCR + 354 * MiB, RW_PQ = WS_SCR + (RWKV_CHUNKED ? 354 : 0) * MiB, RW_SST = WS_SCR + (RWKV_CHUNKED ? 420 : 64) * MiB, RW_O = WS_SCR + 745 * MiB, RW_A5 = WS_SCR, RW_Y = WS_SCR + 812 * MiB, RW_END = WS_SCR + 880 * MiB;
constexpr int RECB = 768;
typedef _Float16 h2_t __attribute__((ext_vector_type(2)));
typedef _Float16 h8_t __attribute__((ext_vector_type(8)));
__device__ __forceinline__ void rwkv_xm_phase(Frame& F, const Args& a) {
    const bf16_t* U = (const bf16_t*)(a.ws + WS_U); bf16_t* XM = (bf16_t*)(a.ws + RW_XM); const float* mu = a.in[15];
    for (int t = F.gw; t < NTOK; t += F.ngw) {
        float u[16], sh[16]; ldrow_bf16(U + (size_t)t * D, F.lane, u);
        const bool hasp = (t != 0 && t != NCTX), hasn = (t != NCTX - 1 && t != NTOK - 1);
        { u32x4 pv = {0u, 0u, 0u, 0u}, nv = {0u, 0u, 0u, 0u};
          if (hasp) pv = *(const u32x4*)(U + (size_t)(t - 1) * D + 8 * F.lane);
          if (hasn) nv = *(const u32x4*)(U + (size_t)(t + 1) * D + 512 + 8 * F.lane);
          sh[0] = bflo(pv.x); sh[1] = bfhi(pv.x); sh[2] = bflo(pv.y); sh[3] = bfhi(pv.y); sh[4] = bflo(pv.z); sh[5] = bfhi(pv.z); sh[6] = bflo(pv.w); sh[7] = bfhi(pv.w);
          sh[8] = bflo(nv.x); sh[9] = bfhi(nv.x); sh[10] = bflo(nv.y); sh[11] = bfhi(nv.y); sh[12] = bflo(nv.z); sh[13] = bfhi(nv.z); sh[14] = bflo(nv.w); sh[15] = bfhi(nv.w); }
#pragma unroll 1
        for (int c = 0; c < 6; ++c) { float m[16], o[16]; ldrow_f32(mu + c * D, F.lane, m);
#pragma unroll
            for (int e = 0; e < 16; ++e) o[e] = u[e] + (sh[e] - u[e]) * m[e];
            strow_bf16(XM + ((size_t)c * NTOK + t) * D, F.lane, o); }
    }
}
struct RwkvInSched {
    const char* XM; const char* Win; const char* Wl1; int G, c;
    __device__ __forceinline__ bool next(int i, gg::Unit& u) const {
        const int L0 = i * G + c; if (L0 >= 975) return false; const int L = xcd_remap(L0, 975);
        int g, pm, pn;
        if (L < 780) { g = L / 260; const int r = L % 260; pm = r >> 2; pn = r & 3; u.b = Win + ((size_t)g * 1024 + pn * 256) * 2048; }
        else { const int r = L - 780; g = 3 + r / 65; pm = r % 65; pn = 0; u.b = Wl1 + (size_t)(g - 3) * 256 * 2048; }
        u.a = XM + ((size_t)g * NTOK + pm * 256) * 2048; u.b2 = nullptr; u.pm = pm; u.pn = pn; u.gofs = 0; u.x = g; return true; }
};
struct EpiRwkvIn {
    static constexpr bool PERM = true;
    bf16_t* RKV; bf16_t* L1;
    __device__ __forceinline__ void operator()(const gg::Acc& acc, const gg::Unit& u, int wr, int wc, int fr, int fq) const {
        const int g = u.x; const bool lora = g >= 3;
        bf16_t* O = lora ? L1 + (size_t)(g - 3) * NTOK * 256 : RKV + (size_t)g * (33 * MiB / 2); const int ldc = lora ? 256 : 1024;
        const int row0 = u.pm * 256 + wr * 64 + fr, col0 = u.pn * 256 + wc * 32 + 8 * fq;
#pragma unroll
        for (int ai = 0; ai < 2; ++ai)
#pragma unroll
            for (int m = 0; m < 4; ++m) { bf16_t* rp = O + (size_t)(row0 + ai * 128 + m * 16) * ldc + col0;
#pragma unroll
                for (int bj = 0; bj < 2; ++bj) { f32x4 v0 = acc[ai][bj][m][0], v1 = acc[ai][bj][m][1];
                    if (g == 3) {
#pragma unroll
                        for (int e = 0; e < 4; ++e) { v0[e] = 1.0f - 2.0f * __builtin_amdgcn_rcpf(1.0f + __expf(2.0f * v0[e])); v1[e] = 1.0f - 2.0f * __builtin_amdgcn_rcpf(1.0f + __expf(2.0f * v1[e])); } }
                    if (g == 5) {
#pragma unroll
                        for (int e = 0; e < 4; ++e) { v0[e] = sigmoidf_(v0[e]); v1[e] = sigmoidf_(v1[e]); } }
                    u32x4 o; o.x = pk2(v0[0], v0[1]); o.y = pk2(v0[2], v0[3]); o.z = pk2(v1[0], v1[1]); o.w = pk2(v1[2], v1[3]);
                    *(u32x4*)(rp + bj * 128) = o; } }
    }
};
__device__ __forceinline__ void rwkv_in_gemm_phase(Frame& F, const Args& a) {
    RwkvInSched S{(const char*)(a.ws + RW_XM), (const char*)(a.ws + WS_W_RWKV_IN), (const char*)(a.ws + WS_W_RWKV_L1), (int)gridDim.x, (int)blockIdx.x};
    EpiRwkvIn E{(bf16_t*)(a.ws + RW_R), (bf16_t*)(a.ws + RW_L1)};
    gg::gemm_phase<EpiRwkvIn, RwkvInSched, false, false>(F.lds + LDS_STAGE, gg::Dims{1024, 1024, 1024, 0, 0}, S, E);
}
struct RwkvL2Sched {
    const char* L1; const char* W2; int G, c;
    __device__ __forceinline__ bool next(int i, gg::Unit& u) const {
        const int L0 = i * G + c; if (L0 >= 1300) return false; const int L = xcd_remap(L0, 1300);
        const int g = L / 260, r = L % 260, pm = r >> 2, pn = r & 3, src = g >> 1;
        u.a = L1 + ((size_t)src * NTOK + pm * 256) * 512; u.b = W2 + ((size_t)g * 1024 + pn * 256) * 512; u.b2 = nullptr; u.pm = pm; u.pn = pn; u.gofs = 0; u.x = g; return true; }
};
struct EpiRwkvL2 {
    static constexpr bool PERM = true;
    float* WW; bf16_t* AA; bf16_t* GG;
    __device__ __forceinline__ void operator()(const gg::Acc& acc, const gg::Unit& u, int wr, int wc, int fr, int fq) const {
        const int g = u.x, z = g & 1; const int row0 = u.pm * 256 + wr * 64 + fr, col0 = u.pn * 256 + wc * 32 + 8 * fq;
        float* wbase = WW + (size_t)z * NTOK * 1024; bf16_t* obase = g < 4 ? AA + (size_t)z * NTOK * 1024 : GG;
#pragma unroll
        for (int ai = 0; ai < 2; ++ai)
#pragma unroll
            for (int m = 0; m < 4; ++m) { const size_t ro = (size_t)(row0 + ai * 128 + m * 16) * 1024 + col0;
#pragma unroll
                for (int bj = 0; bj < 2; ++bj) { const f32x4 v0 = acc[ai][bj][m][0], v1 = acc[ai][bj][m][1];
                    if (g < 2) { float* wp = wbase + ro + bj * 128; *(f32x4*)wp = v0; *(f32x4*)(wp + 4) = v1; }
                    else { u32x4 o; o.x = pk2(v0[0], v0[1]); o.y = pk2(v0[2], v0[3]); o.z = pk2(v1[0], v1[1]); o.w = pk2(v1[2], v1[3]); *(u32x4*)(obase + ro + bj * 128) = o; } } }
    }
};
__device__ __forceinline__ void rwkv_l2_gemm_phase(Frame& F, const Args& a) {
    RwkvL2Sched S{(const char*)(a.ws + RW_L1), (const char*)(a.ws + WS_W_RWKV_WL2), (int)gridDim.x, (int)blockIdx.x};
    EpiRwkvL2 E{(float*)(a.ws + RW_WW), (bf16_t*)(a.ws + RW_AA), (bf16_t*)(a.ws + RW_G)};
    gg::gemm_phase<EpiRwkvL2, RwkvL2Sched, false, false>(F.lds + LDS_STAGE, gg::Dims{256, 256, 256, 0, 0}, S, E);
}
__device__ __forceinline__ int rwkv_row(int z, int n) { return z == 0 ? n : (n < NCTX ? NCTX - 1 - n : NTOK - 1 + NCTX - n); }
__device__ __forceinline__ void rwkv_rec_phase(Frame& F, const Args& a) {
    const bf16_t* R = (const bf16_t*)(a.ws + RW_R); const bf16_t* K = (const bf16_t*)(a.ws + RW_K); const bf16_t* V = (const bf16_t*)(a.ws + RW_V);
    const float* WW = (const float*)(a.ws + RW_WW); const bf16_t* AA = (const bf16_t*)(a.ws + RW_AA); unsigned char* REC = a.ws + RW_REC;
    const int lane = F.lane;
    float kkw[16], kaw[16]; ldrow_f32(a.in[25], lane, kkw); ldrow_f32(a.in[26], lane, kaw);
#pragma unroll 1
    for (int t = F.gw; t < NTOK; t += F.ngw) {
        float k[16], r[16], v[16], kk[16];
        ldrow_bf16(K + (size_t)t * 1024, lane, k); ldrow_bf16(R + (size_t)t * 1024, lane, r); ldrow_bf16(V + (size_t)t * 1024, lane, v);
#pragma unroll
        for (int j = 0; j < 2; ++j) { float ss = 0.f;
#pragma unroll
            for (int e = 0; e < 8; ++e) { kk[8 * j + e] = k[8 * j + e] * kkw[8 * j + e]; ss += kk[8 * j + e] * kk[8 * j + e]; }
#pragma unroll
            for (int m = 1; m < 8; m <<= 1) ss += __shfl_xor(ss, m);
            const float rn = __builtin_amdgcn_rsqf(ss + 1e-12f);
#pragma unroll
            for (int e = 0; e < 8; ++e) kk[8 * j + e] *= rn; }
#pragma unroll
        for (int z = 0; z < 2; ++z) {
            float ap[16], wp[16], a0v[16], w0v[16];
            ldrow_bf16(AA + ((size_t)z * NTOK + t) * 1024, lane, ap); ldrow_f32(WW + ((size_t)z * NTOK + t) * 1024, lane, wp); ldrow_f32(a.in[20] + z * 1024, lane, a0v); ldrow_f32(a.in[17] + z * 1024, lane, w0v);
            const int n = (z == 0) ? t : (t < NCTX ? NCTX - 1 - t : NTOK - 1 + NCTX - t);
#pragma unroll
            for (int j = 0; j < 2; ++j) {
                const int col = 8 * lane + 512 * j, hh = col >> 6, cin = col & 63;
                h8_t ow, okk, ob, okt, orr, ov;
#pragma unroll
                for (int e = 0; e < 8; ++e) { const int x = 8 * j + e; const float av = sigmoidf_(a0v[x] + ap[x]), wv = __expf(-0.6065306597126334f * sigmoidf_(w0v[x] + wp[x]));
                    ow[e] = (_Float16)wv; okk[e] = (_Float16)kk[x]; ob[e] = (_Float16)(av * kk[x]); okt[e] = (_Float16)(k[x] * (1.0f + (av - 1.0f) * kaw[x])); orr[e] = (_Float16)r[x]; ov[e] = (_Float16)v[x]; }
                unsigned char* rec = REC + ((size_t)(z * 16 + hh) * NTOK + n) * RECB + cin * 2;
                *(h8_t*)(rec) = ow; *(h8_t*)(rec + 128) = okk; *(h8_t*)(rec + 256) = ob; *(h8_t*)(rec + 384) = okt; *(h8_t*)(rec + 512) = orr; *(h8_t*)(rec + 640) = ov;
            }
        }
    }
}
__device__ __forceinline__ float quad_sum(float x) {
    x += __builtin_bit_cast(float, __builtin_amdgcn_mov_dpp(__builtin_bit_cast(int, x), 0xB1, 0xF, 0xF, true));
    x += __builtin_bit_cast(float, __builtin_amdgcn_mov_dpp(__builtin_bit_cast(int, x), 0x4E, 0xF, 0xF, true));
    return x;
}
template <bool VTERM, bool OUT>
__device__ __forceinline__ void rwkv_scan_task(const unsigned char* rec, LAS unsigned char* buf, int lane, h2_t (&S)[4][8], bf16_t* Ozh, int z, int n0, int nck) {
    const int v_lo = lane >> 2, kq = lane & 3;
#define RW_DMA(ck_, bsel_) do { _Pragma("unroll") for (int m = 0; m < 6; ++m) \
        __builtin_amdgcn_global_load_lds((const unsigned*)(rec + (size_t)(ck_) * 8 * RECB + (size_t)(lane + 64 * m) * 16), (LAS unsigned*)(buf + (bsel_) * 6144 + m * 1024), 16, 0, 0); } while (0)
    RW_DMA(0, 0);
#pragma unroll 1
    for (int ck = 0; ck < nck; ++ck) {
        if (ck < nck - 1) { RW_DMA(ck + 1, (ck + 1) & 1); asm volatile("s_waitcnt vmcnt(6)" ::: "memory"); }
        else asm volatile("s_waitcnt vmcnt(0)" ::: "memory");
        const LAS unsigned char* cb = buf + (ck & 1) * 6144;
#pragma unroll 2
        for (int st = 0; st < 8; ++st) {
            const LAS unsigned char* b = cb + st * RECB + kq * 32;
            h2_t kk[8], wv[8], bv[8], kt[8], rv[8];
            { const h8_t x0 = *(const LAS h8_t*)(b + 128), x1 = *(const LAS h8_t*)(b + 128 + 16);
#pragma unroll
              for (int p2 = 0; p2 < 4; ++p2) { kk[p2] = (h2_t){x0[2 * p2], x0[2 * p2 + 1]}; kk[4 + p2] = (h2_t){x1[2 * p2], x1[2 * p2 + 1]}; } }
            float sa[4];
#pragma unroll
            for (int i = 0; i < 4; ++i) { float a0 = 0.f, a1 = 0.f;
#pragma unroll
                for (int p2 = 0; p2 < 8; p2 += 2) { a0 = __builtin_amdgcn_fdot2(S[i][p2], kk[p2], a0, false); a1 = __builtin_amdgcn_fdot2(S[i][p2 + 1], kk[p2 + 1], a1, false); }
                sa[i] = quad_sum(a0 + a1); }
            { const h8_t x0 = *(const LAS h8_t*)(b), x1 = *(const LAS h8_t*)(b + 16), y0 = *(const LAS h8_t*)(b + 256), y1 = *(const LAS h8_t*)(b + 256 + 16);
#pragma unroll
              for (int p2 = 0; p2 < 4; ++p2) { wv[p2] = (h2_t){x0[2 * p2], x0[2 * p2 + 1]}; wv[4 + p2] = (h2_t){x1[2 * p2], x1[2 * p2 + 1]}; bv[p2] = (h2_t){y0[2 * p2], y0[2 * p2 + 1]}; bv[4 + p2] = (h2_t){y1[2 * p2], y1[2 * p2 + 1]}; } }
            if (VTERM) { const h8_t x0 = *(const LAS h8_t*)(b + 384), x1 = *(const LAS h8_t*)(b + 384 + 16);
#pragma unroll
              for (int p2 = 0; p2 < 4; ++p2) { kt[p2] = (h2_t){x0[2 * p2], x0[2 * p2 + 1]}; kt[4 + p2] = (h2_t){x1[2 * p2], x1[2 * p2 + 1]}; } }
            if (OUT) { const h8_t x0 = *(const LAS h8_t*)(b + 512), x1 = *(const LAS h8_t*)(b + 512 + 16);
#pragma unroll
              for (int p2 = 0; p2 < 4; ++p2) { rv[p2] = (h2_t){x0[2 * p2], x0[2 * p2 + 1]}; rv[4 + p2] = (h2_t){x1[2 * p2], x1[2 * p2 + 1]}; } }
            float oi[4];
#pragma unroll
            for (int i = 0; i < 4; ++i) {
                const _Float16 nsa = (_Float16)(-sa[i]); const h2_t nsa2 = {nsa, nsa};
                h2_t vv2 = {(_Float16)0, (_Float16)0};
                if (VTERM) { const _Float16 vh = *(const LAS _Float16*)(cb + st * RECB + 640 + (16 * i + v_lo) * 2); vv2 = (h2_t){vh, vh}; }
                float o0 = 0.f, o1 = 0.f;
#pragma unroll
                for (int p2 = 0; p2 < 8; ++p2) {
                    h2_t t = nsa2 * bv[p2]; if (VTERM) t = __builtin_elementwise_fma(vv2, kt[p2], t);
                    S[i][p2] = __builtin_elementwise_fma(S[i][p2], wv[p2], t);
                    if (OUT) { if (p2 & 1) o1 = __builtin_amdgcn_fdot2(S[i][p2], rv[p2], o1, false); else o0 = __builtin_amdgcn_fdot2(S[i][p2], rv[p2], o0, false); } }
                if (OUT) oi[i] = quad_sum(o0 + o1);
            }
            if (OUT) { const float o = kq == 0 ? oi[0] : kq == 1 ? oi[1] : kq == 2 ? oi[2] : oi[3];
                Ozh[(size_t)rwkv_row(z, n0 + ck * 8 + st) * 1024 + 16 * kq + v_lo] = (unsigned short)f2bf(o); }
        }
    }
#undef RW_DMA
}
#define RW_STORE_STATE(dst_) do { _Pragma("unroll") for (int i = 0; i < 4; ++i) _Pragma("unroll") for (int p4 = 0; p4 < 4; ++p4) \
        *(f32x4*)((dst_) + (16 * i + v_lo) * 64 + 16 * kq + 4 * p4) = (f32x4){(float)S[i][2 * p4][0], (float)S[i][2 * p4][1], (float)S[i][2 * p4 + 1][0], (float)S[i][2 * p4 + 1][1]}; } while (0)
template <int KIND>
__device__ __forceinline__ void rwkv_scan_phase(Frame& F, const Args& a) {
    const unsigned char* REC = a.ws + RW_REC; float* PQ = (float*)(a.ws + RW_PQ); float* SST = (float*)(a.ws + RW_SST); bf16_t* O = (bf16_t*)(a.ws + RW_O); bf16_t* Y = (bf16_t*)(a.ws + RW_Y);
    LAS unsigned char* buf = F.lds + LDS_STAGE + F.wave * 12288;
    const int lane = F.lane, v_lo = lane >> 2, kq = lane & 3;
#pragma unroll 1
    for (int task = F.gw; task < 2048; task += F.ngw) {
        const int zh = task & 31, z = zh >> 4, h = zh & 15, sidx = task >> 5;
        h2_t S[4][8];
#pragma unroll
        for (int i = 0; i < 4; ++i)
#pragma unroll
            for (int p2 = 0; p2 < 8; ++p2) S[i][p2] = (h2_t){(_Float16)0.f, (_Float16)0.f};
        if (sidx == 0) {
            rwkv_scan_task<true, true>(REC + (size_t)zh * NTOK * RECB, buf, lane, S, O + (size_t)z * NTOK * 1024 + h * 64, z, 0, 64);
            float* dst = SST + ((size_t)zh * 65 + 2) * 4096; RW_STORE_STATE(dst);
        } else {
            const int s = sidx + 1; const unsigned char* rec = REC + ((size_t)zh * NTOK + (size_t)s * 256) * RECB;
            rwkv_scan_task<true, true>(rec, buf, lane, S, O + (size_t)z * NTOK * 1024 + h * 64, z, s * 256, 32);
            { float* dst = PQ + ((size_t)zh * 64 + (s - 1)) * 8192 + 4096; RW_STORE_STATE(dst); }
#pragma unroll
            for (int i = 0; i < 4; ++i)
#pragma unroll
                for (int p2 = 0; p2 < 8; ++p2) { const int key = 16 * kq + 2 * p2, vr = 16 * i + v_lo; S[i][p2] = (h2_t){(_Float16)(vr == key ? 1.0f : 0.f), (_Float16)(vr == key + 1 ? 1.0f : 0.f)}; }
            asm volatile("s_waitcnt lgkmcnt(0)" ::: "memory");
            rwkv_scan_task<false, true>(rec, buf, lane, S, Y + (size_t)z * NTOK * 1024 + h * 64, z, s * 256, 32);
            { float* dst = PQ + ((size_t)zh * 64 + (s - 1)) * 8192; RW_STORE_STATE(dst); }
        }
        asm volatile("s_waitcnt lgkmcnt(0)" ::: "memory");
    }
}
constexpr int CK_TS = 144, CK_YS = 272;
constexpr int CK_AH = 0, CK_BH = 9216, CK_KH = 18432, CK_RH = 27648, CK_VV = 36864, CK_BB = 46080, CK_KB = 55296, CK_NM = 64512, CK_MAK = 73728, CK_MRB = 82944, CK_MRK = 92160,
              CK_YY = 101376, CK_SS = 118784, CK_DEC = 137216, CK_TOT = 137472, CK_TD = 139776, CK_TMP = 141824, CK_CT = 150016;
__device__ __forceinline__ void rwkv_chunk_phase(Frame& F, const Args& a) {
    float* PQ = (float*)(a.ws + RW_PQ); float* SST = (float*)(a.ws + RW_SST);
    LAS unsigned char* L = F.lds + LDS_STAGE;
    LAS float* DEC = (LAS float*)(L + CK_DEC); LAS float* TOT = (LAS float*)(L + CK_TOT); LAS float* CT = (LAS float*)(L + CK_CT);
    const int tid = F.tid, lane = F.lane, w = F.wave, c16 = lane & 15, q = lane >> 4;
    const int si = tid >> 3, c8 = tid & 7;
    const bool zset = w >= 4;
#pragma unroll 1
    for (int unit = blockIdx.x; unit < 2048; unit += gridDim.x) {
        const int zh = unit & 31, z = zh >> 4, h = zh & 15, sidx = unit >> 5;
        const int n0 = sidx == 0 ? 0 : (sidx + 1) * 256, nblk = sidx == 0 ? 8 : 4; const bool use_p = sidx != 0;
        if (tid < 64) { CT[tid] = a.in[25][h * 64 + tid]; CT[64 + tid] = a.in[26][h * 64 + tid]; CT[128 + tid] = a.in[20][z * 1024 + h * 64 + tid]; CT[192 + tid] = a.in[17][z * 1024 + h * 64 + tid]; }
        f32x4 accS[4];
#pragma unroll
        for (int kt = 0; kt < 4; ++kt)
#pragma unroll
            for (int r = 0; r < 4; ++r) { const float v0 = (!zset && (16 * w + 4 * q + r) == (16 * kt + c16)) ? 1.0f : 0.f; accS[kt][r] = v0;
                *(LAS unsigned short*)(L + CK_SS + (16 * w + 4 * q + r) * CK_TS + (16 * kt + c16) * 2) = (unsigned short)f2bf(v0); }
        __syncthreads();
        u32x4 pkx, pax, prx, pvx; f32x4 pw0, pw1;
#define CK_PREFETCH(blk_) do { int _t = threadIdx.x; asm volatile("" : "+v"(_t)); const int _trow = rwkv_row(z, n0 + (blk_) * 64 + (_t >> 3)); const unsigned _go = (unsigned)(_trow * 1024 + h * 64 + 8 * (_t & 7)) * 2u; \
            const unsigned char* _w = a.ws; const unsigned _zo = (unsigned)z * (unsigned)(NTOK * 1024 * 2); \
            pkx = *(const u32x4*)(_w + RW_K + _go); pax = *(const u32x4*)(_w + RW_AA + _zo + _go); prx = *(const u32x4*)(_w + RW_R + _go); pvx = *(const u32x4*)(_w + RW_V + _go); \
            pw0 = *(const f32x4*)(_w + RW_WW + 2u * _zo + 2u * _go); pw1 = *(const f32x4*)(_w + RW_WW + 2u * _zo + 2u * _go + 16u); } while (0)
        CK_PREFETCH(0);
#pragma unroll 1
        for (int blk = 0; blk < nblk; ++blk) {
            int tid_o = threadIdx.x; asm volatile("" : "+v"(tid_o));
            const int lane = tid_o & 63, c16 = lane & 15, q = lane >> 4, si = tid_o >> 3, c8 = tid_o & 7;
            float lw[8], kkv[8], bv[8], ktv[8]; u32x4 rx, vx;
            {
                const u32x4 kx = pkx, ax = pax; rx = prx; vx = pvx; const f32x4 wx0 = pw0, wx1 = pw1;
                const float kf[8] = {bflo(kx.x), bfhi(kx.x), bflo(kx.y), bfhi(kx.y), bflo(kx.z), bfhi(kx.z), bflo(kx.w), bfhi(kx.w)};
                const float af[8] = {bflo(ax.x), bfhi(ax.x), bflo(ax.y), bfhi(ax.y), bflo(ax.z), bfhi(ax.z), bflo(ax.w), bfhi(ax.w)};
                const float wf[8] = {wx0[0], wx0[1], wx0[2], wx0[3], wx1[0], wx1[1], wx1[2], wx1[3]};
                const f32x4 c0a = *(const LAS f32x4*)(CT + 8 * c8), c0b = *(const LAS f32x4*)(CT + 8 * c8 + 4);
                float ss = 0.f;
#pragma unroll
                for (int e = 0; e < 8; ++e) { const float kkw = e < 4 ? c0a[e] : c0b[e - 4]; kkv[e] = kf[e] * kkw; ss += kkv[e] * kkv[e]; }
                ss += __shfl_xor(ss, 1); ss += __shfl_xor(ss, 2); ss += __shfl_xor(ss, 4);
                const float rn = __builtin_amdgcn_rsqf(ss + 1e-12f);
                asm volatile("" ::: "memory");
                const f32x4 c1a = *(const LAS f32x4*)(CT + 64 + 8 * c8), c1b = *(const LAS f32x4*)(CT + 64 + 8 * c8 + 4);
                const f32x4 c2a = *(const LAS f32x4*)(CT + 128 + 8 * c8), c2b = *(const LAS f32x4*)(CT + 128 + 8 * c8 + 4), c3a = *(const LAS f32x4*)(CT + 192 + 8 * c8), c3b = *(const LAS f32x4*)(CT + 192 + 8 * c8 + 4);
#pragma unroll
                for (int e = 0; e < 8; ++e) { const float kaw = e < 4 ? c1a[e] : c1b[e - 4], a0e = e < 4 ? c2a[e] : c2b[e - 4], w0e = e < 4 ? c3a[e] : c3b[e - 4];
                    const float av = sigmoidf_(a0e + af[e]); kkv[e] *= rn; bv[e] = av * kkv[e]; ktv[e] = kf[e] * (1.0f + (av - 1.0f) * kaw);
                    lw[e] = -0.6065306597126334f * sigmoidf_(w0e + wf[e]); }
            }
            float G[8];
#pragma unroll
            for (int e = 0; e < 8; ++e) { float x = lw[e]; float y = __shfl_up(x, 8); if (lane >= 8) x += y; y = __shfl_up(x, 16); if (lane >= 16) x += y; y = __shfl_up(x, 32); if (lane >= 32) x += y; G[e] = x; }
            if (lane >= 56) { *(LAS f32x4*)(TOT + w * 64 + 8 * c8) = (f32x4){G[0], G[1], G[2], G[3]}; *(LAS f32x4*)(TOT + w * 64 + 8 * c8 + 4) = (f32x4){G[4], G[5], G[6], G[7]}; }
            __syncthreads();
            {
                float tot[8];
#pragma unroll
                for (int e = 0; e < 8; ++e) tot[e] = 0.f;
#pragma unroll
                for (int ww = 0; ww < 8; ++ww) { const f32x4 t0 = *(const LAS f32x4*)(TOT + ww * 64 + 8 * c8), t1 = *(const LAS f32x4*)(TOT + ww * 64 + 8 * c8 + 4);
#pragma unroll
                    for (int e = 0; e < 8; ++e) { const float tv = e < 4 ? t0[e] : t1[e - 4]; tot[e] += tv; if (ww < w) G[e] += tv; } }
                if (si == 0) { *(LAS f32x4*)(DEC + 8 * c8) = (f32x4){__expf(tot[0]), __expf(tot[1]), __expf(tot[2]), __expf(tot[3])}; *(LAS f32x4*)(DEC + 8 * c8 + 4) = (f32x4){__expf(tot[4]), __expf(tot[5]), __expf(tot[6]), __expf(tot[7])}; }
                const unsigned rw4[4] = {rx.x, rx.y, rx.z, rx.w}; const int to = si * CK_TS + 16 * c8;
                *(LAS u32x4*)(L + CK_VV + to) = vx;
#pragma unroll
                for (int e2 = 0; e2 < 4; ++e2) { float o7[6][2];
#pragma unroll
                    for (int hh = 0; hh < 2; ++hh) { const int e = 2 * e2 + hh; const float Ge = G[e]; const float rve = hh ? bfhi(rw4[e2]) : bflo(rw4[e2]);
                        const float eg = __expf(Ge), egm = __expf(Ge - lw[e]), eng = __expf(fminf(-Ge, 80.0f)), etg = __expf(tot[e] - Ge);
                        o7[0][hh] = -kkv[e] * egm; o7[1][hh] = bv[e] * eng; o7[2][hh] = ktv[e] * eng; o7[3][hh] = rve * eg; o7[4][hh] = bv[e] * etg; o7[5][hh] = ktv[e] * etg; }
                    *(LAS unsigned*)(L + CK_AH + to + 4 * e2) = pk2(o7[0][0], o7[0][1]); *(LAS unsigned*)(L + CK_BH + to + 4 * e2) = pk2(o7[1][0], o7[1][1]); *(LAS unsigned*)(L + CK_KH + to + 4 * e2) = pk2(o7[2][0], o7[2][1]);
                    *(LAS unsigned*)(L + CK_RH + to + 4 * e2) = pk2(o7[3][0], o7[3][1]); *(LAS unsigned*)(L + CK_BB + to + 4 * e2) = pk2(o7[4][0], o7[4][1]); *(LAS unsigned*)(L + CK_KB + to + 4 * e2) = pk2(o7[5][0], o7[5][1]); }
                if (blk + 1 < nblk) CK_PREFETCH(blk + 1);
            }
            __syncthreads();
            { const int it = w >> 1;
              bf16x8 fa[2], fr[2];
#pragma unroll
              for (int ks = 0; ks < 2; ++ks) { fa[ks] = lds_row_frag(L + CK_AH, CK_TS, 16 * it + c16, 32 * ks + 8 * q); fr[ks] = lds_row_frag(L + CK_RH, CK_TS, 16 * it + c16, 32 * ks + 8 * q); }
#pragma unroll 1
              for (int s2 = 0; s2 < 2; ++s2) { const int jt = 2 * (w & 1) + s2; f32x4 n0v = {0.f, 0.f, 0.f, 0.f}, n1v = n0v, n2v = n0v, n3v = n0v;
#pragma unroll
                  for (int ks = 0; ks < 2; ++ks) { const bf16x8 fb = lds_row_frag(L + CK_BH, CK_TS, 16 * jt + c16, 32 * ks + 8 * q), fk = lds_row_frag(L + CK_KH, CK_TS, 16 * jt + c16, 32 * ks + 8 * q);
                      n0v = __builtin_amdgcn_mfma_f32_16x16x32_bf16(fa[ks], fb, n0v, 0, 0, 0); n1v = __builtin_amdgcn_mfma_f32_16x16x32_bf16(fa[ks], fk, n1v, 0, 0, 0);
                      n2v = __builtin_amdgcn_mfma_f32_16x16x32_bf16(fr[ks], fb, n2v, 0, 0, 0); n3v = __builtin_amdgcn_mfma_f32_16x16x32_bf16(fr[ks], fk, n3v, 0, 0, 0); }
#pragma unroll
                  for (int r = 0; r < 4; ++r) { const int i = 16 * it + 4 * q + r, j = 16 * jt + c16, o = i * CK_TS + j * 2;
                      n0v[r] = j < i ? n0v[r] : 0.f;
                      *(LAS unsigned short*)(L + CK_NM + o) = (unsigned short)f2bf(n0v[r]); *(LAS unsigned short*)(L + CK_MAK + o) = (unsigned short)f2bf(j < i ? n1v[r] : 0.f);
                      *(LAS unsigned short*)(L + CK_MRB + o) = (unsigned short)f2bf(j <= i ? n2v[r] : 0.f); *(LAS unsigned short*)(L + CK_MRK + o) = (unsigned short)f2bf(j <= i ? n3v[r] : 0.f); }
                  if (jt == it) {
                      LAS unsigned char* tp = L + CK_TMP + w * 1024; LAS unsigned char* tt = tp + 512;
                      f32x4 P = n0v, T = n0v;
#pragma unroll
                      for (int r = 0; r < 4; ++r) T[r] += (4 * q + r == c16) ? 1.0f : 0.f;
#pragma unroll
                      for (int pw = 0; pw < 3; ++pw) {
#pragma unroll
                          for (int r = 0; r < 4; ++r) { *(LAS unsigned short*)(tp + (4 * q + r) * 32 + c16 * 2) = (unsigned short)f2bf(P[r]); *(LAS unsigned short*)(tt + (4 * q + r) * 32 + c16 * 2) = (unsigned short)f2bf(T[r]); }
                          bf16x4 pb; pb[0] = (short)f2bf(P[0]); pb[1] = (short)f2bf(P[1]); pb[2] = (short)f2bf(P[2]); pb[3] = (short)f2bf(P[3]);
                          const bf16x4 pa = *(const LAS bf16x4*)(tp + c16 * 32 + 8 * q), ta = *(const LAS bf16x4*)(tt + c16 * 32 + 8 * q);
                          f32x4 zero = {0.f, 0.f, 0.f, 0.f};
                          P = __builtin_amdgcn_mfma_f32_16x16x16bf16_1k(pa, pb, zero, 0, 0, 0);
                          bf16x4 pn; pn[0] = (short)f2bf(P[0]); pn[1] = (short)f2bf(P[1]); pn[2] = (short)f2bf(P[2]); pn[3] = (short)f2bf(P[3]);
                          T = __builtin_amdgcn_mfma_f32_16x16x16bf16_1k(ta, pn, T, 0, 0, 0);
                      }
#pragma unroll
                      for (int r = 0; r < 4; ++r) *(LAS unsigned short*)(L + CK_TD + it * 512 + (4 * q + r) * 32 + c16 * 2) = (unsigned short)f2bf(T[r]);
                  } } }
            __syncthreads();
            const bool active = zset || use_p;
            if (active) {
                f32x4 yv[4];
#pragma unroll
                for (int it = 0; it < 4; ++it) yv[it] = (f32x4){0.f, 0.f, 0.f, 0.f};
                bf16x8 sb[2];
#pragma unroll
                for (int ks = 0; ks < 2; ++ks) { sb[ks] = lds_row_frag(L + CK_SS, CK_TS, 16 * w + c16, 32 * ks + 8 * q);
#pragma unroll
                    for (int it = 0; it < 4; ++it) yv[it] = __builtin_amdgcn_mfma_f32_16x16x32_bf16(lds_row_frag(L + CK_AH, CK_TS, 16 * it + c16, 32 * ks + 8 * q), sb[ks], yv[it], 0, 0, 0); }
                bf16x8 vb[2];
                if (zset) {
#pragma unroll
                    for (int ks = 0; ks < 2; ++ks) { vb[ks] = lds_tr_frag(L + CK_VV, CK_TS, 32 * ks, 16 * (w - 4), lane);
#pragma unroll
                        for (int it = 0; it < 4; ++it) yv[it] = __builtin_amdgcn_mfma_f32_16x16x32_bf16(lds_row_frag(L + CK_MAK, CK_TS, 16 * it + c16, 32 * ks + 8 * q), vb[ks], yv[it], 0, 0, 0); } }
                asm volatile("" ::: "memory");
                bf16x4 ub[4];
#pragma unroll
                for (int b = 0; b < 4; ++b) { f32x4 acc = yv[b];
#pragma unroll
                    for (int c = 0; c < 4; ++c) if (c < b) acc = __builtin_amdgcn_mfma_f32_16x16x16bf16_1k(*(const LAS bf16x4*)(L + CK_NM + (16 * b + c16) * CK_TS + (16 * c + 4 * q) * 2), ub[c], acc, 0, 0, 0);
                    bf16x4 ab; ab[0] = (short)f2bf(acc[0]); ab[1] = (short)f2bf(acc[1]); ab[2] = (short)f2bf(acc[2]); ab[3] = (short)f2bf(acc[3]);
                    const f32x4 zero = {0.f, 0.f, 0.f, 0.f};
                    const f32x4 ubf = __builtin_amdgcn_mfma_f32_16x16x16bf16_1k(*(const LAS bf16x4*)(L + CK_TD + b * 512 + c16 * 32 + 8 * q), ab, zero, 0, 0, 0);
                    ub[b][0] = (short)f2bf(ubf[0]); ub[b][1] = (short)f2bf(ubf[1]); ub[b][2] = (short)f2bf(ubf[2]); ub[b][3] = (short)f2bf(ubf[3]); }
                asm volatile("" ::: "memory");
                { int q3 = lane >> 4, c3 = lane & 15; asm volatile("" : "+v"(q3), "+v"(c3));
                  unsigned char* dstb = a.ws + (zset ? RW_O : RW_Y); const unsigned dco = ((unsigned)z * (unsigned)(NTOK * 1024) + (unsigned)(h * 64 + 16 * (w & 3) + c3)) * 2u;
#pragma unroll
                  for (int it = 0; it < 4; ++it) { f32x4 ov = {0.f, 0.f, 0.f, 0.f};
#pragma unroll
                      for (int ks = 0; ks < 2; ++ks) ov = __builtin_amdgcn_mfma_f32_16x16x32_bf16(lds_row_frag(L + CK_RH, CK_TS, 16 * it + c16, 32 * ks + 8 * q), sb[ks], ov, 0, 0, 0);
#pragma unroll
                      for (int c = 0; c < 4; ++c) if (c <= it) ov = __builtin_amdgcn_mfma_f32_16x16x16bf16_1k(*(const LAS bf16x4*)(L + CK_MRB + (16 * it + c16) * CK_TS + (16 * c + 4 * q) * 2), ub[c], ov, 0, 0, 0);
                      if (zset) {
#pragma unroll
                          for (int ks = 0; ks < 2; ++ks) ov = __builtin_amdgcn_mfma_f32_16x16x32_bf16(lds_row_frag(L + CK_MRK, CK_TS, 16 * it + c16, 32 * ks + 8 * q), vb[ks], ov, 0, 0, 0); }
#pragma unroll
                      for (int r = 0; r < 4; ++r) *(unsigned short*)(dstb + dco + (unsigned)rwkv_row(z, n0 + blk * 64 + 16 * it + 4 * q3 + r) * 2048u) = (unsigned short)f2bf(ov[r]);
                      asm volatile("" ::: "memory"); } }
                asm volatile("" ::: "memory");
#pragma unroll
                for (int kt = 0; kt < 4; ++kt) { const float dc = DEC[16 * kt + c16];
#pragma unroll
                    for (int r = 0; r < 4; ++r) accS[kt][r] *= dc;
#pragma unroll
                    for (int c = 0; c < 4; ++c) { const int g = lane >> 4, qq = (lane & 15) >> 2, pp = lane & 3;
                        const v4s16 bt = __builtin_amdgcn_ds_read_tr16_b64_v4i16((LAS v4s16*)(L + CK_BB + (16 * c + 4 * g + qq) * CK_TS + (16 * kt + 4 * pp) * 2));
                        accS[kt] = __builtin_amdgcn_mfma_f32_16x16x16bf16_1k(ub[c], (bf16x4){bt[0], bt[1], bt[2], bt[3]}, accS[kt], 0, 0, 0); } }
                if (zset) {
#pragma unroll
                    for (int ks = 0; ks < 2; ++ks) { const bf16x8 va = vb[ks];
#pragma unroll
                        for (int kt = 0; kt < 4; ++kt) accS[kt] = __builtin_amdgcn_mfma_f32_16x16x32_bf16(va, lds_tr_frag(L + CK_KB, CK_TS, 32 * ks, 16 * kt, lane), accS[kt], 0, 0, 0); } }
            }
            __syncthreads();
            if (active) {
#pragma unroll
                for (int kt = 0; kt < 4; ++kt)
#pragma unroll
                    for (int r = 0; r < 4; ++r) *(LAS unsigned short*)(L + CK_SS + (16 * w + 4 * q + r) * CK_TS + (16 * kt + c16) * 2) = (unsigned short)f2bf(accS[kt][r]);
            }
        }
        { float* dst = sidx == 0 ? (zset ? SST + ((size_t)zh * 65 + 2) * 4096 : nullptr) : PQ + ((size_t)zh * 64 + sidx) * 8192 + (zset ? 4096 : 0);
          if (dst) { int q2 = lane >> 4, c2 = lane & 15; asm volatile("" : "+v"(q2), "+v"(c2));
#pragma unroll
              for (int kt = 0; kt < 4; ++kt)
#pragma unroll
                  for (int r = 0; r < 4; ++r) dst[(16 * (w & 3) + 4 * q2 + r) * 64 + 16 * kt + c2] = accS[kt][r]; } }
        __syncthreads();
    }
}
__device__ __forceinline__ void rwkv_corr_phase(Frame& F, const Args& a) {
    const float* SST = (const float*)(a.ws + RW_SST); bf16_t* O = (bf16_t*)(a.ws + RW_O); const bf16_t* Y = (const bf16_t*)(a.ws + RW_Y);
    const int lane = F.lane, c16 = lane & 15, q = lane >> 4;
#pragma unroll 1
    for (int task = F.gw; task < 2016; task += F.ngw) {
        const int zh = task & 31, z = zh >> 4, h = zh & 15, s = (task >> 5) + 2;
        const float* Ss = SST + ((size_t)zh * 65 + s) * 4096;
        bf16x8 Sf[4][2];
#pragma unroll
        for (int vt = 0; vt < 4; ++vt)
#pragma unroll
            for (int ks = 0; ks < 2; ++ks) { const f32x4 x0 = *(const f32x4*)(Ss + (16 * vt + c16) * 64 + 32 * ks + 8 * q), x1 = *(const f32x4*)(Ss + (16 * vt + c16) * 64 + 32 * ks + 8 * q + 4);
                bf16x8 f; f[0] = (short)f2bf(x0[0]); f[1] = (short)f2bf(x0[1]); f[2] = (short)f2bf(x0[2]); f[3] = (short)f2bf(x0[3]); f[4] = (short)f2bf(x1[0]); f[5] = (short)f2bf(x1[1]); f[6] = (short)f2bf(x1[2]); f[7] = (short)f2bf(x1[3]); Sf[vt][ks] = f; }
        const bf16_t* Yz = Y + (size_t)z * NTOK * 1024 + h * 64; bf16_t* Oz = O + (size_t)z * NTOK * 1024 + h * 64;
        LAS float* tile = (LAS float*)(F.lds + LDS_STAGE) + F.wave * (16 * 68);
        const int tr = lane >> 3, pc = lane & 7;
#pragma unroll 2
        for (int T = 0; T < 16; ++T) {
            const size_t row = (size_t)rwkv_row(z, s * 256 + 16 * T + c16) * 1024;
            const bf16x8 y0 = *(const bf16x8*)(Yz + row + 8 * q), y1 = *(const bf16x8*)(Yz + row + 32 + 8 * q);
            u32x4* op0 = (u32x4*)(Oz + (size_t)rwkv_row(z, s * 256 + 16 * T + tr) * 1024 + 8 * pc); u32x4* op1 = (u32x4*)(Oz + (size_t)rwkv_row(z, s * 256 + 16 * T + tr + 8) * 1024 + 8 * pc);
            const u32x4 o0 = *op0, o1 = *op1;
#pragma unroll
            for (int vt = 0; vt < 4; ++vt) { f32x4 d = {0.f, 0.f, 0.f, 0.f};
                d = __builtin_amdgcn_mfma_f32_16x16x32_bf16(Sf[vt][0], y0, d, 0, 0, 0); d = __builtin_amdgcn_mfma_f32_16x16x32_bf16(Sf[vt][1], y1, d, 0, 0, 0);
                *(LAS f32x4*)(tile + c16 * 68 + 16 * vt + 4 * q) = d; }
            const f32x4 a0 = *(const LAS f32x4*)(tile + tr * 68 + 8 * pc), a1 = *(const LAS f32x4*)(tile + tr * 68 + 8 * pc + 4);
            const f32x4 b0 = *(const LAS f32x4*)(tile + (tr + 8) * 68 + 8 * pc), b1 = *(const LAS f32x4*)(tile + (tr + 8) * 68 + 8 * pc + 4);
            u32x4 n0, n1;
            n0.x = pk2(bflo(o0.x) + a0[0], bfhi(o0.x) + a0[1]); n0.y = pk2(bflo(o0.y) + a0[2], bfhi(o0.y) + a0[3]); n0.z = pk2(bflo(o0.z) + a1[0], bfhi(o0.z) + a1[1]); n0.w = pk2(bflo(o0.w) + a1[2], bfhi(o0.w) + a1[3]);
            n1.x = pk2(bflo(o1.x) + b0[0], bfhi(o1.x) + b0[1]); n1.y = pk2(bflo(o1.y) + b0[2], bfhi(o1.y) + b0[3]); n1.z = pk2(bflo(o1.z) + b1[0], bfhi(o1.z) + b1[1]); n1.w = pk2(bflo(o1.w) + b1[2], bfhi(o1.w) + b1[3]);
            *op0 = n0; *op1 = n1;
        }
    }
}
__device__ __forceinline__ void rwkv_prefix_phase(Frame& F, const Args& a) {
    const float* PQ = (const float*)(a.ws + RW_PQ); float* SST = (float*)(a.ws + RW_SST);
    if (blockIdx.x >= 128) return;
    const int zh = blockIdx.x >> 2, r0 = (blockIdx.x & 3) * 16, tid = F.tid, lane = F.lane, w = F.wave, kq = lane >> 4, j = lane & 15;
    constexpr int PS = 68;
    LAS float* Sl = (LAS float*)(F.lds + LDS_STAGE);
    LAS float* Pl = Sl + 2 * 16 * 68;
    { const float* s1 = SST + ((size_t)zh * 65 + 2) * 4096 + r0 * 64;
      for (int i = tid; i < 1024; i += NTHREADS) Sl[(i >> 6) * 68 + (i & 63)] = s1[i]; }
    f32x4 pa[4], pc[4], qb[4];
    const int pr0 = tid >> 4, pc0 = (tid & 15) * 4;
#define RP_PG(step_) (PQ + ((size_t)zh * 64 + ((step_) - 1)) * 8192)
#define RP_LOADP(sl_, step_) do { const float* Pg = RP_PG(step_); pa[sl_] = *(const f32x4*)(Pg + 4 * tid); pc[sl_] = *(const f32x4*)(Pg + 4 * (tid + 512)); } while (0)
#define RP_LOADQ(sl_, step_) do { if (w < 4) { const float* Pg = RP_PG(step_); _Pragma("unroll") for (int r = 0; r < 4; ++r) qb[sl_][r] = Pg[4096 + (r0 + 4 * kq + r) * 64 + 16 * w + j]; } } while (0)
#define RP_PUTP(sl_, buf_) do { LAS float* Pd = Pl + (buf_) * (64 * PS); *(LAS f32x4*)(Pd + pr0 * PS + pc0) = pa[sl_]; *(LAS f32x4*)(Pd + (pr0 + 32) * PS + pc0) = pc[sl_]; } while (0)
    RP_LOADP(2, 2); RP_LOADP(3, 3); RP_LOADP(0, 4); RP_LOADP(1, 5);
    RP_LOADQ(2, 2); RP_LOADQ(3, 3); RP_LOADQ(0, 4); RP_LOADQ(1, 5);
    RP_PUTP(2, 0); RP_LOADP(2, 6);
    __syncthreads();
    int cur = 0;
#pragma unroll 1
    for (int s = 2; s < 64; s += 4) {
#pragma unroll
        for (int u = 0; u < 4; ++u) { const int step = s + u;
            if (step < 64) {
                const int slq = (2 + u) & 3, slp = (3 + u) & 3;
                f32x4 acc = qb[slq];
                if (w < 4) {
                    const LAS float* Sc = Sl + cur * (16 * 68); const LAS float* Pc = Pl + (step & 1) * (64 * PS);
#pragma unroll
                    for (int kk = 0; kk < 16; ++kk) acc = __builtin_amdgcn_mfma_f32_16x16x4f32(Sc[j * 68 + 4 * kk + kq], Pc[(4 * kk + kq) * PS + 16 * w + j], acc, 0, 0, 0);
                }
                if (step + 1 < 64) { RP_PUTP(slp, (step + 1) & 1); if (step + 5 < 64) RP_LOADP(slp, step + 5); }
                if (step + 4 < 64) RP_LOADQ(slq, step + 4);
                if (w < 4) {
                    LAS float* Sn = Sl + (cur ^ 1) * (16 * 68);
                    float* dst = SST + ((size_t)zh * 65 + step + 1) * 4096 + (r0 + 4 * kq) * 64 + 16 * w + j;
#pragma unroll
                    for (int r = 0; r < 4; ++r) { dst[r * 64] = acc[r]; Sn[(4 * kq + r) * 68 + 16 * w + j] = acc[r]; }
                }
                __syncthreads();
                cur ^= 1;
            }
        }
    }
#undef RP_PG
#undef RP_LOADP
#undef RP_LOADQ
#undef RP_PUTP
}
__device__ __forceinline__ void rwkv_readout_phase(Frame& F, const Args& a) {
    const bf16_t* O0 = (const bf16_t*)(a.ws + RW_O); const bf16_t* O1 = O0 + (size_t)NTOK * 1024; const bf16_t* R = (const bf16_t*)(a.ws + RW_R); const bf16_t* K = (const bf16_t*)(a.ws + RW_K);
    const bf16_t* V = (const bf16_t*)(a.ws + RW_V); const bf16_t* A0 = (const bf16_t*)(a.ws + RW_AA); const bf16_t* A1 = A0 + (size_t)NTOK * 1024; const bf16_t* G = (const bf16_t*)(a.ws + RW_G);
    bf16_t* A5 = (bf16_t*)(a.ws + RW_A5); const int lane = F.lane;
    float ka[16], rk[16], lg[16], lb[16], ab0[16], ab1[16]; ldrow_f32(a.in[20], lane, ab0); ldrow_f32(a.in[20] + 1024, lane, ab1); ldrow_f32(a.in[26], lane, ka); ldrow_f32(a.in[27], lane, rk); ldrow_f32(a.in[28], lane, lg); ldrow_f32(a.in[29], lane, lb);
    for (int t = F.gw; t < NTOK; t += F.ngw) {
        float o[16], r[16], k[16], v[16], a0[16], a1[16], g[16];
        ldrow_bf16(O0 + (size_t)t * 1024, lane, o); addrow_bf16(O1 + (size_t)t * 1024, lane, o); ldrow_bf16(R + (size_t)t * 1024, lane, r); ldrow_bf16(K + (size_t)t * 1024, lane, k);
        ldrow_bf16(V + (size_t)t * 1024, lane, v); ldrow_bf16(A0 + (size_t)t * 1024, lane, a0); ldrow_bf16(A1 + (size_t)t * 1024, lane, a1); ldrow_bf16(G + (size_t)t * 1024, lane, g);
#pragma unroll
        for (int j = 0; j < 2; ++j) { float s = 0.f, bn = 0.f;
#pragma unroll
            for (int e = 0; e < 8; ++e) { const int x = 8 * j + e; s += o[x]; bn += r[x] * k[x] * rk[x] * (2.0f + (sigmoidf_(a0[x] + ab0[x]) + sigmoidf_(a1[x] + ab1[x]) - 2.0f) * ka[x]); }
#pragma unroll
            for (int m = 1; m < 8; m <<= 1) { s += __shfl_xor(s, m); bn += __shfl_xor(bn, m); }
            const float mean = s * (1.0f / 64.0f); float q = 0.f;
#pragma unroll
            for (int e = 0; e < 8; ++e) { o[8 * j + e] -= mean; q += o[8 * j + e] * o[8 * j + e]; }
#pragma unroll
            for (int m = 1; m < 8; m <<= 1) q += __shfl_xor(q, m);
            const float rs = 1.0f / sqrtf(q * (1.0f / 64.0f) + 64e-5f);
#pragma unroll
            for (int e = 0; e < 8; ++e) { const int x = 8 * j + e; o[x] = (o[x] * rs * lg[x] + lb[x] + bn * v[x]) * g[x]; } }
        strow_bf16(A5 + (size_t)t * 1024, lane, o);
    }
}

__device__ __forceinline__ void zero_y_phase(Frame& F, const Args& a) {
    u32x4* y = (u32x4*)(a.ws + WS_MX5); const u32x4 z = {0u, 0u, 0u, 0u};
    for (size_t i = (size_t)blockIdx.x * NTHREADS + F.tid; i < (size_t)NTOK * D / 8; i += (size_t)gridDim.x * NTHREADS) y[i] = z;
}

__device__ __forceinline__ Frame mk_frame(const Args& a, unsigned char* lds_raw) {
    Frame F; int tid = threadIdx.x; asm volatile("" : "+v"(tid));
    F.lds = (LAS unsigned char*)lds_raw; F.misc = (volatile LAS unsigned*)(F.lds + LDS_MISC);
    F.tid = tid; F.lane = tid & 63; F.wave = __builtin_amdgcn_readfirstlane(tid >> 6);
    F.ws = a.ws; F.ctl = (unsigned*)(a.ws + WS_CTL);
    F.gw = blockIdx.x * NWAVES + F.wave; F.ngw = gridDim.x * NWAVES; F.tacc = 0;
    return F;
}
__global__ void __launch_bounds__(NTHREADS, 2) fwd_kernel(Args a) {
    extern __shared__ __attribute__((aligned(16))) unsigned char lds_raw[];
    if (threadIdx.x < 64) ((volatile LAS unsigned*)((LAS unsigned char*)lds_raw + LDS_MISC))[threadIdx.x] = 0u;
    __syncthreads();
    (void)xcd_barrier_post((unsigned*)(a.ws + WS_CTL) + CW_BAR, (volatile LAS unsigned*)((LAS unsigned char*)lds_raw + LDS_MISC) + 8);
    int phase = 0;
    unsigned long long pacc = 0; bool pmark = false, pmarkd = false; unsigned long long tstart_ = 0; if (TPROBE) tstart_ = __builtin_amdgcn_s_memrealtime();
#define PMARK(g) do { if (TPROBE) pmark = ((TPROBE >> (g)) & 1) != 0; } while (0)
#define PDUR(g) do { if (TPROBE) pmarkd = ((TPROBE >> (g)) & 1) != 0; } while (0)
#define PHASE(body) do { if (phase >= a.ph_lo && phase < a.ph_hi) { unsigned long long tp0_ = 0; if (TPROBE) tp0_ = __builtin_amdgcn_s_memrealtime(); { Frame F = mk_frame(a, lds_raw); body; if (TPROBE & (1 << 29)) pacc += F.tacc; } \
        unsigned long long t0_ = 0; if (TPROBE) t0_ = __builtin_amdgcn_s_memrealtime(); \
        if (phase + 1 < a.ph_hi) { XcdBarrier bar; bar.bar = (unsigned*)(a.ws + WS_CTL) + CW_BAR; bar.x = xb_xcc_id(); bar.st = (volatile LAS unsigned*)((LAS unsigned char*)lds_raw + LDS_MISC) + 8; xcd_barrier(bar); } \
        if (TPROBE) { if (pmark) pacc += __builtin_amdgcn_s_memrealtime() - t0_; pmark = false; if (pmarkd) pacc += __builtin_amdgcn_s_memrealtime() - tp0_; pmarkd = false; if ((TPROBE & (1 << 28)) && phase == 2) pacc += __builtin_amdgcn_s_memrealtime() - tstart_; } } ++phase; } while (0)

#define PHASED(bit, body) do { PHASE(body); if (DUP & (bit)) PHASE(body); } while (0)
    PHASED(1, p0_phase(F, a));
    PHASE(p1a_phase(F, a));
    PHASE(p1b_phase(F, a));

#define MOE_LAYER(L) do { \
    if (EN_MOE) { PHASE({ PMARK(7); PDUR(8); moe_route_phase<L>(F, a); if (L < 3) bg_slot<(L == 0 ? EV_ROUTE0 : L == 1 ? EV_ROUTE1 : EV_ROUTE2)>(F, a); }); if (DUP & (1 << 20)) PHASE((moe_route_phase<L, true>(F, a))); PHASE({ PDUR(9); moe_dispatch_phase<L>(F, a); }); if (DUP & (1 << 26)) PHASE((moe_dispatch_phase<L, true>(F, a))); PHASED(2, { PDUR(10); moe_gateup_phase<L>(F, a); }); PHASE((moe_down_phase<L, 4>(F, a))); if (DUP & 4) PHASE({ PDUR(11); (moe_down_phase<L, DOWN_PROBE_MODE>(F, a)); }); } \
    PHASE({ PDUR(12); (ln_phase<L, 1>(F, a)); }); if (DUP & (1 << 21)) PHASE((ln_phase<L, 1, true>(F, a))); } while (0)

    if (EN_LRU) {
        PHASED(65536, { PMARK(0); lru_in_gemm_phase(F, a); bg_slot<EV_LRU_IN>(F, a); });
        PHASED(131072, { PMARK(2); lru_scan_phase<true>(F, a); bg_slot<EV_S1>(F, a); });
        PHASED(1 << 24, { PDUR(14); lru_carry_phase(F, a); bg_slot<EV_CARRY>(F, a); });
        PHASED(131072, { PMARK(2); lru_scan_phase<false>(F, a); bg_slot<EV_S3>(F, a); });
        PHASED(1 << 25, { PMARK(0); dense_gemm_bf16(F, (const bf16_t*)(a.ws + WS_MX2), (const bf16_t*)(a.ws + WS_W_LRU_OUT), (bf16_t*)(a.ws + WS_MX5), NTOK, 1024, 1024); bg_slot<EV_LRU_OUT>(F, a); });
    } else PHASE(zero_y_phase(F, a));
    PHASE({ bg_catch<EV_C0>(F, a); (ln_phase<0, 0>(F, a)); }); if (DUP & (1 << 22)) PHASE((ln_phase<0, 0, true>(F, a)));
    MOE_LAYER(0);
    if (EN_RWKV) {
        PHASED(64, rwkv_xm_phase(F, a));
        PHASED(128, { rwkv_in_gemm_phase(F, a); bg_slot<EV_RW_IN>(F, a); });
        PHASED(256, { rwkv_l2_gemm_phase(F, a); bg_slot<EV_RW_L2>(F, a); });
#if !RWKV_CHUNKED
        PHASED(8, rwkv_rec_phase(F, a));
#endif
#if RWKV_CHUNKED
        PHASED(16, { PMARK(3); rwkv_chunk_phase(F, a); bg_slot<EV_RW_CHUNK>(F, a); });
#else
        PHASED(16, rwkv_scan_phase<0>(F, a));
#endif
        PHASED(1 << 24, { PDUR(13); rwkv_prefix_phase(F, a); bg_slot<EV_RW_PREFIX>(F, a); });
        PHASE({ PDUR(17); rwkv_corr_phase(F, a); });
        PHASED(1 << 23, rwkv_readout_phase(F, a));
        PHASED(1 << 25, { PMARK(0); dense_gemm_bf16(F, (const bf16_t*)(a.ws + RW_A5), (const bf16_t*)(a.ws + WS_W_RWKV_OUT), (bf16_t*)(a.ws + WS_MX5), NTOK, 1024, 1024); bg_slot<EV_RW_OUT>(F, a); });
    } else PHASE(zero_y_phase(F, a));
    PHASE({ bg_catch<EV_C1>(F, a); (ln_phase<1, 0>(F, a)); }); if (DUP & (1 << 22)) PHASE((ln_phase<1, 0, true>(F, a)));
    MOE_LAYER(1);
    if (EN_RET) {
        PHASED(4096, { PMARK(0); ret_in_gemm_phase(F, a); bg_slot<EV_RET_IN>(F, a); });
        PHASED(8192, { ret_p_phase(F, a); ret_transpose_phase(F, a); bg_slot<EV_RET_P>(F, a); });
        PHASED(16384, { ret_kv_phase(F, a); bg_slot<EV_RET_KV>(F, a); });
        PHASE({ PDUR(16); ret_prefix_phase<false>(F, a); }); if (DUP & (1 << 27)) PHASE(ret_prefix_phase<true>(F, a));
        PHASED(32768, { PMARK(6); ret_o_phase(F, a); bg_slot<EV_RET_O>(F, a); });
        PHASED(1 << 23, ret_readout_phase(F, a));
        PHASED(1 << 25, { PMARK(1); dense_gemm_bf16(F, (const bf16_t*)(a.ws + RT_A3), (const bf16_t*)(a.ws + WS_W_RET_OUT), (bf16_t*)(a.ws + WS_MX5), NTOK, 1024, 2048); bg_slot<EV_RET_OUT>(F, a); });
    } else PHASE(zero_y_phase(F, a));
    PHASE({ bg_catch<EV_C2>(F, a); (ln_phase<2, 0>(F, a)); }); if (DUP & (1 << 22)) PHASE((ln_phase<2, 0, true>(F, a)));
    MOE_LAYER(2);
    if (EN_HGRN) {
        PHASED(2048, { PMARK(0); hgrn_in_gemm_phase(F, a); bg_slot<EV_HG_IN>(F, a); });
        PHASED(512, { PMARK(4); hgrn_chunk_phase<0>(F, a); bg_slot<EV_HG_C0>(F, a); });
        PHASE({ PDUR(15); hgrn_prefix_phase<false>(F, a); bg_slot<EV_HG_PREFIX>(F, a); }); if (DUP & (1 << 27)) PHASE(hgrn_prefix_phase<true>(F, a));
        PHASED(1024, { PMARK(5); hgrn_chunk_phase<1>(F, a); bg_slot<EV_HG_C1>(F, a); });
        PHASED(1 << 23, hgrn_readout_phase(F, a));
        PHASED(1 << 25, dense_gemm_bf16(F, (const bf16_t*)(a.ws + HG_A4) + (size_t)NCTX * 1024, (const bf16_t*)(a.ws + WS_W_HGRN_OUT), (bf16_t*)(a.ws + WS_MX5) + (size_t)NCTX * 1024, SEQ, 1024, 1024));
    } else PHASE(zero_y_phase(F, a));
    PHASE({ bg_catch<EV_C3>(F, a); (ln_phase<3, 0>(F, a)); }); if (DUP & (1 << 22)) PHASE((ln_phase<3, 0, true>(F, a)));
    MOE_LAYER(3);
    if (TPROBE) { if (blockIdx.x == 200 && threadIdx.x == 0) { const unsigned long long ts = __builtin_amdgcn_s_memrealtime(); while (__builtin_amdgcn_s_memrealtime() - ts < pacc * 20ull) __builtin_amdgcn_s_sleep(8); } }
}

extern "C" void kernel_launch(void* const* d_in, const int* in_sizes, int n_in, void* d_out, int out_size, void* d_ws, size_t ws_size, hipStream_t stream) {
    static int grid = 0;
    if (grid == 0) {
        if (n_in != 47 || out_size != SEQ * D || ws_size < WS_END) { fprintf(stderr, "kernel_launch: unexpected shapes (n_in %d out %d ws %zu need %zu)\n", n_in, out_size, ws_size, (size_t)WS_END); grid = -1; return; }
        int dev = 0, cus = 0, per_cu = 0;
        (void)hipGetDevice(&dev); (void)hipDeviceGetAttribute(&cus, hipDeviceAttributeMultiprocessorCount, dev);
        if (hipFuncSetAttribute((const void*)fwd_kernel, hipFuncAttributeMaxDynamicSharedMemorySize, LDS_BYTES) != hipSuccess) { fprintf(stderr, "kernel_launch: hipFuncSetAttribute failed\n"); grid = -1; return; }
        (void)hipOccupancyMaxActiveBlocksPerMultiprocessor(&per_cu, (const void*)fwd_kernel, NTHREADS, LDS_BYTES);
        (void)hipGetLastError();
        if (per_cu < 1) fprintf(stderr, "kernel_launch: occupancy query says %d blocks per CU\n", per_cu);
        grid = cus;
    }
    if (grid < 0) return;
    (void)hipMemsetAsync((char*)d_ws + WS_CTL, 0, CTL_BYTES, stream);
    Args a; memset(&a, 0, sizeof(a));
    for (int i = 0; i < 47; ++i) a.in[i] = (const float*)d_in[i];
    a.out = (float*)d_out; a.ws = (unsigned char*)d_ws; a.ph_lo = 0; a.ph_hi = 1000;
    hipLaunchKernelGGL(fwd_kernel, dim3(grid), dim3(NTHREADS), LDS_BYTES, stream, a);
}
```
